# Optimizing an MI355X kernel written in HIP

```python
import math
import jax, jax.numpy as jnp
from jax import lax
import numpy as np

D_MODEL = 2048
BATCH = 8
SEQ = 4096
DEPTH = 2

N_HEADS_TOTAL = 16
HEAD_DIM = D_MODEL // N_HEADS_TOTAL
SWA_HEADS = 6
SWA_KV_HEADS = 2
SWA_GROUP = SWA_HEADS // SWA_KV_HEADS
WINDOW = 128
MOBA_HEADS = 4
MOBA_BLOCK = 256
MOBA_TOPK = 3
MOBA_Q_CHUNK = 64
DIFF_HEADS = 6
DIFF_QK_DIM = HEAD_DIM // 2
DIFF_V_DIM = HEAD_DIM
DIFF_Q_BLOCK = 128
MIX_WIDTH = (SWA_HEADS + MOBA_HEADS) * HEAD_DIM + DIFF_HEADS * DIFF_V_DIM
IN_SPLITS = (SWA_HEADS * HEAD_DIM, SWA_KV_HEADS * HEAD_DIM, SWA_KV_HEADS * HEAD_DIM,
             MOBA_HEADS * HEAD_DIM, MOBA_HEADS * HEAD_DIM, MOBA_HEADS * HEAD_DIM,
             DIFF_HEADS * 2 * DIFF_QK_DIM, DIFF_HEADS * 2 * DIFF_QK_DIM, DIFF_HEADS * DIFF_V_DIM)
IN_WIDTH = sum(IN_SPLITS)
IN_OFFSETS = tuple(int(o) for o in np.cumsum(IN_SPLITS)[:-1])
REL_BUCKETS = 32
REL_EXACT = REL_BUCKETS // 2
REL_MAX_DIST = 128
N_GROUPS = 4
EXPERTS_PER_GROUP = 8
N_EXPERTS = N_GROUPS * EXPERTS_PER_GROUP
TOP_E = 2
D_EXPERT = 512
MOE_BLOCK = 256
PLE_DIM = 256
EPS = 1e-6
NEG = -1e30

kernel_name = 'hymba_style_hybrid_swa_moba_diff_hmoe'


def rms_norm(x, g):
    xf = x.astype(jnp.float32)
    y = xf * lax.rsqrt(jnp.mean(xf * xf, axis=-1, keepdims=True) + EPS)
    return (y * g.astype(jnp.float32)).astype(x.dtype)


def rel_bucket(dist):
    n = jnp.maximum(dist, 0)
    is_small = n < REL_EXACT
    nf = jnp.maximum(n, 1).astype(jnp.float32)
    large = REL_EXACT + (jnp.log(nf / REL_EXACT) / math.log(REL_MAX_DIST / REL_EXACT)
                         * (REL_BUCKETS - REL_EXACT)).astype(jnp.int32)
    large = jnp.minimum(large, REL_BUCKETS - 1)
    return jnp.where(is_small, n, large)


def swa_sink_attention(q, k, v, bias_tab, sinks):
    b, s = q.shape[:2]
    nw = s // WINDOW
    qb = q.reshape(b, nw, WINDOW, SWA_KV_HEADS, SWA_GROUP, HEAD_DIM)
    kb = k.reshape(b, nw, WINDOW, SWA_KV_HEADS, HEAD_DIM)
    vb = v.reshape(b, nw, WINDOW, SWA_KV_HEADS, HEAD_DIM)
    pad = jnp.zeros_like(kb[:, :1])
    kcat = jnp.concatenate([jnp.concatenate([pad, kb[:, :-1]], axis=1), kb], axis=2)
    vcat = jnp.concatenate([jnp.concatenate([pad, vb[:, :-1]], axis=1), vb], axis=2)
    logits = jnp.einsum('bnqkgd,bnpkd->bkgnqp', qb, kcat).astype(jnp.float32) * (HEAD_DIM ** -0.5)
    qi = jnp.arange(WINDOW)[:, None]
    pj = jnp.arange(2 * WINDOW)[None, :]
    dist = qi + WINDOW - pj
    bias = bias_tab[rel_bucket(dist)].astype(jnp.float32)
    bias = bias.reshape(WINDOW, 2 * WINDOW, SWA_KV_HEADS, SWA_GROUP).transpose(2, 3, 0, 1)[None, :, :, None]
    in_window = (dist >= 0) & (dist < WINDOW)
    key_exists = (jnp.arange(nw)[:, None, None] > 0) | (pj >= WINDOW)[None]
    mask = in_window[None] & key_exists
    logits = jnp.where(mask, logits + bias, NEG)
    sink = sinks.astype(jnp.float32).reshape(SWA_KV_HEADS, SWA_GROUP)[None, :, :, None, None, None]
    sink = jnp.broadcast_to(sink, logits.shape[:-1] + (1,))
    probs = jax.nn.softmax(jnp.concatenate([logits, sink], axis=-1), axis=-1)[..., :-1]
    out = jnp.einsum('bkgnqp,bnpkd->bnqkgd', probs.astype(v.dtype), vcat)
    return out.reshape(b, s, SWA_HEADS * HEAD_DIM)


def moba_attention(q, k, v, bias_tab):
    b, s = q.shape[:2]
    nb = -(-s // MOBA_BLOCK)
    s_pad = nb * MOBA_BLOCK
    padw = ((0, 0), (0, s_pad - s), (0, 0), (0, 0))
    kb = jnp.pad(k, padw).reshape(b, nb, MOBA_BLOCK, MOBA_HEADS, HEAD_DIM).transpose(0, 3, 1, 2, 4)
    vb = jnp.pad(v, padw).reshape(b, nb, MOBA_BLOCK, MOBA_HEADS, HEAD_DIM).transpose(0, 3, 1, 2, 4)
    kmean = jnp.mean(kb.astype(jnp.float32), axis=3)
    topk = min(MOBA_TOPK, nb)
    nc = s // MOBA_Q_CHUNK
    qc = q.reshape(b, nc, MOBA_Q_CHUNK, MOBA_HEADS, HEAD_DIM).transpose(1, 0, 2, 3, 4)
    bi = jnp.arange(b)[:, None, None, None]
    hi = jnp.arange(MOBA_HEADS)[None, None, :, None]
    offs = jnp.arange(MOBA_BLOCK)
    scale = HEAD_DIM ** -0.5

    def chunk(args):
        qblk, c = args
        qpos = c * MOBA_Q_CHUNK + jnp.arange(MOBA_Q_CHUNK)
        j = (c * MOBA_Q_CHUNK) // MOBA_BLOCK
        gate = jnp.einsum('bqhd,bhnd->bqhn', qblk.astype(jnp.float32), kmean)
        gate = jnp.where(jnp.arange(nb) < j, gate, -jnp.inf)
        _, idx = lax.top_k(gate, topk)
        valid = jnp.arange(topk) < j
        kg = kb[bi, hi, idx]
        vg = vb[bi, hi, idx]
        l_sel = jnp.einsum('bqhd,bqhtsd->bqhts', qblk, kg).astype(jnp.float32) * scale
        kpos_sel = idx[..., None] * MOBA_BLOCK + offs
        dist_sel = qpos[None, :, None, None, None] - kpos_sel
        bias_sel = bias_tab[rel_bucket(dist_sel), hi[..., None]].astype(jnp.float32)
        l_sel = jnp.where(valid[:, None], l_sel + bias_sel, NEG)
        kown = lax.dynamic_index_in_dim(kb, j, axis=2, keepdims=False)
        vown = lax.dynamic_index_in_dim(vb, j, axis=2, keepdims=False)
        l_own = jnp.einsum('bqhd,bhsd->bqhs', qblk, kown).astype(jnp.float32) * scale
        dist_own = qpos[:, None] - (j * MOBA_BLOCK + offs)[None, :]
        bias_own = bias_tab[rel_bucket(dist_own)].astype(jnp.float32).transpose(0, 2, 1)[None]
        l_own = jnp.where((dist_own >= 0)[None, :, None, :], l_own + bias_own, NEG)
        logits = jnp.concatenate([l_sel.reshape(b, MOBA_Q_CHUNK, MOBA_HEADS, topk * MOBA_BLOCK), l_own], axis=-1)
        probs = jax.nn.softmax(logits, axis=-1).astype(v.dtype)
        p_sel = probs[..., :topk * MOBA_BLOCK].reshape(b, MOBA_Q_CHUNK, MOBA_HEADS, topk, MOBA_BLOCK)
        p_own = probs[..., topk * MOBA_BLOCK:]
        return (jnp.einsum('bqhts,bqhtsd->bqhd', p_sel, vg)
                + jnp.einsum('bqhs,bhsd->bqhd', p_own, vown))

    out = lax.map(chunk, (qc, jnp.arange(nc)))
    return out.transpose(1, 0, 2, 3, 4).reshape(b, s, MOBA_HEADS * HEAD_DIM)


def diff_attention(q, k, v, bias_tab, lam, sub_g, lambda_init):
    b, s = q.shape[:2]
    nq = s // DIFF_Q_BLOCK
    qblocks = q.reshape(b, nq, DIFF_Q_BLOCK, DIFF_HEADS, 2, DIFF_QK_DIM).transpose(1, 0, 2, 3, 4, 5)
    kpos = jnp.arange(s)
    scale = DIFF_QK_DIM ** -0.5

    def block(args):
        qblk, c = args
        qpos = c * DIFF_Q_BLOCK + jnp.arange(DIFF_Q_BLOCK)
        logits = jnp.einsum('bqhcd,bkhcd->bhcqk', qblk, k).astype(jnp.float32) * scale
        dist = qpos[:, None] - kpos[None, :]
        bias = bias_tab[rel_bucket(dist)].astype(jnp.float32).transpose(2, 0, 1)[None, :, None]
        logits = jnp.where(dist >= 0, logits + bias, NEG)
        probs = jax.nn.softmax(logits, axis=-1)
        attn = probs[:, :, 0] - lam * probs[:, :, 1]
        return jnp.einsum('bhqk,bkhe->bqhe', attn.astype(v.dtype), v)

    out = lax.map(block, (qblocks, jnp.arange(nq)))
    out = out.transpose(1, 0, 2, 3, 4).reshape(b, s, DIFF_HEADS, DIFF_V_DIM)
    out = rms_norm(out, sub_g) * (1.0 - lambda_init)
    return out.reshape(b, s, DIFF_HEADS * DIFF_V_DIM)


def hier_moe(v, w_group, w_expert, w1, w3, w2):
    b, s, d = v.shape
    t = b * s
    xf = v.reshape(t, d)
    g_prob = jax.nn.softmax((xf @ w_group).astype(jnp.float32), axis=-1)
    grp = jnp.argmax(g_prob, axis=-1)
    g_w = jnp.take_along_axis(g_prob, grp[:, None], axis=1)
    e_logits = (xf @ w_expert).astype(jnp.float32).reshape(t, N_GROUPS, EXPERTS_PER_GROUP)
    e_in = jnp.take_along_axis(e_logits, grp[:, None, None], axis=1)[:, 0]
    top_l, top_i = lax.top_k(e_in, TOP_E)
    gate = g_w * jax.nn.softmax(top_l, axis=-1)
    n_assign = t * TOP_E
    eid = (grp[:, None] * EXPERTS_PER_GROUP + top_i).reshape(n_assign)
    tok = jnp.arange(n_assign) // TOP_E
    wts = gate.reshape(n_assign)
    order = jnp.argsort(eid)
    se = eid[order]
    counts = jnp.bincount(eid, length=N_EXPERTS)
    starts = jnp.cumsum(counts) - counts
    pcounts = ((counts + MOE_BLOCK - 1) // MOE_BLOCK) * MOE_BLOCK
    pends = jnp.cumsum(pcounts)
    pstarts = pends - pcounts
    dest = pstarts[se] + (jnp.arange(n_assign) - starts[se])
    p_rows = n_assign + N_EXPERTS * MOE_BLOCK
    buf_tok = jnp.zeros((p_rows,), jnp.int32).at[dest].set(tok[order].astype(jnp.int32))
    buf_w = jnp.zeros((p_rows,), jnp.float32).at[dest].set(wts[order])
    nblk = p_rows // MOE_BLOCK
    blk_e = jnp.minimum(jnp.searchsorted(pends, jnp.arange(nblk) * MOE_BLOCK, side='right'), N_EXPERTS - 1)

    def expert_block(args):
        toks, e = args
        xb = xf[toks]
        hdn = jax.nn.silu(xb @ w1[e]) * (xb @ w3[e])
        return hdn @ w2[e]

    yb = lax.map(expert_block, (buf_tok.reshape(nblk, MOE_BLOCK), blk_e))
    y = jax.ops.segment_sum(yb.reshape(p_rows, d) * buf_w[:, None].astype(yb.dtype), buf_tok, num_segments=t)
    return y.reshape(b, s, d)


def setup_inputs(seed: int = 0) -> dict:
    key = jax.random.key(seed)
    ks = jax.random.split(key, 24)

    def nrm(k, shape, scale):
        return jax.random.normal(k, shape, jnp.float32) * scale

    return {
        'x': nrm(ks[0], (BATCH, SEQ, D_MODEL), 1.0),
        'p': nrm(ks[1], (DEPTH, BATCH, SEQ, PLE_DIM), 1.0),
        'rel_bias': nrm(ks[2], (REL_BUCKETS, N_HEADS_TOTAL), 0.5),
        'g_final': 1.0 + nrm(ks[3], (D_MODEL,), 0.05),
        'g_mix': 1.0 + nrm(ks[4], (DEPTH, D_MODEL), 0.05),
        'w_in': nrm(ks[5], (DEPTH, D_MODEL, IN_WIDTH), D_MODEL ** -0.5),
        'swa_sinks': nrm(ks[6], (DEPTH, SWA_HEADS), 0.5),
        'lam_q1': nrm(ks[7], (DEPTH, DIFF_QK_DIM), 0.1),
        'lam_k1': nrm(ks[8], (DEPTH, DIFF_QK_DIM), 0.1),
        'lam_q2': nrm(ks[9], (DEPTH, DIFF_QK_DIM), 0.1),
        'lam_k2': nrm(ks[10], (DEPTH, DIFF_QK_DIM), 0.1),
        'diff_subln': 1.0 + nrm(ks[11], (DEPTH, DIFF_V_DIM), 0.05),
        'w_out': nrm(ks[12], (DEPTH, MIX_WIDTH, D_MODEL), MIX_WIDTH ** -0.5),
        'g_ffn': 1.0 + nrm(ks[13], (DEPTH, D_MODEL), 0.05),
        'w_group': nrm(ks[14], (DEPTH, D_MODEL, N_GROUPS), D_MODEL ** -0.5),
        'w_expert': nrm(ks[15], (DEPTH, D_MODEL, N_EXPERTS), D_MODEL ** -0.5),
        'w1': nrm(ks[16], (DEPTH, N_EXPERTS, D_MODEL, D_EXPERT), D_MODEL ** -0.5),
        'w3': nrm(ks[17], (DEPTH, N_EXPERTS, D_MODEL, D_EXPERT), D_MODEL ** -0.5),
        'w2': nrm(ks[18], (DEPTH, N_EXPERTS, D_EXPERT, D_MODEL), D_EXPERT ** -0.5),
        'g_ple': 1.0 + nrm(ks[19], (DEPTH, D_MODEL), 0.05),
        'w_ple_gate': nrm(ks[20], (DEPTH, D_MODEL, D_MODEL), D_MODEL ** -0.5),
        'w_ple_proj': nrm(ks[21], (DEPTH, PLE_DIM, D_MODEL), PLE_DIM ** -0.5),
    }


def reference(x, p, rel_bias, g_final, g_mix, w_in, swa_sinks, lam_q1, lam_k1, lam_q2, lam_k2,
              diff_subln, w_out, g_ffn, w_group, w_expert, w1, w3, w2, g_ple, w_ple_gate, w_ple_proj):
    b, s, _ = x.shape
    bias_a = rel_bias[:, :SWA_HEADS]
    bias_b = rel_bias[:, SWA_HEADS:SWA_HEADS + MOBA_HEADS]
    bias_c = rel_bias[:, SWA_HEADS + MOBA_HEADS:]
    h = x
    for i in range(DEPTH):
        u = rms_norm(h, g_mix[i])
        proj = u @ w_in[i]
        qa, ka, va, qb, kb, vb, qc, kc, vc = jnp.split(proj, IN_OFFSETS, axis=-1)
        ya = swa_sink_attention(qa.reshape(b, s, SWA_HEADS, HEAD_DIM),
                                ka.reshape(b, s, SWA_KV_HEADS, HEAD_DIM),
                                va.reshape(b, s, SWA_KV_HEADS, HEAD_DIM), bias_a, swa_sinks[i])
        yb = moba_attention(qb.reshape(b, s, MOBA_HEADS, HEAD_DIM),
                            kb.reshape(b, s, MOBA_HEADS, HEAD_DIM),
                            vb.reshape(b, s, MOBA_HEADS, HEAD_DIM), bias_b)
        lambda_init = 0.8 - 0.6 * math.exp(-0.3 * i)
        lam = (jnp.exp(jnp.sum(lam_q1[i].astype(jnp.float32) * lam_k1[i].astype(jnp.float32)))
               - jnp.exp(jnp.sum(lam_q2[i].astype(jnp.float32) * lam_k2[i].astype(jnp.float32)))
               + lambda_init)
        yc = diff_attention(qc.reshape(b, s, DIFF_HEADS, 2, DIFF_QK_DIM),
                            kc.reshape(b, s, DIFF_HEADS, 2, DIFF_QK_DIM),
                            vc.reshape(b, s, DIFF_HEADS, DIFF_V_DIM), bias_c, lam, diff_subln[i], lambda_init)
        h = h + jnp.concatenate([ya, yb, yc], axis=-1) @ w_out[i]
        h = h + hier_moe(rms_norm(h, g_ffn[i]), w_group[i], w_expert[i], w1[i], w3[i], w2[i])
        h = h + jax.nn.sigmoid(rms_norm(h, g_ple[i]) @ w_ple_gate[i]) * (p[i] @ w_ple_proj[i])
    return rms_norm(h, g_final)
```

```cpp
#include <hip/hip_runtime.h>
#include <hip/hip_bf16.h>
#include <cstdio>
#include <cstdint>
#include <cmath>
#ifndef MK_PER_PHASE
#define MK_PER_PHASE 0
#endif
#ifndef MK_NAIVE_ATTN
#define MK_NAIVE_ATTN 0
#endif
#ifndef MK_NAIVE_MOE
#define MK_NAIVE_MOE 0
#endif
namespace pg8 {
#define PG8_LAS __attribute__((address_space(3)))
typedef unsigned short bf16_t;
typedef short bf16x8 __attribute__((ext_vector_type(8)));
typedef float f32x4 __attribute__((ext_vector_type(4)));
typedef unsigned u32x4 __attribute__((ext_vector_type(4)));
constexpr int BM = 256, BK = 64, HALF = 128, HTB = HALF * BK * 2  , STAGE_BYTES = 8 * HTB, NXCD = 8, WGM = 8;

__host__ __device__ __forceinline__ int lds_byte(int r, int c) { const int st = (r >> 4) * 2 + (c >> 5), rr = r & 15, cc = c & 31, ob = rr * 64 + cc * 2; return st * 1024 + (ob ^ (((ob >> 9) & 1) << 5)); }
__host__ __device__ __forceinline__ void stage_rc(int b, int& R, int& C) { const int st = b / 1024, sb = b % 1024, swz = sb ^ (((sb >> 9) & 1) << 5); R = (st >> 1) * 16 + swz / 64; C = (st & 1) * 32 + (swz % 64) / 2; }
__host__ __device__ __forceinline__ int perm32(int rho) { const int n = rho >> 4, i = rho & 15; return 8 * (i >> 2) + 4 * n + (i & 3); }

struct Unit { int pm, pn; };
struct Gemm { const bf16_t* A; const bf16_t* Bt; int M, N, K; };

struct StaticOrder {
    int nM, nN, nwg, G, c;
    __host__ __device__ void init(int M, int N, int G_, int c_) { nM = M / BM; nN = N / BM; nwg = nM * nN; G = G_; c = c_; }
    __host__ __device__ bool next(int i, Unit& u) const {
        const long L = (long)i * G + c; if (L >= nwg) return false;
        int wgid = (int)L; { const int q = nwg / NXCD, r = nwg % NXCD, xcd = wgid % NXCD, off = wgid / NXCD; wgid = (xcd < r ? xcd * (q + 1) : r * (q + 1) + (xcd - r) * q) + off; }
        const int nig = WGM * nN, gid = wgid / nig, fm = gid * WGM, gsz = (nM - fm) < WGM ? (nM - fm) : WGM;
        u.pm = fm + ((wgid % nig) % gsz); u.pn = (wgid % nig) / gsz; return true;
    }
    __device__ __forceinline__ void a_ready(const Unit&) const {}
    __device__ __forceinline__ void done(const Unit&) const {}
};

__device__ __forceinline__ unsigned cvt_pk_bf16(float lo, float hi) { unsigned r; asm volatile("v_cvt_pk_bf16_f32 %0, %1, %2" : "=v"(r) : "v"(lo), "v"(hi)); return r; }
typedef float f32x2 __attribute__((ext_vector_type(2)));
template <int ACT  > struct EpiBf16 {
    static constexpr bool PERM = true, AFTER_DRAIN = false; static_assert(ACT == 0 || ACT == 1, "EpiBf16: ACT is 0 (none) or 1 (gelu_pk)");
    bf16_t* O; int ldc; const float* bias; int split_cols; size_t split_stride; float scale0;
    __device__ __forceinline__ void operator()(const f32x4 (&acc)[2][2][4][2], const Unit& u, int wr, int wc, int fr, int fq) const {
        const int row0 = u.pm * BM + wr * 64 + fr; int colt = u.pn * BM; bf16_t* base = O;
        float sc = 1.f; if (split_cols) { const int t = colt / split_cols; base += (size_t)t * split_stride; colt -= t * split_cols; if (t == 0) sc = scale0; }
        const int col0 = colt + wc * 32 + 8 * fq, bcol0 = u.pn * BM + wc * 32 + 8 * fq;
        f32x4 bv[2][2];
#pragma unroll
        for (int bj = 0; bj < 2; ++bj)
#pragma unroll
            for (int n = 0; n < 2; ++n) bv[bj][n] = bias ? *(const f32x4*)(bias + bcol0 + bj * HALF + 4 * n) : (f32x4){0.f, 0.f, 0.f, 0.f};
#pragma unroll
        for (int ai = 0; ai < 2; ++ai)
#pragma unroll
            for (int m = 0; m < 4; ++m) { bf16_t* rowp = base + (size_t)(row0 + ai * HALF + m * 16) * ldc + col0;
#pragma unroll
                for (int bj = 0; bj < 2; ++bj) { f32x4 v0 = acc[ai][bj][m][0] + bv[bj][0], v1 = acc[ai][bj][m][1] + bv[bj][1];
                    v0 = v0 * sc; v1 = v1 * sc; u32x4 w; w.x = cvt_pk_bf16(v0[0], v0[1]); w.y = cvt_pk_bf16(v0[2], v0[3]); w.z = cvt_pk_bf16(v1[0], v1[1]); w.w = cvt_pk_bf16(v1[2], v1[3]);
                    *(u32x4*)(rowp + bj * HALF) = w; } }
    }
};

struct EpiResF32 {
    static constexpr bool PERM = false, AFTER_DRAIN = false;
    const float* base; float* out; int ldc;
    __device__ __forceinline__ void operator()(const f32x4 (&acc)[2][2][4][2], const Unit& u, int wr, int wc, int fr, int fq) const {
        const int row0 = u.pm * BM + wr * 64 + fr, col0 = u.pn * BM + wc * 32 + 4 * fq;
#pragma unroll
        for (int ai = 0; ai < 2; ++ai)
#pragma unroll
            for (int m = 0; m < 4; ++m) { const size_t off = (size_t)(row0 + ai * HALF + m * 16) * ldc + col0;
#pragma unroll
                for (int bj = 0; bj < 2; ++bj)
#pragma unroll
                    for (int n = 0; n < 2; ++n) { const f32x4 b = *(const f32x4*)(base + off + bj * HALF + n * 16); *(f32x4*)(out + off + bj * HALF + n * 16) = b + acc[ai][bj][m][n]; }
                if (m & 1) asm volatile("" ::: "memory"); }
    }
};
__device__ __forceinline__ float sigmoidf_(float a) { return __builtin_amdgcn_rcpf(1.0f + __builtin_amdgcn_exp2f(-1.4426950408889634f * a)); }
struct EpiSiluMul {
    static constexpr bool PERM = true, AFTER_DRAIN = false;
    bf16_t* O; int ldc;
    __device__ __forceinline__ void operator()(const f32x4 (&acc)[2][2][4][2], const Unit& u, int wr, int wc, int fr, int fq) const {
        const int row0 = u.pm * BM + wr * 64 + fr, col0 = (u.pn & 3) * HALF + wc * 32 + 8 * fq;
#pragma unroll
        for (int ai = 0; ai < 2; ++ai)
#pragma unroll
            for (int m = 0; m < 4; ++m) { bf16_t* rowp = O + (size_t)(row0 + ai * HALF + m * 16) * ldc + col0;
                f32x4 v0, v1;
#pragma unroll
                for (int i = 0; i < 4; ++i) { const float a0 = acc[ai][0][m][0][i], a1 = acc[ai][0][m][1][i];
                    v0[i] = a0 * sigmoidf_(a0) * acc[ai][1][m][0][i]; v1[i] = a1 * sigmoidf_(a1) * acc[ai][1][m][1][i]; }
                u32x4 w; w.x = cvt_pk_bf16(v0[0], v0[1]); w.y = cvt_pk_bf16(v0[2], v0[3]); w.z = cvt_pk_bf16(v1[0], v1[1]); w.w = cvt_pk_bf16(v1[2], v1[3]);
                *(u32x4*)rowp = w; }
    }
};
struct EpiGate {
    static constexpr bool PERM = false, AFTER_DRAIN = false;
    const float* base; float* out; const bf16_t* PL; int ldc;
    __device__ __forceinline__ void operator()(const f32x4 (&acc)[2][2][4][2], const Unit& u, int wr, int wc, int fr, int fq) const {
        typedef unsigned u32x2 __attribute__((ext_vector_type(2)));
        const int row0 = u.pm * BM + wr * 64 + fr, col0 = u.pn * BM + wc * 32 + 4 * fq;
#pragma unroll
        for (int ai = 0; ai < 2; ++ai)
#pragma unroll
            for (int m = 0; m < 4; ++m) { const size_t off = (size_t)(row0 + ai * HALF + m * 16) * ldc + col0;
#pragma unroll
                for (int bj = 0; bj < 2; ++bj)
#pragma unroll
                    for (int n = 0; n < 2; ++n) { const size_t p = off + bj * HALF + n * 16;
                        const f32x4 b = *(const f32x4*)(base + p); const u32x2 q = *(const u32x2*)(PL + p); const f32x4 a = acc[ai][bj][m][n];
                        f32x4 pl; pl[0] = __uint_as_float(q.x << 16); pl[1] = __uint_as_float(q.x & 0xffff0000u); pl[2] = __uint_as_float(q.y << 16); pl[3] = __uint_as_float(q.y & 0xffff0000u);
                        f32x4 o;
#pragma unroll
                        for (int i = 0; i < 4; ++i) o[i] = b[i] + sigmoidf_(a[i]) * pl[i];
                        *(f32x4*)(out + p) = o; }
                if (m & 1) asm volatile("" ::: "memory"); }
    }
};
struct GroupedOrder {
    const PG8_LAS unsigned char* tile_e; int nTiles, nN, G, c;
    __device__ __forceinline__ bool next(int i, Unit& u) const {
        const long L = (long)i * G + c; if (L >= (long)nTiles * nN) return false;
        const int pm = (int)(L / nN), j = (int)(L % nN); const int e = __builtin_amdgcn_readfirstlane((int)tile_e[pm]);
        u.pm = pm; u.pn = e * nN + j; return true;
    }
    __device__ __forceinline__ void a_ready(const Unit&) const {}
    __device__ __forceinline__ void done(const Unit&) const {}
};
template <class Epi, class Sched, bool ALIGN_EPI = false, bool SP2 = false>
__device__ __forceinline__ void gemm_phase(PG8_LAS unsigned char* lds, const Gemm g, const Sched& S, const Epi& E) {
    int tid_o = threadIdx.x; asm volatile("" : "+v"(tid_o));
    const int tid = tid_o, wid = __builtin_amdgcn_readfirstlane(tid >> 6), lane = tid & 63, wr = wid >> 2, wc = wid & 3, fr = lane & 15, fq = lane >> 4;
    const int K = g.K, nt = K / BK;
    unsigned voffA[2], voffB[2];
#pragma unroll
    for (int i = 0; i < 2; ++i) { int R, C; stage_rc(tid * 16 + i * 8192, R, C); const int Rb = Epi::PERM ? ((R & ~31) + perm32(R & 31)) : R;
        voffA[i] = (unsigned)(R * K + C) * 2u; voffB[i] = (unsigned)(Rb * K + C) * 2u; }
    const size_t kstep = (size_t)(BK * 2);
    const size_t hstep = (size_t)HALF * K * 2;
    const size_t tstep = 2 * hstep;
    const unsigned ldsw = (unsigned)wid * 1024u;
    const int aoff = lds_byte(wr * 64 + fr, fq * 8), boff = lds_byte(wc * 32 + fr, fq * 8);
#define PG8_SA(b, h) (((b) * 2 + (h)) * HTB)
#define PG8_SB(b, h) ((4 + (b) * 2 + (h)) * HTB)
#define PG8_STAGE(bufoff, gbase, voff) do { _Pragma("unroll") for (int _i = 0; _i < 2; ++_i) \
        __builtin_amdgcn_global_load_lds((const unsigned*)((const char*)(gbase) + (voff)[_i]), (PG8_LAS unsigned*)(lds + (bufoff) + ldsw + _i * 8192), 16, 0, 0); } while (0)
#define PG8_LDA(dst, b, h) do { _Pragma("unroll") for (int m = 0; m < 4; ++m) _Pragma("unroll") for (int k = 0; k < 2; ++k) dst[m][k] = *(const PG8_LAS bf16x8*)(lds + PG8_SA(b, h) + aoff + m * 2048 + k * 1024); } while (0)
#define PG8_LDB(dst, b, h) do { _Pragma("unroll") for (int n = 0; n < 2; ++n) _Pragma("unroll") for (int k = 0; k < 2; ++k) dst[n][k] = *(const PG8_LAS bf16x8*)(lds + PG8_SB(b, h) + boff + n * 2048 + k * 1024); } while (0)
#define PG8_MMA(ai, bj, At, Bt) do { __builtin_amdgcn_s_setprio(1); _Pragma("unroll") for (int m = 0; m < 4; ++m) _Pragma("unroll") for (int n = 0; n < 2; ++n) _Pragma("unroll") for (int k = 0; k < 2; ++k) \
        acc[ai][bj][m][n] = __builtin_amdgcn_mfma_f32_16x16x32_bf16(Bt[n][k], At[m][k], acc[ai][bj][m][n], 0, 0, 0); __builtin_amdgcn_s_setprio(0); } while (0)
#define PG8_WAIT_V(n) asm volatile("s_waitcnt vmcnt(" #n ")" ::: "memory")
#define PG8_WAIT_L(n) asm volatile("s_waitcnt lgkmcnt(" #n ")" ::: "memory")
#define PG8_BAR __builtin_amdgcn_s_barrier()
#define PG8_SCHED __builtin_amdgcn_sched_barrier(0)
    Unit cur, nxt; int ui = 0;
    if (!S.next(0, cur)) return;
    f32x4 acc[2][2][4][2];
#pragma unroll
    for (int a = 0; a < 2; ++a)
#pragma unroll
        for (int b = 0; b < 2; ++b)
#pragma unroll
            for (int m = 0; m < 4; ++m)
#pragma unroll
                for (int n = 0; n < 2; ++n) acc[a][b][m][n] = (f32x4){0.f, 0.f, 0.f, 0.f};
    bf16x8 At[4][2], B0[2][2], B1[2][2];
    const char* cA = (const char*)g.A + (size_t)cur.pm * tstep; const char* cB = (const char*)g.Bt + (size_t)cur.pn * tstep;
    S.a_ready(cur);
    if constexpr (SP2) {
        PG8_STAGE(PG8_SB(0, 0), cB, voffB); PG8_STAGE(PG8_SB(0, 1), cB + hstep, voffB); PG8_STAGE(PG8_SA(0, 0), cA, voffA); PG8_STAGE(PG8_SA(0, 1), cA + hstep, voffA);
        if (wr == 1) PG8_BAR;
        PG8_WAIT_V(2); PG8_BAR;
        PG8_STAGE(PG8_SB(1, 0), cB + kstep, voffB); PG8_STAGE(PG8_SA(1, 0), cA + kstep, voffA); PG8_STAGE(PG8_SB(1, 1), cB + hstep + kstep, voffB);
        PG8_WAIT_V(6); PG8_BAR;
    } else {
        PG8_STAGE(PG8_SB(0, 0), cB, voffB); PG8_STAGE(PG8_SA(0, 0), cA, voffA); PG8_STAGE(PG8_SB(0, 1), cB + hstep, voffB); PG8_STAGE(PG8_SA(0, 1), cA + hstep, voffA);
        if (wr == 1) PG8_BAR;
        PG8_WAIT_V(4); PG8_BAR;
        PG8_STAGE(PG8_SB(1, 0), cB + kstep, voffB); PG8_STAGE(PG8_SA(1, 0), cA + kstep, voffA); PG8_STAGE(PG8_SB(1, 1), cB + hstep + kstep, voffB);
        PG8_WAIT_V(6); PG8_BAR;
    }
    for (;;) {
        const bool has_next = S.next(ui + 1, nxt);
        const char* nA = has_next ? (const char*)g.A + (size_t)nxt.pm * tstep : cA; const char* nB = has_next ? (const char*)g.Bt + (size_t)nxt.pn * tstep : cB;
        for (int t = 0; t < nt; t += 2) {
            const bool last = (t == nt - 2);
            const char* a1 = cA + (size_t)(t + 1) * kstep;
            const char* a2 = last ? nA : cA + (size_t)(t + 2) * kstep; const char* b2 = last ? nB : cB + (size_t)(t + 2) * kstep;
            const char* a3 = a2 + kstep; const char* b3 = b2 + kstep;
            if (last && has_next) S.a_ready(nxt);
            if constexpr (SP2) {
            PG8_LDB(B0, 0, 0); PG8_LDB(B1, 0, 1); PG8_SCHED; PG8_LDA(At, 0, 0); PG8_STAGE(PG8_SA(1, 1), a1 + hstep, voffA);
            PG8_WAIT_V(8); PG8_WAIT_L(0); PG8_BAR; PG8_MMA(0, 0, At, B0); PG8_MMA(0, 1, At, B1); PG8_BAR; PG8_SCHED;
            PG8_LDA(At, 0, 1); PG8_STAGE(PG8_SB(0, 0), b2, voffB); PG8_STAGE(PG8_SB(0, 1), b2 + hstep, voffB); PG8_STAGE(PG8_SA(0, 0), a2, voffA);
            PG8_WAIT_V(8); PG8_WAIT_L(0); PG8_BAR; PG8_MMA(1, 0, At, B0); PG8_MMA(1, 1, At, B1); PG8_BAR; PG8_SCHED;
            PG8_LDB(B0, 1, 0); PG8_LDB(B1, 1, 1); PG8_SCHED; PG8_LDA(At, 1, 0); PG8_STAGE(PG8_SA(0, 1), a2 + hstep, voffA);
            PG8_WAIT_V(8); PG8_WAIT_L(0); PG8_BAR; PG8_MMA(0, 0, At, B0); PG8_MMA(0, 1, At, B1); PG8_BAR; PG8_SCHED;
            PG8_LDA(At, 1, 1); PG8_STAGE(PG8_SB(1, 0), b3, voffB); PG8_STAGE(PG8_SB(1, 1), b3 + hstep, voffB); PG8_STAGE(PG8_SA(1, 0), a3, voffA);
            PG8_WAIT_V(8); PG8_WAIT_L(0); PG8_BAR; PG8_MMA(1, 0, At, B0); PG8_MMA(1, 1, At, B1); PG8_BAR; PG8_SCHED;
            } else {
            PG8_LDB(B0, 0, 0); PG8_SCHED; PG8_LDA(At, 0, 0); PG8_STAGE(PG8_SA(1, 1), a1 + hstep, voffA);
            PG8_WAIT_L(8); PG8_BAR; PG8_WAIT_L(0); PG8_MMA(0, 0, At, B0); PG8_BAR; PG8_SCHED;
            PG8_LDB(B1, 0, 1); PG8_STAGE(PG8_SB(0, 0), b2, voffB);
            PG8_BAR; PG8_WAIT_L(0); PG8_MMA(0, 1, At, B1); PG8_BAR;
            PG8_LDA(At, 0, 1); PG8_STAGE(PG8_SA(0, 0), a2, voffA);
            PG8_BAR; PG8_WAIT_L(0); PG8_MMA(1, 0, At, B0); PG8_BAR; PG8_SCHED;
            PG8_STAGE(PG8_SB(0, 1), b2 + hstep, voffB);
            PG8_WAIT_V(6); PG8_BAR; PG8_MMA(1, 1, At, B1); PG8_BAR;
            PG8_LDB(B0, 1, 0); PG8_SCHED; PG8_LDA(At, 1, 0); PG8_STAGE(PG8_SA(0, 1), a2 + hstep, voffA);
            PG8_WAIT_L(8); PG8_BAR; PG8_WAIT_L(0); PG8_MMA(0, 0, At, B0); PG8_BAR; PG8_SCHED;
            PG8_LDB(B1, 1, 1); PG8_STAGE(PG8_SB(1, 0), b3, voffB);
            PG8_BAR; PG8_WAIT_L(0); PG8_MMA(0, 1, At, B1); PG8_BAR;
            PG8_LDA(At, 1, 1); PG8_STAGE(PG8_SA(1, 0), a3, voffA);
            PG8_BAR; PG8_WAIT_L(0); PG8_MMA(1, 0, At, B0); PG8_BAR; PG8_SCHED;
            PG8_STAGE(PG8_SB(1, 1), b3 + hstep, voffB);
            PG8_WAIT_V(6); PG8_BAR; PG8_MMA(1, 1, At, B1); PG8_BAR;
            }
        }
        if constexpr (ALIGN_EPI) { if (wr == 0) PG8_BAR; }
        if constexpr (!Epi::AFTER_DRAIN) { E(acc, cur, wr, wc, fr, fq); S.done(cur); }
        if (!has_next) break;
#pragma unroll
        for (int a = 0; a < 2; ++a)
#pragma unroll
            for (int b = 0; b < 2; ++b)
#pragma unroll
                for (int m = 0; m < 4; ++m)
#pragma unroll
                    for (int n = 0; n < 2; ++n) acc[a][b][m][n] = (f32x4){0.f, 0.f, 0.f, 0.f};
        cur = nxt; cA = nA; cB = nB; ++ui;
        if constexpr (ALIGN_EPI) { if (wr == 1) PG8_BAR; }
    }
    PG8_WAIT_V(0);
    if constexpr (!ALIGN_EPI) { if (wr == 0) PG8_BAR; }
    PG8_BAR;
    if constexpr (Epi::AFTER_DRAIN) { E.fused(acc, cur, wr, wc, fr, fq, lds, wid, lane); S.done(cur); }
#undef PG8_SA
#undef PG8_SB
#undef PG8_STAGE
#undef PG8_LDA
#undef PG8_LDB
#undef PG8_MMA
#undef PG8_WAIT_V
#undef PG8_WAIT_L
#undef PG8_BAR
#undef PG8_SCHED
}
}

#ifndef ATT_SDEPTH
#define ATT_SDEPTH 1
#endif
namespace att {
using bf16x8 = __attribute__((ext_vector_type(8))) short;
using s16x4  = __attribute__((ext_vector_type(4))) short;
using f32x16 = __attribute__((ext_vector_type(16))) float;
using f32x4  = __attribute__((ext_vector_type(4))) float;
using u32x4  = __attribute__((ext_vector_type(4))) unsigned;
constexpr int NW = 8, QBLK = 32, KVBLK = 64, LDP = 5120, LDY = 2048, SEQL = 4096;
constexpr int SHM_V = 16384, SHM_K = 16384;
constexpr int OFF_V = 0, OFF_K = 2 * SHM_V, OFF_WS = OFF_K + 2 * SHM_K, OFF_LUT = OFF_WS + NW * 64 * 4, OFF_MISC = OFF_LUT + 512, OFF_STG = 69632, STG_PITCH = 272, STG_WAVE = 32 * STG_PITCH;
constexpr int ATT_LDS = OFF_STG + NW * STG_WAVE;
static_assert(OFF_MISC + 256 <= OFF_STG, "attention LDS map");
constexpr float LOG2E = 1.4426950408889634f, NEGB = -1e30f, THR2 = 11.5f;
#define SBAR() __builtin_amdgcn_sched_barrier(0)
__device__ __forceinline__ int crow(int r, int hi) { return (r & 3) + 8 * (r >> 2) + 4 * hi; }
__device__ __forceinline__ unsigned cvtpk(float lo, float hi) { unsigned r; asm volatile("v_cvt_pk_bf16_f32 %0, %1, %2" : "=v"(r) : "v"(lo), "v"(hi)); return r; }
__device__ __forceinline__ float bf2f(short x) { return __uint_as_float(((unsigned)(unsigned short)x) << 16); }
template <int DQK> __device__ __forceinline__ int kswz(int row, int colB) { return row * (2 * DQK) + (colB ^ ((((DQK == 128) ? row : (row >> 1)) & 7) << 4)); }

template <int MODE>
__device__ __forceinline__ void bias_mask(f32x16& p0, f32x16& p1, int kt, int qpos, int wave_qmin, int hi, float C, const float* lut, float cfar, unsigned sel, int jblk) {
  bool lane_off = false;
  if (MODE == 1) { const int blk = kt >> 8; if (blk < jblk) lane_off = !((sel >> blk) & 1u); }
  const bool nearT = (kt + 63 + 128 > wave_qmin);
  if (!nearT) {
    if (MODE == 0) {
#pragma unroll
      for (int r = 0; r < 16; ++r) { p0[r] = NEGB; p1[r] = NEGB; }
    } else {
#pragma unroll
      for (int r = 0; r < 16; ++r) { p0[r] = lane_off ? NEGB : fmaf(p0[r], C, cfar); p1[r] = lane_off ? NEGB : fmaf(p1[r], C, cfar); }
    }
  } else {
    const int kb = kt + 4 * hi;
#pragma unroll
    for (int r = 0; r < 16; ++r) {
      const int d0 = qpos - (kb + (r & 3) + 8 * (r >> 2)), d1 = d0 - 32;
      const unsigned u0 = (unsigned)d0 < 127u ? (unsigned)d0 : 127u, u1 = (unsigned)d1 < 127u ? (unsigned)d1 : 127u;
      const float b0 = lut[u0], b1 = lut[u1];
      bool ok0 = d0 >= 0, ok1 = d1 >= 0;
      if (MODE == 0) { ok0 = ok0 && d0 < 128; ok1 = ok1 && d1 < 128; }
      if (MODE == 1) { ok0 = ok0 && !lane_off; ok1 = ok1 && !lane_off; }
      p0[r] = ok0 ? fmaf(p0[r], C, b0) : NEGB; p1[r] = ok1 ? fmaf(p1[r], C, b1) : NEGB;
      if ((r & 3) == 3) SBAR();
    }
  }
}
__device__ __forceinline__ void partialSM(f32x16& p0, f32x16& p1, float& m_reg, float& alpha) {
  float pmax = p0[0];
#pragma unroll
  for (int r = 1; r < 16; ++r) pmax = fmaxf(pmax, p0[r]);
#pragma unroll
  for (int r = 0; r < 16; ++r) pmax = fmaxf(pmax, p1[r]);
  { auto rr = __builtin_amdgcn_permlane32_swap(__float_as_uint(pmax), __float_as_uint(pmax), false, false);
    pmax = fmaxf(__uint_as_float(rr[0]), __uint_as_float(rr[1])); }
  float mn;
  if (__builtin_expect(__all(pmax - m_reg <= THR2), 1)) { mn = m_reg; alpha = 1.f; }
  else { mn = fmaxf(m_reg, pmax); alpha = __builtin_amdgcn_exp2f(m_reg - mn); m_reg = mn; }
#pragma unroll
  for (int r = 0; r < 16; ++r) { p0[r] = __builtin_amdgcn_exp2f(p0[r] - mn); p1[r] = p1[r] - mn; }
}
__device__ __forceinline__ void finishSM(f32x16& p0, f32x16& p1, float alpha, float& l_reg, bf16x8& pa0, bf16x8& pa1, bf16x8& pa2, bf16x8& pa3) {
#pragma unroll
  for (int r = 0; r < 16; ++r) p1[r] = __builtin_amdgcn_exp2f(p1[r]);
  float ps = 0;
#pragma unroll
  for (int r = 0; r < 16; ++r) ps += p0[r];
#pragma unroll
  for (int r = 0; r < 16; ++r) ps += p1[r];
  { auto rr = __builtin_amdgcn_permlane32_swap(__float_as_uint(ps), __float_as_uint(ps), false, false);
    ps = __uint_as_float(rr[0]) + __uint_as_float(rr[1]); }
  l_reg = l_reg * alpha + ps;
#define PK4(P, BASE, OUT) do { unsigned a0 = cvtpk(P[BASE + 0], P[BASE + 1]), a1 = cvtpk(P[BASE + 2], P[BASE + 3]);   \
    unsigned b0 = cvtpk(P[BASE + 4], P[BASE + 5]), b1 = cvtpk(P[BASE + 6], P[BASE + 7]);                              \
    auto r0 = __builtin_amdgcn_permlane32_swap(a0, b0, false, false); auto r1 = __builtin_amdgcn_permlane32_swap(a1, b1, false, false); \
    u32x4 w = {r0[0], r1[0], r0[1], r1[1]}; OUT = *reinterpret_cast<bf16x8*>(&w); } while (0)
  PK4(p0, 0, pa0); PK4(p0, 8, pa1); PK4(p1, 0, pa2); PK4(p1, 8, pa3);
#undef PK4
}
template <int DQK>
__device__ __forceinline__ void qkt(f32x16& p0, f32x16& p1, const char* Ks, const bf16x8* qr, int r32, int hi) {
  p0 = f32x16{}; p1 = f32x16{};
#pragma unroll
  for (int d0 = 0; d0 < DQK / 16; ++d0) { const int cb = (d0 * 16 + hi * 8) * 2;
    const bf16x8 b0 = *reinterpret_cast<const bf16x8*>(Ks + kswz<DQK>(r32, cb));
    const bf16x8 b1 = *reinterpret_cast<const bf16x8*>(Ks + kswz<DQK>(32 + r32, cb));
    p0 = __builtin_amdgcn_mfma_f32_32x32x16_bf16(b0, qr[d0], p0, 0, 0, 0);
    p1 = __builtin_amdgcn_mfma_f32_32x32x16_bf16(b1, qr[d0], p1, 0, 0, 0); }
}
__device__ __forceinline__ int v_st(int k, int c) { const int kk = (k & ~0xC) | ((k & 4) << 1) | ((k & 8) >> 1); return ((kk >> 3) * 4 + (c >> 5)) * 512 + ((kk & 7) * 32 + (c & 31)) * 2; }
__device__ __forceinline__ int v_rd_base(int lane) { return ((lane & 3) << 3) | (((lane >> 2) & 3) << 6) | (((lane >> 4) & 1) << 5) | (((lane >> 5) & 1) << 8); }
constexpr int v_rd_off(int d0, int ks, int half) { return d0 * 512 + ks * 4096 + half * 2048; }
template <int OFF> __device__ __forceinline__ s16x4 tr_read(int vb) {
  s16x4 r; asm volatile("ds_read_b64_tr_b16 %0, %1 offset:%2" : "=&v"(r) : "v"(vb), "i"(OFF) : "memory"); return r;
}
template <int D0> __device__ __forceinline__ void pv_one(f32x16& od, int vb, bf16x8 pa0, bf16x8 pa1, bf16x8 pa2, bf16x8 pa3) {
  const s16x4 l0 = tr_read<v_rd_off(D0, 0, 0)>(vb), h0 = tr_read<v_rd_off(D0, 0, 1)>(vb), l1 = tr_read<v_rd_off(D0, 1, 0)>(vb), h1 = tr_read<v_rd_off(D0, 1, 1)>(vb);
  const s16x4 l2 = tr_read<v_rd_off(D0, 2, 0)>(vb), h2 = tr_read<v_rd_off(D0, 2, 1)>(vb), l3 = tr_read<v_rd_off(D0, 3, 0)>(vb), h3 = tr_read<v_rd_off(D0, 3, 1)>(vb);
  asm volatile("s_waitcnt lgkmcnt(0)" ::: "memory"); SBAR();
#define PK(L, H) (bf16x8){L[0], L[1], L[2], L[3], H[0], H[1], H[2], H[3]}
  od = __builtin_amdgcn_mfma_f32_32x32x16_bf16(pa0, PK(l0, h0), od, 0, 0, 0);
  od = __builtin_amdgcn_mfma_f32_32x32x16_bf16(pa1, PK(l1, h1), od, 0, 0, 0);
  od = __builtin_amdgcn_mfma_f32_32x32x16_bf16(pa2, PK(l2, h2), od, 0, 0, 0);
  od = __builtin_amdgcn_mfma_f32_32x32x16_bf16(pa3, PK(l3, h3), od, 0, 0, 0);
#undef PK
}
__device__ __forceinline__ void pv_d0(f32x16* o, int vb, bf16x8 pa0, bf16x8 pa1, bf16x8 pa2, bf16x8 pa3) {
  pv_one<0>(o[0], vb, pa0, pa1, pa2, pa3); pv_one<1>(o[1], vb, pa0, pa1, pa2, pa3); pv_one<2>(o[2], vb, pa0, pa1, pa2, pa3); pv_one<3>(o[3], vb, pa0, pa1, pa2, pa3);
}

struct AttnArgs {
  const unsigned short* proj;
  unsigned short* ycat;
  const float* kmean;
  const float* rel_bias;
  const float* sinks;
  const float* lq1; const float* lk1; const float* lq2; const float* lk2;
  const float* subln;
  float lambda_init; int pad_;
};
__device__ const unsigned char REL_BUCKET_TAB[128] = {
  0, 1, 2, 3, 4, 5, 6, 7, 8, 9, 10, 11, 12, 13, 14, 15, 16, 16, 16, 17, 17, 18, 18, 18, 19, 19, 19, 20, 20, 20, 20, 21, 21, 21, 21, 22, 22, 22, 22, 22, 23, 23, 23, 23, 23, 23, 24, 24, 24, 24, 24, 24,
  25, 25, 25, 25, 25, 25, 25, 26, 26, 26, 26, 26, 26, 26, 26, 27, 27, 27, 27, 27, 27, 27, 27, 27, 27, 28, 28, 28, 28, 28, 28, 28, 28, 28, 28, 29, 29, 29, 29, 29, 29, 29, 29, 29, 29, 29, 29,
  30, 30, 30, 30, 30, 30, 30, 30, 30, 30, 30, 30, 30, 30, 31, 31, 31, 31, 31, 31, 31, 31, 31, 31, 31, 31, 31, 31, 31};

template <int MODE>
__device__ __forceinline__ void attn_pass(const AttnArgs& A, int b, int hh, int qb, int pass, float lam, char* lds, int tid) {
  constexpr int DQK = (MODE == 2) ? 64 : 128;
  constexpr int NPASS = (MODE == 2) ? 2 : 1;
  constexpr int SDEPTH = ATT_SDEPTH;
  constexpr int QCOL = (MODE == 0) ? 0 : (MODE == 1) ? 1280 : 2816;
  constexpr int KCOL = (MODE == 0) ? 768 : (MODE == 1) ? 1792 : 3584;
  constexpr int VCOL = (MODE == 0) ? 1024 : (MODE == 1) ? 2304 : 4352;
  constexpr int OCOL = (MODE == 0) ? 0 : (MODE == 1) ? 768 : 1280;
  const float C = ((MODE == 2) ? 0.125f : 0.088388347648318440f) * LOG2E;
  const int lane = tid & 63, r32 = lane & 31, hi = lane >> 5; const int wid = __builtin_amdgcn_readfirstlane(tid >> 6);
  const int kvh = (MODE == 0) ? hh / 3 : hh;
  char* V_lds = lds + OFF_V; char* K_lds = lds + OFF_K;
  float* wsl = (float*)(lds + OFF_WS) + wid * 64; float* li_l = wsl; float* al_l = wsl + 32;
  const float* lut = (const float*)(lds + OFF_LUT);
  char* stg = lds + OFF_STG + wid * STG_WAVE;
  const int q0 = qb * 256;
  const int qpos = q0 + wid * QBLK + r32, wave_qmin = q0 + wid * QBLK;
  const long rowb = (long)b * SEQL;
  const float cfar = lut[127];
  const int t0 = (MODE == 0) ? (qb == 0 ? 0 : 4 * qb - 2) : 0;
  const int NT = 4 * qb + 4 - t0;
  const int sr = tid >> 4, sc = (tid & 15) * 8, vst0 = v_st(sr, sc), vst1 = v_st(32 + sr, sc);
  const int vb0 = (int)(uintptr_t)V_lds + v_rd_base(lane);
  const unsigned short* Vh = A.proj + rowb * LDP + VCOL + kvh * 128;
  {

    const unsigned short* Qw = A.proj + (rowb + q0 + wid * QBLK + r32) * LDP + QCOL + hh * 128 + pass * 64 + hi * 8;
    const unsigned short* Kh = A.proj + rowb * LDP + KCOL + kvh * 128 + pass * 64;
    bf16x8 qr[DQK / 16];
#pragma unroll
    for (int d0 = 0; d0 < DQK / 16; ++d0) qr[d0] = *reinterpret_cast<const bf16x8*>(Qw + d0 * 16);
    unsigned sel = 0u;
    if (MODE == 1) {
      const int jb = qb;
      if (jb <= 3) sel = (1u << jb) - 1u;
      else {
        float g[15];
#pragma unroll
        for (int n = 0; n < 15; ++n) { g[n] = -INFINITY;
          if (n < jb) { const float* km = A.kmean + (size_t)(((b * 4 + hh) * 16 + n) * 128 + hi * 8); float s = 0.f;
#pragma unroll
            for (int d0 = 0; d0 < 8; ++d0) { const f32x4 k0 = *(const f32x4*)(km + d0 * 16), k1 = *(const f32x4*)(km + d0 * 16 + 4);
              s += bf2f(qr[d0 % (DQK / 16)][0]) * k0[0] + bf2f(qr[d0 % (DQK / 16)][1]) * k0[1] + bf2f(qr[d0 % (DQK / 16)][2]) * k0[2] + bf2f(qr[d0 % (DQK / 16)][3]) * k0[3]
                 + bf2f(qr[d0 % (DQK / 16)][4]) * k1[0] + bf2f(qr[d0 % (DQK / 16)][5]) * k1[1] + bf2f(qr[d0 % (DQK / 16)][6]) * k1[2] + bf2f(qr[d0 % (DQK / 16)][7]) * k1[3]; }
            auto rr = __builtin_amdgcn_permlane32_swap(__float_as_uint(s), __float_as_uint(s), false, false);
            g[n] = __uint_as_float(rr[0]) + __uint_as_float(rr[1]); } }
#pragma unroll
        for (int pick = 0; pick < 3; ++pick) { float best = -INFINITY; int bi = 0;
#pragma unroll
          for (int n = 0; n < 15; ++n) { const bool take = (n < jb) && !((sel >> n) & 1u) && (g[n] > best); best = take ? g[n] : best; bi = take ? n : bi; }
          sel |= 1u << bi; }
      }
    }
    float m_reg = NEGB, l_reg = 0.f;
    if (MODE == 0) { m_reg = A.sinks[hh] * LOG2E; l_reg = 1.f; }
    f32x16 o[4] = {};
    struct { bf16x8 vs0, vs1, ks0, ks1; } sr_[SDEPTH];
#define KT(i) ((t0 + (i)) * KVBLK)
#define SLOAD(i, k0) do { sr_[i].vs0 = *reinterpret_cast<const bf16x8*>(&Vh[(long)((k0) + sr) * LDP + sc]); sr_[i].vs1 = *reinterpret_cast<const bf16x8*>(&Vh[(long)((k0) + 32 + sr) * LDP + sc]); \
    if (DQK == 128) { sr_[i].ks0 = *reinterpret_cast<const bf16x8*>(&Kh[(long)((k0) + sr) * LDP + sc]); sr_[i].ks1 = *reinterpret_cast<const bf16x8*>(&Kh[(long)((k0) + 32 + sr) * LDP + sc]); } \
    else { sr_[i].ks0 = *reinterpret_cast<const bf16x8*>(&Kh[(long)((k0) + (tid >> 3)) * LDP + (tid & 7) * 8]); } } while (0)
#define SWRITE(bb, i) do { *(bf16x8*)(V_lds + (bb) * SHM_V + vst0) = sr_[i].vs0; *(bf16x8*)(V_lds + (bb) * SHM_V + vst1) = sr_[i].vs1; \
    if (DQK == 128) { *(bf16x8*)(K_lds + (bb) * SHM_K + kswz<DQK>(sr, sc * 2)) = sr_[i].ks0; *(bf16x8*)(K_lds + (bb) * SHM_K + kswz<DQK>(32 + sr, sc * 2)) = sr_[i].ks1; } \
    else { *(bf16x8*)(K_lds + (bb) * SHM_K + kswz<DQK>(tid >> 3, (tid & 7) * 16)) = sr_[i].ks0; } } while (0)
#define SWAIT() do { if (SDEPTH == 1) asm volatile("s_waitcnt vmcnt(0)" ::: "memory"); else if (DQK == 128) asm volatile("s_waitcnt vmcnt(4)" ::: "memory"); else asm volatile("s_waitcnt vmcnt(3)" ::: "memory"); } while (0)
#define RESC(a) do { if (__any((a) < 1.f)) { if (hi == 0) al_l[r32] = (a); asm volatile("s_waitcnt lgkmcnt(0)" ::: "memory"); \
    _Pragma("unroll") for (int d = 0; d < 4; ++d) _Pragma("unroll") for (int r = 0; r < 16; ++r) o[d][r] *= al_l[crow(r, hi)]; } } while (0)
#define BMASK(P0, P1, ti) bias_mask<MODE>(P0, P1, KT(ti), qpos, wave_qmin, hi, C, lut, cfar, sel, qb)
    f32x16 pA0, pA1, pB0, pB1; float alA, alB; bf16x8 pa0, pa1, pa2, pa3;
    constexpr int SE = 0, SO = SDEPTH - 1;
    __syncthreads();
    SLOAD(SE, KT(0)); asm volatile("s_waitcnt vmcnt(0)" ::: "memory"); SWRITE(0, SE); __syncthreads();
    qkt<DQK>(pA0, pA1, K_lds, qr, r32, hi); BMASK(pA0, pA1, 0); partialSM(pA0, pA1, m_reg, alA);
    SLOAD(SO, KT(1)); if (SDEPTH == 2) { if (2 < NT) SLOAD(SE, KT(2)); }
    SWAIT(); SWRITE(1, SO); __syncthreads();
#pragma unroll 1
    for (int j = 1; j + 1 < NT; j += 2) {
      SBAR(); qkt<DQK>(pB0, pB1, K_lds + SHM_K, qr, r32, hi);
      finishSM(pA0, pA1, alA, l_reg, pa0, pa1, pa2, pa3); SBAR();
      SLOAD(SO, KT(j + SDEPTH)); SBAR();
      pv_d0(o, vb0, pa0, pa1, pa2, pa3); BMASK(pB0, pB1, j); partialSM(pB0, pB1, m_reg, alB);
      __syncthreads(); SWAIT(); SWRITE(0, SE);
      RESC(alB); __syncthreads();
      SBAR(); qkt<DQK>(pA0, pA1, K_lds, qr, r32, hi);
      finishSM(pB0, pB1, alB, l_reg, pa0, pa1, pa2, pa3); SBAR();
      if (SDEPTH == 1 || j + 3 < NT) SLOAD(SE, KT(j + 1 + SDEPTH)); SBAR();
      pv_d0(o, vb0 + SHM_V, pa0, pa1, pa2, pa3); BMASK(pA0, pA1, j + 1); partialSM(pA0, pA1, m_reg, alA);
      __syncthreads(); SWAIT(); SWRITE(1, SO);
      RESC(alA); __syncthreads();
    }
    SBAR(); qkt<DQK>(pB0, pB1, K_lds + SHM_K, qr, r32, hi);
    finishSM(pA0, pA1, alA, l_reg, pa0, pa1, pa2, pa3); SBAR();
    pv_d0(o, vb0, pa0, pa1, pa2, pa3); BMASK(pB0, pB1, NT - 1); partialSM(pB0, pB1, m_reg, alB);
    __syncthreads(); RESC(alB);
    finishSM(pB0, pB1, alB, l_reg, pa0, pa1, pa2, pa3); SBAR();
    pv_d0(o, vb0 + SHM_V, pa0, pa1, pa2, pa3);
#undef KT
#undef SLOAD
#undef SWRITE
#undef SWAIT
#undef RESC
#undef BMASK
    if (hi == 0) li_l[r32] = l_reg; asm volatile("s_waitcnt lgkmcnt(0)" ::: "memory");
#pragma unroll
    for (int r = 0; r < 16; ++r) { const int orow = crow(r, hi); const float rli = __builtin_amdgcn_rcpf(li_l[orow]);
#pragma unroll
      for (int d0 = 0; d0 < 4; ++d0) { unsigned short* sp = (unsigned short*)(stg + orow * STG_PITCH) + d0 * 32 + r32; float v = o[d0][r] * rli;
        if (MODE == 2 && pass == 1) v = __uint_as_float(((unsigned)*sp) << 16) - lam * v;
        *sp = (unsigned short)(cvtpk(v, v) & 0xffffu); } }
    asm volatile("s_waitcnt lgkmcnt(0)" ::: "memory");
    if (pass == NPASS - 1) {
      const char* rp = stg + r32 * STG_PITCH + hi * 128;
      u32x4 w[8];
#pragma unroll
      for (int i = 0; i < 8; ++i) w[i] = *(const u32x4*)(rp + i * 16);
      if (MODE == 2) {
        float ss = 0.f;
#pragma unroll
        for (int i = 0; i < 8; ++i)
#pragma unroll
          for (int k = 0; k < 4; ++k) { const float lo = __uint_as_float(w[i][k] << 16), hi_ = __uint_as_float(w[i][k] & 0xffff0000u); ss += lo * lo + hi_ * hi_; }
        { auto rr = __builtin_amdgcn_permlane32_swap(__float_as_uint(ss), __float_as_uint(ss), false, false); ss = __uint_as_float(rr[0]) + __uint_as_float(rr[1]); }
        const float sc2 = rsqrtf(ss * (1.0f / 128.0f) + 1e-6f) * (1.0f - A.lambda_init);
        const float* gp = A.subln + hi * 64;
#pragma unroll
        for (int i = 0; i < 8; ++i)
#pragma unroll
          for (int k = 0; k < 4; ++k) { const float lo = __uint_as_float(w[i][k] << 16) * sc2 * gp[i * 8 + 2 * k], hi_ = __uint_as_float(w[i][k] & 0xffff0000u) * sc2 * gp[i * 8 + 2 * k + 1]; w[i][k] = cvtpk(lo, hi_); }
      }
      unsigned short* op = A.ycat + (rowb + q0 + wid * QBLK + r32) * LDY + OCOL + hh * 128 + hi * 64;
#pragma unroll
      for (int i = 0; i < 8; ++i) *(u32x4*)(op + i * 8) = w[i];
    }
  }
}
template <int MODE>
__device__ __forceinline__ void attn_unit(const AttnArgs& A, int b, int hh, int qb, char* lds) {
  constexpr int NPASS = (MODE == 2) ? 2 : 1;
  constexpr int HB0 = (MODE == 0) ? 0 : (MODE == 1) ? 6 : 10;
  int tid = threadIdx.x; asm volatile("" : "+v"(tid)); const int lane = tid & 63;
  float* lut = (float*)(lds + OFF_LUT);
  __syncthreads();
  if (tid < 128) lut[tid] = A.rel_bias[(int)REL_BUCKET_TAB[tid] * 16 + HB0 + hh] * LOG2E;
  __syncthreads();
  float lam = 0.f;
  if (MODE == 2) { float a = A.lq1[lane] * A.lk1[lane], c2 = A.lq2[lane] * A.lk2[lane];
#pragma unroll
    for (int o_ = 1; o_ < 64; o_ <<= 1) { a += __shfl_xor(a, o_); c2 += __shfl_xor(c2, o_); }
    lam = __expf(a) - __expf(c2) + A.lambda_init; }
#pragma unroll 1
  for (int pass = 0; pass < NPASS; ++pass) {
    int tid_l = threadIdx.x; asm volatile("" : "+v"(tid_l));
    attn_pass<MODE>(A, b, hh, qb, pass, lam, lds, tid_l);
  }
}
#undef SBAR
}
#define GAS __attribute__((address_space(1)))
#define LAS __attribute__((address_space(3)))
typedef unsigned short bf16;
typedef unsigned v4u __attribute__((ext_vector_type(4)));
typedef float f32x4 __attribute__((ext_vector_type(4)));
typedef short bf16x8 __attribute__((ext_vector_type(8)));
typedef GAS unsigned gu32;
typedef GAS unsigned long long gu64;
#define RLX_AGENT __ATOMIC_RELAXED, __HIP_MEMORY_SCOPE_AGENT
#define LDS_WAIT() asm volatile("s_waitcnt lgkmcnt(0)" ::: "memory")
#define VM_WAIT() asm volatile("s_waitcnt vmcnt(0)" ::: "memory")
__device__ __forceinline__ unsigned long long rt() { return __builtin_amdgcn_s_memrealtime(); }
__device__ __forceinline__ unsigned f2bf(float f) { unsigned u = __builtin_bit_cast(unsigned, f); return (u + 0x7fffu + ((u >> 16) & 1u)) >> 16; }
__device__ __forceinline__ unsigned pk2(float lo, float hi) { return f2bf(lo) | (f2bf(hi) << 16); }

#define XB_TMO      128
#define XB_XCNT(j)  (256  + 64 * (j))
#define XB_XSUB(j)  (1280 + 64 * (j))
#define XB_XGEN(j)  (2304 + 64 * (j))
#define XB_TOP      3328
#define XB_TOPGEN   3392
#define XCD_BAR_WORDS 3456
#define XB_SPIN_CAP (1u << 18)

__device__ __forceinline__ unsigned xb_ld(unsigned* p)              { return __hip_atomic_load(p, __ATOMIC_RELAXED, __HIP_MEMORY_SCOPE_AGENT); }
__device__ __forceinline__ unsigned xb_add(unsigned* p, unsigned v) { return __hip_atomic_fetch_add(p, v, __ATOMIC_RELAXED, __HIP_MEMORY_SCOPE_AGENT); }
__device__ __forceinline__ unsigned xb_xcc_id() { return (unsigned)__builtin_amdgcn_s_getreg((3 << 11) | 20) & 0xFu; }
#define XB_SPIN(cond, bar) do { unsigned _sp = 0; while (cond) { __builtin_amdgcn_s_sleep(1); \
    if ((++_sp & 255u) == 0u) { if (xb_ld(&(bar)[XB_TMO])) break; if (_sp > XB_SPIN_CAP) { atomicAdd(&(bar)[XB_TMO], 1u); break; } } } } while (0)

struct XcdBarrier {
    unsigned* bar; unsigned x;
    volatile LAS unsigned* st;
};

__device__ __forceinline__ XcdBarrier xcd_barrier_post(unsigned* bar, volatile LAS unsigned* st) {
    XcdBarrier b; b.bar = bar; b.x = xb_xcc_id(); b.st = st;
    if (threadIdx.x == 0) (void)xb_add(&bar[XB_XCNT(b.x)], 1u);
    return b;
}
__device__ __forceinline__ void xcd_barrier_complete(unsigned* bar, unsigned x, unsigned& nloc, unsigned& nx) {
    const unsigned G = gridDim.x * gridDim.y * gridDim.z;
    unsigned sum, cnt, mine, sp = 0u;
    for (;;) {
        sum = 0u; cnt = 0u; mine = 0u;
#pragma unroll
        for (unsigned j = 0; j < 16; ++j) { const unsigned c = xb_ld(&bar[XB_XCNT(j)]); sum += c; cnt += (c > 0u) ? 1u : 0u; mine = (j == x) ? c : mine; }
        if (sum == G) break;
        __builtin_amdgcn_s_sleep(1);
        if ((++sp & 255u) == 0u) { if (xb_ld(&bar[XB_TMO])) break; if (sp > XB_SPIN_CAP) { atomicAdd(&bar[XB_TMO], 1u); break; } }
    }
    nloc = mine > 0u ? mine : 1u; nx = cnt > 0u ? cnt : 1u;
}

__device__ __forceinline__ void xcd_barrier(const XcdBarrier& b) {
    asm volatile("s_waitcnt vmcnt(0)" ::: "memory");
    __syncthreads();
    if (threadIdx.x == 0) {
        unsigned* bar = b.bar;
        __builtin_amdgcn_s_waitcnt(0);
        unsigned nloc = b.st[0], nx = b.st[1];
        if (nloc == 0u) { xcd_barrier_complete(bar, b.x, nloc, nx); b.st[0] = nloc; b.st[1] = nx; }
        const unsigned old = xb_add(&bar[XB_XSUB(b.x)], 1u);
        const unsigned gen = old / nloc;
        if (old + 1u == (gen + 1u) * nloc) {
            __builtin_amdgcn_fence(__ATOMIC_RELEASE, "agent");
            asm volatile("s_waitcnt vmcnt(0)" ::: "memory");
            const unsigned og = xb_add(&bar[XB_TOP], 1u);
            const unsigned tg = og / nx;
            if (og + 1u == (tg + 1u) * nx) xb_add(&bar[XB_TOPGEN], 1u);
            else XB_SPIN(xb_ld(&bar[XB_TOPGEN]) == tg, bar);
            __builtin_amdgcn_fence(__ATOMIC_ACQUIRE, "agent");
            xb_add(&bar[XB_XGEN(b.x)], 1u);
            asm volatile("s_waitcnt vmcnt(0)" ::: "memory");
        } else {
            XB_SPIN(xb_ld(&bar[XB_XGEN(b.x)]) == gen, bar);
            __builtin_amdgcn_fence(__ATOMIC_ACQUIRE, "agent");
            asm volatile("s_waitcnt vmcnt(0)" ::: "memory");
        }
    }
    __syncthreads();
}

constexpr int NWAVES = 8;
constexpr int BATCH = 8, SEQ = 4096, DM = 2048, DEPTH = 2, M = BATCH * SEQ, NIN = 5120, NEXP = 32, DEXP = 512, PLE = 256, NROUTE = 36;
constexpr int KB_OFF = 1792;
constexpr int RPAD = 73728;
constexpr float EPS = 1e-6f;
constexpr size_t MiB = 1u << 20;
constexpr size_t WS_CTL = 0, CTL_ZERO_BYTES = 1 * MiB;
constexpr size_t WS_KMEAN = 1 * MiB, WS_RSTD = WS_KMEAN + 256 * 1024, WS_TOKREC = WS_RSTD + 128 * 1024, WS_POS = WS_TOKREC + 1 * MiB, WS_WR = WS_POS + 256 * 1024;
constexpr size_t WS_WIN = 8 * MiB, WS_WOUT = 48 * MiB, WS_W13 = 64 * MiB, WS_W2 = 320 * MiB, WS_WG = 448 * MiB, WS_WP = 464 * MiB, WS_PB = 466 * MiB;
constexpr size_t WS_U = 498 * MiB, WS_PROJ = 626 * MiB, WS_YCAT = 946 * MiB, WS_PL = 1074 * MiB, WS_END = 1202 * MiB;
constexpr size_t WS_XG = WS_PROJ, WS_HID = WS_PROJ + 288 * MiB, WS_Y = WS_XG;
static_assert(WS_WR + 2 * NROUTE * DM * 4 <= WS_WIN && WS_HID + (size_t)RPAD * DEXP * 2 <= WS_PL && (size_t)RPAD * DM * 2 <= 288 * MiB, "d_ws map");
constexpr int CW_TMO = 0, CW_CODE = 1, CW_BAR = 4096, CW_CNT = 16384, CW_Q = 24576;
constexpr int PHASE_LDS = 139264;
constexpr int LDS_TILE_E = PHASE_LDS, LDS_OFFS = PHASE_LDS + 512, LDS_MISC = PHASE_LDS + 1024, LDSCTL_OFF = PHASE_LDS;
constexpr int LDS_BYTES = 147456;
static_assert(att::ATT_LDS <= PHASE_LDS && pg8::STAGE_BYTES <= PHASE_LDS && LDS_MISC + 128 <= LDS_BYTES, "LDS map");

#define CAS __attribute__((address_space(4)))
__device__ __forceinline__ const CAS char* kargs() { const CAS char* kp = (const CAS char*)__builtin_amdgcn_kernarg_segment_ptr(); asm volatile("" : "+s"(kp)); return kp; }
__device__ __forceinline__ const float* inptr(int k) { return *(const float* const CAS*)(kargs() + 8 * k); }
__device__ __forceinline__ float* outptr() { return *(float* const CAS*)(kargs() + 176); }
__device__ __forceinline__ unsigned char* wsptr() { return *(unsigned char* const CAS*)(kargs() + 184); }
__device__ __forceinline__ gu32* ctlptr() { return (gu32*)(wsptr() + WS_CTL); }
typedef float f32x2g __attribute__((ext_vector_type(2)));
typedef unsigned u32x2g __attribute__((ext_vector_type(2)));
struct Frame {
    LAS unsigned char* lds;
    volatile LAS unsigned* MISC;
    int tid, lane, wave, G, gw, NGW;
};
struct Args { const float* in[22]; float* out; unsigned char* ws; int ph_lo, ph_hi, use_bar, pad; };
__device__ __forceinline__ Frame relaunder(const Frame& F0) {
    Frame F = F0; int t = threadIdx.x; asm volatile("" : "+v"(t));
    F.tid = t; F.lane = t & 63; F.wave = __builtin_amdgcn_readfirstlane(t >> 6); F.gw = blockIdx.x * NWAVES + F.wave; return F;
}
__device__ __forceinline__ int opaque_i(int x) { asm volatile("" : "+s"(x)); return x; }
__device__ __forceinline__ float wave_sum(float v) {
#pragma unroll
    for (int o = 1; o < 64; o <<= 1) v += __shfl_xor(v, o);
    return v;
}
__device__ __forceinline__ unsigned pk2rne(float lo, float hi) { return pg8::cvt_pk_bf16(lo, hi); }
__device__ __forceinline__ float bfround(float x) { return __uint_as_float(pk2rne(x, x) << 16); }

__device__ __forceinline__ void p0_transpose_item(const float* W, int K, int N, bf16* WT, int dst_row0, LAS float* scr, int k0, int n0, int lane) {
#pragma unroll 8
    for (int i = 0; i < 32; ++i) { const int kk = 2 * i + (lane >> 5); scr[kk * 33 + (lane & 31)] = W[(size_t)(k0 + kk) * N + n0 + (lane & 31)]; }
    LDS_WAIT(); asm volatile("" ::: "memory");
    const int c = lane & 7;
#pragma unroll
    for (int j = 0; j < 4; ++j) { const int n = (lane >> 3) + 8 * j; const LAS float* s = scr + (8 * c) * 33 + n;
        v4u o; o.x = pk2rne(s[0 * 33], s[1 * 33]); o.y = pk2rne(s[2 * 33], s[3 * 33]); o.z = pk2rne(s[4 * 33], s[5 * 33]); o.w = pk2rne(s[6 * 33], s[7 * 33]);
        *(GAS v4u*)(WT + (size_t)(dst_row0 + n) * K + k0 + 8 * c) = o; }
    LDS_WAIT(); asm volatile("" ::: "memory");
}
__device__ __forceinline__ void norm_row_bf16(const float* xrow, const float* g, bf16* orow, int lane) {
    const GAS f32x4* xr = (const GAS f32x4*)xrow + lane; const GAS f32x4* gr = (const GAS f32x4*)g + lane;
    f32x4 v[8]; float s = 0.f;
#pragma unroll
    for (int j = 0; j < 8; ++j) { v[j] = xr[64 * j]; s += (v[j].x * v[j].x + v[j].y * v[j].y) + (v[j].z * v[j].z + v[j].w * v[j].w); }
    const float rstd = rsqrtf(wave_sum(s) * (1.f / DM) + EPS);
    GAS unsigned long long* o8 = (GAS unsigned long long*)orow + lane;
#pragma unroll
    for (int j = 0; j < 8; ++j) { const f32x4 gv = gr[64 * j]; o8[64 * j] = (unsigned long long)pk2rne(v[j].x * rstd * gv.x, v[j].y * rstd * gv.y) | ((unsigned long long)pk2rne(v[j].z * rstd * gv.z, v[j].w * rstd * gv.w) << 32); }
}

__device__ __forceinline__ void p0_prologue(Frame& F0, const Args& AR) {
    Frame F = relaunder(F0);
    LAS float* scr = (LAS float*)(F.lds + F.wave * 16384);
    constexpr int I_IN = 32 * 160, I_OUT = 32 * 64, I_W1 = 32 * 512, I_W2 = 32 * 512, I_WG = 32 * 64, I_WP = 4 * 64, I_L = I_IN + I_OUT + 2 * I_W1 + I_W2 + I_WG + I_WP;
    bf16* WIN = (bf16*)(wsptr() + WS_WIN); bf16* WOUT = (bf16*)(wsptr() + WS_WOUT); bf16* W13 = (bf16*)(wsptr() + WS_W13); bf16* W2 = (bf16*)(wsptr() + WS_W2); bf16* WG = (bf16*)(wsptr() + WS_WG); bf16* WP = (bf16*)(wsptr() + WS_WP);
    for (int it = F.gw; it < 2 * I_L; it += F.NGW) {
        const int L = it / I_L; int r = it % I_L;
        if (r < I_IN) { p0_transpose_item(inptr(5) + (size_t)L * DM * NIN, DM, NIN, WIN + (size_t)L * NIN * DM, 32 * (r % 160), scr, 64 * (r / 160), 32 * (r % 160), F.lane); continue; } r -= I_IN;
        if (r < I_OUT) { p0_transpose_item(inptr(12) + (size_t)L * DM * DM, DM, DM, WOUT + (size_t)L * DM * DM, 32 * (r % 64), scr, 64 * (r / 64), 32 * (r % 64), F.lane); continue; } r -= I_OUT;
        if (r < 2 * I_W1) { const int w3 = r >= I_W1; if (w3) r -= I_W1; const int e = r / 512, rr = r % 512, n0 = 32 * (rr % 16);
            p0_transpose_item((w3 ? inptr(17) : inptr(16)) + ((size_t)L * NEXP + e) * DM * DEXP, DM, DEXP, W13 + ((size_t)L * NEXP + e) * 1024 * DM, 256 * (n0 / 128) + (n0 % 128) + (w3 ? 128 : 0), scr, 64 * (rr / 16), n0, F.lane); continue; } r -= 2 * I_W1;
        if (r < I_W2) { const int e = r / 512, rr = r % 512;
            p0_transpose_item(inptr(18) + ((size_t)L * NEXP + e) * DEXP * DM, DEXP, DM, W2 + ((size_t)L * NEXP + e) * DM * DEXP, 32 * (rr % 64), scr, 64 * (rr / 64), 32 * (rr % 64), F.lane); continue; } r -= I_W2;
        if (r < I_WG) { p0_transpose_item(inptr(20) + (size_t)L * DM * DM, DM, DM, WG + (size_t)L * DM * DM, 32 * (r % 64), scr, 64 * (r / 64), 32 * (r % 64), F.lane); continue; } r -= I_WG;
        p0_transpose_item(inptr(21) + (size_t)L * PLE * DM, PLE, DM, WP + (size_t)L * DM * PLE, 32 * (r % 64), scr, 64 * (r / 64), 32 * (r % 64), F.lane);
    }
    { const GAS f32x4* src = (const GAS f32x4*)inptr(1); GAS v4u* dst = (GAS v4u*)(wsptr() + WS_PB); const long n8 = (long)DEPTH * M * PLE / 8;
      for (long i = (long)F.gw * 64 + F.lane; i < n8; i += (long)F.NGW * 64) { const f32x4 a = src[2 * i], b = src[2 * i + 1]; v4u o; o.x = pk2rne(a.x, a.y); o.y = pk2rne(a.z, a.w); o.z = pk2rne(b.x, b.y); o.w = pk2rne(b.z, b.w); dst[i] = o; } }
    { float* WR = (float*)(wsptr() + WS_WR);
      for (int i = F.gw * 64 + F.lane; i < DEPTH * NROUTE * DM; i += F.NGW * 64) { const int L = i / (NROUTE * DM), n = (i / DM) % NROUTE, k = i % DM;
        WR[i] = n < 4 ? inptr(14)[((size_t)L * DM + k) * 4 + n] : inptr(15)[((size_t)L * DM + k) * 32 + (n - 4)]; } }
    for (int m = F.gw; m < M; m += F.NGW) norm_row_bf16(inptr(0) + (size_t)m * DM, inptr(4), (bf16*)(wsptr() + WS_U) + (size_t)m * DM, F.lane);
}
__device__ __forceinline__ void kmean_phase(Frame& F0, const Args& AR) {
    Frame F = relaunder(F0);
    const bf16* proj = (const bf16*)(wsptr() + WS_PROJ); float* km = (float*)(wsptr() + WS_KMEAN);
    for (int u = F.gw; u < BATCH * 4 * 16; u += F.NGW) { const int b = u >> 6, h = (u >> 4) & 3, blk = u & 15;
        const bf16* kp = proj + ((size_t)b * SEQ + blk * 256) * NIN + KB_OFF + h * 128 + 2 * F.lane; float s0 = 0.f, s1 = 0.f;
#pragma unroll 8
        for (int r = 0; r < 256; ++r) { const unsigned v = *(const GAS unsigned*)(kp + (size_t)r * NIN); s0 += __uint_as_float(v << 16); s1 += __uint_as_float(v & 0xffff0000u); }
        f32x2g o; o.x = s0 * (1.f / 256.f); o.y = s1 * (1.f / 256.f); *(GAS f32x2g*)(km + (size_t)u * 128 + 2 * F.lane) = o; }
}
struct TokRec { int e0, e1, s0, s1; float w0, w1; int pad0, pad1; };
__device__ __forceinline__ void router_phase(Frame& F0, const Args& AR, int layer) {
    Frame F = relaunder(F0);
    const float* h = outptr(); const float* g = inptr(13) + (size_t)layer * DM; const float* WR = (const float*)(wsptr() + WS_WR) + (size_t)layer * NROUTE * DM;
    float* rstd_o = (float*)(wsptr() + WS_RSTD); TokRec* rec = (TokRec*)(wsptr() + WS_TOKREC); gu32* cnt = ctlptr() + CW_CNT + layer * 32 * 64;
    for (int rg = F.gw; rg < M / 4; rg += F.NGW) {
        f32x4 v[4][8]; float rs[4];
#pragma unroll
        for (int r = 0; r < 4; ++r) { const GAS f32x4* xr = (const GAS f32x4*)(h + (size_t)(4 * rg + r) * DM) + F.lane; float s = 0.f;
#pragma unroll
            for (int j = 0; j < 8; ++j) { v[r][j] = xr[64 * j]; s += (v[r][j].x * v[r][j].x + v[r][j].y * v[r][j].y) + (v[r][j].z * v[r][j].z + v[r][j].w * v[r][j].w); }
            rs[r] = rsqrtf(wave_sum(s) * (1.f / DM) + EPS); }
#pragma unroll
        for (int j = 0; j < 8; ++j) { const f32x4 gv = ((const GAS f32x4*)g)[F.lane + 64 * j];
#pragma unroll
            for (int r = 0; r < 4; ++r) v[r][j] = v[r][j] * gv * rs[r]; }
        float mylog[4] = {0.f, 0.f, 0.f, 0.f};
#pragma unroll 1
        for (int n = 0; n < NROUTE; ++n) { const GAS f32x4* wr = (const GAS f32x4*)(WR + (size_t)n * DM) + F.lane; float a0 = 0.f, a1 = 0.f, a2 = 0.f, a3 = 0.f;
#pragma unroll
            for (int j = 0; j < 8; ++j) { const f32x4 w = wr[64 * j];
                a0 += (v[0][j].x * w.x + v[0][j].y * w.y) + (v[0][j].z * w.z + v[0][j].w * w.w); a1 += (v[1][j].x * w.x + v[1][j].y * w.y) + (v[1][j].z * w.z + v[1][j].w * w.w);
                a2 += (v[2][j].x * w.x + v[2][j].y * w.y) + (v[2][j].z * w.z + v[2][j].w * w.w); a3 += (v[3][j].x * w.x + v[3][j].y * w.y) + (v[3][j].z * w.z + v[3][j].w * w.w); }
            a0 = wave_sum(a0); a1 = wave_sum(a1); a2 = wave_sum(a2); a3 = wave_sum(a3);
            if (F.lane == n) { mylog[0] = a0; mylog[1] = a1; mylog[2] = a2; mylog[3] = a3; } }
#pragma unroll
        for (int r = 0; r < 4; ++r) {
            float gl[4];
#pragma unroll
            for (int i = 0; i < 4; ++i) gl[i] = __shfl(mylog[r], i);
            int grp = 0; float gm = gl[0];
#pragma unroll
            for (int i = 1; i < 4; ++i) if (gl[i] > gm) { gm = gl[i]; grp = i; }
            float gs = 0.f;
#pragma unroll
            for (int i = 0; i < 4; ++i) gs += __expf(gl[i] - gm);
            const float gw_ = 1.f / gs;
            float el[8];
#pragma unroll
            for (int i = 0; i < 8; ++i) el[i] = __shfl(mylog[r], 4 + grp * 8 + i);
            int i1 = 0; float t1 = el[0];
#pragma unroll
            for (int i = 1; i < 8; ++i) if (el[i] > t1) { t1 = el[i]; i1 = i; }
            int i2 = -1; float t2 = -INFINITY;
#pragma unroll
            for (int i = 0; i < 8; ++i) if (i != i1 && el[i] > t2) { t2 = el[i]; i2 = i; }
            const float ex = __expf(t2 - t1), w0 = gw_ / (1.f + ex), w1 = gw_ * ex / (1.f + ex);
            if (F.lane == 0) { const int row = 4 * rg + r, e0 = grp * 8 + i1, e1 = grp * 8 + i2;
                const int s0 = (int)__hip_atomic_fetch_add(cnt + e0 * 64, 1u, RLX_AGENT), s1 = (int)__hip_atomic_fetch_add(cnt + e1 * 64, 1u, RLX_AGENT);
                TokRec t; t.e0 = e0; t.e1 = e1; t.s0 = s0; t.s1 = s1; t.w0 = w0; t.w1 = w1; t.pad0 = 0; t.pad1 = 0; rec[row] = t; rstd_o[row] = rs[r]; }
        }
    }
}
__device__ __forceinline__ int build_tiles(Frame& F, int layer) {
    gu32* cnt = ctlptr() + CW_CNT + layer * 32 * 64; LAS int* offs = (LAS int*)(F.lds + LDS_OFFS); LAS unsigned char* te = F.lds + LDS_TILE_E;
    __syncthreads();
    if (F.tid == 0) { int acc = 0;
#pragma unroll 1
        for (int e = 0; e < NEXP; ++e) { const int c = (int)__hip_atomic_load(cnt + e * 64, RLX_AGENT); offs[e] = acc * 256; const int nt = (c + 255) >> 8; for (int t = 0; t < nt && acc + t < RPAD / 256; ++t) te[acc + t] = (unsigned char)e; acc += nt; }
        offs[32] = acc < RPAD / 256 ? acc : RPAD / 256; }
    __syncthreads();
    return offs[32];
}
__device__ __forceinline__ void gather_phase(Frame& F0, const Args& AR, int layer) {
    Frame F = relaunder(F0);
    (void)build_tiles(F, layer);
    const LAS int* offs = (const LAS int*)(F.lds + LDS_OFFS);
    const float* h = outptr(); const float* g = inptr(13) + (size_t)layer * DM; const float* rstd = (const float*)(wsptr() + WS_RSTD); const TokRec* rec = (const TokRec*)(wsptr() + WS_TOKREC);
    bf16* xg = (bf16*)(wsptr() + WS_XG); int2* pos = (int2*)(wsptr() + WS_POS);
    for (int m = F.gw; m < M; m += F.NGW) {
        const TokRec t = rec[m]; const float rs = rstd[m]; const int p0 = offs[t.e0] + t.s0, p1 = offs[t.e1] + t.s1;
        const GAS f32x4* xr = (const GAS f32x4*)(h + (size_t)m * DM) + F.lane; const GAS f32x4* gr = (const GAS f32x4*)g + F.lane;
        GAS unsigned long long* o0 = (GAS unsigned long long*)(xg + (size_t)p0 * DM) + F.lane; GAS unsigned long long* o1 = (GAS unsigned long long*)(xg + (size_t)p1 * DM) + F.lane;
#pragma unroll
        for (int j = 0; j < 8; ++j) { const f32x4 v = xr[64 * j], gv = gr[64 * j];
            const unsigned long long w = (unsigned long long)pk2rne(v.x * rs * gv.x, v.y * rs * gv.y) | ((unsigned long long)pk2rne(v.z * rs * gv.z, v.w * rs * gv.w) << 32);
            o0[64 * j] = w; o1[64 * j] = w; }
        if (F.lane == 0) pos[m] = make_int2(p0, p1);
    }
}
__device__ __forceinline__ void combine_phase(Frame& F0, const Args& AR, int layer) {
    Frame F = relaunder(F0);
    float* h = outptr(); const float* g = inptr(19) + (size_t)layer * DM; const TokRec* rec = (const TokRec*)(wsptr() + WS_TOKREC); const int2* pos = (const int2*)(wsptr() + WS_POS);
    const bf16* y = (const bf16*)(wsptr() + WS_Y); bf16* u = (bf16*)(wsptr() + WS_U);
    for (int m = F.gw; m < M; m += F.NGW) {
        const TokRec t = rec[m]; const int2 p = pos[m];
        GAS f32x4* xr = (GAS f32x4*)(h + (size_t)m * DM) + F.lane; const GAS f32x4* gr = (const GAS f32x4*)g + F.lane;
        const GAS u32x2g* y0 = (const GAS u32x2g*)(y + (size_t)p.x * DM) + F.lane; const GAS u32x2g* y1 = (const GAS u32x2g*)(y + (size_t)p.y * DM) + F.lane;
        f32x4 v[8]; float s = 0.f;
#pragma unroll
        for (int j = 0; j < 8; ++j) { v[j] = xr[64 * j]; const u32x2g a = y0[64 * j], b = y1[64 * j];
            v[j].x += t.w0 * __uint_as_float(a.x << 16) + t.w1 * __uint_as_float(b.x << 16); v[j].y += t.w0 * __uint_as_float(a.x & 0xffff0000u) + t.w1 * __uint_as_float(b.x & 0xffff0000u);
            v[j].z += t.w0 * __uint_as_float(a.y << 16) + t.w1 * __uint_as_float(b.y << 16); v[j].w += t.w0 * __uint_as_float(a.y & 0xffff0000u) + t.w1 * __uint_as_float(b.y & 0xffff0000u);
            xr[64 * j] = v[j]; s += (v[j].x * v[j].x + v[j].y * v[j].y) + (v[j].z * v[j].z + v[j].w * v[j].w); }
        const float rstd = rsqrtf(wave_sum(s) * (1.f / DM) + EPS);
        GAS unsigned long long* o8 = (GAS unsigned long long*)(u + (size_t)m * DM) + F.lane;
#pragma unroll
        for (int j = 0; j < 8; ++j) { const f32x4 gv = gr[64 * j]; o8[64 * j] = (unsigned long long)pk2rne(v[j].x * rstd * gv.x, v[j].y * rstd * gv.y) | ((unsigned long long)pk2rne(v[j].z * rstd * gv.z, v[j].w * rstd * gv.w) << 32); }
    }
}
__device__ __forceinline__ void endnorm_phase(Frame& F0, const Args& AR, int layer) {
    Frame F = relaunder(F0);
    if (layer + 1 < DEPTH) { for (int m = F.gw; m < M; m += F.NGW) norm_row_bf16(outptr() + (size_t)m * DM, inptr(4) + (size_t)(layer + 1) * DM, (bf16*)(wsptr() + WS_U) + (size_t)m * DM, F.lane); }
    else { for (int m = F.gw; m < M; m += F.NGW) { GAS f32x4* xr = (GAS f32x4*)(outptr() + (size_t)m * DM) + F.lane; const GAS f32x4* gr = (const GAS f32x4*)inptr(3) + F.lane; f32x4 v[8]; float s = 0.f;
#pragma unroll
            for (int j = 0; j < 8; ++j) { v[j] = xr[64 * j]; s += (v[j].x * v[j].x + v[j].y * v[j].y) + (v[j].z * v[j].z + v[j].w * v[j].w); }
            const float rstd = rsqrtf(wave_sum(s) * (1.f / DM) + EPS);
#pragma unroll
            for (int j = 0; j < 8; ++j) xr[64 * j] = v[j] * rstd * gr[64 * j]; } }
}
template <int MODE> __device__ __forceinline__ void attn_queue(Frame& F0, const att::AttnArgs& A, gu32* qhead, int nunits) {
    Frame F = relaunder(F0);
    volatile LAS int* mb = (volatile LAS int*)(F.lds + att::OFF_MISC);
    for (;;) {
        __syncthreads();
        if (F.tid == 0) mb[0] = (int)__hip_atomic_fetch_add(qhead, 1u, RLX_AGENT);
        __syncthreads();
        const int idx = __builtin_amdgcn_readfirstlane(mb[0]);
        if (idx >= nunits) break;
        int b, hh, qb;
        if (MODE == 2) { qb = 15 - idx / 48; const int r = idx % 48; b = r / 6; hh = r % 6; }
        else if (MODE == 1) { qb = 15 - idx / 32; const int r = idx % 32; b = r / 4; hh = r % 4; }
        else { qb = idx / 48; const int r = idx % 48; b = r / 6; hh = r % 6; }
        att::attn_unit<MODE>(A, b, hh, qb, (char*)F.lds);
    }
}
__device__ __forceinline__ att::AttnArgs make_attn_args(int layer) {
    att::AttnArgs A{}; unsigned char* ws = wsptr(); A.proj = (const unsigned short*)(ws + WS_PROJ); A.ycat = (unsigned short*)(ws + WS_YCAT); A.kmean = (const float*)(ws + WS_KMEAN); A.rel_bias = inptr(2);
    A.sinks = inptr(6) + layer * 6; A.lq1 = inptr(7) + layer * 64; A.lk1 = inptr(8) + layer * 64; A.lq2 = inptr(9) + layer * 64; A.lk2 = inptr(10) + layer * 64; A.subln = inptr(11) + layer * 128;
    A.lambda_init = 0.8f - 0.6f * __expf(-0.3f * (float)layer); return A;
}

#ifndef MK_PH_MASK
#define MK_PH_MASK 0xFFFFFFFFu
#endif
#ifndef MK_ATT_MASK
#define MK_ATT_MASK 7
#endif
#define ATM(k) ((MK_ATT_MASK >> (k)) & 1)
#define PHM(k) ((MK_PH_MASK >> (k)) & 1u)
constexpr int NPH_LAYER = 11, NPHASES = 1 + DEPTH * NPH_LAYER;
__global__ void __launch_bounds__(NWAVES * 64, 2) mk_fwd(Args args) {
    extern __shared__ __attribute__((aligned(16))) unsigned char lds[];
    Frame F;
    F.lds = (LAS unsigned char*)lds; F.MISC = (volatile LAS unsigned*)(F.lds + LDS_MISC);
    F.tid = threadIdx.x; F.lane = F.tid & 63; F.wave = __builtin_amdgcn_readfirstlane(F.tid >> 6); F.G = gridDim.x;
    F.gw = blockIdx.x * NWAVES + F.wave; F.NGW = F.G * NWAVES;
    for (int u = F.tid; u < (LDS_BYTES - LDSCTL_OFF) / 4; u += NWAVES * 64) ((LAS unsigned*)(F.lds + LDSCTL_OFF))[u] = 0u;
    __syncthreads();
    XcdBarrier bar; bar.bar = (unsigned*)(ctlptr() + CW_BAR); bar.x = 0; bar.st = nullptr;
    if (args.use_bar) bar = xcd_barrier_post((unsigned*)(ctlptr() + CW_BAR), F.MISC + 8);
    const int lo = args.ph_lo, hi = args.ph_hi;
#define IN(k) (lo <= (k) && (k) < hi)
#define SEAM(k) do { if (IN(k) && IN((k) + 1)) xcd_barrier(bar); } while (0)
    if (PHM(0) && IN(0)) { p0_prologue(F, args); } SEAM(0);
#pragma unroll 1
    for (int layer = 0; layer < DEPTH; ++layer) {
        const int pb = 1 + layer * NPH_LAYER;
        const bf16* U = (const bf16*)(wsptr() + WS_U);
        if (PHM(1) && IN(pb + 0)) { pg8::Gemm g{U, (const bf16*)(wsptr() + WS_WIN) + (size_t)layer * NIN * DM, M, NIN, DM}; pg8::StaticOrder S; S.init(M, NIN, F.G, (int)blockIdx.x);
            pg8::EpiBf16<0> E{(bf16*)(wsptr() + WS_PROJ), NIN, nullptr, 0, 0, 1.f};
            pg8::gemm_phase<pg8::EpiBf16<0>, pg8::StaticOrder, true, true>(F.lds, g, S, E); }
        SEAM(pb + 0);
        if (PHM(2) && IN(pb + 1)) { kmean_phase(F, args);
            pg8::Gemm g{(const bf16*)(wsptr() + WS_PB) + (size_t)layer * M * PLE, (const bf16*)(wsptr() + WS_WP) + (size_t)layer * DM * PLE, M, DM, opaque_i(PLE)}; pg8::StaticOrder S; S.init(M, DM, F.G, (int)blockIdx.x);
            pg8::EpiBf16<0> E{(bf16*)(wsptr() + WS_PL), DM, nullptr, 0, 0, 1.f};
            pg8::gemm_phase<pg8::EpiBf16<0>, pg8::StaticOrder, true, true>(F.lds, g, S, E); }
        SEAM(pb + 1);
        if (PHM(3) && IN(pb + 2)) { const att::AttnArgs A = make_attn_args(layer);
            if (ATM(2)) attn_queue<2>(F, A, ctlptr() + CW_Q + (layer * 4 + 0) * 64, 768);
            if (ATM(1)) attn_queue<1>(F, A, ctlptr() + CW_Q + (layer * 4 + 1) * 64, 512);
            if (ATM(0)) attn_queue<0>(F, A, ctlptr() + CW_Q + (layer * 4 + 2) * 64, 768); }
        SEAM(pb + 2);
        if (PHM(4) && IN(pb + 3)) { pg8::Gemm g{(const bf16*)(wsptr() + WS_YCAT), (const bf16*)(wsptr() + WS_WOUT) + (size_t)layer * DM * DM, M, DM, DM}; pg8::StaticOrder S; S.init(M, DM, F.G, (int)blockIdx.x);
            pg8::EpiResF32 E{layer == 0 ? inptr(0) : outptr(), outptr(), DM};
            pg8::gemm_phase<pg8::EpiResF32, pg8::StaticOrder, true, true>(F.lds, g, S, E); }
        SEAM(pb + 3);
        if (PHM(5) && IN(pb + 4)) router_phase(F, args, layer);
        SEAM(pb + 4);
        if (PHM(6) && IN(pb + 5)) gather_phase(F, args, layer);
        SEAM(pb + 5);
        if (PHM(7) && IN(pb + 6)) { const int nT = build_tiles(F, layer);
            pg8::Gemm g{(const bf16*)(wsptr() + WS_XG), (const bf16*)(wsptr() + WS_W13) + (size_t)layer * NEXP * 1024 * DM, RPAD, NEXP * 1024, DM};
            pg8::GroupedOrder S{(const LAS unsigned char*)(F.lds + LDS_TILE_E), nT, 4, F.G, (int)blockIdx.x};
            pg8::EpiSiluMul E{(bf16*)(wsptr() + WS_HID), DEXP};
            pg8::gemm_phase<pg8::EpiSiluMul, pg8::GroupedOrder, true, true>(F.lds, g, S, E); }
        SEAM(pb + 6);
        if (PHM(8) && IN(pb + 7)) { const int nT = build_tiles(F, layer);
            pg8::Gemm g{(const bf16*)(wsptr() + WS_HID), (const bf16*)(wsptr() + WS_W2) + (size_t)layer * NEXP * DM * DEXP, RPAD, NEXP * DM, DEXP};
            pg8::GroupedOrder S{(const LAS unsigned char*)(F.lds + LDS_TILE_E), nT, 8, F.G, (int)blockIdx.x};
            pg8::EpiBf16<0> E{(bf16*)(wsptr() + WS_Y), DM, nullptr, DM, 0, 1.f};
            pg8::gemm_phase<pg8::EpiBf16<0>, pg8::GroupedOrder, true, true>(F.lds, g, S, E); }
        SEAM(pb + 7);
        if (PHM(9) && IN(pb + 8)) combine_phase(F, args, layer);
        SEAM(pb + 8);
        if (PHM(10) && IN(pb + 9)) { pg8::Gemm g{U, (const bf16*)(wsptr() + WS_WG) + (size_t)layer * DM * DM, M, DM, DM}; pg8::StaticOrder S; S.init(M, DM, F.G, (int)blockIdx.x);
            pg8::EpiGate E{outptr(), outptr(), (const bf16*)(wsptr() + WS_PL), DM};
            pg8::gemm_phase<pg8::EpiGate, pg8::StaticOrder, true, true>(F.lds, g, S, E); }
        SEAM(pb + 9);
        if (PHM(11) && IN(pb + 10)) endnorm_phase(F, args, layer);
        SEAM(pb + 10);
    }
#undef IN
#undef SEAM
}

#if MK_NAIVE_ATTN
__device__ __forceinline__ int nv_bucket(int d) { return (int)att::REL_BUCKET_TAB[d < 127 ? d : 127]; }
__global__ void __launch_bounds__(256) naive_attn(att::AttnArgs A) {
    const int gwv = blockIdx.x * 4 + (threadIdx.x >> 6), lane = threadIdx.x & 63;
    const int t = gwv >> 4, s = gwv & 15; if (t >= M) return;
    const int b = t / SEQ, pos = t % SEQ; const size_t rowb = (size_t)b * SEQ;
    const unsigned short* proj = A.proj;
    int mode, hh; if (s < 6) { mode = 0; hh = s; } else if (s < 10) { mode = 1; hh = s - 6; } else { mode = 2; hh = s - 10; }
    const int qcol = mode == 0 ? 0 + hh * 128 : mode == 1 ? 1280 + hh * 128 : 2816 + hh * 128;
    const int kcol = mode == 0 ? 768 + (hh / 3) * 128 : mode == 1 ? 1792 + hh * 128 : 3584 + hh * 128;
    const int vcol = mode == 0 ? 1024 + (hh / 3) * 128 : mode == 1 ? 2304 + hh * 128 : 4352 + hh * 128;
    const int ocol = mode == 0 ? hh * 128 : mode == 1 ? 768 + hh * 128 : 1280 + hh * 128;
    const int bh = mode == 0 ? hh : mode == 1 ? 6 + hh : 10 + hh;
    const float scale = mode == 2 ? 0.125f : 0.088388347648318440f;
    unsigned sel = 0u; const int jb = pos >> 8;
    if (mode == 1) {
        const unsigned qv = *(const unsigned*)(proj + (rowb + pos) * NIN + qcol + 2 * lane); const float q0 = __uint_as_float(qv << 16), q1 = __uint_as_float(qv & 0xffff0000u);
        if (jb <= 3) sel = (1u << jb) - 1u;
        else { float g[15];
            for (int n = 0; n < 15; ++n) { g[n] = -INFINITY; if (n < jb) { const float* km = A.kmean + (size_t)(((b * 4 + hh) * 16 + n) * 128) + 2 * lane; g[n] = wave_sum(q0 * km[0] + q1 * km[1]); } }
            for (int pick = 0; pick < 3; ++pick) { float best = -INFINITY; int bi = 0; for (int n = 0; n < 15; ++n) if (n < jb && !((sel >> n) & 1u) && g[n] > best) { best = g[n]; bi = n; } sel |= 1u << bi; } }
    }
    float res0 = 0.f, res1 = 0.f;
    const int npass = mode == 2 ? 2 : 1;
    float lam = 0.f;
    if (mode == 2) { float a = A.lq1[lane] * A.lk1[lane], c2 = A.lq2[lane] * A.lk2[lane]; a = wave_sum(a); c2 = wave_sum(c2); lam = __expf(a) - __expf(c2) + A.lambda_init; }
    for (int pass = 0; pass < npass; ++pass) {
        float q0 = 0.f, q1 = 0.f; const bool qact = (mode != 2) || lane < 32;
        if (qact) { const unsigned qv = *(const unsigned*)(proj + (rowb + pos) * NIN + qcol + pass * 64 + 2 * lane); q0 = __uint_as_float(qv << 16); q1 = __uint_as_float(qv & 0xffff0000u); }
        float m = -1e30f, l = 0.f, o0 = 0.f, o1 = 0.f;
        if (mode == 0) { m = A.sinks[hh]; l = 1.f; }
        const int klo = mode == 0 ? (pos - 127 > 0 ? pos - 127 : 0) : 0;
        for (int k = klo; k <= pos; ++k) {
            if (mode == 1) { const int blk = k >> 8; if (blk < jb && !((sel >> blk) & 1u)) continue; }
            float kk0 = 0.f, kk1 = 0.f;
            if (qact) { const unsigned kv = *(const unsigned*)(proj + (rowb + k) * NIN + kcol + pass * 64 + 2 * lane); kk0 = __uint_as_float(kv << 16); kk1 = __uint_as_float(kv & 0xffff0000u); }
            const float sc = wave_sum(q0 * kk0 + q1 * kk1) * scale + A.rel_bias[nv_bucket(pos - k) * 16 + bh];
            const float mn = fmaxf(m, sc), a = __expf(m - mn), p = __expf(sc - mn);
            const unsigned vv = *(const unsigned*)(proj + (rowb + k) * NIN + vcol + 2 * lane);
            l = l * a + p; o0 = o0 * a + p * __uint_as_float(vv << 16); o1 = o1 * a + p * __uint_as_float(vv & 0xffff0000u); m = mn;
        }
        o0 /= l; o1 /= l;
        if (mode != 2) { res0 = o0; res1 = o1; }
        else if (pass == 0) { res0 = o0; res1 = o1; }
        else { res0 -= lam * o0; res1 -= lam * o1; const float ss = wave_sum(res0 * res0 + res1 * res1); const float sc2 = rsqrtf(ss * (1.f / 128.f) + 1e-6f) * (1.f - A.lambda_init);
            res0 *= sc2 * A.subln[2 * lane]; res1 *= sc2 * A.subln[2 * lane + 1]; }
    }
    *(unsigned*)(A.ycat + (rowb + pos) * DM + ocol + 2 * lane) = pk2rne(res0, res1);
}
#endif
#if MK_NAIVE_MOE
__device__ __forceinline__ float dot_bf16row(const float* x, const unsigned short* w, int n) {
    float s = 0.f;
    for (int k = 0; k < n; k += 8) { const v4u q = *(const v4u*)(w + k);
        s += x[k] * __uint_as_float(q.x << 16) + x[k + 1] * __uint_as_float(q.x & 0xffff0000u) + x[k + 2] * __uint_as_float(q.y << 16) + x[k + 3] * __uint_as_float(q.y & 0xffff0000u)
           + x[k + 4] * __uint_as_float(q.z << 16) + x[k + 5] * __uint_as_float(q.z & 0xffff0000u) + x[k + 6] * __uint_as_float(q.w << 16) + x[k + 7] * __uint_as_float(q.w & 0xffff0000u); }
    return s;
}
__global__ void __launch_bounds__(256) naive_moe(float* h, const float* g_ffn, const float* g_ple, unsigned char* ws, int layer) {
    __shared__ float xf[DM]; __shared__ float hid[DEXP]; __shared__ float red[4];
    const int m = blockIdx.x, tid = threadIdx.x;
    const TokRec t = ((const TokRec*)(ws + WS_TOKREC))[m];
    float hv[8]; float s = 0.f;
    for (int i = 0; i < 8; ++i) { hv[i] = h[(size_t)m * DM + tid + 256 * i]; s += hv[i] * hv[i]; }
    s = wave_sum(s); if ((tid & 63) == 0) red[tid >> 6] = s; __syncthreads();
    const float rstd = rsqrtf((red[0] + red[1] + red[2] + red[3]) * (1.f / DM) + EPS); __syncthreads();
    for (int i = 0; i < 8; ++i) xf[tid + 256 * i] = bfround(hv[i] * rstd * g_ffn[tid + 256 * i]);
    __syncthreads();
    float yacc[8] = {0, 0, 0, 0, 0, 0, 0, 0};
    for (int j = 0; j < 2; ++j) {
        const int e = j ? t.e1 : t.e0; const float w = j ? t.w1 : t.w0;
        const unsigned short* W13 = (const unsigned short*)(ws + WS_W13) + ((size_t)layer * NEXP + e) * 1024 * DM;
        const unsigned short* W2 = (const unsigned short*)(ws + WS_W2) + ((size_t)layer * NEXP + e) * DM * DEXP;
        for (int c = tid; c < DEXP; c += 256) { const int r1 = 256 * (c / 128) + (c % 128); const float a = dot_bf16row(xf, W13 + (size_t)r1 * DM, DM), bb = dot_bf16row(xf, W13 + (size_t)(r1 + 128) * DM, DM);
            hid[c] = bfround(a / (1.f + __expf(-a)) * bb); }
        __syncthreads();
        for (int i = 0; i < 8; ++i) yacc[i] += w * bfround(dot_bf16row(hid, W2 + (size_t)(tid + 256 * i) * DEXP, DEXP));
        __syncthreads();
    }
    s = 0.f;
    for (int i = 0; i < 8; ++i) { hv[i] += yacc[i]; h[(size_t)m * DM + tid + 256 * i] = hv[i]; s += hv[i] * hv[i]; }
    s = wave_sum(s); if ((tid & 63) == 0) red[tid >> 6] = s; __syncthreads();
    const float rstd2 = rsqrtf((red[0] + red[1] + red[2] + red[3]) * (1.f / DM) + EPS);
    unsigned short* u = (unsigned short*)(ws + WS_U) + (size_t)m * DM;
    for (int i = 0; i < 8; ++i) u[tid + 256 * i] = (unsigned short)(pk2rne(hv[i] * rstd2 * g_ple[(size_t)layer * DM + tid + 256 * i], 0.f) & 0xffffu);
}
#endif

extern "C" void kernel_launch(void* const* d_in, const int* in_sizes, int n_in, void* d_out, int out_size, void* d_ws, size_t ws_size, hipStream_t stream) {
    static int grid = 0;
    if (grid == 0) {
        if (n_in != 22 || in_sizes[0] != M * DM || out_size != M * DM || ws_size < WS_END) { fprintf(stderr, "kernel_launch: shape mismatch (n_in %d, in0 %d, out %d, ws %zu < %zu); nothing launched\n", n_in, n_in > 0 ? in_sizes[0] : -1, out_size, ws_size, (size_t)WS_END); grid = -1; return; }
        int dev = 0, cus = 0, per_cu = 0;
        if (hipGetDevice(&dev) != hipSuccess || hipDeviceGetAttribute(&cus, hipDeviceAttributeMultiprocessorCount, dev) != hipSuccess) { grid = -1; return; }
        if (hipFuncSetAttribute((const void*)mk_fwd, hipFuncAttributeMaxDynamicSharedMemorySize, LDS_BYTES) != hipSuccess) { fprintf(stderr, "kernel_launch: hipFuncSetAttribute failed\n"); grid = -1; return; }
        if (hipOccupancyMaxActiveBlocksPerMultiprocessor(&per_cu, (const void*)mk_fwd, NWAVES * 64, LDS_BYTES) != hipSuccess || per_cu < 1) { fprintf(stderr, "kernel_launch: occupancy query says %d blocks per CU\n", per_cu); }
        (void)hipGetLastError();
        grid = cus;
    }
    if (grid < 0) return;
    if (hipMemsetAsync((char*)d_ws + WS_CTL, 0, CTL_ZERO_BYTES, stream) != hipSuccess) return;
    Args a{};
    for (int i = 0; i < 22; ++i) a.in[i] = (const float*)d_in[i];
    a.out = (float*)d_out; a.ws = (unsigned char*)d_ws;
#if MK_PER_PHASE
    a.use_bar = 0;
    for (int ph = 0; ph < NPHASES; ++ph) {
        const int layer = ph > 0 ? (ph - 1) / NPH_LAYER : -1, k = ph > 0 ? (ph - 1) % NPH_LAYER : -1;
#if MK_NAIVE_ATTN
        if (k == 2) { att::AttnArgs A{}; A.proj = (const unsigned short*)((char*)d_ws + WS_PROJ); A.ycat = (unsigned short*)((char*)d_ws + WS_YCAT); A.kmean = (const float*)((char*)d_ws + WS_KMEAN); A.rel_bias = a.in[2];
            A.sinks = a.in[6] + layer * 6; A.lq1 = a.in[7] + layer * 64; A.lk1 = a.in[8] + layer * 64; A.lq2 = a.in[9] + layer * 64; A.lk2 = a.in[10] + layer * 64; A.subln = a.in[11] + layer * 128;
            A.lambda_init = 0.8f - 0.6f * expf(-0.3f * (float)layer);
            hipLaunchKernelGGL(naive_attn, dim3(M * 16 / 4), dim3(256), 0, stream, A); continue; }
#endif
#if MK_NAIVE_MOE
        if (k == 5) { hipLaunchKernelGGL(naive_moe, dim3(M), dim3(256), 0, stream, (float*)d_out, a.in[13] + (size_t)layer * DM, a.in[19], (unsigned char*)d_ws, layer); continue; }
        if (k == 6 || k == 7 || k == 8) continue;
#endif
        a.ph_lo = ph; a.ph_hi = ph + 1;
        hipLaunchKernelGGL(mk_fwd, dim3(grid), dim3(NWAVES * 64), LDS_BYTES, stream, a);
    }
#else
    a.use_bar = 1; a.ph_lo = 0; a.ph_hi = NPHASES;
    hipLaunchKernelGGL(mk_fwd, dim3(grid), dim3(NWAVES * 64), LDS_BYTES, stream, a);
#endif
    const hipError_t le = hipPeekAtLastError();
    if (le != hipSuccess) fprintf(stderr, "kernel_launch: launch failed: %s\n", hipGetErrorName(le));
}
```

```cpp
#include <hip/hip_runtime.h>
#include <hip/hip_bf16.h>
#include <cstdio>
#include <cstdint>
#include <cmath>
#ifndef MK_PER_PHASE
#define MK_PER_PHASE 0
#endif
__device__ __forceinline__ int mk_lane() { unsigned m = ~0u; asm volatile("" : "+s"(m)); return (int)__builtin_amdgcn_mbcnt_hi(m, __builtin_amdgcn_mbcnt_lo(m, 0u)); }
__device__ __forceinline__ float mk_shfl_xor_l(float v, int o, int l) { return __uint_as_float((unsigned)__builtin_amdgcn_ds_bpermute((l ^ o) << 2, (int)__float_as_uint(v))); }
__device__ __forceinline__ float mk_shfl_xor(float v, int o) { return mk_shfl_xor_l(v, o, mk_lane()); }
#define CAS __attribute__((address_space(4)))
__device__ __forceinline__ const CAS char* kargs() { const CAS char* kp = (const CAS char*)__builtin_amdgcn_kernarg_segment_ptr(); asm volatile("" : "+s"(kp)); return kp; }
__device__ __forceinline__ const float* inptr(int k) { return *(const float* const CAS*)(kargs() + 8 * k); }
__device__ __forceinline__ float* outptr() { return *(float* const CAS*)(kargs() + 176); }
__device__ __forceinline__ unsigned char* wsptr() { return *(unsigned char* const CAS*)(kargs() + 184); }
namespace pg8 {
#define PG8_LAS __attribute__((address_space(3)))
typedef unsigned short bf16_t;
typedef short bf16x8 __attribute__((ext_vector_type(8)));
typedef float f32x4 __attribute__((ext_vector_type(4)));
typedef unsigned u32x4 __attribute__((ext_vector_type(4)));
constexpr int BM = 256, BK = 64, HALF = 128, HTB = HALF * BK * 2  , STAGE_BYTES = 8 * HTB, NXCD = 8, WGM = 8;

__host__ __device__ __forceinline__ int lds_byte(int r, int c) { const int st = (r >> 4) * 2 + (c >> 5), rr = r & 15, cc = c & 31, ob = rr * 64 + cc * 2; return st * 1024 + (ob ^ (((ob >> 9) & 1) << 5)); }
__host__ __device__ __forceinline__ void stage_rc(int b, int& R, int& C) { const int st = b / 1024, sb = b % 1024, swz = sb ^ (((sb >> 9) & 1) << 5); R = (st >> 1) * 16 + swz / 64; C = (st & 1) * 32 + (swz % 64) / 2; }
__host__ __device__ __forceinline__ int perm32(int rho) { const int n = rho >> 4, i = rho & 15; return 8 * (i >> 2) + 4 * n + (i & 3); }

struct Unit { int pm, pn; };
struct Gemm { const bf16_t* A; const bf16_t* Bt; int M, N, K; };

struct StaticOrder {
    static constexpr bool B_NT = false;
    int nM, nN, nwg, G, c;
    __host__ __device__ void init(int M, int N, int G_, int c_) { nM = M / BM; nN = N / BM; nwg = nM * nN; G = G_; c = c_; }
    __host__ __device__ bool next(int i, Unit& u) const {
        const long L = (long)i * G + c; if (L >= nwg) return false;
        int wgid = (int)L; { const int q = nwg / NXCD, r = nwg % NXCD, xcd = wgid % NXCD, off = wgid / NXCD; wgid = (xcd < r ? xcd * (q + 1) : r * (q + 1) + (xcd - r) * q) + off; }
        const int nig = WGM * nN, gid = wgid / nig, fm = gid * WGM, gsz = (nM - fm) < WGM ? (nM - fm) : WGM;
        u.pm = fm + ((wgid % nig) % gsz); u.pn = (wgid % nig) / gsz; return true;
    }
    __device__ __forceinline__ void a_ready(const Unit&) const {}
    __device__ __forceinline__ void done(const Unit&) const {}
    __device__ __forceinline__ int row_tok(const Unit&, int) const { return 0; }
};

__device__ __forceinline__ unsigned cvt_pk_bf16(float lo, float hi) { unsigned r; asm volatile("v_cvt_pk_bf16_f32 %0, %1, %2" : "=v"(r) : "v"(lo), "v"(hi)); return r; }
typedef float f32x2 __attribute__((ext_vector_type(2)));
template <int ACT  > struct EpiBf16 {
    static constexpr bool PERM = true, AFTER_DRAIN = false, PROBE = false; static_assert(ACT == 0 || ACT == 1, "EpiBf16: ACT is 0 (none) or 1 (gelu_pk)");
    bf16_t* O; int ldc; const float* bias; int split_cols; size_t split_stride; float scale0; const float* rowscale; int nt;
    __device__ __forceinline__ void operator()(const f32x4 (&acc)[2][2][4][2], const Unit& u, int wr, int wc, int fr, int fq) const {
        const int row0 = u.pm * BM + wr * 64 + fr; int colt = u.pn * BM; bf16_t* base = O;
        float sc = 1.f; if (split_cols) { const int t = colt / split_cols; base += (size_t)t * split_stride; colt -= t * split_cols; if (t == 0) sc = scale0; }
        const int col0 = colt + wc * 32 + 8 * fq, bcol0 = u.pn * BM + wc * 32 + 8 * fq;
        f32x4 bv[2][2];
#pragma unroll
        for (int bj = 0; bj < 2; ++bj)
#pragma unroll
            for (int n = 0; n < 2; ++n) bv[bj][n] = bias ? *(const f32x4*)(bias + bcol0 + bj * HALF + 4 * n) : (f32x4){0.f, 0.f, 0.f, 0.f};
#pragma unroll
        for (int ai = 0; ai < 2; ++ai)
#pragma unroll
            for (int m = 0; m < 4; ++m) { bf16_t* rowp = base + (size_t)(row0 + ai * HALF + m * 16) * ldc + col0; const float rsc = rowscale ? rowscale[row0 + ai * HALF + m * 16] * sc : sc;
#pragma unroll
                for (int bj = 0; bj < 2; ++bj) { f32x4 v0 = acc[ai][bj][m][0] + bv[bj][0], v1 = acc[ai][bj][m][1] + bv[bj][1];
                    v0 = v0 * rsc; v1 = v1 * rsc; u32x4 w; w.x = cvt_pk_bf16(v0[0], v0[1]); w.y = cvt_pk_bf16(v0[2], v0[3]); w.z = cvt_pk_bf16(v1[0], v1[1]); w.w = cvt_pk_bf16(v1[2], v1[3]);
                    if (nt) __builtin_nontemporal_store(w, (u32x4*)(rowp + bj * HALF)); else *(u32x4*)(rowp + bj * HALF) = w; } }
    }
};

__device__ __forceinline__ float bflo(unsigned w) { return __uint_as_float(w << 16); }
__device__ __forceinline__ float bfhi(unsigned w) { return __uint_as_float(w & 0xffff0000u); }
struct EpiRes {
    static constexpr bool PERM = true, AFTER_DRAIN = false, PROBE = true;
    bf16_t* hb; int ldc;
    __device__ __forceinline__ void operator()(const f32x4 (&acc)[2][2][4][2], const Unit& u, int wr, int wc, int fr, int fq) const {
        const int row0 = u.pm * BM + wr * 64 + fr, col0 = u.pn * BM + wc * 32 + 8 * fq;
        u32x4 q[2][4][2];
#pragma unroll
        for (int ai = 0; ai < 2; ++ai)
#pragma unroll
            for (int m = 0; m < 4; ++m)
#pragma unroll
                for (int bj = 0; bj < 2; ++bj) q[ai][m][bj] = *(const u32x4*)(hb + (size_t)(row0 + ai * HALF + m * 16) * ldc + col0 + bj * HALF);
#pragma unroll
        for (int ai = 0; ai < 2; ++ai)
#pragma unroll
            for (int m = 0; m < 4; ++m)
#pragma unroll
                for (int bj = 0; bj < 2; ++bj) { const u32x4 qq = q[ai][m][bj]; const f32x4 a0 = acc[ai][bj][m][0], a1 = acc[ai][bj][m][1];
                    u32x4 w; w.x = cvt_pk_bf16(bflo(qq.x) + a0[0], bfhi(qq.x) + a0[1]); w.y = cvt_pk_bf16(bflo(qq.y) + a0[2], bfhi(qq.y) + a0[3]); w.z = cvt_pk_bf16(bflo(qq.z) + a1[0], bfhi(qq.z) + a1[1]); w.w = cvt_pk_bf16(bflo(qq.w) + a1[2], bfhi(qq.w) + a1[3]);
                    *(u32x4*)(hb + (size_t)(row0 + ai * HALF + m * 16) * ldc + col0 + bj * HALF) = w; }
    }
};
__device__ __forceinline__ float sigmoidf_(float a) { return __builtin_amdgcn_rcpf(1.0f + __builtin_amdgcn_exp2f(-1.4426950408889634f * a)); }
struct EpiSiluMul {
    static constexpr bool PERM = true, AFTER_DRAIN = false, PROBE = false;
    bf16_t* O; int ldc; const int* list; const PG8_LAS int* offs; const float* rstd;
    __device__ __forceinline__ void operator()(const f32x4 (&acc)[2][2][4][2], const Unit& u, int wr, int wc, int fr, int fq) const {
        const int row0 = u.pm * BM + wr * 64 + fr, col0 = (u.pn & 3) * HALF + wc * 32 + 8 * fq;
        const int e = u.pn >> 2; const float* lp = rstd + e * 32768 + (u.pm * BM - offs[e]) + wr * 64 + fr;
        float rsv[2][4];
#pragma unroll
        for (int ai = 0; ai < 2; ++ai)
#pragma unroll
            for (int m = 0; m < 4; ++m) rsv[ai][m] = lp[ai * HALF + m * 16];
#pragma unroll
        for (int ai = 0; ai < 2; ++ai)
#pragma unroll
            for (int m = 0; m < 4; ++m) { bf16_t* rowp = O + (size_t)(row0 + ai * HALF + m * 16) * ldc + col0;
                const float rs = rsv[ai][m];
                f32x4 v0, v1;
#pragma unroll
                for (int i = 0; i < 4; ++i) { const float a0 = acc[ai][0][m][0][i] * rs, a1 = acc[ai][0][m][1][i] * rs;
                    v0[i] = a0 * sigmoidf_(a0) * (acc[ai][1][m][0][i] * rs); v1[i] = a1 * sigmoidf_(a1) * (acc[ai][1][m][1][i] * rs); }
                u32x4 w; w.x = cvt_pk_bf16(v0[0], v0[1]); w.y = cvt_pk_bf16(v0[2], v0[3]); w.z = cvt_pk_bf16(v1[0], v1[1]); w.w = cvt_pk_bf16(v1[2], v1[3]);
                *(u32x4*)rowp = w; }
    }
};
struct EpiGate {
    static constexpr bool PERM = true, AFTER_DRAIN = false, PROBE = false;
    const bf16_t* hin; bf16_t* hout; const bf16_t* PL; const float* rs; int ldc; float* part;
    __device__ __forceinline__ void operator()(const f32x4 (&acc)[2][2][4][2], const Unit& u, int wr, int wc, int fr, int fq) const {
        const int row0 = u.pm * BM + wr * 64 + fr, col0 = u.pn * BM + wc * 32 + 8 * fq;
#pragma unroll
        for (int ai = 0; ai < 2; ++ai) { u32x4 q[4][2], p[4][2]; float r_[4], ss[4];
#pragma unroll
            for (int m = 0; m < 4; ++m) { r_[m] = rs[row0 + ai * HALF + m * 16];
#pragma unroll
                for (int bj = 0; bj < 2; ++bj) { const size_t off = (size_t)(row0 + ai * HALF + m * 16) * ldc + col0 + bj * HALF; q[m][bj] = __builtin_nontemporal_load((const u32x4*)(hin + off)); p[m][bj] = __builtin_nontemporal_load((const u32x4*)(PL + off)); } }
#pragma unroll
            for (int m = 0; m < 4; ++m) { float s = 0.f;
#pragma unroll
                for (int bj = 0; bj < 2; ++bj) { const u32x4 qq = q[m][bj], pp = p[m][bj]; const f32x4 a0 = acc[ai][bj][m][0] * r_[m], a1 = acc[ai][bj][m][1] * r_[m];
                    const float v0 = bflo(qq.x) + sigmoidf_(a0[0]) * bflo(pp.x), v1 = bfhi(qq.x) + sigmoidf_(a0[1]) * bfhi(pp.x), v2 = bflo(qq.y) + sigmoidf_(a0[2]) * bflo(pp.y), v3 = bfhi(qq.y) + sigmoidf_(a0[3]) * bfhi(pp.y);
                    const float v4 = bflo(qq.z) + sigmoidf_(a1[0]) * bflo(pp.z), v5 = bfhi(qq.z) + sigmoidf_(a1[1]) * bfhi(pp.z), v6 = bflo(qq.w) + sigmoidf_(a1[2]) * bflo(pp.w), v7 = bfhi(qq.w) + sigmoidf_(a1[3]) * bfhi(pp.w);
                    u32x4 w; w.x = cvt_pk_bf16(v0, v1); w.y = cvt_pk_bf16(v2, v3); w.z = cvt_pk_bf16(v4, v5); w.w = cvt_pk_bf16(v6, v7);
                    s += ((v0 * v0 + v1 * v1) + (v2 * v2 + v3 * v3)) + ((v4 * v4 + v5 * v5) + (v6 * v6 + v7 * v7));
                    *(u32x4*)(hout + (size_t)(row0 + ai * HALF + m * 16) * ldc + col0 + bj * HALF) = w; }
                ss[m] = s; }
            if (part) { const int l = mk_lane();
#pragma unroll
                for (int m = 0; m < 4; ++m) { float s = ss[m]; s += mk_shfl_xor_l(s, 16, l); s += mk_shfl_xor_l(s, 32, l);
                    if (fq == 0) part[(size_t)(row0 + ai * HALF + m * 16) * 32 + 4 * u.pn + wc] = s; } }
            asm volatile("" ::: "memory"); }
    }
};
__device__ __forceinline__ float row_sum16(float v) {
    v += __int_as_float(__builtin_amdgcn_update_dpp(0, __float_as_int(v), 0x128, 0xf, 0xf, false));
    v += __int_as_float(__builtin_amdgcn_update_dpp(0, __float_as_int(v), 0x124, 0xf, 0xf, false));
    v += __int_as_float(__builtin_amdgcn_update_dpp(0, __float_as_int(v), 0x122, 0xf, 0xf, false));
    v += __int_as_float(__builtin_amdgcn_update_dpp(0, __float_as_int(v), 0x121, 0xf, 0xf, false));
    return v;
}
struct EpiProj {
    static constexpr bool PERM = true, AFTER_DRAIN = false, PROBE = false;
    bf16_t* O; int ldc; const PG8_LAS int* tab; const PG8_LAS float* rs; float* kp; int kt0, kpn; const float* rsg;
    __device__ __forceinline__ void operator()(const f32x4 (&acc)[2][2][4][2], const Unit& u, int wr, int wc, int fr, int fq) const {
        const int row0 = u.pm * BM + wr * 64 + fr, col0 = u.pn * BM + wc * 32 + 8 * fq;
        int s = -1;
#pragma unroll
        for (int k = 0; k < 4; ++k) s = (tab[k] == u.pm) ? k : s;
        s = __builtin_amdgcn_readfirstlane(s);
        float rsv[2][4];
        if (s >= 0) { const PG8_LAS float* r = rs + s * 256 + wr * 64 + fr;
#pragma unroll
            for (int ai = 0; ai < 2; ++ai)
#pragma unroll
                for (int m = 0; m < 4; ++m) rsv[ai][m] = r[ai * HALF + m * 16]; }
        else { const float* rg = rsg + row0;
#pragma unroll
            for (int ai = 0; ai < 2; ++ai)
#pragma unroll
                for (int m = 0; m < 4; ++m) { rsv[ai][m] = rg[ai * HALF + m * 16]; asm volatile("" : "+v"(rsv[ai][m])); } }
        if (u.pn == kt0 || u.pn == kt0 + 1) {
            float cs[2][8];
#pragma unroll
            for (int bj = 0; bj < 2; ++bj)
#pragma unroll
                for (int i = 0; i < 8; ++i) cs[bj][i] = 0.f;
#pragma unroll
            for (int ai = 0; ai < 2; ++ai)
#pragma unroll
                for (int m = 0; m < 4; ++m) { bf16_t* rowp = O + (size_t)(row0 + ai * HALF + m * 16) * ldc + col0; const float rsc = rsv[ai][m];
#pragma unroll
                    for (int bj = 0; bj < 2; ++bj) { const f32x4 v0 = acc[ai][bj][m][0] * rsc, v1 = acc[ai][bj][m][1] * rsc;
                        u32x4 w; w.x = cvt_pk_bf16(v0[0], v0[1]); w.y = cvt_pk_bf16(v0[2], v0[3]); w.z = cvt_pk_bf16(v1[0], v1[1]); w.w = cvt_pk_bf16(v1[2], v1[3]);
                        cs[bj][0] += bflo(w.x); cs[bj][1] += bfhi(w.x); cs[bj][2] += bflo(w.y); cs[bj][3] += bfhi(w.y); cs[bj][4] += bflo(w.z); cs[bj][5] += bfhi(w.z); cs[bj][6] += bflo(w.w); cs[bj][7] += bfhi(w.w);
                        *(u32x4*)(rowp + bj * HALF) = w; } }
#pragma unroll
            for (int bj = 0; bj < 2; ++bj) { f32x4 a, b;
#pragma unroll
                for (int i = 0; i < 4; ++i) { a[i] = row_sum16(cs[bj][i]); b[i] = row_sum16(cs[bj][4 + i]); }
                if (fr == 0) { float* dp = kp + (size_t)wr * kpn + (size_t)((((u.pm >> 4) * 4 + (u.pn - kt0) * 2 + bj) * 16 + (u.pm & 15)) * 128 + wc * 32 + 8 * fq); *(f32x4*)dp = a; *(f32x4*)(dp + 4) = b; } }
            return;
        }
#pragma unroll
        for (int ai = 0; ai < 2; ++ai)
#pragma unroll
            for (int m = 0; m < 4; ++m) { bf16_t* rowp = O + (size_t)(row0 + ai * HALF + m * 16) * ldc + col0; const float rsc = rsv[ai][m];
#pragma unroll
                for (int bj = 0; bj < 2; ++bj) { const f32x4 v0 = acc[ai][bj][m][0] * rsc, v1 = acc[ai][bj][m][1] * rsc;
                    u32x4 w; w.x = cvt_pk_bf16(v0[0], v0[1]); w.y = cvt_pk_bf16(v0[2], v0[3]); w.z = cvt_pk_bf16(v1[0], v1[1]); w.w = cvt_pk_bf16(v1[2], v1[3]);
                    *(u32x4*)(rowp + bj * HALF) = w; } }
    }
};
struct GroupedOrder {
    static constexpr bool B_NT = false;
    const PG8_LAS unsigned char* tile_e; int nTiles, nN, G, c;
    const int* list; const PG8_LAS int* offs;
    __device__ __forceinline__ bool next(int i, Unit& u) const {
        const int x = c & 7, slot = c >> 3, per = G >> 3; int L = i * per + slot;
#pragma unroll
        for (int k = 0; k < 4; ++k) { const int e = x + 8 * k; const int t0 = offs[e] >> 8, t1 = (e == 31) ? nTiles : (offs[e + 1] >> 8); const int n = (t1 - t0) * nN;
            if (L < n) { u.pm = __builtin_amdgcn_readfirstlane(t0 + L / nN); u.pn = __builtin_amdgcn_readfirstlane(e * nN + L % nN); return true; }
            L -= n; }
        return false;
    }
    __device__ __forceinline__ void a_ready(const Unit&) const {}
    __device__ __forceinline__ void done(const Unit&) const {}
    static constexpr int LTAB_UNITS = 8;
    const PG8_LAS int* ltab;
    __device__ __forceinline__ int row_tok(const Unit& u, int r, int ord) const { if (ltab != nullptr && ord < LTAB_UNITS) return ltab[ord * 256 + r]; const int e = u.pn / nN; int v = list[e * 32768 + (u.pm * BM - offs[e]) + r];
        asm volatile("" : "+v"(v)); return v; }
};
template <class Epi, class Sched, bool ALIGN_EPI = false, bool SP2 = false, bool GATHER = false>
__device__ __forceinline__ void gemm_phase(PG8_LAS unsigned char* lds, const Gemm g, const Sched& S, const Epi& E, const int wave_idx) {
    int wid_o = wave_idx; asm volatile("" : "+s"(wid_o));
    const int tid = wid_o * 64 + mk_lane(), wid = wid_o    , lane = tid & 63, wr = wid >> 2, wc = wid & 3, fr = lane & 15, fq = lane >> 4;
    const int K = g.K, nt = K / BK;
    unsigned voffA[2], voffB[2];
#pragma unroll
    for (int i = 0; i < 2; ++i) { int R, C; stage_rc(tid * 16 + i * 8192, R, C); const int Rb = Epi::PERM ? ((R & ~31) + perm32(R & 31)) : R;
        voffA[i] = (unsigned)(R * K + C) * 2u; voffB[i] = (unsigned)(Rb * K + C) * 2u; }
    const size_t kstep = (size_t)(BK * 2);
    const size_t hstep = (size_t)HALF * K * 2;
    const size_t tstep = 2 * hstep;
    const unsigned ldsw = (unsigned)wid * 1024u;
    const int aoff = lds_byte(wr * 64 + fr, fq * 8), boff = lds_byte(wc * 32 + fr, fq * 8);
#define PG8_SA(b, h) (((b) * 2 + (h)) * HTB)
#define PG8_SB(b, h) ((4 + (b) * 2 + (h)) * HTB)
#define PG8_STAGE(bufoff, gbase, voff) do { _Pragma("unroll") for (int _i = 0; _i < 2; ++_i) \
        __builtin_amdgcn_global_load_lds((const unsigned*)((const char*)(gbase) + (voff)[_i]), (PG8_LAS unsigned*)(lds + (bufoff) + ldsw + _i * 8192), 16, 0, 0); } while (0)
#define PG8_STAGE_B(bufoff, gbase, voff) do { _Pragma("unroll") for (int _i = 0; _i < 2; ++_i) \
        __builtin_amdgcn_global_load_lds((const unsigned*)((const char*)(gbase) + (voff)[_i]), (PG8_LAS unsigned*)(lds + (bufoff) + ldsw + _i * 8192), 16, 0, Sched::B_NT ? 2 : 0); } while (0)
#define PG8_STAGE_A(bufoff, base, hh_, nx_) do { if constexpr (GATHER) { unsigned og_[2] = {(nx_) ? offN[hh_][0] : offA[hh_][0], (nx_) ? offN[hh_][1] : offA[hh_][1]}; asm volatile("" : "+v"(og_[0]), "+v"(og_[1]));   PG8_STAGE(bufoff, base, og_); } \
        else PG8_STAGE(bufoff, (base) + ((hh_) ? hstep : 0), voffA); } while (0)
#define PG8_ROWOFFS(dst, un, ord) do { _Pragma("unroll") for (int h_ = 0; h_ < 2; ++h_) _Pragma("unroll") for (int i_ = 0; i_ < 2; ++i_) { int R_, C_; stage_rc(tid * 16 + i_ * 8192, R_, C_); \
        dst[h_][i_] = ((unsigned)S.row_tok(un, h_ * HALF + R_, ord) & 0x7fffu) * (unsigned)(K * 2) + (unsigned)(C_ * 2); } } while (0)
#define PG8_LDA(dst, b, h) do { _Pragma("unroll") for (int m = 0; m < 4; ++m) _Pragma("unroll") for (int k = 0; k < 2; ++k) dst[m][k] = *(const PG8_LAS bf16x8*)(lds + PG8_SA(b, h) + aoff + m * 2048 + k * 1024); } while (0)
#define PG8_LDB(dst, b, h) do { _Pragma("unroll") for (int n = 0; n < 2; ++n) _Pragma("unroll") for (int k = 0; k < 2; ++k) dst[n][k] = *(const PG8_LAS bf16x8*)(lds + PG8_SB(b, h) + boff + n * 2048 + k * 1024); } while (0)
#define PG8_MMA(ai, bj, At, Bt) do { __builtin_amdgcn_s_setprio(1); _Pragma("unroll") for (int m = 0; m < 4; ++m) _Pragma("unroll") for (int n = 0; n < 2; ++n) _Pragma("unroll") for (int k = 0; k < 2; ++k) \
        acc[ai][bj][m][n] = __builtin_amdgcn_mfma_f32_16x16x32_bf16(Bt[n][k], At[m][k], acc[ai][bj][m][n], 0, 0, 0); __builtin_amdgcn_s_setprio(0); } while (0)
#define PG8_WAIT_V(n) asm volatile("s_waitcnt vmcnt(" #n ")" ::: "memory")
#define PG8_WAIT_L(n) asm volatile("s_waitcnt lgkmcnt(" #n ")" ::: "memory")
#define PG8_BAR __builtin_amdgcn_s_barrier()
#define PG8_SCHED __builtin_amdgcn_sched_barrier(0)
    Unit cur, nxt; int ui = 0;
    if (!S.next(0, cur)) return;
    f32x4 acc[2][2][4][2];
#pragma unroll
    for (int a = 0; a < 2; ++a)
#pragma unroll
        for (int b = 0; b < 2; ++b)
#pragma unroll
            for (int m = 0; m < 4; ++m)
#pragma unroll
                for (int n = 0; n < 2; ++n) acc[a][b][m][n] = (f32x4){0.f, 0.f, 0.f, 0.f};
    bf16x8 At[4][2], B0[2][2], B1[2][2];
    const char* cA = (const char*)g.A + (GATHER ? (size_t)0 : (size_t)cur.pm * tstep);
    unsigned offA[2][2] = {{0u, 0u}, {0u, 0u}}, offN[2][2] = {{0u, 0u}, {0u, 0u}};
    if constexpr (GATHER) PG8_ROWOFFS(offA, cur, 0); const char* cB = (const char*)g.Bt + (size_t)cur.pn * tstep;
    S.a_ready(cur);
    if constexpr (SP2) {
        PG8_STAGE_B(PG8_SB(0, 0), cB, voffB); PG8_STAGE_B(PG8_SB(0, 1), cB + hstep, voffB); PG8_STAGE_A(PG8_SA(0, 0), cA, 0, false); PG8_STAGE_A(PG8_SA(0, 1), cA, 1, false);
        if (wr == 1) PG8_BAR;
        PG8_WAIT_V(2); PG8_BAR;
        PG8_STAGE_B(PG8_SB(1, 0), cB + kstep, voffB); PG8_STAGE_A(PG8_SA(1, 0), cA + kstep, 0, false); PG8_STAGE_B(PG8_SB(1, 1), cB + hstep + kstep, voffB);
        PG8_WAIT_V(6); PG8_BAR;
    } else {
        PG8_STAGE_B(PG8_SB(0, 0), cB, voffB); PG8_STAGE_A(PG8_SA(0, 0), cA, 0, false); PG8_STAGE_B(PG8_SB(0, 1), cB + hstep, voffB); PG8_STAGE_A(PG8_SA(0, 1), cA, 1, false);
        if (wr == 1) PG8_BAR;
        PG8_WAIT_V(4); PG8_BAR;
        PG8_STAGE_B(PG8_SB(1, 0), cB + kstep, voffB); PG8_STAGE_A(PG8_SA(1, 0), cA + kstep, 0, false); PG8_STAGE_B(PG8_SB(1, 1), cB + hstep + kstep, voffB);
        PG8_WAIT_V(6); PG8_BAR;
    }
    for (;;) {
        const bool has_next = S.next(ui + 1, nxt);
        const char* nA = (has_next && !GATHER) ? (const char*)g.A + (size_t)nxt.pm * tstep : cA;
        if constexpr (GATHER) { if (has_next) PG8_ROWOFFS(offN, nxt, ui + 1); else { offN[0][0] = offA[0][0]; offN[0][1] = offA[0][1]; offN[1][0] = offA[1][0]; offN[1][1] = offA[1][1]; } } const char* nB = has_next ? (const char*)g.Bt + (size_t)nxt.pn * tstep : cB;
        for (int t = 0; t < nt; t += 2) {
            const bool last = (t == nt - 2);
            const char* a1 = cA + (size_t)(t + 1) * kstep;
            const char* a2 = last ? nA : cA + (size_t)(t + 2) * kstep; const char* b2 = last ? nB : cB + (size_t)(t + 2) * kstep;
            const char* a3 = a2 + kstep; const char* b3 = b2 + kstep;
            if (last && has_next) S.a_ready(nxt);
            if constexpr (SP2) {
            PG8_LDB(B0, 0, 0); PG8_LDB(B1, 0, 1); PG8_SCHED; PG8_LDA(At, 0, 0); PG8_STAGE_A(PG8_SA(1, 1), a1, 1, false);
            PG8_WAIT_V(8); PG8_WAIT_L(0); PG8_BAR; PG8_MMA(0, 0, At, B0); PG8_MMA(0, 1, At, B1); PG8_BAR; PG8_SCHED;
            PG8_LDA(At, 0, 1); PG8_STAGE_B(PG8_SB(0, 0), b2, voffB); PG8_STAGE_B(PG8_SB(0, 1), b2 + hstep, voffB); PG8_STAGE_A(PG8_SA(0, 0), a2, 0, last);
            PG8_WAIT_V(8); PG8_WAIT_L(0); PG8_BAR; PG8_MMA(1, 0, At, B0); PG8_MMA(1, 1, At, B1); PG8_BAR; PG8_SCHED;
            PG8_LDB(B0, 1, 0); PG8_LDB(B1, 1, 1); PG8_SCHED; PG8_LDA(At, 1, 0); PG8_STAGE_A(PG8_SA(0, 1), a2, 1, last);
            PG8_WAIT_V(8); PG8_WAIT_L(0); PG8_BAR; PG8_MMA(0, 0, At, B0); PG8_MMA(0, 1, At, B1); PG8_BAR; PG8_SCHED;
            PG8_LDA(At, 1, 1); PG8_STAGE_B(PG8_SB(1, 0), b3, voffB); PG8_STAGE_B(PG8_SB(1, 1), b3 + hstep, voffB); PG8_STAGE_A(PG8_SA(1, 0), a3, 0, last);
            PG8_WAIT_V(8); PG8_WAIT_L(0); PG8_BAR; PG8_MMA(1, 0, At, B0); PG8_MMA(1, 1, At, B1); PG8_BAR; PG8_SCHED;
            } else {
            PG8_LDB(B0, 0, 0); PG8_SCHED; PG8_LDA(At, 0, 0); PG8_STAGE_A(PG8_SA(1, 1), a1, 1, false);
            PG8_WAIT_L(8); PG8_BAR; PG8_WAIT_L(0); PG8_MMA(0, 0, At, B0); PG8_BAR; PG8_SCHED;
            PG8_LDB(B1, 0, 1); PG8_STAGE_B(PG8_SB(0, 0), b2, voffB);
            PG8_BAR; PG8_WAIT_L(0); PG8_MMA(0, 1, At, B1); PG8_BAR;
            PG8_LDA(At, 0, 1); PG8_STAGE_A(PG8_SA(0, 0), a2, 0, last);
            PG8_BAR; PG8_WAIT_L(0); PG8_MMA(1, 0, At, B0); PG8_BAR; PG8_SCHED;
            PG8_STAGE_B(PG8_SB(0, 1), b2 + hstep, voffB);
            PG8_WAIT_V(6); PG8_BAR; PG8_MMA(1, 1, At, B1); PG8_BAR;
            PG8_LDB(B0, 1, 0); PG8_SCHED; PG8_LDA(At, 1, 0); PG8_STAGE_A(PG8_SA(0, 1), a2, 1, last);
            PG8_WAIT_L(8); PG8_BAR; PG8_WAIT_L(0); PG8_MMA(0, 0, At, B0); PG8_BAR; PG8_SCHED;
            PG8_LDB(B1, 1, 1); PG8_STAGE_B(PG8_SB(1, 0), b3, voffB);
            PG8_BAR; PG8_WAIT_L(0); PG8_MMA(0, 1, At, B1); PG8_BAR;
            PG8_LDA(At, 1, 1); PG8_STAGE_A(PG8_SA(1, 0), a3, 0, last);
            PG8_BAR; PG8_WAIT_L(0); PG8_MMA(1, 0, At, B0); PG8_BAR; PG8_SCHED;
            PG8_STAGE_B(PG8_SB(1, 1), b3 + hstep, voffB);
            PG8_WAIT_V(6); PG8_BAR; PG8_MMA(1, 1, At, B1); PG8_BAR;
            }
        }
        if constexpr (ALIGN_EPI) { if (wr == 0) PG8_BAR; }
#ifdef PG8_EPI_PROBE
        if constexpr (!Epi::AFTER_DRAIN) { unsigned long long t0_ = 0ull; if constexpr (Epi::PROBE) t0_ = __builtin_amdgcn_s_memrealtime();
            E(acc, cur, wr, wc, fr, fq); S.done(cur);
            if constexpr (Epi::PROBE) { if (blockIdx.x == 0 && wid == 0 && mk_lane() == 0) *(PG8_LAS unsigned long long*)(lds + PG8_EPI_PROBE) += __builtin_amdgcn_s_memrealtime() - t0_; } }
#else
        if constexpr (!Epi::AFTER_DRAIN) { E(acc, cur, wr, wc, fr, fq); S.done(cur); }
#endif
        if (!has_next) break;
#pragma unroll
        for (int a = 0; a < 2; ++a)
#pragma unroll
            for (int b = 0; b < 2; ++b)
#pragma unroll
                for (int m = 0; m < 4; ++m)
#pragma unroll
                    for (int n = 0; n < 2; ++n) acc[a][b][m][n] = (f32x4){0.f, 0.f, 0.f, 0.f};
        cur = nxt; cA = nA; cB = nB; ++ui;
        if constexpr (GATHER) { offA[0][0] = offN[0][0]; offA[0][1] = offN[0][1]; offA[1][0] = offN[1][0]; offA[1][1] = offN[1][1]; }
        if constexpr (ALIGN_EPI) { if (wr == 1) PG8_BAR; }
    }
    PG8_WAIT_V(0);
    if constexpr (!ALIGN_EPI) { if (wr == 0) PG8_BAR; }
    PG8_BAR;
    if constexpr (Epi::AFTER_DRAIN) { E.fused(acc, cur, wr, wc, fr, fq, lds, wid, lane); S.done(cur); }
#undef PG8_SA
#undef PG8_SB
#undef PG8_STAGE
#undef PG8_STAGE_B
#undef PG8_STAGE_A
#undef PG8_ROWOFFS
#undef PG8_LDA
#undef PG8_LDB
#undef PG8_MMA
#undef PG8_WAIT_V
#undef PG8_WAIT_L
#undef PG8_BAR
#undef PG8_SCHED
}
}

#ifndef ATT_SDEPTH
#define ATT_SDEPTH 1
#endif
#ifndef ATT_PRIO
#define ATT_PRIO 1
#endif
#ifndef ATT_SWA_WAVE
#define ATT_SWA_WAVE 1
#endif
#ifndef ATT_DIFF_FUSED
#define ATT_DIFF_FUSED 1
#endif
#ifndef ATT_SDEPTH_DIFF
#define ATT_SDEPTH_DIFF 2
#endif
namespace att {
using bf16x8 = __attribute__((ext_vector_type(8))) short;
using s16x4  = __attribute__((ext_vector_type(4))) short;
using f32x16 = __attribute__((ext_vector_type(16))) float;
using f32x4  = __attribute__((ext_vector_type(4))) float;
using u32x4  = __attribute__((ext_vector_type(4))) unsigned;
constexpr int NW = 8, QBLK = 32, KVBLK = 64, LDP = 5120, LDY = 2048, SEQL = 4096;
constexpr int SHM_V = 16384, SHM_K = 16384;
constexpr int OFF_V = 0, OFF_K = 2 * SHM_V, OFF_WS = OFF_K + 2 * SHM_K, OFF_LUT = OFF_WS + NW * 64 * 4, OFF_MISC = OFF_LUT + 512, OFF_STG = 69632, STG_PITCH = 272, STG_WAVE = 32 * STG_PITCH;
constexpr int ATT_LDS = OFF_STG + NW * STG_WAVE;
constexpr int OFF_LUT4 = 147456, LUT4_N = 528, LUT4_COPIES = 5, OFF_LUTH = OFF_LUT4 + LUT4_COPIES * LUT4_N * 4, LUTH_BYTES = 6 * 128 * 4;
static_assert(OFF_MISC + 256 <= OFF_STG, "attention LDS map");
constexpr float LOG2E = 1.4426950408889634f, NEGB = -1e30f, THR2 = 11.5f;
#define SBAR() __builtin_amdgcn_sched_barrier(0)
__device__ __forceinline__ int crow(int r, int hi) { return (r & 3) + 8 * (r >> 2) + 4 * hi; }
__device__ __forceinline__ unsigned cvtpk(float lo, float hi) { unsigned r; asm volatile("v_cvt_pk_bf16_f32 %0, %1, %2" : "=v"(r) : "v"(lo), "v"(hi)); return r; }
__device__ __forceinline__ float bf2f(short x) { return __uint_as_float(((unsigned)(unsigned short)x) << 16); }
template <int DQK> __device__ __forceinline__ int kswz(int row, int colB) { return row * (2 * DQK) + (colB ^ ((((DQK == 128) ? row : (row >> 1)) & 7) << 4)); }

template <int MODE>
__device__ __forceinline__ void bias_mask(f32x16& p0, f32x16& p1, int kt, int qpos, int wave_qmin, int hi, float C, const float* lut4, float cfar, unsigned sel, int jblk) {
  bool lane_off = false;
  if (MODE == 1) { const int blk = kt >> 8; if (blk < jblk) lane_off = !((sel >> blk) & 1u); }
  const bool nearT = (kt + 63 + 128 > wave_qmin);
  if (!nearT) {
    if (MODE == 0) {
#pragma unroll
      for (int r = 0; r < 16; ++r) { p0[r] = NEGB; p1[r] = NEGB; }
    } else {
#pragma unroll
      for (int r = 0; r < 16; ++r) { p0[r] = lane_off ? NEGB : fmaf(p0[r], C, cfar); p1[r] = lane_off ? NEGB : fmaf(p1[r], C, cfar); }
    }
  } else {
    const int kb = kt + 4 * hi, D = qpos - kb, c4 = qpos & 3;
    const float* Lc = lut4 + ((MODE == 1 && lane_off) ? 4 * LUT4_N + (256 + c4 - D) : c4 * LUT4_N + (256 + c4 - D));
#pragma unroll
    for (int g = 0; g < 4; ++g) {
      const f32x4 b0 = *(const f32x4*)(Lc + 8 * g), b1 = *(const f32x4*)(Lc + 8 * g + 32);
#pragma unroll
      for (int i = 0; i < 4; ++i) { const int r = 4 * g + i; p0[r] = fmaf(p0[r], C, b0[i]); p1[r] = fmaf(p1[r], C, b1[i]); }
      if (g & 1) SBAR();
    }
  }
}
__device__ __forceinline__ void partialSM(f32x16& p0, f32x16& p1, float& m_reg, float& alpha) {
  float pmax = p0[0];
#pragma unroll
  for (int r = 1; r < 16; ++r) pmax = fmaxf(pmax, p0[r]);
#pragma unroll
  for (int r = 0; r < 16; ++r) pmax = fmaxf(pmax, p1[r]);
  { auto rr = __builtin_amdgcn_permlane32_swap(__float_as_uint(pmax), __float_as_uint(pmax), false, false);
    pmax = fmaxf(__uint_as_float(rr[0]), __uint_as_float(rr[1])); }
  float mn;
  if (__builtin_expect(__all(pmax - m_reg <= THR2), 1)) { mn = m_reg; alpha = 1.f; }
  else { mn = fmaxf(m_reg, pmax); alpha = __builtin_amdgcn_exp2f(m_reg - mn); m_reg = mn; }
#pragma unroll
  for (int r = 0; r < 16; ++r) { p0[r] = __builtin_amdgcn_exp2f(p0[r] - mn); p1[r] = p1[r] - mn; }
}
template <int MODE>
__device__ __forceinline__ void tile_sm(f32x16& p0, f32x16& p1, int kt, int qpos, int wave_qmin, int hi, float C, const float* lut, float cfar, unsigned sel, int jblk, float& m_reg, float& alpha) {
  const bool nearT = (kt + 63 + 128 > wave_qmin);
  if (nearT) { bias_mask<MODE>(p0, p1, kt, qpos, wave_qmin, hi, C, (const float*)((const char*)lut + (OFF_LUT4 - OFF_LUT)), cfar, sel, jblk); partialSM(p0, p1, m_reg, alpha); return; }
  if (MODE == 0) {
#pragma unroll
    for (int r = 0; r < 16; ++r) { p0[r] = 0.f; p1[r] = NEGB; }
    alpha = 1.f; return;
  }
  bool lane_off = false;
  if (MODE == 1) { const int blk = kt >> 8; if (blk < jblk) lane_off = !((sel >> blk) & 1u); }
  float pmax = p0[0];
#pragma unroll
  for (int r = 1; r < 16; ++r) pmax = fmaxf(pmax, p0[r]);
#pragma unroll
  for (int r = 0; r < 16; ++r) pmax = fmaxf(pmax, p1[r]);
  { auto rr = __builtin_amdgcn_permlane32_swap(__float_as_uint(pmax), __float_as_uint(pmax), false, false);
    pmax = fmaxf(__uint_as_float(rr[0]), __uint_as_float(rr[1])); }
  const float tmax = lane_off ? NEGB : fmaf(pmax, C, cfar);
  float mn;
  if (__builtin_expect(__all(tmax - m_reg <= THR2), 1)) { mn = m_reg; alpha = 1.f; }
  else { mn = fmaxf(m_reg, tmax); alpha = __builtin_amdgcn_exp2f(m_reg - mn); m_reg = mn; }
  const float off = lane_off ? NEGB : cfar - mn;
#pragma unroll
  for (int r = 0; r < 16; ++r) { p0[r] = __builtin_amdgcn_exp2f(fmaf(p0[r], C, off)); p1[r] = fmaf(p1[r], C, off); }
}
__device__ __forceinline__ void finishSM(f32x16& p0, f32x16& p1, float alpha, float& l_reg, bf16x8& pa0, bf16x8& pa1, bf16x8& pa2, bf16x8& pa3) {
#pragma unroll
  for (int r = 0; r < 16; ++r) p1[r] = __builtin_amdgcn_exp2f(p1[r]);
  float ps = 0;
#pragma unroll
  for (int r = 0; r < 16; ++r) ps += p0[r];
#pragma unroll
  for (int r = 0; r < 16; ++r) ps += p1[r];
  { auto rr = __builtin_amdgcn_permlane32_swap(__float_as_uint(ps), __float_as_uint(ps), false, false);
    ps = __uint_as_float(rr[0]) + __uint_as_float(rr[1]); }
  l_reg = l_reg * alpha + ps;
#define PK4(P, BASE, OUT) do { unsigned a0 = cvtpk(P[BASE + 0], P[BASE + 1]), a1 = cvtpk(P[BASE + 2], P[BASE + 3]);   \
    unsigned b0 = cvtpk(P[BASE + 4], P[BASE + 5]), b1 = cvtpk(P[BASE + 6], P[BASE + 7]);                              \
    auto r0 = __builtin_amdgcn_permlane32_swap(a0, b0, false, false); auto r1 = __builtin_amdgcn_permlane32_swap(a1, b1, false, false); \
    u32x4 w = {r0[0], r1[0], r0[1], r1[1]}; OUT = *reinterpret_cast<bf16x8*>(&w); } while (0)
  PK4(p0, 0, pa0); PK4(p0, 8, pa1); PK4(p1, 0, pa2); PK4(p1, 8, pa3);
#undef PK4
}
template <int DQK>
__device__ __forceinline__ void qkt(f32x16& p0, f32x16& p1, const char* Ks, const bf16x8* qr, int r32, int hi) {
  p0 = f32x16{}; p1 = f32x16{};
#pragma unroll
  for (int d0 = 0; d0 < DQK / 16; ++d0) { const int cb = (d0 * 16 + hi * 8) * 2;
    const bf16x8 b0 = *reinterpret_cast<const bf16x8*>(Ks + kswz<DQK>(r32, cb));
    const bf16x8 b1 = *reinterpret_cast<const bf16x8*>(Ks + kswz<DQK>(32 + r32, cb));
    p0 = __builtin_amdgcn_mfma_f32_32x32x16_bf16(b0, qr[d0], p0, 0, 0, 0);
    p1 = __builtin_amdgcn_mfma_f32_32x32x16_bf16(b1, qr[d0], p1, 0, 0, 0); }
}
__device__ __forceinline__ int v_st(int k, int c) { const int kk = (k & ~0xC) | ((k & 4) << 1) | ((k & 8) >> 1); return ((kk >> 3) * 4 + (c >> 5)) * 512 + ((kk & 7) * 32 + (c & 31)) * 2; }
__device__ __forceinline__ int v_rd_base(int lane) { return ((lane & 3) << 3) | (((lane >> 2) & 3) << 6) | (((lane >> 4) & 1) << 5) | (((lane >> 5) & 1) << 8); }
constexpr int v_rd_off(int d0, int ks, int half) { return d0 * 512 + ks * 4096 + half * 2048; }
template <int OFF> __device__ __forceinline__ s16x4 tr_read(int vb) {
  s16x4 r; asm volatile("ds_read_b64_tr_b16 %0, %1 offset:%2" : "=&v"(r) : "v"(vb), "i"(OFF) : "memory"); return r;
}
template <int D0> __device__ __forceinline__ void pv_one(f32x16& od, int vb, bf16x8 pa0, bf16x8 pa1, bf16x8 pa2, bf16x8 pa3) {
  const s16x4 l0 = tr_read<v_rd_off(D0, 0, 0)>(vb), h0 = tr_read<v_rd_off(D0, 0, 1)>(vb), l1 = tr_read<v_rd_off(D0, 1, 0)>(vb), h1 = tr_read<v_rd_off(D0, 1, 1)>(vb);
  const s16x4 l2 = tr_read<v_rd_off(D0, 2, 0)>(vb), h2 = tr_read<v_rd_off(D0, 2, 1)>(vb), l3 = tr_read<v_rd_off(D0, 3, 0)>(vb), h3 = tr_read<v_rd_off(D0, 3, 1)>(vb);
  asm volatile("s_waitcnt lgkmcnt(0)" ::: "memory"); SBAR();
#if ATT_PRIO
  __builtin_amdgcn_s_setprio(ATT_PRIO);
#endif
#define PK(L, H) (bf16x8){L[0], L[1], L[2], L[3], H[0], H[1], H[2], H[3]}
  od = __builtin_amdgcn_mfma_f32_32x32x16_bf16(pa0, PK(l0, h0), od, 0, 0, 0);
  od = __builtin_amdgcn_mfma_f32_32x32x16_bf16(pa1, PK(l1, h1), od, 0, 0, 0);
  od = __builtin_amdgcn_mfma_f32_32x32x16_bf16(pa2, PK(l2, h2), od, 0, 0, 0);
  od = __builtin_amdgcn_mfma_f32_32x32x16_bf16(pa3, PK(l3, h3), od, 0, 0, 0);
#if ATT_PRIO
  __builtin_amdgcn_s_setprio(0);
#endif
#undef PK
}
__device__ __forceinline__ void pv_d0(f32x16* o, int vb, bf16x8 pa0, bf16x8 pa1, bf16x8 pa2, bf16x8 pa3) {
  pv_one<0>(o[0], vb, pa0, pa1, pa2, pa3); pv_one<1>(o[1], vb, pa0, pa1, pa2, pa3); pv_one<2>(o[2], vb, pa0, pa1, pa2, pa3); pv_one<3>(o[3], vb, pa0, pa1, pa2, pa3);
}

__device__ __forceinline__ void pv_all1(f32x16* o, int vb, bf16x8 pa0, bf16x8 pa1, bf16x8 pa2, bf16x8 pa3) {
  s16x4 va[8], vc[8];
#define TR8(D0, L) do { L[0] = tr_read<v_rd_off(D0, 0, 0)>(vb); L[1] = tr_read<v_rd_off(D0, 0, 1)>(vb); L[2] = tr_read<v_rd_off(D0, 1, 0)>(vb); L[3] = tr_read<v_rd_off(D0, 1, 1)>(vb); \
    L[4] = tr_read<v_rd_off(D0, 2, 0)>(vb); L[5] = tr_read<v_rd_off(D0, 2, 1)>(vb); L[6] = tr_read<v_rd_off(D0, 3, 0)>(vb); L[7] = tr_read<v_rd_off(D0, 3, 1)>(vb); } while (0)
#define PK(L, H) (bf16x8){L[0], L[1], L[2], L[3], H[0], H[1], H[2], H[3]}
#define MM4(OA, L) do { OA = __builtin_amdgcn_mfma_f32_32x32x16_bf16(pa0, PK(L[0], L[1]), OA, 0, 0, 0); OA = __builtin_amdgcn_mfma_f32_32x32x16_bf16(pa1, PK(L[2], L[3]), OA, 0, 0, 0); \
    OA = __builtin_amdgcn_mfma_f32_32x32x16_bf16(pa2, PK(L[4], L[5]), OA, 0, 0, 0); OA = __builtin_amdgcn_mfma_f32_32x32x16_bf16(pa3, PK(L[6], L[7]), OA, 0, 0, 0); } while (0)
  TR8(0, va); TR8(1, vc); asm volatile("s_waitcnt lgkmcnt(8)" ::: "memory"); SBAR(); MM4(o[0], va); SBAR();
  TR8(2, va); asm volatile("s_waitcnt lgkmcnt(8)" ::: "memory"); SBAR(); MM4(o[1], vc); SBAR();
  TR8(3, vc); asm volatile("s_waitcnt lgkmcnt(8)" ::: "memory"); SBAR(); MM4(o[2], va); SBAR();
  asm volatile("s_waitcnt lgkmcnt(0)" ::: "memory"); SBAR(); MM4(o[3], vc);
#undef MM4
#undef PK
#undef TR8
}

struct AttnArgs { int layer; float lambda_init; };
constexpr size_t ATT_WS_PROJ = (size_t)434 << 20, ATT_WS_YCAT = (size_t)754 << 20, ATT_WS_KMEAN = (size_t)1 << 20;
#define A_proj ((const unsigned short*)(wsptr() + ATT_WS_PROJ))
#define A_ycat ((unsigned short*)(wsptr() + ATT_WS_YCAT))
#define A_kmean ((const float*)(wsptr() + ATT_WS_KMEAN))
#define A_kpart ((const float*)(wsptr() + ATT_WS_KP))
constexpr size_t ATT_WS_KP = (size_t)882 << 20; constexpr int ATT_KP_N = 8 * 4 * 16 * 128;
#define A_rel_bias (inptr(2))
#define A_sinks (inptr(6) + A.layer * 6)
#define A_lq1 (inptr(7) + A.layer * 64)
#define A_lk1 (inptr(8) + A.layer * 64)
#define A_lq2 (inptr(9) + A.layer * 64)
#define A_lk2 (inptr(10) + A.layer * 64)
#define A_subln (inptr(11) + A.layer * 128)
__device__ const unsigned char REL_BUCKET_TAB[128] = {
  0, 1, 2, 3, 4, 5, 6, 7, 8, 9, 10, 11, 12, 13, 14, 15, 16, 16, 16, 17, 17, 18, 18, 18, 19, 19, 19, 20, 20, 20, 20, 21, 21, 21, 21, 22, 22, 22, 22, 22, 23, 23, 23, 23, 23, 23, 24, 24, 24, 24, 24, 24,
  25, 25, 25, 25, 25, 25, 25, 26, 26, 26, 26, 26, 26, 26, 26, 27, 27, 27, 27, 27, 27, 27, 27, 27, 27, 28, 28, 28, 28, 28, 28, 28, 28, 28, 28, 29, 29, 29, 29, 29, 29, 29, 29, 29, 29, 29, 29,
  30, 30, 30, 30, 30, 30, 30, 30, 30, 30, 30, 30, 30, 30, 31, 31, 31, 31, 31, 31, 31, 31, 31, 31, 31, 31, 31, 31, 31};

template <int MODE>
__device__ __forceinline__ void attn_pass(const AttnArgs& A, int b, int hh, int qb, int pass, float lam, char* lds, int tid) {
  constexpr int DQK = (MODE == 2) ? 64 : 128;
  constexpr int NPASS = (MODE == 2) ? 2 : 1;
  constexpr int SDEPTH = (MODE == 2) ? ATT_SDEPTH_DIFF : ATT_SDEPTH;
  constexpr int QCOL = (MODE == 0) ? 0 : (MODE == 1) ? 1280 : 2816;
  constexpr int KCOL = (MODE == 0) ? 768 : (MODE == 1) ? 1792 : 3584;
  constexpr int VCOL = (MODE == 0) ? 1024 : (MODE == 1) ? 2304 : 4352;
  constexpr int OCOL = (MODE == 0) ? 0 : (MODE == 1) ? 768 : 1280;
  const float C = ((MODE == 2) ? 0.125f : 0.088388347648318440f) * LOG2E;
  const int lane = tid & 63, r32 = lane & 31, hi = lane >> 5; const int wid = __builtin_amdgcn_readfirstlane(tid >> 6);
  const int kvh = (MODE == 0) ? hh / 3 : hh;
  char* V_lds = lds + OFF_V; char* K_lds = lds + OFF_K;
  float* wsl = (float*)(lds + OFF_WS) + wid * 64; float* li_l = wsl; float* al_l = wsl + 32;
  const float* lut = (const float*)(lds + OFF_LUT);
  char* stg = lds + OFF_STG + wid * STG_WAVE;
  const int q0 = qb * 256;
  const int qpos = q0 + wid * QBLK + r32, wave_qmin = q0 + wid * QBLK;
  const long rowb = (long)b * SEQL;
  const float cfar = lut[127];
  const int t0 = (MODE == 0) ? (qb == 0 ? 0 : 4 * qb - 2) : 0;
  const int NT = 4 * qb + 4 - t0;
  const int sr = tid >> 4, sc = (tid & 15) * 8, vst0 = v_st(sr, sc), vst1 = v_st(32 + sr, sc);
  const int vb0 = (int)(uintptr_t)V_lds + v_rd_base(lane);
  const unsigned short* Vh = A_proj + rowb * LDP + VCOL + kvh * 128;
  {

    const unsigned short* Qw = A_proj + (rowb + q0 + wid * QBLK + r32) * LDP + QCOL + hh * 128 + pass * 64 + hi * 8;
    const unsigned short* Kh = A_proj + rowb * LDP + KCOL + kvh * 128 + pass * 64;
    bf16x8 qr[DQK / 16];
#pragma unroll
    for (int d0 = 0; d0 < DQK / 16; ++d0) qr[d0] = *reinterpret_cast<const bf16x8*>(Qw + d0 * 16);
    unsigned sel = 0u;
    if (MODE == 1) {
      const int jb = qb;
      if (jb <= 3) sel = (1u << jb) - 1u;
      else {
        float g[15];
#pragma unroll
        for (int n = 0; n < 15; ++n) { g[n] = -INFINITY;
          if (n < jb) { const float* km = (const float*)(lds + OFF_STG) + n * 128 + hi * 8; float s = 0.f;
#pragma unroll
            for (int d0 = 0; d0 < 8; ++d0) { const f32x4 k0 = *(const f32x4*)(km + d0 * 16), k1 = *(const f32x4*)(km + d0 * 16 + 4);
              s += bf2f(qr[d0 % (DQK / 16)][0]) * k0[0] + bf2f(qr[d0 % (DQK / 16)][1]) * k0[1] + bf2f(qr[d0 % (DQK / 16)][2]) * k0[2] + bf2f(qr[d0 % (DQK / 16)][3]) * k0[3]
                 + bf2f(qr[d0 % (DQK / 16)][4]) * k1[0] + bf2f(qr[d0 % (DQK / 16)][5]) * k1[1] + bf2f(qr[d0 % (DQK / 16)][6]) * k1[2] + bf2f(qr[d0 % (DQK / 16)][7]) * k1[3]; }
            auto rr = __builtin_amdgcn_permlane32_swap(__float_as_uint(s), __float_as_uint(s), false, false);
            g[n] = __uint_as_float(rr[0]) + __uint_as_float(rr[1]); } }
#pragma unroll
        for (int pick = 0; pick < 3; ++pick) { float best = -INFINITY; int bi = 0;
#pragma unroll
          for (int n = 0; n < 15; ++n) { const bool take = (n < jb) && !((sel >> n) & 1u) && (g[n] > best); best = take ? g[n] : best; bi = take ? n : bi; }
          sel |= 1u << bi; }
      }
    }
    int NTm = NT;
    if (MODE == 1) {
      unsigned* mw = (unsigned*)(lds + OFF_MISC);
      if (qb > 3) { unsigned um = 0u;
#pragma unroll
        for (int n = 0; n < 15; ++n) if (__any((int)((sel >> n) & 1u))) um |= 1u << n;
        if (lane == 0) atomicOr(&mw[4], um); }
      __syncthreads();
      unsigned U = (qb <= 3) ? ((1u << qb) - 1u) : mw[4]; U |= 1u << qb;
      if (tid < 17) { unsigned rem = U; int bit = 0;
        for (int k = 0; k < tid; ++k) rem &= rem - 1u;
        bit = rem ? __builtin_ctz(rem) : 0; mw[8 + tid] = (unsigned)bit; }
      __syncthreads();
      NTm = 4 * __builtin_popcount(U);
    }
    const int NTT = __builtin_amdgcn_readfirstlane(NTm);
    float m_reg = NEGB, l_reg = 0.f;
    if (MODE == 0) { m_reg = A_sinks[hh] * LOG2E; l_reg = 1.f; }
    f32x16 o[4] = {};
#define KT(i) ((MODE == 1) ? (int)(__builtin_amdgcn_readfirstlane(((const unsigned*)(lds + OFF_MISC))[8 + ((i) >> 2)]) * 256u) + ((i) & 3) * KVBLK : (t0 + (i)) * KVBLK)
#define SLOAD(i, k0) do { sr_[i].vs0 = *reinterpret_cast<const bf16x8*>(&Vh[(long)((k0) + sr) * LDP + sc]); sr_[i].vs1 = *reinterpret_cast<const bf16x8*>(&Vh[(long)((k0) + 32 + sr) * LDP + sc]); \
    if (DQK == 128) { sr_[i].ks0 = *reinterpret_cast<const bf16x8*>(&Kh[(long)((k0) + sr) * LDP + sc]); sr_[i].ks1 = *reinterpret_cast<const bf16x8*>(&Kh[(long)((k0) + 32 + sr) * LDP + sc]); } \
    else { sr_[i].ks0 = *reinterpret_cast<const bf16x8*>(&Kh[(long)((k0) + (tid >> 3)) * LDP + (tid & 7) * 8]); } } while (0)
#define SWRITE(bb, i) do { *(bf16x8*)(V_lds + (bb) * SHM_V + vst0) = sr_[i].vs0; *(bf16x8*)(V_lds + (bb) * SHM_V + vst1) = sr_[i].vs1; \
    if (DQK == 128) { *(bf16x8*)(K_lds + (bb) * SHM_K + kswz<DQK>(sr, sc * 2)) = sr_[i].ks0; *(bf16x8*)(K_lds + (bb) * SHM_K + kswz<DQK>(32 + sr, sc * 2)) = sr_[i].ks1; } \
    else { *(bf16x8*)(K_lds + (bb) * SHM_K + kswz<DQK>(tid >> 3, (tid & 7) * 16)) = sr_[i].ks0; } } while (0)
#define SWAIT() do { if (SDEPTH == 1) asm volatile("s_waitcnt vmcnt(0)" ::: "memory"); else if (DQK == 128) asm volatile("s_waitcnt vmcnt(4)" ::: "memory"); else asm volatile("s_waitcnt vmcnt(3)" ::: "memory"); } while (0)
#define RESC(a) do { if (__any((a) < 1.f)) { if (hi == 0) al_l[r32] = (a); asm volatile("s_waitcnt lgkmcnt(0)" ::: "memory"); \
    _Pragma("unroll") for (int d = 0; d < 4; ++d) _Pragma("unroll") for (int r = 0; r < 16; ++r) o[d][r] *= al_l[crow(r, hi)]; } } while (0)
#define TSM(P0, P1, ti, AL) tile_sm<MODE>(P0, P1, KT(ti), qpos, wave_qmin, hi, C, lut, cfar, sel, qb, m_reg, AL)
    typedef __attribute__((address_space(3))) unsigned las_u32;
#define MLOAD2(k0, bb) do { const char* kg_ = (const char*)(Kh + (long)(k0) * LDP); const char* vg_ = (const char*)(Vh + (long)(k0) * LDP); \
    int ll_ = lane; asm volatile("" : "+v"(ll_));                 \
    _Pragma("unroll") for (int i_ = 0; i_ < 2; ++i_) { const int q_ = (i_ * 8 + wid) * 64 + ll_; \
      const int row_ = q_ >> 4, pos_ = q_ & 15; const unsigned koff_ = (unsigned)((row_ * LDP + ((pos_ ^ (row_ & 7)) << 3)) * 2); \
      const int st_ = q_ >> 5, kk_ = ((st_ >> 2) << 3) | ((q_ >> 2) & 7), c_ = ((st_ & 3) << 5) | ((q_ & 3) << 3), k_ = (kk_ & ~0xC) | ((kk_ & 4) << 1) | ((kk_ & 8) >> 1); const unsigned voff_ = (unsigned)((k_ * LDP + c_) * 2); \
      __builtin_amdgcn_global_load_lds((const unsigned*)(kg_ + koff_), (las_u32*)(K_lds + (bb) * SHM_K + (i_ * 8 + wid) * 1024), 16, 0, 0); \
      __builtin_amdgcn_global_load_lds((const unsigned*)(vg_ + voff_), (las_u32*)(V_lds + (bb) * SHM_V + (i_ * 8 + wid) * 1024), 16, 0, 0); } } while (0)
    __syncthreads();
    MLOAD2(KT(0), 0); asm volatile("s_waitcnt vmcnt(0)" ::: "memory"); __syncthreads();
#pragma unroll 1
    for (int j = 0; j < NTT; ++j) {
      const int bb = j & 1; const int kt = KT(j);
      if (j + 1 < NTT) MLOAD2(KT(j + 1), bb ^ 1);
      if (kt <= wave_qmin + QBLK - 1) {
        f32x16 p0, p1; float al; bf16x8 pa0, pa1, pa2, pa3;
        qkt<DQK>(p0, p1, K_lds + bb * SHM_K, qr, r32, hi);
        tile_sm<MODE>(p0, p1, kt, qpos, wave_qmin, hi, C, lut, cfar, sel, qb, m_reg, al);
        finishSM(p0, p1, al, l_reg, pa0, pa1, pa2, pa3); RESC(al);
        SBAR();
        pv_all1(o, vb0 + bb * SHM_V, pa0, pa1, pa2, pa3);
      }
      asm volatile("s_waitcnt vmcnt(0)" ::: "memory");
      __syncthreads();
    }
#undef MLOAD2
#undef KT
#undef SLOAD
#undef SWRITE
#undef SWAIT
#undef RESC
#undef TSM
    int r32e = r32, hie = hi; asm volatile("" : "+v"(r32e), "+v"(hie));
    if (hi == 0) li_l[r32] = l_reg; asm volatile("s_waitcnt lgkmcnt(0)" ::: "memory");
#pragma unroll
    for (int r = 0; r < 16; ++r) { const int orow = crow(r, hie); const float rli = __builtin_amdgcn_rcpf(li_l[orow]);
#pragma unroll
      for (int d0 = 0; d0 < 4; ++d0) { unsigned short* sp = (unsigned short*)(stg + orow * STG_PITCH) + d0 * 32 + r32e; float v = o[d0][r] * rli;
        if (MODE == 2 && pass == 1) v = __uint_as_float(((unsigned)*sp) << 16) - lam * v;
        *sp = (unsigned short)(cvtpk(v, v) & 0xffffu); } }
    asm volatile("s_waitcnt lgkmcnt(0)" ::: "memory");
    if (pass == NPASS - 1) {
      const char* rp = stg + r32e * STG_PITCH + hie * 128;
      u32x4 w[8];
#pragma unroll
      for (int i = 0; i < 8; ++i) w[i] = *(const u32x4*)(rp + i * 16);
      if (MODE == 2) {
        float ss = 0.f;
#pragma unroll
        for (int i = 0; i < 8; ++i)
#pragma unroll
          for (int k = 0; k < 4; ++k) { const float lo = __uint_as_float(w[i][k] << 16), hi_ = __uint_as_float(w[i][k] & 0xffff0000u); ss += lo * lo + hi_ * hi_; }
        { auto rr = __builtin_amdgcn_permlane32_swap(__float_as_uint(ss), __float_as_uint(ss), false, false); ss = __uint_as_float(rr[0]) + __uint_as_float(rr[1]); }
        const float sc2 = rsqrtf(ss * (1.0f / 128.0f) + 1e-6f) * (1.0f - A.lambda_init);
        const float* gp = A_subln + hie * 64;
#pragma unroll
        for (int i = 0; i < 8; ++i)
#pragma unroll
          for (int k = 0; k < 4; ++k) { const float lo = __uint_as_float(w[i][k] << 16) * sc2 * gp[i * 8 + 2 * k], hi_ = __uint_as_float(w[i][k] & 0xffff0000u) * sc2 * gp[i * 8 + 2 * k + 1]; w[i][k] = cvtpk(lo, hi_); }
      }
      unsigned short* op = A_ycat + (rowb + q0 + wid * QBLK + r32e) * LDY + OCOL + hh * 128 + hie * 64;
#pragma unroll
      for (int i = 0; i < 8; ++i) *(u32x4*)(op + i * 8) = w[i];
    }
  }
}
template <int MODE> __device__ __forceinline__ void unit_luts(char* lds, int hh, int tid) {
  float* lut = (float*)(lds + OFF_LUT); const float* lh = (const float*)(lds + OFF_LUTH) + hh * 128;
  if (tid < 128) lut[tid] = lh[tid];
  float* l4 = (float*)(lds + OFF_LUT4);
#pragma unroll 1
  for (int i = tid; i < LUT4_COPIES * LUT4_N; i += 512) { const int c = i / LUT4_N, j = i % LUT4_N, d = 256 + c - j;
    l4[i] = (c == 4 || d < 0 || (MODE == 0 && d >= 128)) ? NEGB : lh[d < 127 ? d : 127]; }
}
template <int D0> __device__ __forceinline__ void pv_one2(f32x16& oa, f32x16& ob, int vb, bf16x8 pa0, bf16x8 pa1, bf16x8 pa2, bf16x8 pa3, bf16x8 pb0, bf16x8 pb1, bf16x8 pb2, bf16x8 pb3) {
  const s16x4 l0 = tr_read<v_rd_off(D0, 0, 0)>(vb), h0 = tr_read<v_rd_off(D0, 0, 1)>(vb), l1 = tr_read<v_rd_off(D0, 1, 0)>(vb), h1 = tr_read<v_rd_off(D0, 1, 1)>(vb);
  const s16x4 l2 = tr_read<v_rd_off(D0, 2, 0)>(vb), h2 = tr_read<v_rd_off(D0, 2, 1)>(vb), l3 = tr_read<v_rd_off(D0, 3, 0)>(vb), h3 = tr_read<v_rd_off(D0, 3, 1)>(vb);
  asm volatile("s_waitcnt lgkmcnt(0)" ::: "memory"); SBAR();
#if ATT_PRIO
  __builtin_amdgcn_s_setprio(ATT_PRIO);
#endif
#define PK(L, H) (bf16x8){L[0], L[1], L[2], L[3], H[0], H[1], H[2], H[3]}
  oa = __builtin_amdgcn_mfma_f32_32x32x16_bf16(pa0, PK(l0, h0), oa, 0, 0, 0); ob = __builtin_amdgcn_mfma_f32_32x32x16_bf16(pb0, PK(l0, h0), ob, 0, 0, 0);
  oa = __builtin_amdgcn_mfma_f32_32x32x16_bf16(pa1, PK(l1, h1), oa, 0, 0, 0); ob = __builtin_amdgcn_mfma_f32_32x32x16_bf16(pb1, PK(l1, h1), ob, 0, 0, 0);
  oa = __builtin_amdgcn_mfma_f32_32x32x16_bf16(pa2, PK(l2, h2), oa, 0, 0, 0); ob = __builtin_amdgcn_mfma_f32_32x32x16_bf16(pb2, PK(l2, h2), ob, 0, 0, 0);
  oa = __builtin_amdgcn_mfma_f32_32x32x16_bf16(pa3, PK(l3, h3), oa, 0, 0, 0); ob = __builtin_amdgcn_mfma_f32_32x32x16_bf16(pb3, PK(l3, h3), ob, 0, 0, 0);
#if ATT_PRIO
  __builtin_amdgcn_s_setprio(0);
#endif
#undef PK
}
__device__ __forceinline__ void qkt_half(f32x16& p0, f32x16& p1, const char* Ks, const char* Qs, int c, int r32, int hi) {
  asm volatile("" : "+v"(r32));
  p0 = f32x16{}; p1 = f32x16{};
#pragma unroll
  for (int d0 = 0; d0 < 4; ++d0) { const int cb = (c * 64 + d0 * 16 + hi * 8) * 2;
    const bf16x8 qf = *reinterpret_cast<const bf16x8*>(Qs + kswz<128>(r32, cb));
    const bf16x8 b0 = *reinterpret_cast<const bf16x8*>(Ks + kswz<128>(r32, cb));
    const bf16x8 b1 = *reinterpret_cast<const bf16x8*>(Ks + kswz<128>(32 + r32, cb));
    p0 = __builtin_amdgcn_mfma_f32_32x32x16_bf16(b0, qf, p0, 0, 0, 0);
    p1 = __builtin_amdgcn_mfma_f32_32x32x16_bf16(b1, qf, p1, 0, 0, 0); }
}
__device__ __forceinline__ void attn_diff_fused(const AttnArgs& A, int b, int hh, int qb, float lam, char* lds, int tid) {
  constexpr int QCOL = 2816, KCOL = 3584, VCOL = 4352, OCOL = 1280;
  const float C = 0.125f * LOG2E;
  const int lane = tid & 63, r32 = lane & 31, hi = lane >> 5; const int wid = __builtin_amdgcn_readfirstlane(tid >> 6);
  char* V_lds = lds + OFF_V; char* K_lds = lds + OFF_K;
  float* wsl = (float*)(lds + OFF_WS) + wid * 64;
  const float* lut = (const float*)(lds + OFF_LUT);
  char* stg = lds + OFF_STG + wid * STG_WAVE;
  const int q0 = qb * 256;
  const int qpos = q0 + wid * QBLK + r32, wave_qmin = q0 + wid * QBLK;
  const long rowb = (long)b * SEQL;
  const int NT = 4 * qb + 4;
  const int vb0 = (int)(uintptr_t)V_lds + v_rd_base(lane);
  const unsigned short* Vh = A_proj + rowb * LDP + VCOL + hh * 128;
  const unsigned short* Kh = A_proj + rowb * LDP + KCOL + hh * 128;
  float m0 = NEGB, l0 = 0.f, m1 = NEGB, l1 = 0.f;
  f32x16 o0[4] = {}, o1[4] = {};
  typedef __attribute__((address_space(3))) unsigned las_u32;
#define SLOAD2(k0, bb) do { const char* kg_ = (const char*)(Kh + (long)(k0) * LDP); const char* vg_ = (const char*)(Vh + (long)(k0) * LDP); \
    int ll_ = lane; asm volatile("" : "+v"(ll_));                 \
    _Pragma("unroll") for (int i_ = 0; i_ < 2; ++i_) { const int q_ = (i_ * 8 + wid) * 64 + ll_; \
      const int row_ = q_ >> 4, pos_ = q_ & 15; const unsigned koff_ = (unsigned)((row_ * LDP + ((pos_ ^ (row_ & 7)) << 3)) * 2); \
      const int st_ = q_ >> 5, kk_ = ((st_ >> 2) << 3) | ((q_ >> 2) & 7), c_ = ((st_ & 3) << 5) | ((q_ & 3) << 3), k_ = (kk_ & ~0xC) | ((kk_ & 4) << 1) | ((kk_ & 8) >> 1); const unsigned voff_ = (unsigned)((k_ * LDP + c_) * 2); \
      __builtin_amdgcn_global_load_lds((const unsigned*)(kg_ + koff_), (las_u32*)(K_lds + (bb) * SHM_K + (i_ * 8 + wid) * 1024), 16, 0, 0); \
      __builtin_amdgcn_global_load_lds((const unsigned*)(vg_ + voff_), (las_u32*)(V_lds + (bb) * SHM_V + (i_ * 8 + wid) * 1024), 16, 0, 0); } } while (0)
#define RESC2(a, oo, sl) do { if (__any((a) < 1.f)) { if (hi == 0) (sl)[r32] = (a); asm volatile("s_waitcnt lgkmcnt(0)" ::: "memory"); \
    _Pragma("unroll") for (int d = 0; d < 4; ++d) _Pragma("unroll") for (int r = 0; r < 16; ++r) oo[d][r] *= (sl)[crow(r, hi)]; } } while (0)
  SLOAD2(0, 0);
  { const unsigned short* Qg = A_proj + (rowb + q0 + wid * QBLK) * LDP + QCOL + hh * 128;
    bf16x8 qv[8];
#pragma unroll
    for (int i = 0; i < 8; ++i) { const int c = lane + 64 * i, row = c >> 4, cc = c & 15; qv[i] = *reinterpret_cast<const bf16x8*>(Qg + (long)row * LDP + cc * 8); }
    unit_luts<2>(lds, hh, tid);
#pragma unroll
    for (int i = 0; i < 8; ++i) { const int c = lane + 64 * i, row = c >> 4, cc = c & 15; *(bf16x8*)(stg + kswz<128>(row, cc * 16)) = qv[i]; } }
  asm volatile("s_waitcnt vmcnt(0)" ::: "memory"); __syncthreads();
  const float cfar = lut[127];
#pragma unroll 1
  for (int j = 0; j < NT; ++j) {
    const int bb = j & 1; const int kt = j * KVBLK;
    if (j + 1 < NT) SLOAD2((j + 1) * KVBLK, bb ^ 1);
    if (kt <= wave_qmin + QBLK - 1) {
    f32x16 p0, p1; float al0, al1; bf16x8 pa0, pa1, pa2, pa3, pb0, pb1, pb2, pb3;
    qkt_half(p0, p1, K_lds + bb * SHM_K, stg, 0, r32, hi);
    tile_sm<2>(p0, p1, kt, qpos, wave_qmin, hi, C, lut, cfar, 0u, qb, m0, al0);
    finishSM(p0, p1, al0, l0, pa0, pa1, pa2, pa3); RESC2(al0, o0, wsl);
    SBAR();
    qkt_half(p0, p1, K_lds + bb * SHM_K, stg, 1, r32, hi);
    tile_sm<2>(p0, p1, kt, qpos, wave_qmin, hi, C, lut, cfar, 0u, qb, m1, al1);
    finishSM(p0, p1, al1, l1, pb0, pb1, pb2, pb3);
    RESC2(al1, o1, wsl + 32);
    SBAR();
    pv_one2<0>(o0[0], o1[0], vb0 + bb * SHM_V, pa0, pa1, pa2, pa3, pb0, pb1, pb2, pb3); pv_one2<1>(o0[1], o1[1], vb0 + bb * SHM_V, pa0, pa1, pa2, pa3, pb0, pb1, pb2, pb3);
    pv_one2<2>(o0[2], o1[2], vb0 + bb * SHM_V, pa0, pa1, pa2, pa3, pb0, pb1, pb2, pb3); pv_one2<3>(o0[3], o1[3], vb0 + bb * SHM_V, pa0, pa1, pa2, pa3, pb0, pb1, pb2, pb3);
    }
    asm volatile("s_waitcnt vmcnt(0)" ::: "memory");
    __syncthreads();
  }
#undef SLOAD2
#undef RESC2
  int r32e = r32, hie = hi; asm volatile("" : "+v"(r32e), "+v"(hie));
  if (hi == 0) { wsl[r32] = l0; wsl[32 + r32] = l1; } asm volatile("s_waitcnt lgkmcnt(0)" ::: "memory");
#pragma unroll
  for (int r = 0; r < 16; ++r) { const int orow = crow(r, hie); const float ra = __builtin_amdgcn_rcpf(wsl[orow]), rb = lam * __builtin_amdgcn_rcpf(wsl[32 + orow]);
#pragma unroll
    for (int d0 = 0; d0 < 4; ++d0) { unsigned short* sp = (unsigned short*)(stg + orow * STG_PITCH) + d0 * 32 + r32e; const float v = o0[d0][r] * ra - o1[d0][r] * rb;
      *sp = (unsigned short)(cvtpk(v, v) & 0xffffu); } }
  asm volatile("s_waitcnt lgkmcnt(0)" ::: "memory");
  { const char* rp = stg + r32e * STG_PITCH + hie * 128;
    u32x4 w[8];
#pragma unroll
    for (int i = 0; i < 8; ++i) w[i] = *(const u32x4*)(rp + i * 16);
    float ss = 0.f;
#pragma unroll
    for (int i = 0; i < 8; ++i)
#pragma unroll
      for (int k = 0; k < 4; ++k) { const float lo = __uint_as_float(w[i][k] << 16), hi_ = __uint_as_float(w[i][k] & 0xffff0000u); ss += lo * lo + hi_ * hi_; }
    { auto rr = __builtin_amdgcn_permlane32_swap(__float_as_uint(ss), __float_as_uint(ss), false, false); ss = __uint_as_float(rr[0]) + __uint_as_float(rr[1]); }
    const float sc2 = rsqrtf(ss * (1.0f / 128.0f) + 1e-6f) * (1.0f - A.lambda_init);
    const f32x4* gp = (const f32x4*)(A_subln + hie * 64);
    f32x4 gq[16];
#pragma unroll
    for (int i = 0; i < 16; ++i) gq[i] = gp[i];
#pragma unroll
    for (int i = 0; i < 8; ++i)
#pragma unroll
      for (int k = 0; k < 4; ++k) { const float lo = __uint_as_float(w[i][k] << 16) * sc2 * gq[2 * i + (k >> 1)][2 * (k & 1)], hi_ = __uint_as_float(w[i][k] & 0xffff0000u) * sc2 * gq[2 * i + (k >> 1)][2 * (k & 1) + 1]; w[i][k] = cvtpk(lo, hi_); }
    unsigned short* op = A_ycat + (rowb + q0 + wid * QBLK + r32e) * LDY + OCOL + hh * 128 + hie * 64;
#pragma unroll
    for (int i = 0; i < 8; ++i) *(u32x4*)(op + i * 8) = w[i];
  }
}
__device__ __forceinline__ void attn_swa_wave(const AttnArgs& A, int b, int hh, int qb, char* lds, int tid) {
  constexpr int QCOL = 0, KCOL = 768, VCOL = 1024, OCOL = 0;
  const float C = 0.088388347648318440f * LOG2E;
  const int lane = tid & 63, r32 = lane & 31, hi = lane >> 5; const int wid = __builtin_amdgcn_readfirstlane(tid >> 6);
  const int kvh = hh / 3;
  char* vpriv = lds + (wid < 4 ? wid * 16384 : OFF_STG + (wid - 4) * 16384);
  float* wsl = (float*)(lds + OFF_WS) + wid * 64; float* li_l = wsl; float* al_l = wsl + 32;
  const float* lut = (const float*)(lds + OFF_LUT);
  const int q0 = qb * 256, q0w = q0 + wid * QBLK, qpos = q0w + r32;
  const long rowb = (long)b * SEQL;
  const float cfar = lut[127];
  const unsigned short* Vh = A_proj + rowb * LDP + VCOL + kvh * 128;
  const unsigned short* Kh = A_proj + rowb * LDP + KCOL + kvh * 128 + hi * 8;
  const unsigned short* Qw = A_proj + (rowb + qpos) * LDP + QCOL + hh * 128 + hi * 8;
  bf16x8 qr[8];
#pragma unroll
  for (int d0 = 0; d0 < 8; ++d0) qr[d0] = *reinterpret_cast<const bf16x8*>(Qw + d0 * 16);
  float m_reg = A_sinks[hh] * LOG2E, l_reg = 1.f;
  f32x16 o[4] = {};
  const int vb = (int)(uintptr_t)vpriv + v_rd_base(lane);
  const int tfirst = (q0w >= 127) ? ((q0w - 127) >> 6) : 0, tlast = (q0w + 31) >> 6;
#pragma unroll 1
  for (int t = tfirst; t <= tlast; ++t) {
    const int kt = t * KVBLK;
    f32x16 p0 = {}, p1 = {};
    { bf16x8 kf0[8], kf1[8];
#pragma unroll
      for (int d0 = 0; d0 < 8; ++d0) { kf0[d0] = *reinterpret_cast<const bf16x8*>(Kh + (long)(kt + r32) * LDP + d0 * 16); kf1[d0] = *reinterpret_cast<const bf16x8*>(Kh + (long)(kt + 32 + r32) * LDP + d0 * 16); }
#pragma unroll
      for (int d0 = 0; d0 < 8; ++d0) { p0 = __builtin_amdgcn_mfma_f32_32x32x16_bf16(kf0[d0], qr[d0], p0, 0, 0, 0); p1 = __builtin_amdgcn_mfma_f32_32x32x16_bf16(kf1[d0], qr[d0], p1, 0, 0, 0); } }
    bf16x8 vs[16];
#pragma unroll
    for (int i = 0; i < 16; ++i) { const int q = lane + 64 * i; vs[i] = *reinterpret_cast<const bf16x8*>(Vh + (long)(kt + (q >> 4)) * LDP + (q & 15) * 8); }
    float al; bf16x8 pa0, pa1, pa2, pa3;
    tile_sm<0>(p0, p1, kt, qpos, q0w, hi, C, lut, cfar, 0u, qb, m_reg, al);
    finishSM(p0, p1, al, l_reg, pa0, pa1, pa2, pa3);
    if (__any(al < 1.f)) { if (hi == 0) al_l[r32] = al; asm volatile("s_waitcnt lgkmcnt(0)" ::: "memory");
#pragma unroll
      for (int d = 0; d < 4; ++d)
#pragma unroll
        for (int r = 0; r < 16; ++r) o[d][r] *= al_l[crow(r, hi)]; }
#pragma unroll
    for (int i = 0; i < 16; ++i) { const int q = lane + 64 * i; *(bf16x8*)(vpriv + v_st(q >> 4, (q & 15) * 8)) = vs[i]; }
    asm volatile("s_waitcnt lgkmcnt(0)" ::: "memory"); SBAR();
    pv_d0(o, vb, pa0, pa1, pa2, pa3);
    asm volatile("s_waitcnt lgkmcnt(0)" ::: "memory"); SBAR();
  }
  int r32e = r32, hie = hi; asm volatile("" : "+v"(r32e), "+v"(hie));
  if (hi == 0) li_l[r32] = l_reg; asm volatile("s_waitcnt lgkmcnt(0)" ::: "memory");
#pragma unroll
  for (int r = 0; r < 16; ++r) { const int orow = crow(r, hie); const float rli = __builtin_amdgcn_rcpf(li_l[orow]);
#pragma unroll
    for (int d0 = 0; d0 < 4; ++d0) { unsigned short* sp = (unsigned short*)(vpriv + orow * STG_PITCH) + d0 * 32 + r32e; const float v = o[d0][r] * rli; *sp = (unsigned short)(cvtpk(v, v) & 0xffffu); } }
  asm volatile("s_waitcnt lgkmcnt(0)" ::: "memory");
  { const char* rp = vpriv + r32e * STG_PITCH + hie * 128; u32x4 w[8];
#pragma unroll
    for (int i = 0; i < 8; ++i) w[i] = *(const u32x4*)(rp + i * 16);
    unsigned short* op = A_ycat + (rowb + q0w + r32e) * LDY + OCOL + hh * 128 + hie * 64;
#pragma unroll
    for (int i = 0; i < 8; ++i) *(u32x4*)(op + i * 8) = w[i]; }
}
template <int MODE>
__device__ __forceinline__ float attn_mode_setup(const AttnArgs& A, char* lds, const int wave_idx) {
  constexpr int HB0 = (MODE == 0) ? 0 : (MODE == 1) ? 6 : 10, NH = (MODE == 1) ? 4 : 6;
  const int lane = mk_lane(), tid = wave_idx * 64 + lane;
  __syncthreads();
  float* lh = (float*)(lds + OFF_LUTH);
#pragma unroll 1
  for (int i = tid; i < NH * 128; i += 512) lh[i] = A_rel_bias[(int)REL_BUCKET_TAB[i & 127] * 16 + HB0 + (i >> 7)] * LOG2E;
  float lam = 0.f;
  if (MODE == 2) { float a = A_lq1[lane] * A_lk1[lane], c2 = A_lq2[lane] * A_lk2[lane];
#pragma unroll
    for (int o_ = 1; o_ < 64; o_ <<= 1) { a += mk_shfl_xor(a, o_); c2 += mk_shfl_xor(c2, o_); }
    lam = __expf(a) - __expf(c2) + A.lambda_init; }
  __syncthreads();
  return __builtin_bit_cast(float, __builtin_amdgcn_readfirstlane(__builtin_bit_cast(int, lam)));
}
template <int MODE>
__device__ __forceinline__ void attn_unit(const AttnArgs& A, int b, int hh, int qb, char* lds, const int wave_idx, float lam) {
  constexpr int NPASS = (MODE == 2) ? 2 : 1;
  const int lane = mk_lane(), tid = wave_idx * 64 + lane;
  float* lut = (float*)(lds + OFF_LUT);
  __syncthreads();
  if (MODE == 1 && tid == 0) ((unsigned*)(lds + OFF_MISC))[4] = 0u;
  if (MODE == 1) { const float* kp_ = A_kpart + (size_t)((b * 4 + hh) * 16) * 128 + tid * 4; *(f32x4*)(lds + OFF_STG + tid * 16) = (*(const f32x4*)kp_ + *(const f32x4*)(kp_ + ATT_KP_N)) * (1.f / 256.f); }
  if (!(MODE == 2 && ATT_DIFF_FUSED)) { unit_luts<MODE>(lds, hh, tid); __syncthreads(); }
  asm volatile("" : "+v"(lam));
  if (MODE == 2 && ATT_DIFF_FUSED) { attn_diff_fused(A, b, hh, qb, lam, lds, wave_idx * 64 + mk_lane()); }
  else if (MODE == 0 && ATT_SWA_WAVE) { attn_swa_wave(A, b, hh, qb, lds, wave_idx * 64 + mk_lane()); }
  else {
#pragma unroll 1
  for (int pass = 0; pass < NPASS; ++pass) {
    attn_pass<MODE>(A, b, hh, qb, pass, lam, lds, wave_idx * 64 + mk_lane());
  }
  }
}
#undef SBAR
}
#undef A_proj
#undef A_ycat
#undef A_kmean
#undef A_kpart
#undef A_rel_bias
#undef A_sinks
#undef A_lq1
#undef A_lk1
#undef A_lq2
#undef A_lk2
#undef A_subln
#define GAS __attribute__((address_space(1)))
#define LAS __attribute__((address_space(3)))
typedef unsigned short bf16;
typedef unsigned v4u __attribute__((ext_vector_type(4)));
typedef float f32x4 __attribute__((ext_vector_type(4)));
typedef short bf16x8 __attribute__((ext_vector_type(8)));
typedef GAS unsigned gu32;
typedef GAS unsigned long long gu64;
#define RLX_AGENT __ATOMIC_RELAXED, __HIP_MEMORY_SCOPE_AGENT
#define LDS_WAIT() asm volatile("s_waitcnt lgkmcnt(0)" ::: "memory")
#define VM_WAIT() asm volatile("s_waitcnt vmcnt(0)" ::: "memory")
__device__ __forceinline__ unsigned long long rt() { return __builtin_amdgcn_s_memrealtime(); }
__device__ __forceinline__ unsigned f2bf(float f) { unsigned u = __builtin_bit_cast(unsigned, f); return (u + 0x7fffu + ((u >> 16) & 1u)) >> 16; }
__device__ __forceinline__ unsigned pk2(float lo, float hi) { return f2bf(lo) | (f2bf(hi) << 16); }

#define XB_TMO      128
#define XB_XCNT(j)  (256  + 64 * (j))
#define XB_XSUB(j)  (1280 + 64 * (j))
#define XB_XGEN(j)  (2304 + 64 * (j))
#define XB_TOP      3328
#define XB_TOPGEN   3392
#define XCD_BAR_WORDS 3456
#define XB_SPIN_CAP (1u << 18)

__device__ __forceinline__ unsigned xb_ld(unsigned* p)              { return __hip_atomic_load(p, __ATOMIC_RELAXED, __HIP_MEMORY_SCOPE_AGENT); }
__device__ __forceinline__ unsigned xb_add(unsigned* p, unsigned v) { return __hip_atomic_fetch_add(p, v, __ATOMIC_RELAXED, __HIP_MEMORY_SCOPE_AGENT); }
__device__ __forceinline__ unsigned xb_xcc_id() { return (unsigned)__builtin_amdgcn_s_getreg((3 << 11) | 20) & 0xFu; }
#define XB_SPIN(cond, bar) do { unsigned _sp = 0; while (cond) { __builtin_amdgcn_s_sleep(1); \
    if ((++_sp & 255u) == 0u) { if (xb_ld(&(bar)[XB_TMO])) break; if (_sp > XB_SPIN_CAP) { atomicAdd(&(bar)[XB_TMO], 1u); break; } } } } while (0)

struct XcdBarrier {
    unsigned* bar; unsigned x;
    volatile LAS unsigned* st;
};

__device__ __forceinline__ XcdBarrier xcd_barrier_post(unsigned* bar, volatile LAS unsigned* st) {
    XcdBarrier b; b.bar = bar; b.x = xb_xcc_id(); b.st = st;
    if (threadIdx.x == 0) (void)xb_add(&bar[XB_XCNT(b.x)], 1u);
    return b;
}
__device__ __forceinline__ void xcd_barrier_complete(unsigned* bar, unsigned x, unsigned& nloc, unsigned& nx) {
    const unsigned G = gridDim.x * gridDim.y * gridDim.z;
    unsigned sum, cnt, mine, sp = 0u;
    for (;;) {
        sum = 0u; cnt = 0u; mine = 0u;
#pragma unroll
        for (unsigned j = 0; j < 16; ++j) { const unsigned c = xb_ld(&bar[XB_XCNT(j)]); sum += c; cnt += (c > 0u) ? 1u : 0u; mine = (j == x) ? c : mine; }
        if (sum == G) break;
        __builtin_amdgcn_s_sleep(1);
        if ((++sp & 255u) == 0u) { if (xb_ld(&bar[XB_TMO])) break; if (sp > XB_SPIN_CAP) { atomicAdd(&bar[XB_TMO], 1u); break; } }
    }
    nloc = mine > 0u ? mine : 1u; nx = cnt > 0u ? cnt : 1u;
}

__device__ __forceinline__ void xcd_barrier(const XcdBarrier& b) {
    asm volatile("s_waitcnt vmcnt(0)" ::: "memory");
    __syncthreads();
    if (threadIdx.x == 0) {
        unsigned* bar = b.bar;
        __builtin_amdgcn_s_waitcnt(0);
        unsigned nloc = b.st[0], nx = b.st[1];
        if (nloc == 0u) { xcd_barrier_complete(bar, b.x, nloc, nx); b.st[0] = nloc; b.st[1] = nx; }
        const unsigned old = xb_add(&bar[XB_XSUB(b.x)], 1u);
        const unsigned gen = old / nloc;
        if (old + 1u == (gen + 1u) * nloc) {
            __builtin_amdgcn_fence(__ATOMIC_RELEASE, "agent");
            asm volatile("s_waitcnt vmcnt(0)" ::: "memory");
            const unsigned og = xb_add(&bar[XB_TOP], 1u);
            const unsigned tg = og / nx;
            if (og + 1u == (tg + 1u) * nx) xb_add(&bar[XB_TOPGEN], 1u);
            else XB_SPIN(xb_ld(&bar[XB_TOPGEN]) == tg, bar);
            __builtin_amdgcn_fence(__ATOMIC_ACQUIRE, "agent");
            xb_add(&bar[XB_XGEN(b.x)], 1u);
            asm volatile("s_waitcnt vmcnt(0)" ::: "memory");
        } else {
            XB_SPIN(xb_ld(&bar[XB_XGEN(b.x)]) == gen, bar);
            __builtin_amdgcn_fence(__ATOMIC_ACQUIRE, "agent");
            asm volatile("s_waitcnt vmcnt(0)" ::: "memory");
        }
    }
    __syncthreads();
}

constexpr int NWAVES = 8;
constexpr int BATCH = 8, SEQ = 4096, DM = 2048, DEPTH = 2, M = BATCH * SEQ, NIN = 5120, NEXP = 32, DEXP = 512, PLE = 256, NROUTE = 36;
constexpr int KB_OFF = 1792;
constexpr int RPAD = 73728;
constexpr float EPS = 1e-6f;
constexpr size_t MiB = 1u << 20;
constexpr size_t WS_CTL = 0, CTL_ZERO_BYTES = 1 * MiB;
constexpr size_t WS_KMEAN = 1 * MiB, WS_RSTD = WS_KMEAN + 256 * 1024, WS_TOKREC = WS_RSTD + 128 * 1024, WS_POS = WS_TOKREC + 1 * MiB, WS_WR = WS_POS + 256 * 1024;
constexpr size_t WS_WIN = 8 * MiB, WS_WOUT = 48 * MiB, WS_W13 = 64 * MiB, WS_W2 = 192 * MiB, WS_WG = 256 * MiB, WS_WP = 272 * MiB, WS_PB = 274 * MiB;
constexpr size_t WS_U = 306 * MiB, WS_PROJ = 434 * MiB, WS_YCAT = 754 * MiB, WS_PL = 882 * MiB, WS_HB = 1010 * MiB, WS_END = 1138 * MiB;
constexpr size_t WS_SSQ = WS_YCAT + 64 * MiB;
constexpr size_t WS_SRS = WS_YCAT + 72 * MiB;
constexpr size_t WS_LIST = 4 * MiB;
constexpr size_t WS_RSIN = WS_POS, WS_RSPLE = WS_POS + 128 * 1024;
constexpr size_t WS_XG = WS_PROJ, WS_HID = WS_PROJ + 288 * MiB, WS_Y = WS_XG;
static_assert(WS_WR + 2 * 2 * 48 * DM * 2 <= WS_LIST && WS_LIST + NEXP * 32768 * 4 <= WS_WIN && WS_HID + (size_t)RPAD * DEXP * 2 <= WS_PL && (size_t)RPAD * DM * 2 <= 288 * MiB && WS_W13 + (size_t)NEXP * 1024 * DM * 2 <= WS_W2 && WS_W2 + (size_t)NEXP * DM * DEXP * 2 <= WS_WG && WS_PB + (size_t)DEPTH * M * PLE * 2 <= WS_U, "d_ws map");
constexpr int CW_TMO = 0, CW_CODE = 1, CW_BAR = 4096, CW_CNT = 16384, CW_Q = 24576;
constexpr int PHASE_LDS = 139264;
constexpr int LDS_TILE_E = PHASE_LDS, LDS_OFFS = PHASE_LDS + 512, LDS_MISC = PHASE_LDS + 1024, LDSCTL_OFF = PHASE_LDS;
constexpr int LDS_BYTES = 147456 + att::LUT4_COPIES * att::LUT4_N * 4 + att::LUTH_BYTES;
static_assert(att::OFF_LUT4 == 147456 && LDS_BYTES <= 163840 && att::ATT_LDS <= PHASE_LDS && pg8::STAGE_BYTES <= PHASE_LDS && LDS_MISC + 128 + 8 * 32 <= LDS_BYTES, "LDS map");

__device__ __forceinline__ gu32* ctlptr() { return (gu32*)(wsptr() + WS_CTL); }
typedef float f32x2g __attribute__((ext_vector_type(2)));
typedef unsigned u32x2g __attribute__((ext_vector_type(2)));
__device__ __forceinline__ size_t hb_off(int k) { return (k & 1) ? WS_U : WS_HB; }
struct Frame {
    LAS unsigned char* lds;
    volatile LAS unsigned* MISC;
    int tid, lane, wave, G, gw, NGW;
};
struct Args { const float* in[22]; float* out; unsigned char* ws; int ph_lo, ph_hi, use_bar, pad; };
__device__ __forceinline__ Frame relaunder(const Frame& F0) {
    Frame F = F0; int w = F0.wave; asm volatile("" : "+s"(w)); F.wave = w; F.lane = mk_lane(); F.tid = w * 64 + F.lane; F.gw = blockIdx.x * NWAVES + w; return F;
}
__device__ __forceinline__ int opaque_i(int x) { asm volatile("" : "+s"(x)); return x; }
__device__ __forceinline__ float wave_sum(float v) {
#pragma unroll
    for (int o = 1; o < 64; o <<= 1) v += mk_shfl_xor(v, o);
    return v;
}
__device__ __forceinline__ unsigned pk2rne(float lo, float hi) { return pg8::cvt_pk_bf16(lo, hi); }
__device__ __forceinline__ float bfround(float x) { return __uint_as_float(pk2rne(x, x) << 16); }

struct ConvDesc { const float* W; int K, N; bf16* WT; int dst_row0, k0, n0; const float* gk; };
__device__ __forceinline__ void transpose_gains(const ConvDesc& d, float (&gv)[8], int lane) {
    const int rr = lane >> 3;
#pragma unroll
    for (int i = 0; i < 8; ++i) gv[i] = d.gk ? d.gk[d.k0 + 8 * i + rr] : 1.f;
}
__device__ __forceinline__ void transpose_load(const ConvDesc& d, f32x4 (&v)[8], int lane) {
    const int rr = lane >> 3, c4 = (lane & 7) * 4;
#pragma unroll
    for (int i = 0; i < 8; ++i) v[i] = __builtin_nontemporal_load((const GAS f32x4*)(d.W + (size_t)(d.k0 + 8 * i + rr) * d.N + d.n0 + c4));
}
__device__ __forceinline__ void transpose_store(const ConvDesc& d, f32x4 (&v)[8], float (&gv)[8], LAS float* scr, int lane, bool nt = false) {
    { const int rr = lane >> 3, c4 = (lane & 7) * 4;
#pragma unroll
      for (int i = 0; i < 8; ++i) { const f32x4 w = v[i] * gv[i]; LAS float* p = scr + (8 * i + rr) * 33 + c4; p[0] = w.x; p[1] = w.y; p[2] = w.z; p[3] = w.w; } }
    LDS_WAIT(); asm volatile("" ::: "memory");
    const int c = lane & 7;
#pragma unroll
    for (int j = 0; j < 4; ++j) { const int n = (lane >> 3) + 8 * j; const LAS float* s = scr + (8 * c) * 33 + n;
        v4u o; o.x = pk2rne(s[0 * 33], s[1 * 33]); o.y = pk2rne(s[2 * 33], s[3 * 33]); o.z = pk2rne(s[4 * 33], s[5 * 33]); o.w = pk2rne(s[6 * 33], s[7 * 33]);
        GAS v4u* dp = (GAS v4u*)(d.WT + (size_t)(d.dst_row0 + n) * d.K + d.k0 + 8 * c); if (nt) __builtin_nontemporal_store(o, dp); else *dp = o; }
    LDS_WAIT(); asm volatile("" ::: "memory");
}
__device__ __forceinline__ void p0_transpose_item(const float* W, int K, int N, bf16* WT, int dst_row0, LAS float* scr, int k0, int n0, int lane, const float* gk = nullptr) {
    const ConvDesc d{W, K, N, WT, dst_row0, k0, n0, gk}; f32x4 v[8]; float gv[8]; transpose_gains(d, gv, lane); transpose_load(d, v, lane); transpose_store(d, v, gv, scr, lane);
}
__device__ __forceinline__ void norm_row_bf16(const float* xrow, const float* g, bf16* orow, int lane) {
    const GAS f32x4* xr = (const GAS f32x4*)xrow + lane; const GAS f32x4* gr = (const GAS f32x4*)g + lane;
    f32x4 v[8]; float s = 0.f;
#pragma unroll
    for (int j = 0; j < 8; ++j) { v[j] = xr[64 * j]; s += (v[j].x * v[j].x + v[j].y * v[j].y) + (v[j].z * v[j].z + v[j].w * v[j].w); }
    const float rstd = rsqrtf(wave_sum(s) * (1.f / DM) + EPS);
    GAS unsigned long long* o8 = (GAS unsigned long long*)orow + lane;
#pragma unroll
    for (int j = 0; j < 8; ++j) { const f32x4 gv = gr[64 * j]; o8[64 * j] = (unsigned long long)pk2rne(v[j].x * rstd * gv.x, v[j].y * rstd * gv.y) | ((unsigned long long)pk2rne(v[j].z * rstd * gv.z, v[j].w * rstd * gv.w) << 32); }
}

__device__ __forceinline__ void convert_expert_weights(Frame& F, int L) {
    LAS float* scr = (LAS float*)(F.lds + F.wave * 16384);
    constexpr int I_W1 = 32 * 512, I_W2 = 32 * 512;
    bf16* W13 = (bf16*)(wsptr() + WS_W13); bf16* W2 = (bf16*)(wsptr() + WS_W2);
    for (int it = F.gw; it < 2 * I_W1 + I_W2; it += F.NGW) { int r = it;
        if (r < 2 * I_W1) { const int w3 = r >= I_W1; if (w3) r -= I_W1; const int e = r / 512, rr = r % 512, n0 = 32 * (rr % 16);
            p0_transpose_item((w3 ? inptr(17) : inptr(16)) + ((size_t)L * NEXP + e) * DM * DEXP, DM, DEXP, W13 + (size_t)e * 1024 * DM, 256 * (n0 / 128) + (n0 % 128) + (w3 ? 128 : 0), scr, 64 * (rr / 16), n0, F.lane, inptr(13) + (size_t)L * DM); continue; } r -= 2 * I_W1;
        const int e = r / 512, rr = r % 512;
        p0_transpose_item(inptr(18) + ((size_t)L * NEXP + e) * DEXP * DM, DEXP, DM, W2 + (size_t)e * DM * DEXP, 32 * (rr % 64), scr, 64 * (rr / 64), 32 * (rr % 64), F.lane); }
}
static_assert(true, "");
constexpr int CONV_NCH = 8, CONV_IE = 3 * 32 * 512, CONV_ID = 32 * 160 + 32 * 64 + 32 * 64 + 4 * 64;
__device__ __forceinline__ ConvDesc conv_desc(int job, int idx) {
    bf16* W13 = (bf16*)(wsptr() + WS_W13); bf16* W2 = (bf16*)(wsptr() + WS_W2);
    if (idx < CONV_IE) { const int L = job; int r = idx;
        if (r < 2 * 32 * 512) { const int w3 = r >= 32 * 512; if (w3) r -= 32 * 512; const int e = r / 512, rr = r % 512, n0 = 32 * (rr % 16);
            return ConvDesc{(w3 ? inptr(17) : inptr(16)) + ((size_t)L * NEXP + e) * DM * DEXP, DM, DEXP, W13 + (size_t)e * 1024 * DM, 256 * (n0 / 128) + (n0 % 128) + (w3 ? 128 : 0), 64 * (rr / 16), n0, inptr(13) + (size_t)L * DM}; }
        r -= 2 * 32 * 512; const int e = r / 512, rr = r % 512;
        return ConvDesc{inptr(18) + ((size_t)L * NEXP + e) * DEXP * DM, DEXP, DM, W2 + (size_t)e * DM * DEXP, 32 * (rr % 64), 64 * (rr / 64), 32 * (rr % 64), nullptr}; }
    int r = idx - CONV_IE; const int L = 1;
    bf16* WIN = (bf16*)(wsptr() + WS_WIN); bf16* WOUT = (bf16*)(wsptr() + WS_WOUT); bf16* WG = (bf16*)(wsptr() + WS_WG); bf16* WP = (bf16*)(wsptr() + WS_WP);
    if (r < 32 * 160) { return ConvDesc{inptr(5) + (size_t)L * DM * NIN, DM, NIN, WIN + (size_t)L * NIN * DM, 32 * (r % 160), 64 * (r / 160), 32 * (r % 160), inptr(4) + (size_t)L * DM}; } r -= 32 * 160;
    if (r < 32 * 64) { return ConvDesc{inptr(12) + (size_t)L * DM * DM, DM, DM, WOUT + (size_t)L * DM * DM, 32 * (r % 64), 64 * (r / 64), 32 * (r % 64), nullptr}; } r -= 32 * 64;
    if (r < 32 * 64) { return ConvDesc{inptr(20) + (size_t)L * DM * DM, DM, DM, WG + (size_t)L * DM * DM, 32 * (r % 64), 64 * (r / 64), 32 * (r % 64), inptr(19) + (size_t)L * DM}; } r -= 32 * 64;
    return ConvDesc{inptr(21) + (size_t)L * PLE * DM, PLE, DM, WP + (size_t)L * DM * PLE, 32 * (r % 64), 64 * (r / 64), 32 * (r % 64), nullptr};
}
__device__ __forceinline__ void conv_chunk(Frame& F0, int job, int k, gu32* tq = nullptr) {
    unsigned tk_ = 0u; const bool tkd = (tq != nullptr) && (F0.wave == 0) && (mk_lane() == 0);
    if (tkd) tk_ = __hip_atomic_fetch_add(tq, 1u, RLX_AGENT);
    __syncthreads();
    Frame F = relaunder(F0);
    LAS float* scr = (LAS float*)(F.lds + F.wave * 16384 + (F.wave >= 4 ? 8192 : 0));
    const int N = job == 0 ? CONV_IE + CONV_ID : CONV_IE, ipc = (N + F.G * CONV_NCH - 1) / (F.G * CONV_NCH), base = ((int)blockIdx.x * CONV_NCH + k) * ipc;
    f32x4 v[4][8]; ConvDesc d[4]; bool has[4];
#pragma unroll
    for (int t = 0; t < 4; ++t) { const int i = F.wave + NWAVES * t, idx = base + i; has[t] = (i < ipc) && (idx < N); d[t] = conv_desc(job, has[t] ? idx : 0); }
    float gA[8], gB[8];
    transpose_gains(d[0], gA, F.lane); transpose_gains(d[1], gB, F.lane);
#pragma unroll
    for (int t = 0; t < 4; ++t) if (has[t]) transpose_load(d[t], v[t], F.lane);
    if (has[0]) transpose_store(d[0], v[0], gA, scr, F.lane, true);
    transpose_gains(d[2], gA, F.lane); if (has[1]) transpose_store(d[1], v[1], gB, scr, F.lane, true);
    transpose_gains(d[3], gB, F.lane); if (has[2]) transpose_store(d[2], v[2], gA, scr, F.lane, true);
    if (has[3]) transpose_store(d[3], v[3], gB, scr, F.lane, true);
    if (tkd) ((volatile LAS int*)(F.lds + att::OFF_MISC))[0] = (int)tk_;
    __syncthreads();
}
__device__ __forceinline__ void p0_prologue(Frame& F0, const Args& AR) {
    Frame F = relaunder(F0);
    LAS float* scr = (LAS float*)(F.lds + F.wave * 16384);
    constexpr int I_IN = 32 * 160, I_OUT = 32 * 64, I_WG = 32 * 64, I_WP = 4 * 64, I_L = I_IN + I_OUT + I_WG + I_WP;
    bf16* WIN = (bf16*)(wsptr() + WS_WIN); bf16* WOUT = (bf16*)(wsptr() + WS_WOUT); bf16* WG = (bf16*)(wsptr() + WS_WG); bf16* WP = (bf16*)(wsptr() + WS_WP);
    for (int it = F.gw; it < I_L; it += F.NGW) {
        const int L = 0; int r = it;
        if (r < I_IN) { p0_transpose_item(inptr(5) + (size_t)L * DM * NIN, DM, NIN, WIN + (size_t)L * NIN * DM, 32 * (r % 160), scr, 64 * (r / 160), 32 * (r % 160), F.lane, inptr(4) + (size_t)L * DM); continue; } r -= I_IN;
        if (r < I_OUT) { p0_transpose_item(inptr(12) + (size_t)L * DM * DM, DM, DM, WOUT + (size_t)L * DM * DM, 32 * (r % 64), scr, 64 * (r / 64), 32 * (r % 64), F.lane); continue; } r -= I_OUT;
        if (r < I_WG) { p0_transpose_item(inptr(20) + (size_t)L * DM * DM, DM, DM, WG + (size_t)L * DM * DM, 32 * (r % 64), scr, 64 * (r / 64), 32 * (r % 64), F.lane, inptr(19) + (size_t)L * DM); continue; } r -= I_WG;
        p0_transpose_item(inptr(21) + (size_t)L * PLE * DM, PLE, DM, WP + (size_t)L * DM * PLE, 32 * (r % 64), scr, 64 * (r / 64), 32 * (r % 64), F.lane);
    }
    { GAS v4u* lz = (GAS v4u*)(wsptr() + WS_LIST); for (int i = F.gw * 64 + F.lane; i < NEXP * 32768 / 4; i += F.NGW * 64) lz[i] = (v4u){0u, 0u, 0u, 0u}; }
    { const GAS f32x4* src = (const GAS f32x4*)inptr(1); GAS v4u* dst = (GAS v4u*)(wsptr() + WS_PB); const long n8 = (long)DEPTH * M * PLE / 8;
      const long st = (long)F.NGW * 64;
      for (long i = (long)F.gw * 64 + F.lane; i < n8; i += 4 * st) {
        f32x4 a[4], b[4];
#pragma unroll
        for (int u = 0; u < 4; ++u) if (i + u * st < n8) { a[u] = __builtin_nontemporal_load(src + 2 * (i + u * st)); b[u] = __builtin_nontemporal_load(src + 2 * (i + u * st) + 1); }
#pragma unroll
        for (int u = 0; u < 4; ++u) if (i + u * st < n8) { v4u o; o.x = pk2rne(a[u].x, a[u].y); o.y = pk2rne(a[u].z, a[u].w); o.z = pk2rne(b[u].x, b[u].y); o.w = pk2rne(b[u].z, b[u].w); dst[i + u * st] = o; } } }

    { bf16* WRH = (bf16*)(wsptr() + WS_WR); bf16* WRL = WRH + DEPTH * 48 * DM;
      for (int i = F.gw * 64 + F.lane; i < DEPTH * 48 * DM; i += F.NGW * 64) { const int L = i / (48 * DM), n = (i / DM) % 48, k = i % DM;
        const float w = (n < 4 ? inptr(14)[((size_t)L * DM + k) * 4 + n] : n < NROUTE ? inptr(15)[((size_t)L * DM + k) * 32 + (n - 4)] : 0.f) * inptr(13)[(size_t)L * DM + k];
        const unsigned h = pk2rne(w, 0.f) & 0xffffu; const float r = w - __uint_as_float(h << 16);
        WRH[i] = (bf16)h; WRL[i] = (bf16)(pk2rne(r, 0.f) & 0xffffu); } }
    { float* rsin = (float*)(wsptr() + WS_RSIN); bf16* hb = (bf16*)(wsptr() + hb_off(0));
      for (int m4 = F.gw; m4 < M / 4; m4 += F.NGW) {
        f32x4 v[4][8];
#pragma unroll
        for (int r = 0; r < 4; ++r) { const GAS f32x4* xr = (const GAS f32x4*)(inptr(0) + (size_t)(4 * m4 + r) * DM) + F.lane;
#pragma unroll
          for (int j = 0; j < 8; ++j) v[r][j] = __builtin_nontemporal_load(xr + 64 * j); }
#pragma unroll
        for (int r = 0; r < 4; ++r) { GAS unsigned long long* o8 = (GAS unsigned long long*)(hb + (size_t)(4 * m4 + r) * DM) + F.lane; float s = 0.f;
#pragma unroll
          for (int j = 0; j < 8; ++j) { const f32x4 w = v[r][j]; s += (w.x * w.x + w.y * w.y) + (w.z * w.z + w.w * w.w); o8[64 * j] = (unsigned long long)pk2rne(w.x, w.y) | ((unsigned long long)pk2rne(w.z, w.w) << 32); }
          s = wave_sum(s); if (F.lane == 0) rsin[4 * m4 + r] = rsqrtf(s * (1.f / DM) + EPS); } } }
}
constexpr int LDS_RSTAB = 131072, LDS_RSVAL = 131072 + 64;
template <class Sched> __device__ __forceinline__ void rsin_table(Frame& F0, const Sched& S, bool from_parts) {
    Frame F = relaunder(F0);
    LAS int* tab = (LAS int*)(F.lds + LDS_RSTAB); LAS float* rs = (LAS float*)(F.lds + LDS_RSVAL);
    if (F.tid < 4) tab[F.tid] = -1;
    __syncthreads();
    int ns = 0; pg8::Unit u;
#pragma unroll 1
    for (int i = 0; S.next(i, u); ++i) {
        bool have = false;
#pragma unroll 1
        for (int k = 0; k < ns; ++k) have = have || (tab[k] == u.pm);
        if (have || ns >= 4) continue;
        const int row = F.tid >> 1, h = F.tid & 1; float v;
        if (from_parts) { const GAS f32x4* pp = (const GAS f32x4*)((const float*)(wsptr() + WS_SSQ) + ((size_t)u.pm * 256 + row) * 32 + 16 * h);
            const f32x4 a = pp[0], b = pp[1], c = pp[2], d = pp[3]; float s = ((a.x + a.y) + (a.z + a.w)) + ((b.x + b.y) + (b.z + b.w)) + (((c.x + c.y) + (c.z + c.w)) + ((d.x + d.y) + (d.z + d.w)));
            s += mk_shfl_xor(s, 1); v = rsqrtf(s * (1.f / DM) + EPS); }
        else v = ((const float*)(wsptr() + WS_RSIN))[u.pm * 256 + row];
        if (h == 0) rs[ns * 256 + row] = v;
        if (F.tid == 0) tab[ns] = u.pm;
        ++ns;
        __syncthreads();
    }
}
__device__ __forceinline__ void kmean_phase(Frame& F0, const Args& AR) {
    Frame F = relaunder(F0);
    const bf16* proj = (const bf16*)(wsptr() + WS_PROJ); float* km = (float*)(wsptr() + WS_KMEAN);
    LAS float* part = (LAS float*)F.lds;
    for (int w = blockIdx.x; w < BATCH * 4 * 16 / 2; w += F.G) {
        const int u = 2 * w + (F.wave >> 2), q = F.wave & 3, b = u >> 6, h = (u >> 4) & 3, blk = u & 15, rg = F.lane >> 4, c = F.lane & 15;
        const bf16* kp = proj + ((size_t)b * SEQ + blk * 256 + q * 64 + rg) * NIN + KB_OFF + h * 128 + 8 * c;
        float s[8] = {0.f, 0.f, 0.f, 0.f, 0.f, 0.f, 0.f, 0.f};
#pragma unroll
        for (int i = 0; i < 16; ++i) { const v4u v = *(const GAS v4u*)(kp + (size_t)(4 * i) * NIN);
            s[0] += __uint_as_float(v.x << 16); s[1] += __uint_as_float(v.x & 0xffff0000u); s[2] += __uint_as_float(v.y << 16); s[3] += __uint_as_float(v.y & 0xffff0000u);
            s[4] += __uint_as_float(v.z << 16); s[5] += __uint_as_float(v.z & 0xffff0000u); s[6] += __uint_as_float(v.w << 16); s[7] += __uint_as_float(v.w & 0xffff0000u); }
#pragma unroll
        for (int j = 0; j < 8; ++j) { s[j] += mk_shfl_xor(s[j], 16); s[j] += mk_shfl_xor(s[j], 32); }
        __syncthreads();
        if (F.lane < 16) {
#pragma unroll
            for (int j = 0; j < 8; ++j) part[F.wave * 128 + 8 * c + j] = s[j]; }
        __syncthreads();
        if (F.tid < 256) { const int uu = F.tid >> 7, d = F.tid & 127; const LAS float* pp = part + uu * 512 + d;
            km[(size_t)(2 * w + uu) * 128 + d] = ((pp[0] + pp[128]) + (pp[256] + pp[384])) * (1.f / 256.f); }
    }
    __syncthreads();
}
struct TokRec { int e0, e1, s0, s1; float w0, w1; int pad0, pad1; };
__device__ __forceinline__ void router_phase(Frame& F0, const Args& AR, int layer) {
    Frame F = relaunder(F0);
    typedef float f32x4r __attribute__((ext_vector_type(4)));
    const bf16* h = (const bf16*)(wsptr() + hb_off(layer));
    const bf16* WRH = (const bf16*)(wsptr() + WS_WR) + (size_t)layer * 48 * DM; const bf16* WRL = WRH + DEPTH * 48 * DM;
    float* rstd_o = (float*)(wsptr() + WS_RSTD); TokRec* rec = (TokRec*)(wsptr() + WS_TOKREC); gu32* cnt = ctlptr() + CW_CNT + layer * 32 * 64;
    int* list = (int*)(wsptr() + WS_LIST);
    constexpr int KC = 512, NCH = DM / KC, WB_BYTES = 96 * KC * 2;
    LAS float* lg = (LAS float*)(F.lds + WB_BYTES) + F.wave * (16 * 49);
    LAS int* lc = (LAS int*)(F.lds + WB_BYTES + 8 * (16 * 49) * 4);
    static_assert(WB_BYTES + 8 * 16 * 49 * 4 + 64 * 4 <= PHASE_LDS, "router LDS");
    const int row = F.lane & 15, kg = F.lane >> 4;
    constexpr int NTASK = M / 128;
    typedef __attribute__((address_space(3))) unsigned las_u32r;
#pragma unroll 1
    for (int tk = (int)blockIdx.x; tk < NTASK; tk += F.G) {
        if (F.tid < 32) lc[F.tid] = 0;
        const bf16* hp = h + (size_t)(128 * tk + 16 * F.wave + row) * DM + 8 * kg;
        f32x4r acc[3]; float ss = 0.f;
#pragma unroll
        for (int t = 0; t < 3; ++t) acc[t] = (f32x4r){0.f, 0.f, 0.f, 0.f};
        v4u hq[2][16];
#pragma unroll
        for (int s = 0; s < 16; ++s) hq[0][s] = *(const GAS v4u*)(hp + 32 * s);
#pragma unroll
        for (int c = 0; c < NCH; ++c) {
            __syncthreads();
#pragma unroll
            for (int q = 0; q < 9; ++q) { const int r72 = q * 8 + F.wave, rc = r72 < NROUTE ? r72 : r72 + (48 - NROUTE), n = rc < 48 ? rc : rc - 48; const bf16* src = (rc < 48 ? WRH : WRL) + (size_t)n * DM + c * KC;
                int ll = F.lane; asm volatile("" : "+v"(ll));
                __builtin_amdgcn_global_load_lds((const unsigned*)((const char*)src + ((ll ^ (n & 15)) << 4)), (las_u32r*)(F.lds + rc * (KC * 2)), 16, 0, 0); }
            asm volatile("s_waitcnt vmcnt(0)" ::: "memory");
            __syncthreads();
            if (c + 1 < NCH) {
#pragma unroll
                for (int s = 0; s < 16; ++s) hq[(c + 1) & 1][s] = *(const GAS v4u*)(hp + (c + 1) * KC + 32 * s); }
#pragma unroll
            for (int s = 0; s < 16; ++s) { const v4u q = hq[c & 1][s];
                const float a0 = __uint_as_float(q.x << 16), a1 = __uint_as_float(q.x & 0xffff0000u), a2 = __uint_as_float(q.y << 16), a3 = __uint_as_float(q.y & 0xffff0000u);
                const float a4 = __uint_as_float(q.z << 16), a5 = __uint_as_float(q.z & 0xffff0000u), a6 = __uint_as_float(q.w << 16), a7 = __uint_as_float(q.w & 0xffff0000u);
                ss += (a0 * a0 + a1 * a1) + (a2 * a2 + a3 * a3) + (a4 * a4 + a5 * a5) + (a6 * a6 + a7 * a7);
                const bf16x8 Ah = __builtin_bit_cast(bf16x8, q);
                const int piece = ((4 * s + kg) ^ row) << 4;
#pragma unroll
                for (int t = 0; t < 3; ++t) { const bf16x8 Bh = *(const LAS bf16x8*)(F.lds + (16 * t + row) * (KC * 2) + piece), Bl = *(const LAS bf16x8*)(F.lds + (48 + 16 * t + row) * (KC * 2) + piece);
                    acc[t] = __builtin_amdgcn_mfma_f32_16x16x32_bf16(Ah, Bh, acc[t], 0, 0, 0); acc[t] = __builtin_amdgcn_mfma_f32_16x16x32_bf16(Ah, Bl, acc[t], 0, 0, 0); } }
        }
        { float s2 = ss; s2 += mk_shfl_xor(s2, 16); s2 += mk_shfl_xor(s2, 32); if (kg == 0) lg[row * 49 + 48] = s2;
#pragma unroll
            for (int t = 0; t < 3; ++t)
#pragma unroll
                for (int i = 0; i < 4; ++i) lg[(4 * kg + i) * 49 + 16 * t + row] = acc[t][i]; }
        LDS_WAIT(); asm volatile("" ::: "memory");
        int e0 = 0, e1 = 0, sl0 = 0, sl1 = 0; float w0 = 0.f, w1 = 0.f, rs = 0.f;
        if (F.lane < 16) {
            const LAS float* lr = lg + F.lane * 49;
            const float rs_ = rsqrtf(lr[48] * (1.f / DM) + EPS);
            float gl[4];
#pragma unroll
            for (int i = 0; i < 4; ++i) gl[i] = lr[i] * rs_;
            int grp = 0; float gm = gl[0];
#pragma unroll
            for (int i = 1; i < 4; ++i) if (gl[i] > gm) { gm = gl[i]; grp = i; }
            float gs = 0.f;
#pragma unroll
            for (int i = 0; i < 4; ++i) gs += __expf(gl[i] - gm);
            const float gw_ = 1.f / gs;
            float el[8];
#pragma unroll
            for (int i = 0; i < 8; ++i) el[i] = lr[4 + grp * 8 + i] * rs_;
            int i1 = 0; float t1 = el[0];
#pragma unroll
            for (int i = 1; i < 8; ++i) if (el[i] > t1) { t1 = el[i]; i1 = i; }
            int i2 = -1; float t2 = -INFINITY;
#pragma unroll
            for (int i = 0; i < 8; ++i) if (i != i1 && el[i] > t2) { t2 = el[i]; i2 = i; }
            const float ex = __expf(t2 - t1), w0_ = gw_ / (1.f + ex), w1_ = gw_ * ex / (1.f + ex);
            e0 = grp * 8 + i1; e1 = grp * 8 + i2; w0 = w0_; w1 = w1_; rs = rs_;
            sl0 = __hip_atomic_fetch_add(lc + e0, 1, __ATOMIC_RELAXED, __HIP_MEMORY_SCOPE_WORKGROUP); sl1 = __hip_atomic_fetch_add(lc + e1, 1, __ATOMIC_RELAXED, __HIP_MEMORY_SCOPE_WORKGROUP);
        }
        LDS_WAIT(); asm volatile("" ::: "memory");
        __syncthreads();
        if (F.tid < 32) { const int c = lc[F.tid]; lc[32 + F.tid] = c > 0 ? (int)__hip_atomic_fetch_add(cnt + F.tid * 64, (unsigned)c, RLX_AGENT) : 0; }
        __syncthreads();
        if (F.lane < 16) { const int rowg = 128 * tk + 16 * F.wave + F.lane; const int s0 = lc[32 + e0] + sl0, s1 = lc[32 + e1] + sl1;
            TokRec t; t.e0 = e0; t.e1 = e1; t.s0 = s0; t.s1 = s1; t.w0 = w0; t.w1 = w1; t.pad0 = 0; t.pad1 = 0; rec[rowg] = t; rstd_o[rowg] = rs;
            list[e0 * 32768 + s0] = rowg; list[e1 * 32768 + s1] = rowg; float* srs = (float*)(wsptr() + WS_SRS); srs[e0 * 32768 + s0] = rs; srs[e1 * 32768 + s1] = rs; }
        __syncthreads();
    }
}
constexpr int PL_UNITS = (M / 256) * (DM / 256), PL_R = 5;
__device__ __forceinline__ int build_tiles(Frame& F0, int layer) {
    Frame F = relaunder(F0);
    gu32* cnt = ctlptr() + CW_CNT + layer * 32 * 64; LAS int* offs = (LAS int*)(F.lds + LDS_OFFS); LAS unsigned char* te = F.lds + LDS_TILE_E;
    __syncthreads();
    if (F.tid < NEXP) offs[40 + F.tid] = (int)__hip_atomic_load(cnt + F.tid * 64, RLX_AGENT);
    __syncthreads();
    if (F.tid == 0) { int acc = 0;
#pragma unroll 1
        for (int e = 0; e < NEXP; ++e) { const int c = offs[40 + e]; offs[e] = acc * 256; const int nt = (c + 255) >> 8; for (int t = 0; t < nt && acc + t < RPAD / 256; ++t) te[acc + t] = (unsigned char)e; acc += nt; }
        offs[32] = acc < RPAD / 256 ? acc : RPAD / 256;
        const int nTl = offs[32], per = F.G >> 3, x = (int)blockIdx.x & 7, s = (int)blockIdx.x >> 3; int gmax = 0;
#pragma unroll 1
        for (int xx = 0; xx < 8; ++xx) { int n = 0;
#pragma unroll 1
            for (int k = 0; k < 4; ++k) { const int e = xx + 8 * k; const int t0 = offs[e] >> 8, t1 = (e == 31) ? nTl : (offs[e + 1] >> 8); n += (t1 > t0 ? t1 - t0 : 0) * 4; }
            offs[72 + xx] = n; const int gh = (n + per - 1) / per; gmax = gh > gmax ? gh : gmax; }
        int Dtot = 0, Dbefore = 0, dme = 0, dpre = 0;
#pragma unroll 1
        for (int xx = 0; xx < 8; ++xx) { const int n = offs[72 + xx], gh = (n + per - 1) / per, r = n > 0 ? n - (gh - 1) * per : per; const int D = per * (gmax - gh) + (per - r);
            if (xx < x) Dbefore += D; Dtot += D;
            if (xx == x) { dme = (gmax - gh) + (s >= r ? 1 : 0); dpre = s * (gmax - gh) + (s > r ? s - r : 0); } }
        int base = (PL_UNITS - PL_R * Dtot + F.G - 1) / F.G; base = base > 0 ? base : 0;
        int start = PL_R * (Dbefore + dpre) + (x * per + s) * base, count = PL_R * dme + base;
        if ((F.G & 7) || per == 0) { start = (int)blockIdx.x * ((PL_UNITS + F.G - 1) / F.G); count = (PL_UNITS + F.G - 1) / F.G; }
        if (start > PL_UNITS) start = PL_UNITS; if (start + count > PL_UNITS) count = PL_UNITS - start;
        offs[33] = start; offs[34] = count; }
    __syncthreads();
    return offs[32];
}
struct ListOrder {
    static constexpr bool B_NT = false;
    int start, count;
    __device__ __forceinline__ bool next(int i, pg8::Unit& u) const { if (i >= count) return false; const int L = start + i; u.pm = L >> 3; u.pn = L & 7; return true; }
    __device__ __forceinline__ void a_ready(const pg8::Unit&) const {}
    __device__ __forceinline__ void done(const pg8::Unit&) const {}
};
__device__ __forceinline__ void combine_phase(Frame& F0, const Args& AR, int layer) {
#if MK_PER_PHASE
    (void)build_tiles(F0, layer);
#endif
    Frame F = relaunder(F0);
    const LAS int* offs = (const LAS int*)(F.lds + LDS_OFFS);
    bf16* hb = (bf16*)(wsptr() + hb_off(layer)); const TokRec* rec = (const TokRec*)(wsptr() + WS_TOKREC);
    const bf16* y = (const bf16*)(wsptr() + WS_Y); float* rsple = (float*)(wsptr() + WS_RSPLE);
    TokRec tn[2];
    if (F.gw < M / 2) {
#pragma unroll
        for (int r = 0; r < 2; ++r) tn[r] = rec[F.gw + r * (M / 2)]; }
    for (int m2 = F.gw; m2 < M / 2; m2 += F.NGW) {
        TokRec t[2]; int p0[2], p1[2];
#pragma unroll
        for (int r = 0; r < 2; ++r) t[r] = tn[r];
        if (m2 + F.NGW < M / 2) {
#pragma unroll
            for (int r = 0; r < 2; ++r) tn[r] = rec[m2 + F.NGW + r * (M / 2)]; }
#pragma unroll
        for (int r = 0; r < 2; ++r) { p0[r] = offs[t[r].e0] + t[r].s0; p1[r] = offs[t[r].e1] + t[r].s1; }
        v4u hq[2][4], ya[2][4], yb[2][4];
#pragma unroll
        for (int r = 0; r < 2; ++r) { const GAS v4u* xr = (const GAS v4u*)(hb + (size_t)(m2 + r * (M / 2)) * DM) + F.lane;
            const GAS v4u* y0 = (const GAS v4u*)(y + (size_t)p0[r] * DM) + F.lane; const GAS v4u* y1 = (const GAS v4u*)(y + (size_t)p1[r] * DM) + F.lane;
#pragma unroll
            for (int j = 0; j < 4; ++j) { hq[r][j] = xr[64 * j]; ya[r][j] = __builtin_nontemporal_load(y0 + 64 * j); yb[r][j] = __builtin_nontemporal_load(y1 + 64 * j); } }
#pragma unroll
        for (int r = 0; r < 2; ++r) { const int m = m2 + r * (M / 2); GAS v4u* xw = (GAS v4u*)(hb + (size_t)m * DM) + F.lane; float s = 0.f; const float w0 = t[r].w0, w1 = t[r].w1;
#pragma unroll
            for (int j = 0; j < 4; ++j) { const v4u q = hq[r][j], a = ya[r][j], b = yb[r][j]; v4u o;
#define CMB(QW, AW, BW, OW) do { const float lo_ = __uint_as_float((QW) << 16) + w0 * __uint_as_float((AW) << 16) + w1 * __uint_as_float((BW) << 16), hi_ = __uint_as_float((QW) & 0xffff0000u) + w0 * __uint_as_float((AW) & 0xffff0000u) + w1 * __uint_as_float((BW) & 0xffff0000u); \
                    OW = pk2rne(lo_, hi_); s += lo_ * lo_ + hi_ * hi_; } while (0)
                CMB(q.x, a.x, b.x, o.x); CMB(q.y, a.y, b.y, o.y); CMB(q.z, a.z, b.z, o.z); CMB(q.w, a.w, b.w, o.w);
#undef CMB
                xw[64 * j] = o; }
            s = wave_sum(s); if (F.lane == 0) rsple[m] = rsqrtf(s * (1.f / DM) + EPS); }
    }
}
__device__ __forceinline__ void endnorm_phase(Frame& F0, const Args& AR, int layer) {
    Frame F = relaunder(F0);
    const bf16* hb = (const bf16*)(wsptr() + hb_off(layer + 1));
    const bool last = layer + 1 >= DEPTH;
    float* rsin = (float*)(wsptr() + WS_RSIN);
    f32x4 g8[8];
#pragma unroll
    for (int j = 0; j < 8; ++j) g8[j] = last ? ((const GAS f32x4*)inptr(3) + F.lane)[64 * j] : (f32x4){0.f, 0.f, 0.f, 0.f};
    for (int m4 = F.gw; m4 < M / 4; m4 += F.NGW) {
        u32x2g q[4][8];
#pragma unroll
        for (int r = 0; r < 4; ++r) { const GAS u32x2g* xr = (const GAS u32x2g*)(hb + (size_t)(4 * m4 + r) * DM) + F.lane;
#pragma unroll
            for (int j = 0; j < 8; ++j) q[r][j] = last ? __builtin_nontemporal_load(xr + 64 * j) : xr[64 * j]; }
#pragma unroll
        for (int r = 0; r < 4; ++r) { const int m = 4 * m4 + r; float s = 0.f;
#pragma unroll
            for (int j = 0; j < 8; ++j) { const float a = __uint_as_float(q[r][j].x << 16), b = __uint_as_float(q[r][j].x & 0xffff0000u), c = __uint_as_float(q[r][j].y << 16), d = __uint_as_float(q[r][j].y & 0xffff0000u); s += (a * a + b * b) + (c * c + d * d); }
            const float rstd = rsqrtf(wave_sum(s) * (1.f / DM) + EPS);
            if (last) { GAS f32x4* o = (GAS f32x4*)(outptr() + (size_t)m * DM) + F.lane;
#pragma unroll
                for (int j = 0; j < 8; ++j) { const f32x4 v = (f32x4){__uint_as_float(q[r][j].x << 16), __uint_as_float(q[r][j].x & 0xffff0000u), __uint_as_float(q[r][j].y << 16), __uint_as_float(q[r][j].y & 0xffff0000u)}; __builtin_nontemporal_store(v * rstd * g8[j], o + 64 * j); } }
            else if (F.lane == 0) rsin[m] = rstd; }
    }
}
template <int MODE> __device__ __forceinline__ void attn_queue(Frame& F0, const att::AttnArgs& A, gu32* qbase, int& cc) {
    Frame F = relaunder(F0);
    volatile LAS int* mb = (volatile LAS int*)(F.lds + att::OFF_MISC);
    constexpr int NPER = (MODE == 2) ? 96 : (MODE == 1) ? 64 : 96;
    const int myx = (int)(xb_xcc_id() & 7u);
    const float lam = att::attn_mode_setup<MODE>(A, (char*)F.lds, F.wave);
#pragma unroll 1
    for (int xs = 0; xs < 8; ++xs) {
        const int x = (myx + xs) & 7;
        if (xs == 1) {
            __syncthreads();
            { const int t8 = mk_lane(); if (F.wave == 0 && t8 < 8) mb[32 + t8] = (int)__hip_atomic_load(qbase + t8 * 64, RLX_AGENT); }
            __syncthreads(); }
        if (xs >= 1 && mb[32 + x] >= NPER) continue;
        bool have = false;
        for (;;) {
            if (!have) { __syncthreads();
                if (F.tid == 0) mb[0] = (int)__hip_atomic_fetch_add(qbase + x * 64, 1u, RLX_AGENT);
                __syncthreads(); }
            have = false;
            const int idx = __builtin_amdgcn_readfirstlane(mb[0]);
            if (idx >= NPER) break;
            int b, hh, qb;
            if (MODE == 2) { const int p = (idx % 6) * 8 + x; b = p / 6; hh = p % 6; qb = 15 - idx / 6; }
            else if (MODE == 1) { const int p = (idx & 3) * 8 + x; b = p >> 2; hh = p & 3; qb = 15 - (idx >> 2); }
            else { const int kvp = (idx / 48) * 8 + x, r = idx % 48; b = kvp >> 1; hh = (kvp & 1) * 3 + r % 3; qb = r / 3; }
            att::attn_unit<MODE>(A, b, hh, qb, (char*)F.lds, F.wave, lam);
            if (cc < CONV_NCH) { conv_chunk(F0, A.layer, cc, qbase + x * 64); ++cc; have = true; }
        }
    }
}
__device__ __forceinline__ att::AttnArgs make_attn_args(int layer) { att::AttnArgs A{}; A.layer = layer; A.lambda_init = 0.8f - 0.6f * __expf(-0.3f * (float)layer); return A; }
static_assert(NROUTE == 36 && 2 * NROUTE == 72, "router staging: 72 row chunks over 8 waves");
static_assert(att::ATT_WS_KP == WS_PL && KB_OFF % 256 == 0 && SEQ % 256 == 0 && SEQ / 256 == 16, "block means from the projection epilogue");
static_assert(att::ATT_WS_PROJ == WS_PROJ && att::ATT_WS_YCAT == WS_YCAT && att::ATT_WS_KMEAN == WS_KMEAN, "attention body's workspace offsets");

#ifndef MK_PH_MASK
#define MK_PH_MASK 0xFFFFFFFFu
#endif
#ifndef MK_ATT_MASK
#define MK_ATT_MASK 7
#endif
#define ATM(k) ((MK_ATT_MASK >> (k)) & 1)
#define PHM(k) ((MK_PH_MASK >> (k)) & 1u)
constexpr int NPH_LAYER = 11, NPHASES = 1 + DEPTH * NPH_LAYER;
__global__ void __launch_bounds__(NWAVES * 64, 2) mk_fwd(Args args) {
    extern __shared__ __attribute__((aligned(16))) unsigned char lds[];
    Frame F;
    F.lds = (LAS unsigned char*)lds; F.MISC = (volatile LAS unsigned*)(F.lds + LDS_MISC);
    F.wave = __builtin_amdgcn_readfirstlane((int)threadIdx.x >> 6); F.lane = mk_lane(); F.tid = F.wave * 64 + F.lane; F.G = gridDim.x;
    F.gw = blockIdx.x * NWAVES + F.wave; F.NGW = F.G * NWAVES;
    for (int u = F.tid; u < (LDS_BYTES - LDSCTL_OFF) / 4; u += NWAVES * 64) ((LAS unsigned*)(F.lds + LDSCTL_OFF))[u] = 0u;
    __syncthreads();
    XcdBarrier bar; bar.bar = (unsigned*)(ctlptr() + CW_BAR); bar.x = 0; bar.st = nullptr;
    if (args.use_bar) bar = xcd_barrier_post((unsigned*)(ctlptr() + CW_BAR), F.MISC + 8);
    const int lo = args.ph_lo, hi = args.ph_hi;
#define IN(k) (lo <= (k) && (k) < hi)
#define SEAM(k) do { if (IN(k) && IN((k) + 1)) xcd_barrier(bar); } while (0)
    if (PHM(0) && IN(0)) { p0_prologue(F, args); } SEAM(0);
#pragma unroll 1
    for (int layer = 0; layer < DEPTH; ++layer) {
        const int pb = 1 + layer * NPH_LAYER;
        const bool fuse_norm = (F.G == 256);
        if (PHM(1) && IN(pb + 0)) { pg8::Gemm g{(const bf16*)(wsptr() + hb_off(layer)), (const bf16*)(wsptr() + WS_WIN) + (size_t)layer * NIN * DM, M, NIN, DM}; pg8::StaticOrder S; S.init(M, NIN, F.G, (int)blockIdx.x);
            rsin_table(F, S, fuse_norm && layer > 0);
            pg8::EpiProj E{(bf16*)(wsptr() + WS_PROJ), NIN, (const LAS int*)(F.lds + LDS_RSTAB), (const LAS float*)(F.lds + LDS_RSVAL), (float*)(wsptr() + WS_PL), KB_OFF / 256, att::ATT_KP_N, (const float*)(wsptr() + WS_RSIN)};
            pg8::gemm_phase<pg8::EpiProj, pg8::StaticOrder, true, true>(F.lds, g, S, E, F.wave);
            }
        SEAM(pb + 0);
        if (PHM(3) && IN(pb + 2)) { const att::AttnArgs A = make_attn_args(layer);
            int cc = 0;
            if (ATM(2)) attn_queue<2>(F, A, ctlptr() + CW_Q + ((layer * 3 + 0) * 8) * 64, cc);
            if (ATM(1)) attn_queue<1>(F, A, ctlptr() + CW_Q + ((layer * 3 + 1) * 8) * 64, cc);
            if (ATM(0)) attn_queue<0>(F, A, ctlptr() + CW_Q + ((layer * 3 + 2) * 8) * 64, cc);
#pragma unroll 1
            for (; cc < CONV_NCH; ++cc) conv_chunk(F, layer, cc);
            }
        SEAM(pb + 2);
        if (PHM(4) && IN(pb + 3)) { pg8::Gemm g{(const bf16*)(wsptr() + WS_YCAT), (const bf16*)(wsptr() + WS_WOUT) + (size_t)layer * DM * DM, M, DM, DM}; pg8::StaticOrder S; S.init(M, DM, F.G, (int)blockIdx.x);
            pg8::EpiRes E{(bf16*)(wsptr() + hb_off(layer)), DM};
            pg8::gemm_phase<pg8::EpiRes, pg8::StaticOrder, true, true>(F.lds, g, S, E, F.wave); }
        SEAM(pb + 3);
        if (PHM(5) && IN(pb + 4)) router_phase(F, args, layer);
        SEAM(pb + 4);
        if (PHM(7) && IN(pb + 6)) { const int nT = build_tiles(F, layer);
            pg8::Gemm g{(const bf16*)(wsptr() + hb_off(layer)), (const bf16*)(wsptr() + WS_W13), M, NEXP * 1024, DM};
            pg8::GroupedOrder S{(const LAS unsigned char*)(F.lds + LDS_TILE_E), nT, 4, F.G, (int)blockIdx.x, (const int*)(wsptr() + WS_LIST), (const LAS int*)(F.lds + LDS_OFFS), (const LAS int*)(F.lds + 131072)};
            { LAS int* lt = (LAS int*)(F.lds + 131072); pg8::Unit u;
              const int t_ = F.wave * 64 + mk_lane();
#pragma unroll 1
              for (int i = 0; i < pg8::GroupedOrder::LTAB_UNITS && S.next(i, u); ++i) if (t_ < 256) { const int e = u.pn / 4; lt[i * 256 + t_] = ((const int*)(wsptr() + WS_LIST))[e * 32768 + (u.pm * 256 - ((const LAS int*)(F.lds + LDS_OFFS))[e]) + t_]; }
              __syncthreads(); }
            pg8::EpiSiluMul E{(bf16*)(wsptr() + WS_HID), DEXP, (const int*)(wsptr() + WS_LIST), (const LAS int*)(F.lds + LDS_OFFS), (const float*)(wsptr() + WS_SRS)};
            pg8::gemm_phase<pg8::EpiSiluMul, pg8::GroupedOrder, true, true, true>(F.lds, g, S, E, F.wave);
            { const LAS int* offs = (const LAS int*)(F.lds + LDS_OFFS); ListOrder S2{offs[33], offs[34]};
              pg8::Gemm g2{(const bf16*)(wsptr() + WS_PB) + (size_t)layer * M * PLE, (const bf16*)(wsptr() + WS_WP) + (size_t)layer * DM * PLE, M, DM, opaque_i(PLE)};
              pg8::EpiBf16<0> E2{(bf16*)(wsptr() + WS_PL), DM, nullptr, 0, 0, 1.f, nullptr, 1};
              pg8::gemm_phase<pg8::EpiBf16<0>, ListOrder, true, true>(F.lds, g2, S2, E2, F.wave); }
            }
        SEAM(pb + 6);
        if (PHM(8) && IN(pb + 7)) {
#if MK_PER_PHASE
            (void)build_tiles(F, layer);
#endif
            const int nT = ((const LAS int*)(F.lds + LDS_OFFS))[32];
            pg8::Gemm g{(const bf16*)(wsptr() + WS_HID), (const bf16*)(wsptr() + WS_W2), RPAD, NEXP * DM, DEXP};
            pg8::GroupedOrder S{(const LAS unsigned char*)(F.lds + LDS_TILE_E), nT, 8, F.G, (int)blockIdx.x, nullptr, (const LAS int*)(F.lds + LDS_OFFS), nullptr};
            pg8::EpiBf16<0> E{(bf16*)(wsptr() + WS_Y), DM, nullptr, DM, 0, 1.f, nullptr, 1};
            pg8::gemm_phase<pg8::EpiBf16<0>, pg8::GroupedOrder, true, true>(F.lds, g, S, E, F.wave);
            }
        SEAM(pb + 7);
        if (PHM(9) && IN(pb + 8)) combine_phase(F, args, layer);
        SEAM(pb + 8);
        if (PHM(10) && IN(pb + 9)) { pg8::Gemm g{(const bf16*)(wsptr() + hb_off(layer)), (const bf16*)(wsptr() + WS_WG) + (size_t)layer * DM * DM, M, DM, DM}; pg8::StaticOrder S; S.init(M, DM, F.G, (int)blockIdx.x);
            pg8::EpiGate E{(const bf16*)(wsptr() + hb_off(layer)), (bf16*)(wsptr() + hb_off(layer + 1)), (const bf16*)(wsptr() + WS_PL), (const float*)(wsptr() + WS_RSPLE), DM, (fuse_norm && layer + 1 < DEPTH) ? (float*)(wsptr() + WS_SSQ) : nullptr};
            pg8::gemm_phase<pg8::EpiGate, pg8::StaticOrder, true, true>(F.lds, g, S, E, F.wave); }
        SEAM(pb + 9);
        if (!(fuse_norm && layer + 1 < DEPTH)) { if (PHM(11) && IN(pb + 10)) endnorm_phase(F, args, layer);
        SEAM(pb + 10); }
    }
#undef IN
#undef SEAM
}

extern "C" void kernel_launch(void* const* d_in, const int* in_sizes, int n_in, void* d_out, int out_size, void* d_ws, size_t ws_size, hipStream_t stream) {
    static int grid = 0;
    if (grid == 0) {
        if (n_in != 22 || in_sizes[0] != M * DM || out_size != M * DM || ws_size < WS_END) { fprintf(stderr, "kernel_launch: shape mismatch (n_in %d, in0 %d, out %d, ws %zu < %zu); nothing launched\n", n_in, n_in > 0 ? in_sizes[0] : -1, out_size, ws_size, (size_t)WS_END); grid = -1; return; }
        int dev = 0, cus = 0, per_cu = 0;
        if (hipGetDevice(&dev) != hipSuccess || hipDeviceGetAttribute(&cus, hipDeviceAttributeMultiprocessorCount, dev) != hipSuccess) { grid = -1; return; }
        if (hipFuncSetAttribute((const void*)mk_fwd, hipFuncAttributeMaxDynamicSharedMemorySize, LDS_BYTES) != hipSuccess) { fprintf(stderr, "kernel_launch: hipFuncSetAttribute failed\n"); grid = -1; return; }
        if (hipOccupancyMaxActiveBlocksPerMultiprocessor(&per_cu, (const void*)mk_fwd, NWAVES * 64, LDS_BYTES) != hipSuccess || per_cu < 1) { fprintf(stderr, "kernel_launch: occupancy query says %d blocks per CU\n", per_cu); }
        (void)hipGetLastError();
        grid = cus;
    }
    if (grid < 0) return;
    if (hipMemsetAsync((char*)d_ws + WS_CTL, 0, CTL_ZERO_BYTES, stream) != hipSuccess) return;
    Args a{};
    for (int i = 0; i < 22; ++i) a.in[i] = (const float*)d_in[i];
    a.out = (float*)d_out; a.ws = (unsigned char*)d_ws;
#if MK_PER_PHASE
    a.use_bar = 0;
    for (int ph = 0; ph < NPHASES; ++ph) {
        const int layer = ph > 0 ? (ph - 1) / NPH_LAYER : -1, k = ph > 0 ? (ph - 1) % NPH_LAYER : -1;
        a.ph_lo = ph; a.ph_hi = ph + 1;
        hipLaunchKernelGGL(mk_fwd, dim3(grid), dim3(NWAVES * 64), LDS_BYTES, stream, a);
    }
#else
    a.use_bar = 1; a.ph_lo = 0; a.ph_hi = NPHASES;
    hipLaunchKernelGGL(mk_fwd, dim3(grid), dim3(NWAVES * 64), LDS_BYTES, stream, a);
#endif
    const hipError_t le = hipPeekAtLastError();
    if (le != hipSuccess) fprintf(stderr, "kernel_launch: launch failed: %s\n", hipGetErrorName(le));
}
```

```cpp
#include <hip/hip_runtime.h>
#include <hip/hip_bf16.h>
#include <cstdio>
#include <cstdint>
#include <cmath>
#ifndef MK_PER_PHASE
#define MK_PER_PHASE 0
#endif
__device__ __forceinline__ int mk_lane() { unsigned m = ~0u; asm volatile("" : "+s"(m)); return (int)__builtin_amdgcn_mbcnt_hi(m, __builtin_amdgcn_mbcnt_lo(m, 0u)); }
__device__ __forceinline__ float mk_shfl_xor_l(float v, int o, int l) { return __uint_as_float((unsigned)__builtin_amdgcn_ds_bpermute((l ^ o) << 2, (int)__float_as_uint(v))); }
__device__ __forceinline__ float mk_shfl_xor(float v, int o) { return mk_shfl_xor_l(v, o, mk_lane()); }
#define CAS __attribute__((address_space(4)))
__device__ __forceinline__ const CAS char* kargs() { const CAS char* kp = (const CAS char*)__builtin_amdgcn_kernarg_segment_ptr(); asm volatile("" : "+s"(kp)); return kp; }
__device__ __forceinline__ const float* inptr(int k) { return *(const float* const CAS*)(kargs() + 8 * k); }
__device__ __forceinline__ float* outptr() { return *(float* const CAS*)(kargs() + 176); }
__device__ __forceinline__ unsigned char* wsptr() { return *(unsigned char* const CAS*)(kargs() + 184); }
namespace pg8 {
#define PG8_LAS __attribute__((address_space(3)))
typedef unsigned short bf16_t;
typedef short bf16x8 __attribute__((ext_vector_type(8)));
typedef float f32x4 __attribute__((ext_vector_type(4)));
typedef unsigned u32x4 __attribute__((ext_vector_type(4)));
constexpr int BM = 256, BK = 64, HALF = 128, HTB = HALF * BK * 2  , STAGE_BYTES = 8 * HTB, NXCD = 8, WGM = 8;

__host__ __device__ __forceinline__ int lds_byte(int r, int c) { const int st = (r >> 4) * 2 + (c >> 5), rr = r & 15, cc = c & 31, ob = rr * 64 + cc * 2; return st * 1024 + (ob ^ (((ob >> 9) & 1) << 5)); }
__host__ __device__ __forceinline__ void stage_rc(int b, int& R, int& C) { const int st = b / 1024, sb = b % 1024, swz = sb ^ (((sb >> 9) & 1) << 5); R = (st >> 1) * 16 + swz / 64; C = (st & 1) * 32 + (swz % 64) / 2; }
__host__ __device__ __forceinline__ int perm32(int rho) { const int n = rho >> 4, i = rho & 15; return 8 * (i >> 2) + 4 * n + (i & 3); }

struct Unit { int pm, pn; };
struct Gemm { const bf16_t* A; const bf16_t* Bt; int M, N, K; };

struct StaticOrder {
    static constexpr bool B_NT = false;
    int nM, nN, nwg, G, c;
    __host__ __device__ void init(int M, int N, int G_, int c_) { nM = M / BM; nN = N / BM; nwg = nM * nN; G = G_; c = c_; }
    __host__ __device__ bool next(int i, Unit& u) const {
        const long L = (long)i * G + c; if (L >= nwg) return false;
        int wgid = (int)L; { const int q = nwg / NXCD, r = nwg % NXCD, xcd = wgid % NXCD, off = wgid / NXCD; wgid = (xcd < r ? xcd * (q + 1) : r * (q + 1) + (xcd - r) * q) + off; }
        const int nig = WGM * nN, gid = wgid / nig, fm = gid * WGM, gsz = (nM - fm) < WGM ? (nM - fm) : WGM;
        u.pm = fm + ((wgid % nig) % gsz); u.pn = (wgid % nig) / gsz; return true;
    }
    __device__ __forceinline__ void a_ready(const Unit&) const {}
    __device__ __forceinline__ void done(const Unit&) const {}
    __device__ __forceinline__ int row_tok(const Unit&, int) const { return 0; }
};

__device__ __forceinline__ unsigned cvt_pk_bf16(float lo, float hi) { unsigned r; asm volatile("v_cvt_pk_bf16_f32 %0, %1, %2" : "=v"(r) : "v"(lo), "v"(hi)); return r; }
typedef float f32x2 __attribute__((ext_vector_type(2)));
template <int ACT  > struct EpiBf16 {
    static constexpr bool PERM = true, AFTER_DRAIN = false, PROBE = false; static_assert(ACT == 0 || ACT == 1, "EpiBf16: ACT is 0 (none) or 1 (gelu_pk)");
    bf16_t* O; int ldc; const float* bias; int split_cols; size_t split_stride; float scale0; const float* rowscale; int nt;
    __device__ __forceinline__ void operator()(const f32x4 (&acc)[2][2][4][2], const Unit& u, int wr, int wc, int fr, int fq) const {
        const int row0 = u.pm * BM + wr * 64 + fr; int colt = u.pn * BM; bf16_t* base = O;
        float sc = 1.f; if (split_cols) { const int t = colt / split_cols; base += (size_t)t * split_stride; colt -= t * split_cols; if (t == 0) sc = scale0; }
        const int col0 = colt + wc * 32 + 8 * fq, bcol0 = u.pn * BM + wc * 32 + 8 * fq;
        f32x4 bv[2][2];
#pragma unroll
        for (int bj = 0; bj < 2; ++bj)
#pragma unroll
            for (int n = 0; n < 2; ++n) bv[bj][n] = bias ? *(const f32x4*)(bias + bcol0 + bj * HALF + 4 * n) : (f32x4){0.f, 0.f, 0.f, 0.f};
#pragma unroll
        for (int ai = 0; ai < 2; ++ai)
#pragma unroll
            for (int m = 0; m < 4; ++m) { bf16_t* rowp = base + (size_t)(row0 + ai * HALF + m * 16) * ldc + col0; const float rsc = rowscale ? rowscale[row0 + ai * HALF + m * 16] * sc : sc;
#pragma unroll
                for (int bj = 0; bj < 2; ++bj) { f32x4 v0 = acc[ai][bj][m][0] + bv[bj][0], v1 = acc[ai][bj][m][1] + bv[bj][1];
                    v0 = v0 * rsc; v1 = v1 * rsc; u32x4 w; w.x = cvt_pk_bf16(v0[0], v0[1]); w.y = cvt_pk_bf16(v0[2], v0[3]); w.z = cvt_pk_bf16(v1[0], v1[1]); w.w = cvt_pk_bf16(v1[2], v1[3]);
                    if (nt) __builtin_nontemporal_store(w, (u32x4*)(rowp + bj * HALF)); else *(u32x4*)(rowp + bj * HALF) = w; } }
    }
};

__device__ __forceinline__ float bflo(unsigned w) { return __uint_as_float(w << 16); }
__device__ __forceinline__ float bfhi(unsigned w) { return __uint_as_float(w & 0xffff0000u); }
struct EpiRes {
    static constexpr bool PERM = true, AFTER_DRAIN = false, PROBE = true;
    bf16_t* hb; int ldc;
    __device__ __forceinline__ void operator()(const f32x4 (&acc)[2][2][4][2], const Unit& u, int wr, int wc, int fr, int fq) const {
        const int row0 = u.pm * BM + wr * 64 + fr, col0 = u.pn * BM + wc * 32 + 8 * fq;
        u32x4 q[2][4][2];
#pragma unroll
        for (int ai = 0; ai < 2; ++ai)
#pragma unroll
            for (int m = 0; m < 4; ++m)
#pragma unroll
                for (int bj = 0; bj < 2; ++bj) q[ai][m][bj] = *(const u32x4*)(hb + (size_t)(row0 + ai * HALF + m * 16) * ldc + col0 + bj * HALF);
#pragma unroll
        for (int ai = 0; ai < 2; ++ai)
#pragma unroll
            for (int m = 0; m < 4; ++m)
#pragma unroll
                for (int bj = 0; bj < 2; ++bj) { const u32x4 qq = q[ai][m][bj]; const f32x4 a0 = acc[ai][bj][m][0], a1 = acc[ai][bj][m][1];
                    u32x4 w; w.x = cvt_pk_bf16(bflo(qq.x) + a0[0], bfhi(qq.x) + a0[1]); w.y = cvt_pk_bf16(bflo(qq.y) + a0[2], bfhi(qq.y) + a0[3]); w.z = cvt_pk_bf16(bflo(qq.z) + a1[0], bfhi(qq.z) + a1[1]); w.w = cvt_pk_bf16(bflo(qq.w) + a1[2], bfhi(qq.w) + a1[3]);
                    *(u32x4*)(hb + (size_t)(row0 + ai * HALF + m * 16) * ldc + col0 + bj * HALF) = w; }
    }
};
__device__ __forceinline__ float sigmoidf_(float a) { return __builtin_amdgcn_rcpf(1.0f + __builtin_amdgcn_exp2f(-1.4426950408889634f * a)); }
struct EpiSiluMul {
    static constexpr bool PERM = true, AFTER_DRAIN = false, PROBE = false;
    bf16_t* O; int ldc; const int* list; const PG8_LAS int* offs; const float* rstd;
    __device__ __forceinline__ void operator()(const f32x4 (&acc)[2][2][4][2], const Unit& u, int wr, int wc, int fr, int fq) const {
        const int row0 = u.pm * BM + wr * 64 + fr, col0 = (u.pn & 3) * HALF + wc * 32 + 8 * fq;
        const int e = u.pn >> 2; const float* lp = rstd + e * 32768 + (u.pm * BM - offs[e]) + wr * 64 + fr;
        float rsv[2][4];
#pragma unroll
        for (int ai = 0; ai < 2; ++ai)
#pragma unroll
            for (int m = 0; m < 4; ++m) rsv[ai][m] = lp[ai * HALF + m * 16];
#pragma unroll
        for (int ai = 0; ai < 2; ++ai)
#pragma unroll
            for (int m = 0; m < 4; ++m) { bf16_t* rowp = O + (size_t)(row0 + ai * HALF + m * 16) * ldc + col0;
                const float rs = rsv[ai][m];
                f32x4 v0, v1;
#pragma unroll
                for (int i = 0; i < 4; ++i) { const float a0 = acc[ai][0][m][0][i] * rs, a1 = acc[ai][0][m][1][i] * rs;
                    v0[i] = a0 * sigmoidf_(a0) * (acc[ai][1][m][0][i] * rs); v1[i] = a1 * sigmoidf_(a1) * (acc[ai][1][m][1][i] * rs); }
                u32x4 w; w.x = cvt_pk_bf16(v0[0], v0[1]); w.y = cvt_pk_bf16(v0[2], v0[3]); w.z = cvt_pk_bf16(v1[0], v1[1]); w.w = cvt_pk_bf16(v1[2], v1[3]);
                *(u32x4*)rowp = w; }
    }
};
struct EpiGate {
    static constexpr bool PERM = true, AFTER_DRAIN = false, PROBE = false;
    const bf16_t* hin; bf16_t* hout; const bf16_t* PL; const float* rs; int ldc; float* part;
    __device__ __forceinline__ void operator()(const f32x4 (&acc)[2][2][4][2], const Unit& u, int wr, int wc, int fr, int fq) const {
        const int row0 = u.pm * BM + wr * 64 + fr, col0 = u.pn * BM + wc * 32 + 8 * fq;
#pragma unroll
        for (int ai = 0; ai < 2; ++ai) { u32x4 q[4][2], p[4][2]; float r_[4], ss[4];
#pragma unroll
            for (int m = 0; m < 4; ++m) { r_[m] = rs[row0 + ai * HALF + m * 16];
#pragma unroll
                for (int bj = 0; bj < 2; ++bj) { const size_t off = (size_t)(row0 + ai * HALF + m * 16) * ldc + col0 + bj * HALF; q[m][bj] = __builtin_nontemporal_load((const u32x4*)(hin + off)); p[m][bj] = __builtin_nontemporal_load((const u32x4*)(PL + off)); } }
#pragma unroll
            for (int m = 0; m < 4; ++m) { float s = 0.f;
#pragma unroll
                for (int bj = 0; bj < 2; ++bj) { const u32x4 qq = q[m][bj], pp = p[m][bj]; const f32x4 a0 = acc[ai][bj][m][0] * r_[m], a1 = acc[ai][bj][m][1] * r_[m];
                    const float v0 = bflo(qq.x) + sigmoidf_(a0[0]) * bflo(pp.x), v1 = bfhi(qq.x) + sigmoidf_(a0[1]) * bfhi(pp.x), v2 = bflo(qq.y) + sigmoidf_(a0[2]) * bflo(pp.y), v3 = bfhi(qq.y) + sigmoidf_(a0[3]) * bfhi(pp.y);
                    const float v4 = bflo(qq.z) + sigmoidf_(a1[0]) * bflo(pp.z), v5 = bfhi(qq.z) + sigmoidf_(a1[1]) * bfhi(pp.z), v6 = bflo(qq.w) + sigmoidf_(a1[2]) * bflo(pp.w), v7 = bfhi(qq.w) + sigmoidf_(a1[3]) * bfhi(pp.w);
                    u32x4 w; w.x = cvt_pk_bf16(v0, v1); w.y = cvt_pk_bf16(v2, v3); w.z = cvt_pk_bf16(v4, v5); w.w = cvt_pk_bf16(v6, v7);
                    s += ((v0 * v0 + v1 * v1) + (v2 * v2 + v3 * v3)) + ((v4 * v4 + v5 * v5) + (v6 * v6 + v7 * v7));
                    *(u32x4*)(hout + (size_t)(row0 + ai * HALF + m * 16) * ldc + col0 + bj * HALF) = w; }
                ss[m] = s; }
            if (part) { const int l = mk_lane();
#pragma unroll
                for (int m = 0; m < 4; ++m) { float s = ss[m]; s += mk_shfl_xor_l(s, 16, l); s += mk_shfl_xor_l(s, 32, l);
                    if (fq == 0) part[(size_t)(row0 + ai * HALF + m * 16) * 32 + 4 * u.pn + wc] = s; } }
            asm volatile("" ::: "memory"); }
    }
};
__device__ __forceinline__ float row_sum16(float v) {
    v += __int_as_float(__builtin_amdgcn_update_dpp(0, __float_as_int(v), 0x128, 0xf, 0xf, false));
    v += __int_as_float(__builtin_amdgcn_update_dpp(0, __float_as_int(v), 0x124, 0xf, 0xf, false));
    v += __int_as_float(__builtin_amdgcn_update_dpp(0, __float_as_int(v), 0x122, 0xf, 0xf, false));
    v += __int_as_float(__builtin_amdgcn_update_dpp(0, __float_as_int(v), 0x121, 0xf, 0xf, false));
    return v;
}
struct EpiProj {
    static constexpr bool PERM = true, AFTER_DRAIN = false, PROBE = false;
    bf16_t* O; int ldc; const PG8_LAS int* tab; const PG8_LAS float* rs; float* kp; int kt0, kpn; const float* rsg;
    __device__ __forceinline__ void operator()(const f32x4 (&acc)[2][2][4][2], const Unit& u, int wr, int wc, int fr, int fq) const {
        const int row0 = u.pm * BM + wr * 64 + fr, col0 = u.pn * BM + wc * 32 + 8 * fq;
        int s = -1;
#pragma unroll
        for (int k = 0; k < 4; ++k) s = (tab[k] == u.pm) ? k : s;
        s = __builtin_amdgcn_readfirstlane(s);
        float rsv[2][4];
        if (s >= 0) { const PG8_LAS float* r = rs + s * 256 + wr * 64 + fr;
#pragma unroll
            for (int ai = 0; ai < 2; ++ai)
#pragma unroll
                for (int m = 0; m < 4; ++m) rsv[ai][m] = r[ai * HALF + m * 16]; }
        else { const float* rg = rsg + row0;
#pragma unroll
            for (int ai = 0; ai < 2; ++ai)
#pragma unroll
                for (int m = 0; m < 4; ++m) { rsv[ai][m] = rg[ai * HALF + m * 16]; asm volatile("" : "+v"(rsv[ai][m])); } }
        if (u.pn == kt0 || u.pn == kt0 + 1) {
            float cs[2][8];
#pragma unroll
            for (int bj = 0; bj < 2; ++bj)
#pragma unroll
                for (int i = 0; i < 8; ++i) cs[bj][i] = 0.f;
#pragma unroll
            for (int ai = 0; ai < 2; ++ai)
#pragma unroll
                for (int m = 0; m < 4; ++m) { bf16_t* rowp = O + (size_t)(row0 + ai * HALF + m * 16) * ldc + col0; const float rsc = rsv[ai][m];
#pragma unroll
                    for (int bj = 0; bj < 2; ++bj) { const f32x4 v0 = acc[ai][bj][m][0] * rsc, v1 = acc[ai][bj][m][1] * rsc;
                        u32x4 w; w.x = cvt_pk_bf16(v0[0], v0[1]); w.y = cvt_pk_bf16(v0[2], v0[3]); w.z = cvt_pk_bf16(v1[0], v1[1]); w.w = cvt_pk_bf16(v1[2], v1[3]);
                        cs[bj][0] += bflo(w.x); cs[bj][1] += bfhi(w.x); cs[bj][2] += bflo(w.y); cs[bj][3] += bfhi(w.y); cs[bj][4] += bflo(w.z); cs[bj][5] += bfhi(w.z); cs[bj][6] += bflo(w.w); cs[bj][7] += bfhi(w.w);
                        *(u32x4*)(rowp + bj * HALF) = w; } }
#pragma unroll
            for (int bj = 0; bj < 2; ++bj) { f32x4 a, b;
#pragma unroll
                for (int i = 0; i < 4; ++i) { a[i] = row_sum16(cs[bj][i]); b[i] = row_sum16(cs[bj][4 + i]); }
                if (fr == 0) { float* dp = kp + (size_t)wr * kpn + (size_t)((((u.pm >> 4) * 4 + (u.pn - kt0) * 2 + bj) * 16 + (u.pm & 15)) * 128 + wc * 32 + 8 * fq); *(f32x4*)dp = a; *(f32x4*)(dp + 4) = b; } }
            return;
        }
#pragma unroll
        for (int ai = 0; ai < 2; ++ai)
#pragma unroll
            for (int m = 0; m < 4; ++m) { bf16_t* rowp = O + (size_t)(row0 + ai * HALF + m * 16) * ldc + col0; const float rsc = rsv[ai][m];
#pragma unroll
                for (int bj = 0; bj < 2; ++bj) { const f32x4 v0 = acc[ai][bj][m][0] * rsc, v1 = acc[ai][bj][m][1] * rsc;
                    u32x4 w; w.x = cvt_pk_bf16(v0[0], v0[1]); w.y = cvt_pk_bf16(v0[2], v0[3]); w.z = cvt_pk_bf16(v1[0], v1[1]); w.w = cvt_pk_bf16(v1[2], v1[3]);
                    *(u32x4*)(rowp + bj * HALF) = w; } }
    }
};
struct GroupedOrder {
    static constexpr bool B_NT = false;
    const PG8_LAS unsigned char* tile_e; int nTiles, nN, G, c;
    const int* list; const PG8_LAS int* offs;
    __device__ __forceinline__ bool next(int i, Unit& u) const {
        const int x = c & 7, slot = c >> 3, per = G >> 3; int L = i * per + slot;
#pragma unroll
        for (int k = 0; k < 4; ++k) { const int e = x + 8 * k; const int t0 = offs[e] >> 8, t1 = (e == 31) ? nTiles : (offs[e + 1] >> 8); const int n = (t1 - t0) * nN;
            if (L < n) { u.pm = __builtin_amdgcn_readfirstlane(t0 + L / nN); u.pn = __builtin_amdgcn_readfirstlane(e * nN + L % nN); return true; }
            L -= n; }
        return false;
    }
    __device__ __forceinline__ void a_ready(const Unit&) const {}
    __device__ __forceinline__ void done(const Unit&) const {}
    static constexpr int LTAB_UNITS = 8;
    const PG8_LAS int* ltab;
    __device__ __forceinline__ int row_tok(const Unit& u, int r, int ord) const { if (ltab != nullptr && ord < LTAB_UNITS) return ltab[ord * 256 + r]; const int e = u.pn / nN; int v = list[e * 32768 + (u.pm * BM - offs[e]) + r];
        asm volatile("" : "+v"(v)); return v; }
};
template <class Epi, class Sched, bool ALIGN_EPI = false, bool SP2 = false, bool GATHER = false>
__device__ __forceinline__ void gemm_phase(PG8_LAS unsigned char* lds, const Gemm g, const Sched& S, const Epi& E, const int wave_idx) {
    int wid_o = wave_idx; asm volatile("" : "+s"(wid_o));
    const int tid = wid_o * 64 + mk_lane(), wid = wid_o    , lane = tid & 63, wr = wid >> 2, wc = wid & 3, fr = lane & 15, fq = lane >> 4;
    const int K = g.K, nt = K / BK;
    unsigned voffA[2], voffB[2];
#pragma unroll
    for (int i = 0; i < 2; ++i) { int R, C; stage_rc(tid * 16 + i * 8192, R, C); const int Rb = Epi::PERM ? ((R & ~31) + perm32(R & 31)) : R;
        voffA[i] = (unsigned)(R * K + C) * 2u; voffB[i] = (unsigned)(Rb * K + C) * 2u; }
    const size_t kstep = (size_t)(BK * 2);
    const size_t hstep = (size_t)HALF * K * 2;
    const size_t tstep = 2 * hstep;
    const unsigned ldsw = (unsigned)wid * 1024u;
    const int aoff = lds_byte(wr * 64 + fr, fq * 8), boff = lds_byte(wc * 32 + fr, fq * 8);
#define PG8_SA(b, h) (((b) * 2 + (h)) * HTB)
#define PG8_SB(b, h) ((4 + (b) * 2 + (h)) * HTB)
#define PG8_STAGE(bufoff, gbase, voff) do { _Pragma("unroll") for (int _i = 0; _i < 2; ++_i) \
        __builtin_amdgcn_global_load_lds((const unsigned*)((const char*)(gbase) + (voff)[_i]), (PG8_LAS unsigned*)(lds + (bufoff) + ldsw + _i * 8192), 16, 0, 0); } while (0)
#define PG8_STAGE_B(bufoff, gbase, voff) do { _Pragma("unroll") for (int _i = 0; _i < 2; ++_i) \
        __builtin_amdgcn_global_load_lds((const unsigned*)((const char*)(gbase) + (voff)[_i]), (PG8_LAS unsigned*)(lds + (bufoff) + ldsw + _i * 8192), 16, 0, Sched::B_NT ? 2 : 0); } while (0)
#define PG8_STAGE_A(bufoff, base, hh_, nx_) do { if constexpr (GATHER) { unsigned og_[2] = {(nx_) ? offN[hh_][0] : offA[hh_][0], (nx_) ? offN[hh_][1] : offA[hh_][1]}; asm volatile("" : "+v"(og_[0]), "+v"(og_[1]));   PG8_STAGE(bufoff, base, og_); } \
        else PG8_STAGE(bufoff, (base) + ((hh_) ? hstep : 0), voffA); } while (0)
#define PG8_ROWOFFS(dst, un, ord) do { _Pragma("unroll") for (int h_ = 0; h_ < 2; ++h_) _Pragma("unroll") for (int i_ = 0; i_ < 2; ++i_) { int R_, C_; stage_rc(tid * 16 + i_ * 8192, R_, C_); \
        dst[h_][i_] = ((unsigned)S.row_tok(un, h_ * HALF + R_, ord) & 0x7fffu) * (unsigned)(K * 2) + (unsigned)(C_ * 2); } } while (0)
#define PG8_LDA(dst, b, h) do { _Pragma("unroll") for (int m = 0; m < 4; ++m) _Pragma("unroll") for (int k = 0; k < 2; ++k) dst[m][k] = *(const PG8_LAS bf16x8*)(lds + PG8_SA(b, h) + aoff + m * 2048 + k * 1024); } while (0)
#define PG8_LDB(dst, b, h) do { _Pragma("unroll") for (int n = 0; n < 2; ++n) _Pragma("unroll") for (int k = 0; k < 2; ++k) dst[n][k] = *(const PG8_LAS bf16x8*)(lds + PG8_SB(b, h) + boff + n * 2048 + k * 1024); } while (0)
#define PG8_MMA(ai, bj, At, Bt) do { __builtin_amdgcn_s_setprio(1); _Pragma("unroll") for (int m = 0; m < 4; ++m) _Pragma("unroll") for (int n = 0; n < 2; ++n) _Pragma("unroll") for (int k = 0; k < 2; ++k) \
        acc[ai][bj][m][n] = __builtin_amdgcn_mfma_f32_16x16x32_bf16(Bt[n][k], At[m][k], acc[ai][bj][m][n], 0, 0, 0); __builtin_amdgcn_s_setprio(0); } while (0)
#define PG8_WAIT_V(n) asm volatile("s_waitcnt vmcnt(" #n ")" ::: "memory")
#define PG8_WAIT_L(n) asm volatile("s_waitcnt lgkmcnt(" #n ")" ::: "memory")
#define PG8_BAR __builtin_amdgcn_s_barrier()
#define PG8_SCHED __builtin_amdgcn_sched_barrier(0)
    Unit cur, nxt; int ui = 0;
    if (!S.next(0, cur)) return;
    f32x4 acc[2][2][4][2];
#pragma unroll
    for (int a = 0; a < 2; ++a)
#pragma unroll
        for (int b = 0; b < 2; ++b)
#pragma unroll
            for (int m = 0; m < 4; ++m)
#pragma unroll
                for (int n = 0; n < 2; ++n) acc[a][b][m][n] = (f32x4){0.f, 0.f, 0.f, 0.f};
    bf16x8 At[4][2], B0[2][2], B1[2][2];
    const char* cA = (const char*)g.A + (GATHER ? (size_t)0 : (size_t)cur.pm * tstep);
    unsigned offA[2][2] = {{0u, 0u}, {0u, 0u}}, offN[2][2] = {{0u, 0u}, {0u, 0u}};
    if constexpr (GATHER) PG8_ROWOFFS(offA, cur, 0); const char* cB = (const char*)g.Bt + (size_t)cur.pn * tstep;
    S.a_ready(cur);
    if constexpr (SP2) {
        PG8_STAGE_B(PG8_SB(0, 0), cB, voffB); PG8_STAGE_B(PG8_SB(0, 1), cB + hstep, voffB); PG8_STAGE_A(PG8_SA(0, 0), cA, 0, false); PG8_STAGE_A(PG8_SA(0, 1), cA, 1, false);
        if (wr == 1) PG8_BAR;
        PG8_WAIT_V(2); PG8_BAR;
        PG8_STAGE_B(PG8_SB(1, 0), cB + kstep, voffB); PG8_STAGE_A(PG8_SA(1, 0), cA + kstep, 0, false); PG8_STAGE_B(PG8_SB(1, 1), cB + hstep + kstep, voffB);
        PG8_WAIT_V(6); PG8_BAR;
    } else {
        PG8_STAGE_B(PG8_SB(0, 0), cB, voffB); PG8_STAGE_A(PG8_SA(0, 0), cA, 0, false); PG8_STAGE_B(PG8_SB(0, 1), cB + hstep, voffB); PG8_STAGE_A(PG8_SA(0, 1), cA, 1, false);
        if (wr == 1) PG8_BAR;
        PG8_WAIT_V(4); PG8_BAR;
        PG8_STAGE_B(PG8_SB(1, 0), cB + kstep, voffB); PG8_STAGE_A(PG8_SA(1, 0), cA + kstep, 0, false); PG8_STAGE_B(PG8_SB(1, 1), cB + hstep + kstep, voffB);
        PG8_WAIT_V(6); PG8_BAR;
    }
    for (;;) {
        const bool has_next = S.next(ui + 1, nxt);
        const char* nA = (has_next && !GATHER) ? (const char*)g.A + (size_t)nxt.pm * tstep : cA;
        if constexpr (GATHER) { if (has_next) PG8_ROWOFFS(offN, nxt, ui + 1); else { offN[0][0] = offA[0][0]; offN[0][1] = offA[0][1]; offN[1][0] = offA[1][0]; offN[1][1] = offA[1][1]; } } const char* nB = has_next ? (const char*)g.Bt + (size_t)nxt.pn * tstep : cB;
        for (int t = 0; t < nt; t += 2) {
            const bool last = (t == nt - 2);
            const char* a1 = cA + (size_t)(t + 1) * kstep;
            const char* a2 = last ? nA : cA + (size_t)(t + 2) * kstep; const char* b2 = last ? nB : cB + (size_t)(t + 2) * kstep;
            const char* a3 = a2 + kstep; const char* b3 = b2 + kstep;
            if (last && has_next) S.a_ready(nxt);
            if constexpr (SP2) {
            PG8_LDB(B0, 0, 0); PG8_LDB(B1, 0, 1); PG8_SCHED; PG8_LDA(At, 0, 0); PG8_STAGE_A(PG8_SA(1, 1), a1, 1, false);
            PG8_WAIT_V(8); PG8_WAIT_L(0); PG8_BAR; PG8_MMA(0, 0, At, B0); PG8_MMA(0, 1, At, B1); PG8_BAR; PG8_SCHED;
            PG8_LDA(At, 0, 1); PG8_STAGE_B(PG8_SB(0, 0), b2, voffB); PG8_STAGE_B(PG8_SB(0, 1), b2 + hstep, voffB); PG8_STAGE_A(PG8_SA(0, 0), a2, 0, last);
            PG8_WAIT_V(8); PG8_WAIT_L(0); PG8_BAR; PG8_MMA(1, 0, At, B0); PG8_MMA(1, 1, At, B1); PG8_BAR; PG8_SCHED;
            PG8_LDB(B0, 1, 0); PG8_LDB(B1, 1, 1); PG8_SCHED; PG8_LDA(At, 1, 0); PG8_STAGE_A(PG8_SA(0, 1), a2, 1, last);
            PG8_WAIT_V(8); PG8_WAIT_L(0); PG8_BAR; PG8_MMA(0, 0, At, B0); PG8_MMA(0, 1, At, B1); PG8_BAR; PG8_SCHED;
            PG8_LDA(At, 1, 1); PG8_STAGE_B(PG8_SB(1, 0), b3, voffB); PG8_STAGE_B(PG8_SB(1, 1), b3 + hstep, voffB); PG8_STAGE_A(PG8_SA(1, 0), a3, 0, last);
            PG8_WAIT_V(8); PG8_WAIT_L(0); PG8_BAR; PG8_MMA(1, 0, At, B0); PG8_MMA(1, 1, At, B1); PG8_BAR; PG8_SCHED;
            } else {
            PG8_LDB(B0, 0, 0); PG8_SCHED; PG8_LDA(At, 0, 0); PG8_STAGE_A(PG8_SA(1, 1), a1, 1, false);
            PG8_WAIT_L(8); PG8_BAR; PG8_WAIT_L(0); PG8_MMA(0, 0, At, B0); PG8_BAR; PG8_SCHED;
            PG8_LDB(B1, 0, 1); PG8_STAGE_B(PG8_SB(0, 0), b2, voffB);
            PG8_BAR; PG8_WAIT_L(0); PG8_MMA(0, 1, At, B1); PG8_BAR;
            PG8_LDA(At, 0, 1); PG8_STAGE_A(PG8_SA(0, 0), a2, 0, last);
            PG8_BAR; PG8_WAIT_L(0); PG8_MMA(1, 0, At, B0); PG8_BAR; PG8_SCHED;
            PG8_STAGE_B(PG8_SB(0, 1), b2 + hstep, voffB);
            PG8_WAIT_V(6); PG8_BAR; PG8_MMA(1, 1, At, B1); PG8_BAR;
            PG8_LDB(B0, 1, 0); PG8_SCHED; PG8_LDA(At, 1, 0); PG8_STAGE_A(PG8_SA(0, 1), a2, 1, last);
            PG8_WAIT_L(8); PG8_BAR; PG8_WAIT_L(0); PG8_MMA(0, 0, At, B0); PG8_BAR; PG8_SCHED;
            PG8_LDB(B1, 1, 1); PG8_STAGE_B(PG8_SB(1, 0), b3, voffB);
            PG8_BAR; PG8_WAIT_L(0); PG8_MMA(0, 1, At, B1); PG8_BAR;
            PG8_LDA(At, 1, 1); PG8_STAGE_A(PG8_SA(1, 0), a3, 0, last);
            PG8_BAR; PG8_WAIT_L(0); PG8_MMA(1, 0, At, B0); PG8_BAR; PG8_SCHED;
            PG8_STAGE_B(PG8_SB(1, 1), b3 + hstep, voffB);
            PG8_WAIT_V(6); PG8_BAR; PG8_MMA(1, 1, At, B1); PG8_BAR;
            }
        }
        if constexpr (ALIGN_EPI) { if (wr == 0) PG8_BAR; }
#ifdef PG8_EPI_PROBE
        if constexpr (!Epi::AFTER_DRAIN) { unsigned long long t0_ = 0ull; if constexpr (Epi::PROBE) t0_ = __builtin_amdgcn_s_memrealtime();
            E(acc, cur, wr, wc, fr, fq); S.done(cur);
            if constexpr (Epi::PROBE) { if (blockIdx.x == 0 && wid == 0 && mk_lane() == 0) *(PG8_LAS unsigned long long*)(lds + PG8_EPI_PROBE) += __builtin_amdgcn_s_memrealtime() - t0_; } }
#else
        if constexpr (!Epi::AFTER_DRAIN) { E(acc, cur, wr, wc, fr, fq); S.done(cur); }
#endif
        if (!has_next) break;
#pragma unroll
        for (int a = 0; a < 2; ++a)
#pragma unroll
            for (int b = 0; b < 2; ++b)
#pragma unroll
                for (int m = 0; m < 4; ++m)
#pragma unroll
                    for (int n = 0; n < 2; ++n) acc[a][b][m][n] = (f32x4){0.f, 0.f, 0.f, 0.f};
        cur = nxt; cA = nA; cB = nB; ++ui;
        if constexpr (GATHER) { offA[0][0] = offN[0][0]; offA[0][1] = offN[0][1]; offA[1][0] = offN[1][0]; offA[1][1] = offN[1][1]; }
        if constexpr (ALIGN_EPI) { if (wr == 1) PG8_BAR; }
    }
    PG8_WAIT_V(0);
    if constexpr (!ALIGN_EPI) { if (wr == 0) PG8_BAR; }
    PG8_BAR;
    if constexpr (Epi::AFTER_DRAIN) { E.fused(acc, cur, wr, wc, fr, fq, lds, wid, lane); S.done(cur); }
#undef PG8_SA
#undef PG8_SB
#undef PG8_STAGE
#undef PG8_STAGE_B
#undef PG8_STAGE_A
#undef PG8_ROWOFFS
#undef PG8_LDA
#undef PG8_LDB
#undef PG8_MMA
#undef PG8_WAIT_V
#undef PG8_WAIT_L
#undef PG8_BAR
#undef PG8_SCHED
}
}

#ifndef ATT_SDEPTH
#define ATT_SDEPTH 1
#endif
#ifndef ATT_PRIO
#define ATT_PRIO 1
#endif
#ifndef ATT_SWA_WAVE
#define ATT_SWA_WAVE 1
#endif
#ifndef ATT_DIFF_FUSED
#define ATT_DIFF_FUSED 1
#endif
#ifndef ATT_SDEPTH_DIFF
#define ATT_SDEPTH_DIFF 2
#endif
namespace att {
using bf16x8 = __attribute__((ext_vector_type(8))) short;
using s16x4  = __attribute__((ext_vector_type(4))) short;
using f32x16 = __attribute__((ext_vector_type(16))) float;
using f32x4  = __attribute__((ext_vector_type(4))) float;
using u32x4  = __attribute__((ext_vector_type(4))) unsigned;
constexpr int NW = 8, QBLK = 32, KVBLK = 64, LDP = 5120, LDY = 2048, SEQL = 4096;
constexpr int SHM_V = 16384, SHM_K = 16384;
constexpr int OFF_V = 0, OFF_K = 2 * SHM_V, OFF_WS = OFF_K + 2 * SHM_K, OFF_LUT = OFF_WS + NW * 64 * 4, OFF_MISC = OFF_LUT + 512, OFF_STG = 69632, STG_PITCH = 272, STG_WAVE = 32 * STG_PITCH;
constexpr int ATT_LDS = OFF_STG + NW * STG_WAVE;
constexpr int OFF_LUT4 = 147456, LUT4_N = 528, LUT4_COPIES = 5, OFF_LUTH = OFF_LUT4 + LUT4_COPIES * LUT4_N * 4, LUTH_BYTES = 6 * 128 * 4;
static_assert(OFF_MISC + 256 <= OFF_STG, "attention LDS map");
constexpr float LOG2E = 1.4426950408889634f, NEGB = -1e30f, THR2 = 11.5f;
#define SBAR() __builtin_amdgcn_sched_barrier(0)
__device__ __forceinline__ int crow(int r, int hi) { return (r & 3) + 8 * (r >> 2) + 4 * hi; }
__device__ __forceinline__ unsigned cvtpk(float lo, float hi) { unsigned r; asm volatile("v_cvt_pk_bf16_f32 %0, %1, %2" : "=v"(r) : "v"(lo), "v"(hi)); return r; }
__device__ __forceinline__ float bf2f(short x) { return __uint_as_float(((unsigned)(unsigned short)x) << 16); }
template <int DQK> __device__ __forceinline__ int kswz(int row, int colB) { return row * (2 * DQK) + (colB ^ ((((DQK == 128) ? row : (row >> 1)) & 7) << 4)); }

template <int MODE>
__device__ __forceinline__ void bias_mask(f32x16& p0, f32x16& p1, int kt, int qpos, int wave_qmin, int hi, float C, const float* lut4, float cfar, unsigned sel, int jblk) {
  bool lane_off = false;
  if (MODE == 1) { const int blk = kt >> 8; if (blk < jblk) lane_off = !((sel >> blk) & 1u); }
  const bool nearT = (kt + 63 + 128 > wave_qmin);
  if (!nearT) {
    if (MODE == 0) {
#pragma unroll
      for (int r = 0; r < 16; ++r) { p0[r] = NEGB; p1[r] = NEGB; }
    } else {
#pragma unroll
      for (int r = 0; r < 16; ++r) { p0[r] = lane_off ? NEGB : fmaf(p0[r], C, cfar); p1[r] = lane_off ? NEGB : fmaf(p1[r], C, cfar); }
    }
  } else {
    const int kb = kt + 4 * hi, D = qpos - kb, c4 = qpos & 3;
    const float* Lc = lut4 + ((MODE == 1 && lane_off) ? 4 * LUT4_N + (256 + c4 - D) : c4 * LUT4_N + (256 + c4 - D));
#pragma unroll
    for (int g = 0; g < 4; ++g) {
      const f32x4 b0 = *(const f32x4*)(Lc + 8 * g), b1 = *(const f32x4*)(Lc + 8 * g + 32);
#pragma unroll
      for (int i = 0; i < 4; ++i) { const int r = 4 * g + i; p0[r] = fmaf(p0[r], C, b0[i]); p1[r] = fmaf(p1[r], C, b1[i]); }
      if (g & 1) SBAR();
    }
  }
}
__device__ __forceinline__ void partialSM(f32x16& p0, f32x16& p1, float& m_reg, float& alpha) {
  float pmax = p0[0];
#pragma unroll
  for (int r = 1; r < 16; ++r) pmax = fmaxf(pmax, p0[r]);
#pragma unroll
  for (int r = 0; r < 16; ++r) pmax = fmaxf(pmax, p1[r]);
  { auto rr = __builtin_amdgcn_permlane32_swap(__float_as_uint(pmax), __float_as_uint(pmax), false, false);
    pmax = fmaxf(__uint_as_float(rr[0]), __uint_as_float(rr[1])); }
  float mn;
  if (__builtin_expect(__all(pmax - m_reg <= THR2), 1)) { mn = m_reg; alpha = 1.f; }
  else { mn = fmaxf(m_reg, pmax); alpha = __builtin_amdgcn_exp2f(m_reg - mn); m_reg = mn; }
#pragma unroll
  for (int r = 0; r < 16; ++r) { p0[r] = __builtin_amdgcn_exp2f(p0[r] - mn); p1[r] = p1[r] - mn; }
}
template <int MODE>
__device__ __forceinline__ void tile_sm(f32x16& p0, f32x16& p1, int kt, int qpos, int wave_qmin, int hi, float C, const float* lut, float cfar, unsigned sel, int jblk, float& m_reg, float& alpha) {
  const bool nearT = (kt + 63 + 128 > wave_qmin);
  if (nearT) { bias_mask<MODE>(p0, p1, kt, qpos, wave_qmin, hi, C, (const float*)((const char*)lut + (OFF_LUT4 - OFF_LUT)), cfar, sel, jblk); partialSM(p0, p1, m_reg, alpha); return; }
  if (MODE == 0) {
#pragma unroll
    for (int r = 0; r < 16; ++r) { p0[r] = 0.f; p1[r] = NEGB; }
    alpha = 1.f; return;
  }
  bool lane_off = false;
  if (MODE == 1) { const int blk = kt >> 8; if (blk < jblk) lane_off = !((sel >> blk) & 1u); }
  float pmax = p0[0];
#pragma unroll
  for (int r = 1; r < 16; ++r) pmax = fmaxf(pmax, p0[r]);
#pragma unroll
  for (int r = 0; r < 16; ++r) pmax = fmaxf(pmax, p1[r]);
  { auto rr = __builtin_amdgcn_permlane32_swap(__float_as_uint(pmax), __float_as_uint(pmax), false, false);
    pmax = fmaxf(__uint_as_float(rr[0]), __uint_as_float(rr[1])); }
  const float tmax = lane_off ? NEGB : fmaf(pmax, C, cfar);
  float mn;
  if (__builtin_expect(__all(tmax - m_reg <= THR2), 1)) { mn = m_reg; alpha = 1.f; }
  else { mn = fmaxf(m_reg, tmax); alpha = __builtin_amdgcn_exp2f(m_reg - mn); m_reg = mn; }
  const float off = lane_off ? NEGB : cfar - mn;
#pragma unroll
  for (int r = 0; r < 16; ++r) { p0[r] = __builtin_amdgcn_exp2f(fmaf(p0[r], C, off)); p1[r] = fmaf(p1[r], C, off); }
}
__device__ __forceinline__ void finishSM(f32x16& p0, f32x16& p1, float alpha, float& l_reg, bf16x8& pa0, bf16x8& pa1, bf16x8& pa2, bf16x8& pa3) {
#pragma unroll
  for (int r = 0; r < 16; ++r) p1[r] = __builtin_amdgcn_exp2f(p1[r]);
  float ps = 0;
#pragma unroll
  for (int r = 0; r < 16; ++r) ps += p0[r];
#pragma unroll
  for (int r = 0; r < 16; ++r) ps += p1[r];
  { auto rr = __builtin_amdgcn_permlane32_swap(__float_as_uint(ps), __float_as_uint(ps), false, false);
    ps = __uint_as_float(rr[0]) + __uint_as_float(rr[1]); }
  l_reg = l_reg * alpha + ps;
#define PK4(P, BASE, OUT) do { unsigned a0 = cvtpk(P[BASE + 0], P[BASE + 1]), a1 = cvtpk(P[BASE + 2], P[BASE + 3]);   \
    unsigned b0 = cvtpk(P[BASE + 4], P[BASE + 5]), b1 = cvtpk(P[BASE + 6], P[BASE + 7]);                              \
    auto r0 = __builtin_amdgcn_permlane32_swap(a0, b0, false, false); auto r1 = __builtin_amdgcn_permlane32_swap(a1, b1, false, false); \
    u32x4 w = {r0[0], r1[0], r0[1], r1[1]}; OUT = *reinterpret_cast<bf16x8*>(&w); } while (0)
  PK4(p0, 0, pa0); PK4(p0, 8, pa1); PK4(p1, 0, pa2); PK4(p1, 8, pa3);
#undef PK4
}
template <int DQK>
__device__ __forceinline__ void qkt(f32x16& p0, f32x16& p1, const char* Ks, const bf16x8* qr, int r32, int hi) {
  p0 = f32x16{}; p1 = f32x16{};
#pragma unroll
  for (int d0 = 0; d0 < DQK / 16; ++d0) { const int cb = (d0 * 16 + hi * 8) * 2;
    const bf16x8 b0 = *reinterpret_cast<const bf16x8*>(Ks + kswz<DQK>(r32, cb));
    const bf16x8 b1 = *reinterpret_cast<const bf16x8*>(Ks + kswz<DQK>(32 + r32, cb));
    p0 = __builtin_amdgcn_mfma_f32_32x32x16_bf16(b0, qr[d0], p0, 0, 0, 0);
    p1 = __builtin_amdgcn_mfma_f32_32x32x16_bf16(b1, qr[d0], p1, 0, 0, 0); }
}
__device__ __forceinline__ int v_st(int k, int c) { const int kk = (k & ~0xC) | ((k & 4) << 1) | ((k & 8) >> 1); return ((kk >> 3) * 4 + (c >> 5)) * 512 + ((kk & 7) * 32 + (c & 31)) * 2; }
__device__ __forceinline__ int v_rd_base(int lane) { return ((lane & 3) << 3) | (((lane >> 2) & 3) << 6) | (((lane >> 4) & 1) << 5) | (((lane >> 5) & 1) << 8); }
constexpr int v_rd_off(int d0, int ks, int half) { return d0 * 512 + ks * 4096 + half * 2048; }
template <int OFF> __device__ __forceinline__ s16x4 tr_read(int vb) {
  s16x4 r; asm volatile("ds_read_b64_tr_b16 %0, %1 offset:%2" : "=&v"(r) : "v"(vb), "i"(OFF) : "memory"); return r;
}
template <int D0> __device__ __forceinline__ void pv_one(f32x16& od, int vb, bf16x8 pa0, bf16x8 pa1, bf16x8 pa2, bf16x8 pa3) {
  const s16x4 l0 = tr_read<v_rd_off(D0, 0, 0)>(vb), h0 = tr_read<v_rd_off(D0, 0, 1)>(vb), l1 = tr_read<v_rd_off(D0, 1, 0)>(vb), h1 = tr_read<v_rd_off(D0, 1, 1)>(vb);
  const s16x4 l2 = tr_read<v_rd_off(D0, 2, 0)>(vb), h2 = tr_read<v_rd_off(D0, 2, 1)>(vb), l3 = tr_read<v_rd_off(D0, 3, 0)>(vb), h3 = tr_read<v_rd_off(D0, 3, 1)>(vb);
  asm volatile("s_waitcnt lgkmcnt(0)" ::: "memory"); SBAR();
#if ATT_PRIO
  __builtin_amdgcn_s_setprio(ATT_PRIO);
#endif
#define PK(L, H) (bf16x8){L[0], L[1], L[2], L[3], H[0], H[1], H[2], H[3]}
  od = __builtin_amdgcn_mfma_f32_32x32x16_bf16(pa0, PK(l0, h0), od, 0, 0, 0);
  od = __builtin_amdgcn_mfma_f32_32x32x16_bf16(pa1, PK(l1, h1), od, 0, 0, 0);
  od = __builtin_amdgcn_mfma_f32_32x32x16_bf16(pa2, PK(l2, h2), od, 0, 0, 0);
  od = __builtin_amdgcn_mfma_f32_32x32x16_bf16(pa3, PK(l3, h3), od, 0, 0, 0);
#if ATT_PRIO
  __builtin_amdgcn_s_setprio(0);
#endif
#undef PK
}
__device__ __forceinline__ void pv_d0(f32x16* o, int vb, bf16x8 pa0, bf16x8 pa1, bf16x8 pa2, bf16x8 pa3) {
  pv_one<0>(o[0], vb, pa0, pa1, pa2, pa3); pv_one<1>(o[1], vb, pa0, pa1, pa2, pa3); pv_one<2>(o[2], vb, pa0, pa1, pa2, pa3); pv_one<3>(o[3], vb, pa0, pa1, pa2, pa3);
}

__device__ __forceinline__ void pv_all1(f32x16* o, int vb, bf16x8 pa0, bf16x8 pa1, bf16x8 pa2, bf16x8 pa3) {
  s16x4 va[8], vc[8];
#define TR8(D0, L) do { L[0] = tr_read<v_rd_off(D0, 0, 0)>(vb); L[1] = tr_read<v_rd_off(D0, 0, 1)>(vb); L[2] = tr_read<v_rd_off(D0, 1, 0)>(vb); L[3] = tr_read<v_rd_off(D0, 1, 1)>(vb); \
    L[4] = tr_read<v_rd_off(D0, 2, 0)>(vb); L[5] = tr_read<v_rd_off(D0, 2, 1)>(vb); L[6] = tr_read<v_rd_off(D0, 3, 0)>(vb); L[7] = tr_read<v_rd_off(D0, 3, 1)>(vb); } while (0)
#define PK(L, H) (bf16x8){L[0], L[1], L[2], L[3], H[0], H[1], H[2], H[3]}
#define MM4(OA, L) do { OA = __builtin_amdgcn_mfma_f32_32x32x16_bf16(pa0, PK(L[0], L[1]), OA, 0, 0, 0); OA = __builtin_amdgcn_mfma_f32_32x32x16_bf16(pa1, PK(L[2], L[3]), OA, 0, 0, 0); \
    OA = __builtin_amdgcn_mfma_f32_32x32x16_bf16(pa2, PK(L[4], L[5]), OA, 0, 0, 0); OA = __builtin_amdgcn_mfma_f32_32x32x16_bf16(pa3, PK(L[6], L[7]), OA, 0, 0, 0); } while (0)
  TR8(0, va); TR8(1, vc); asm volatile("s_waitcnt lgkmcnt(8)" ::: "memory"); SBAR(); MM4(o[0], va); SBAR();
  TR8(2, va); asm volatile("s_waitcnt lgkmcnt(8)" ::: "memory"); SBAR(); MM4(o[1], vc); SBAR();
  TR8(3, vc); asm volatile("s_waitcnt lgkmcnt(8)" ::: "memory"); SBAR(); MM4(o[2], va); SBAR();
  asm volatile("s_waitcnt lgkmcnt(0)" ::: "memory"); SBAR(); MM4(o[3], vc);
#undef MM4
#undef PK
#undef TR8
}

struct AttnArgs { int layer; float lambda_init; };
constexpr size_t ATT_WS_PROJ = (size_t)434 << 20, ATT_WS_YCAT = (size_t)754 << 20, ATT_WS_KMEAN = (size_t)1 << 20;
#define A_proj ((const unsigned short*)(wsptr() + ATT_WS_PROJ))
#define A_ycat ((unsigned short*)(wsptr() + ATT_WS_YCAT))
#define A_kmean ((const float*)(wsptr() + ATT_WS_KMEAN))
#define A_kpart ((const float*)(wsptr() + ATT_WS_KP))
constexpr size_t ATT_WS_KP = (size_t)882 << 20; constexpr int ATT_KP_N = 8 * 4 * 16 * 128;
#define A_rel_bias (inptr(2))
#define A_sinks (inptr(6) + A.layer * 6)
#define A_lq1 (inptr(7) + A.layer * 64)
#define A_lk1 (inptr(8) + A.layer * 64)
#define A_lq2 (inptr(9) + A.layer * 64)
#define A_lk2 (inptr(10) + A.layer * 64)
#define A_subln (inptr(11) + A.layer * 128)
__device__ const unsigned char REL_BUCKET_TAB[128] = {
  0, 1, 2, 3, 4, 5, 6, 7, 8, 9, 10, 11, 12, 13, 14, 15, 16, 16, 16, 17, 17, 18, 18, 18, 19, 19, 19, 20, 20, 20, 20, 21, 21, 21, 21, 22, 22, 22, 22, 22, 23, 23, 23, 23, 23, 23, 24, 24, 24, 24, 24, 24,
  25, 25, 25, 25, 25, 25, 25, 26, 26, 26, 26, 26, 26, 26, 26, 27, 27, 27, 27, 27, 27, 27, 27, 27, 27, 28, 28, 28, 28, 28, 28, 28, 28, 28, 28, 29, 29, 29, 29, 29, 29, 29, 29, 29, 29, 29, 29,
  30, 30, 30, 30, 30, 30, 30, 30, 30, 30, 30, 30, 30, 30, 31, 31, 31, 31, 31, 31, 31, 31, 31, 31, 31, 31, 31, 31, 31};

template <int MODE>
__device__ __forceinline__ void attn_pass(const AttnArgs& A, int b, int hh, int qb, int pass, float lam, char* lds, int tid) {
  constexpr int DQK = (MODE == 2) ? 64 : 128;
  constexpr int NPASS = (MODE == 2) ? 2 : 1;
  constexpr int SDEPTH = (MODE == 2) ? ATT_SDEPTH_DIFF : ATT_SDEPTH;
  constexpr int QCOL = (MODE == 0) ? 0 : (MODE == 1) ? 1280 : 2816;
  constexpr int KCOL = (MODE == 0) ? 768 : (MODE == 1) ? 1792 : 3584;
  constexpr int VCOL = (MODE == 0) ? 1024 : (MODE == 1) ? 2304 : 4352;
  constexpr int OCOL = (MODE == 0) ? 0 : (MODE == 1) ? 768 : 1280;
  const float C = ((MODE == 2) ? 0.125f : 0.088388347648318440f) * LOG2E;
  const int lane = tid & 63, r32 = lane & 31, hi = lane >> 5; const int wid = __builtin_amdgcn_readfirstlane(tid >> 6);
  const int kvh = (MODE == 0) ? hh / 3 : hh;
  char* V_lds = lds + OFF_V; char* K_lds = lds + OFF_K;
  float* wsl = (float*)(lds + OFF_WS) + wid * 64; float* li_l = wsl; float* al_l = wsl + 32;
  const float* lut = (const float*)(lds + OFF_LUT);
  char* stg = lds + OFF_STG + wid * STG_WAVE;
  const int q0 = qb * 256;
  const int qpos = q0 + wid * QBLK + r32, wave_qmin = q0 + wid * QBLK;
  const long rowb = (long)b * SEQL;
  const float cfar = lut[127];
  const int t0 = (MODE == 0) ? (qb == 0 ? 0 : 4 * qb - 2) : 0;
  const int NT = 4 * qb + 4 - t0;
  const int sr = tid >> 4, sc = (tid & 15) * 8, vst0 = v_st(sr, sc), vst1 = v_st(32 + sr, sc);
  const int vb0 = (int)(uintptr_t)V_lds + v_rd_base(lane);
  const unsigned short* Vh = A_proj + rowb * LDP + VCOL + kvh * 128;
  {

    const unsigned short* Qw = A_proj + (rowb + q0 + wid * QBLK + r32) * LDP + QCOL + hh * 128 + pass * 64 + hi * 8;
    const unsigned short* Kh = A_proj + rowb * LDP + KCOL + kvh * 128 + pass * 64;
    bf16x8 qr[DQK / 16];
#pragma unroll
    for (int d0 = 0; d0 < DQK / 16; ++d0) qr[d0] = *reinterpret_cast<const bf16x8*>(Qw + d0 * 16);
    unsigned sel = 0u;
    if (MODE == 1) {
      const int jb = qb;
      if (jb <= 3) sel = (1u << jb) - 1u;
      else {
        float g[15];
#pragma unroll
        for (int n = 0; n < 15; ++n) { g[n] = -INFINITY;
          if (n < jb) { const float* km = (const float*)(lds + OFF_STG) + n * 128 + hi * 8; float s = 0.f;
#pragma unroll
            for (int d0 = 0; d0 < 8; ++d0) { const f32x4 k0 = *(const f32x4*)(km + d0 * 16), k1 = *(const f32x4*)(km + d0 * 16 + 4);
              s += bf2f(qr[d0 % (DQK / 16)][0]) * k0[0] + bf2f(qr[d0 % (DQK / 16)][1]) * k0[1] + bf2f(qr[d0 % (DQK / 16)][2]) * k0[2] + bf2f(qr[d0 % (DQK / 16)][3]) * k0[3]
                 + bf2f(qr[d0 % (DQK / 16)][4]) * k1[0] + bf2f(qr[d0 % (DQK / 16)][5]) * k1[1] + bf2f(qr[d0 % (DQK / 16)][6]) * k1[2] + bf2f(qr[d0 % (DQK / 16)][7]) * k1[3]; }
            auto rr = __builtin_amdgcn_permlane32_swap(__float_as_uint(s), __float_as_uint(s), false, false);
            g[n] = __uint_as_float(rr[0]) + __uint_as_float(rr[1]); } }
#pragma unroll
        for (int pick = 0; pick < 3; ++pick) { float best = -INFINITY; int bi = 0;
#pragma unroll
          for (int n = 0; n < 15; ++n) { const bool take = (n < jb) && !((sel >> n) & 1u) && (g[n] > best); best = take ? g[n] : best; bi = take ? n : bi; }
          sel |= 1u << bi; }
      }
    }
    int NTm = NT;
    if (MODE == 1) {
      unsigned* mw = (unsigned*)(lds + OFF_MISC);
      if (qb > 3) { unsigned um = 0u;
#pragma unroll
        for (int n = 0; n < 15; ++n) if (__any((int)((sel >> n) & 1u))) um |= 1u << n;
        if (lane == 0) atomicOr(&mw[4], um); }
      __syncthreads();
      unsigned U = (qb <= 3) ? ((1u << qb) - 1u) : mw[4]; U |= 1u << qb;
      if (tid < 17) { unsigned rem = U; int bit = 0;
        for (int k = 0; k < tid; ++k) rem &= rem - 1u;
        bit = rem ? __builtin_ctz(rem) : 0; mw[8 + tid] = (unsigned)bit; }
      __syncthreads();
      NTm = 4 * __builtin_popcount(U);
    }
    const int NTT = __builtin_amdgcn_readfirstlane(NTm);
    float m_reg = NEGB, l_reg = 0.f;
    if (MODE == 0) { m_reg = A_sinks[hh] * LOG2E; l_reg = 1.f; }
    f32x16 o[4] = {};
#define KT(i) ((MODE == 1) ? (int)(__builtin_amdgcn_readfirstlane(((const unsigned*)(lds + OFF_MISC))[8 + ((i) >> 2)]) * 256u) + ((i) & 3) * KVBLK : (t0 + (i)) * KVBLK)
#define SLOAD(i, k0) do { sr_[i].vs0 = *reinterpret_cast<const bf16x8*>(&Vh[(long)((k0) + sr) * LDP + sc]); sr_[i].vs1 = *reinterpret_cast<const bf16x8*>(&Vh[(long)((k0) + 32 + sr) * LDP + sc]); \
    if (DQK == 128) { sr_[i].ks0 = *reinterpret_cast<const bf16x8*>(&Kh[(long)((k0) + sr) * LDP + sc]); sr_[i].ks1 = *reinterpret_cast<const bf16x8*>(&Kh[(long)((k0) + 32 + sr) * LDP + sc]); } \
    else { sr_[i].ks0 = *reinterpret_cast<const bf16x8*>(&Kh[(long)((k0) + (tid >> 3)) * LDP + (tid & 7) * 8]); } } while (0)
#define SWRITE(bb, i) do { *(bf16x8*)(V_lds + (bb) * SHM_V + vst0) = sr_[i].vs0; *(bf16x8*)(V_lds + (bb) * SHM_V + vst1) = sr_[i].vs1; \
    if (DQK == 128) { *(bf16x8*)(K_lds + (bb) * SHM_K + kswz<DQK>(sr, sc * 2)) = sr_[i].ks0; *(bf16x8*)(K_lds + (bb) * SHM_K + kswz<DQK>(32 + sr, sc * 2)) = sr_[i].ks1; } \
    else { *(bf16x8*)(K_lds + (bb) * SHM_K + kswz<DQK>(tid >> 3, (tid & 7) * 16)) = sr_[i].ks0; } } while (0)
#define SWAIT() do { if (SDEPTH == 1) asm volatile("s_waitcnt vmcnt(0)" ::: "memory"); else if (DQK == 128) asm volatile("s_waitcnt vmcnt(4)" ::: "memory"); else asm volatile("s_waitcnt vmcnt(3)" ::: "memory"); } while (0)
#define RESC(a) do { if (__any((a) < 1.f)) { if (hi == 0) al_l[r32] = (a); asm volatile("s_waitcnt lgkmcnt(0)" ::: "memory"); \
    _Pragma("unroll") for (int d = 0; d < 4; ++d) _Pragma("unroll") for (int r = 0; r < 16; ++r) o[d][r] *= al_l[crow(r, hi)]; } } while (0)
#define TSM(P0, P1, ti, AL) tile_sm<MODE>(P0, P1, KT(ti), qpos, wave_qmin, hi, C, lut, cfar, sel, qb, m_reg, AL)
    typedef __attribute__((address_space(3))) unsigned las_u32;
#define MLOAD2(k0, bb) do { const char* kg_ = (const char*)(Kh + (long)(k0) * LDP); const char* vg_ = (const char*)(Vh + (long)(k0) * LDP); \
    int ll_ = lane; asm volatile("" : "+v"(ll_));                 \
    _Pragma("unroll") for (int i_ = 0; i_ < 2; ++i_) { const int q_ = (i_ * 8 + wid) * 64 + ll_; \
      const int row_ = q_ >> 4, pos_ = q_ & 15; const unsigned koff_ = (unsigned)((row_ * LDP + ((pos_ ^ (row_ & 7)) << 3)) * 2); \
      const int st_ = q_ >> 5, kk_ = ((st_ >> 2) << 3) | ((q_ >> 2) & 7), c_ = ((st_ & 3) << 5) | ((q_ & 3) << 3), k_ = (kk_ & ~0xC) | ((kk_ & 4) << 1) | ((kk_ & 8) >> 1); const unsigned voff_ = (unsigned)((k_ * LDP + c_) * 2); \
      __builtin_amdgcn_global_load_lds((const unsigned*)(kg_ + koff_), (las_u32*)(K_lds + (bb) * SHM_K + (i_ * 8 + wid) * 1024), 16, 0, 0); \
      __builtin_amdgcn_global_load_lds((const unsigned*)(vg_ + voff_), (las_u32*)(V_lds + (bb) * SHM_V + (i_ * 8 + wid) * 1024), 16, 0, 0); } } while (0)
    __syncthreads();
    MLOAD2(KT(0), 0); asm volatile("s_waitcnt vmcnt(0)" ::: "memory"); __syncthreads();
#pragma unroll 1
    for (int j = 0; j < NTT; ++j) {
      const int bb = j & 1; const int kt = KT(j);
      if (j + 1 < NTT) MLOAD2(KT(j + 1), bb ^ 1);
      if (kt <= wave_qmin + QBLK - 1) {
        f32x16 p0, p1; float al; bf16x8 pa0, pa1, pa2, pa3;
        qkt<DQK>(p0, p1, K_lds + bb * SHM_K, qr, r32, hi);
        tile_sm<MODE>(p0, p1, kt, qpos, wave_qmin, hi, C, lut, cfar, sel, qb, m_reg, al);
        finishSM(p0, p1, al, l_reg, pa0, pa1, pa2, pa3); RESC(al);
        SBAR();
        pv_all1(o, vb0 + bb * SHM_V, pa0, pa1, pa2, pa3);
      }
      asm volatile("s_waitcnt vmcnt(0)" ::: "memory");
      __syncthreads();
    }
#undef MLOAD2
#undef KT
#undef SLOAD
#undef SWRITE
#undef SWAIT
#undef RESC
#undef TSM
    int r32e = r32, hie = hi; asm volatile("" : "+v"(r32e), "+v"(hie));
    if (hi == 0) li_l[r32] = l_reg; asm volatile("s_waitcnt lgkmcnt(0)" ::: "memory");
#pragma unroll
    for (int r = 0; r < 16; ++r) { const int orow = crow(r, hie); const float rli = __builtin_amdgcn_rcpf(li_l[orow]);
#pragma unroll
      for (int d0 = 0; d0 < 4; ++d0) { unsigned short* sp = (unsigned short*)(stg + orow * STG_PITCH) + d0 * 32 + r32e; float v = o[d0][r] * rli;
        if (MODE == 2 && pass == 1) v = __uint_as_float(((unsigned)*sp) << 16) - lam * v;
        *sp = (unsigned short)(cvtpk(v, v) & 0xffffu); } }
    asm volatile("s_waitcnt lgkmcnt(0)" ::: "memory");
    if (pass == NPASS - 1) {
      const char* rp = stg + r32e * STG_PITCH + hie * 128;
      u32x4 w[8];
#pragma unroll
      for (int i = 0; i < 8; ++i) w[i] = *(const u32x4*)(rp + i * 16);
      if (MODE == 2) {
        float ss = 0.f;
#pragma unroll
        for (int i = 0; i < 8; ++i)
#pragma unroll
          for (int k = 0; k < 4; ++k) { const float lo = __uint_as_float(w[i][k] << 16), hi_ = __uint_as_float(w[i][k] & 0xffff0000u); ss += lo * lo + hi_ * hi_; }
        { auto rr = __builtin_amdgcn_permlane32_swap(__float_as_uint(ss), __float_as_uint(ss), false, false); ss = __uint_as_float(rr[0]) + __uint_as_float(rr[1]); }
        const float sc2 = rsqrtf(ss * (1.0f / 128.0f) + 1e-6f) * (1.0f - A.lambda_init);
        const float* gp = A_subln + hie * 64;
#pragma unroll
        for (int i = 0; i < 8; ++i)
#pragma unroll
          for (int k = 0; k < 4; ++k) { const float lo = __uint_as_float(w[i][k] << 16) * sc2 * gp[i * 8 + 2 * k], hi_ = __uint_as_float(w[i][k] & 0xffff0000u) * sc2 * gp[i * 8 + 2 * k + 1]; w[i][k] = cvtpk(lo, hi_); }
      }
      unsigned short* op = A_ycat + (rowb + q0 + wid * QBLK + r32e) * LDY + OCOL + hh * 128 + hie * 64;
#pragma unroll
      for (int i = 0; i < 8; ++i) *(u32x4*)(op + i * 8) = w[i];
    }
  }
}
template <int MODE> __device__ __forceinline__ void unit_luts(char* lds, int hh, int tid) {
  float* lut = (float*)(lds + OFF_LUT); const float* lh = (const float*)(lds + OFF_LUTH) + hh * 128;
  if (tid < 128) lut[tid] = lh[tid];
  float* l4 = (float*)(lds + OFF_LUT4);
#pragma unroll 1
  for (int i = tid; i < LUT4_COPIES * LUT4_N; i += 512) { const int c = i / LUT4_N, j = i % LUT4_N, d = 256 + c - j;
    l4[i] = (c == 4 || d < 0 || (MODE == 0 && d >= 128)) ? NEGB : lh[d < 127 ? d : 127]; }
}
__device__ __forceinline__ void pv_sm_split(f32x16* o, int vb, bf16x8 pa0, bf16x8 pa1, bf16x8 pa2, bf16x8 pa3,
                                            f32x16& p0, f32x16& p1, float alpha, float& l_reg, bf16x8& pb0, bf16x8& pb1, bf16x8& pb2, bf16x8& pb3) {
  s16x4 va[8], vc[8]; float ps = 0.f;
#define TR8(D0, L) do { L[0] = tr_read<v_rd_off(D0, 0, 0)>(vb); L[1] = tr_read<v_rd_off(D0, 0, 1)>(vb); L[2] = tr_read<v_rd_off(D0, 1, 0)>(vb); L[3] = tr_read<v_rd_off(D0, 1, 1)>(vb); \
    L[4] = tr_read<v_rd_off(D0, 2, 0)>(vb); L[5] = tr_read<v_rd_off(D0, 2, 1)>(vb); L[6] = tr_read<v_rd_off(D0, 3, 0)>(vb); L[7] = tr_read<v_rd_off(D0, 3, 1)>(vb); } while (0)
#define PK(L, H) (bf16x8){L[0], L[1], L[2], L[3], H[0], H[1], H[2], H[3]}
#define MF(OA, PA, L, K) do { OA = __builtin_amdgcn_mfma_f32_32x32x16_bf16(PA, PK(L[2 * (K)], L[2 * (K) + 1]), OA, 0, 0, 0); SBAR(); } while (0)
#define FE(K) do { p1[2 * (K)] = __builtin_amdgcn_exp2f(p1[2 * (K)]); p1[2 * (K) + 1] = __builtin_amdgcn_exp2f(p1[2 * (K) + 1]); ps += p0[2 * (K)]; ps += p0[2 * (K) + 1]; SBAR(); } while (0)
#define FS(K) do { ps += p1[4 * (K)]; ps += p1[4 * (K) + 1]; ps += p1[4 * (K) + 2]; ps += p1[4 * (K) + 3]; SBAR(); } while (0)
#define PK4(P, BASE, OUT) do { unsigned a0 = cvtpk(P[BASE + 0], P[BASE + 1]), a1 = cvtpk(P[BASE + 2], P[BASE + 3]);   \
    unsigned b0 = cvtpk(P[BASE + 4], P[BASE + 5]), b1 = cvtpk(P[BASE + 6], P[BASE + 7]);                              \
    auto r0 = __builtin_amdgcn_permlane32_swap(a0, b0, false, false); auto r1 = __builtin_amdgcn_permlane32_swap(a1, b1, false, false); \
    u32x4 w = {r0[0], r1[0], r0[1], r1[1]}; OUT = *reinterpret_cast<bf16x8*>(&w); SBAR(); } while (0)
  TR8(0, va); TR8(1, vc); asm volatile("s_waitcnt lgkmcnt(8)" ::: "memory"); SBAR();
  MF(o[0], pa0, va, 0); FE(0); MF(o[0], pa1, va, 1); FE(1); MF(o[0], pa2, va, 2); FE(2); MF(o[0], pa3, va, 3); FE(3);
  TR8(2, va); asm volatile("s_waitcnt lgkmcnt(8)" ::: "memory"); SBAR();
  MF(o[1], pa0, vc, 0); FE(4); MF(o[1], pa1, vc, 1); FE(5); MF(o[1], pa2, vc, 2); FE(6); MF(o[1], pa3, vc, 3); FE(7);
  TR8(3, vc); asm volatile("s_waitcnt lgkmcnt(8)" ::: "memory"); SBAR();
  MF(o[2], pa0, va, 0); FS(0); MF(o[2], pa1, va, 1); FS(1); MF(o[2], pa2, va, 2); FS(2); MF(o[2], pa3, va, 3); FS(3);
  { auto rr = __builtin_amdgcn_permlane32_swap(__float_as_uint(ps), __float_as_uint(ps), false, false); ps = __uint_as_float(rr[0]) + __uint_as_float(rr[1]); }
  l_reg = l_reg * alpha + ps;
  asm volatile("s_waitcnt lgkmcnt(0)" ::: "memory"); SBAR();
  MF(o[3], pa0, vc, 0); PK4(p0, 0, pb0); MF(o[3], pa1, vc, 1); PK4(p0, 8, pb1); MF(o[3], pa2, vc, 2); PK4(p1, 0, pb2); MF(o[3], pa3, vc, 3); PK4(p1, 8, pb3);
#undef PK4
#undef FS
#undef FE
#undef MF
#undef PK
#undef TR8
}
template <int D0> __device__ __forceinline__ void pv_one2(f32x16& oa, f32x16& ob, int vb, bf16x8 pa0, bf16x8 pa1, bf16x8 pa2, bf16x8 pa3, bf16x8 pb0, bf16x8 pb1, bf16x8 pb2, bf16x8 pb3) {
  const s16x4 l0 = tr_read<v_rd_off(D0, 0, 0)>(vb), h0 = tr_read<v_rd_off(D0, 0, 1)>(vb), l1 = tr_read<v_rd_off(D0, 1, 0)>(vb), h1 = tr_read<v_rd_off(D0, 1, 1)>(vb);
  const s16x4 l2 = tr_read<v_rd_off(D0, 2, 0)>(vb), h2 = tr_read<v_rd_off(D0, 2, 1)>(vb), l3 = tr_read<v_rd_off(D0, 3, 0)>(vb), h3 = tr_read<v_rd_off(D0, 3, 1)>(vb);
  asm volatile("s_waitcnt lgkmcnt(0)" ::: "memory"); SBAR();
#if ATT_PRIO
  __builtin_amdgcn_s_setprio(ATT_PRIO);
#endif
#define PK(L, H) (bf16x8){L[0], L[1], L[2], L[3], H[0], H[1], H[2], H[3]}
  oa = __builtin_amdgcn_mfma_f32_32x32x16_bf16(pa0, PK(l0, h0), oa, 0, 0, 0); ob = __builtin_amdgcn_mfma_f32_32x32x16_bf16(pb0, PK(l0, h0), ob, 0, 0, 0);
  oa = __builtin_amdgcn_mfma_f32_32x32x16_bf16(pa1, PK(l1, h1), oa, 0, 0, 0); ob = __builtin_amdgcn_mfma_f32_32x32x16_bf16(pb1, PK(l1, h1), ob, 0, 0, 0);
  oa = __builtin_amdgcn_mfma_f32_32x32x16_bf16(pa2, PK(l2, h2), oa, 0, 0, 0); ob = __builtin_amdgcn_mfma_f32_32x32x16_bf16(pb2, PK(l2, h2), ob, 0, 0, 0);
  oa = __builtin_amdgcn_mfma_f32_32x32x16_bf16(pa3, PK(l3, h3), oa, 0, 0, 0); ob = __builtin_amdgcn_mfma_f32_32x32x16_bf16(pb3, PK(l3, h3), ob, 0, 0, 0);
#if ATT_PRIO
  __builtin_amdgcn_s_setprio(0);
#endif
#undef PK
}
__device__ __forceinline__ void qkt_half(f32x16& p0, f32x16& p1, const char* Ks, const char* Qs, int c, int r32, int hi) {
  asm volatile("" : "+v"(r32));
  p0 = f32x16{}; p1 = f32x16{};
#pragma unroll
  for (int d0 = 0; d0 < 4; ++d0) { const int cb = (c * 64 + d0 * 16 + hi * 8) * 2;
    const bf16x8 qf = *reinterpret_cast<const bf16x8*>(Qs + kswz<128>(r32, cb));
    const bf16x8 b0 = *reinterpret_cast<const bf16x8*>(Ks + kswz<128>(r32, cb));
    const bf16x8 b1 = *reinterpret_cast<const bf16x8*>(Ks + kswz<128>(32 + r32, cb));
    p0 = __builtin_amdgcn_mfma_f32_32x32x16_bf16(b0, qf, p0, 0, 0, 0);
    p1 = __builtin_amdgcn_mfma_f32_32x32x16_bf16(b1, qf, p1, 0, 0, 0); }
}
__device__ __forceinline__ void attn_diff_fused(const AttnArgs& A, int b, int hh, int qb, float lam, char* lds, int tid) {
  constexpr int QCOL = 2816, KCOL = 3584, VCOL = 4352, OCOL = 1280;
  const float C = 0.125f * LOG2E;
  const int lane = tid & 63, r32 = lane & 31, hi = lane >> 5; const int wid = __builtin_amdgcn_readfirstlane(tid >> 6);
  char* V_lds = lds + OFF_V; char* K_lds = lds + OFF_K;
  float* wsl = (float*)(lds + OFF_WS) + wid * 64;
  const float* lut = (const float*)(lds + OFF_LUT);
  char* stg = lds + OFF_STG + wid * STG_WAVE;
  const int q0 = qb * 256;
  const int qpos = q0 + wid * QBLK + r32, wave_qmin = q0 + wid * QBLK;
  const long rowb = (long)b * SEQL;
  const int NT = 4 * qb + 4;
  const int vb0 = (int)(uintptr_t)V_lds + v_rd_base(lane);
  const unsigned short* Vh = A_proj + rowb * LDP + VCOL + hh * 128;
  const unsigned short* Kh = A_proj + rowb * LDP + KCOL + hh * 128;
  float m0 = NEGB, l0 = 0.f, m1 = NEGB, l1 = 0.f;
  f32x16 o0[4] = {}, o1[4] = {};
  typedef __attribute__((address_space(3))) unsigned las_u32;
#define SLOAD2(k0, bb) do { const char* kg_ = (const char*)(Kh + (long)(k0) * LDP); const char* vg_ = (const char*)(Vh + (long)(k0) * LDP); \
    int ll_ = lane; asm volatile("" : "+v"(ll_));                 \
    _Pragma("unroll") for (int i_ = 0; i_ < 2; ++i_) { const int q_ = (i_ * 8 + wid) * 64 + ll_; \
      const int row_ = q_ >> 4, pos_ = q_ & 15; const unsigned koff_ = (unsigned)((row_ * LDP + ((pos_ ^ (row_ & 7)) << 3)) * 2); \
      const int st_ = q_ >> 5, kk_ = ((st_ >> 2) << 3) | ((q_ >> 2) & 7), c_ = ((st_ & 3) << 5) | ((q_ & 3) << 3), k_ = (kk_ & ~0xC) | ((kk_ & 4) << 1) | ((kk_ & 8) >> 1); const unsigned voff_ = (unsigned)((k_ * LDP + c_) * 2); \
      __builtin_amdgcn_global_load_lds((const unsigned*)(kg_ + koff_), (las_u32*)(K_lds + (bb) * SHM_K + (i_ * 8 + wid) * 1024), 16, 0, 0); \
      __builtin_amdgcn_global_load_lds((const unsigned*)(vg_ + voff_), (las_u32*)(V_lds + (bb) * SHM_V + (i_ * 8 + wid) * 1024), 16, 0, 0); } } while (0)
#define RESC2(a, oo, sl) do { if (__any((a) < 1.f)) { if (hi == 0) (sl)[r32] = (a); asm volatile("s_waitcnt lgkmcnt(0)" ::: "memory"); \
    _Pragma("unroll") for (int d = 0; d < 4; ++d) _Pragma("unroll") for (int r = 0; r < 16; ++r) oo[d][r] *= (sl)[crow(r, hi)]; } } while (0)
  SLOAD2(0, 0);
  { const unsigned short* Qg = A_proj + (rowb + q0 + wid * QBLK) * LDP + QCOL + hh * 128;
    bf16x8 qv[8];
#pragma unroll
    for (int i = 0; i < 8; ++i) { const int c = lane + 64 * i, row = c >> 4, cc = c & 15; qv[i] = *reinterpret_cast<const bf16x8*>(Qg + (long)row * LDP + cc * 8); }
    unit_luts<2>(lds, hh, tid);
#pragma unroll
    for (int i = 0; i < 8; ++i) { const int c = lane + 64 * i, row = c >> 4, cc = c & 15; *(bf16x8*)(stg + kswz<128>(row, cc * 16)) = qv[i]; } }
  asm volatile("s_waitcnt vmcnt(0)" ::: "memory"); __syncthreads();
  const float cfar = lut[127];
#pragma unroll 1
  for (int j = 0; j < NT; ++j) {
    const int bb = j & 1; const int kt = j * KVBLK;
    if (j + 1 < NT) SLOAD2((j + 1) * KVBLK, bb ^ 1);
    if (kt <= wave_qmin + QBLK - 1) {
    f32x16 p0, p1; float al0, al1; bf16x8 pa0, pa1, pa2, pa3, pb0, pb1, pb2, pb3;
    qkt_half(p0, p1, K_lds + bb * SHM_K, stg, 0, r32, hi);
    tile_sm<2>(p0, p1, kt, qpos, wave_qmin, hi, C, lut, cfar, 0u, qb, m0, al0);
    finishSM(p0, p1, al0, l0, pa0, pa1, pa2, pa3); RESC2(al0, o0, wsl);
    SBAR();
    qkt_half(p0, p1, K_lds + bb * SHM_K, stg, 1, r32, hi);
    tile_sm<2>(p0, p1, kt, qpos, wave_qmin, hi, C, lut, cfar, 0u, qb, m1, al1);
    RESC2(al1, o1, wsl + 32);
    SBAR();
    pv_sm_split(o0, vb0 + bb * SHM_V, pa0, pa1, pa2, pa3, p0, p1, al1, l1, pb0, pb1, pb2, pb3);
    SBAR();
    pv_all1(o1, vb0 + bb * SHM_V, pb0, pb1, pb2, pb3);
    }
    asm volatile("s_waitcnt vmcnt(0)" ::: "memory");
    __syncthreads();
  }
#undef SLOAD2
#undef RESC2
  int r32e = r32, hie = hi; asm volatile("" : "+v"(r32e), "+v"(hie));
  if (hi == 0) { wsl[r32] = l0; wsl[32 + r32] = l1; } asm volatile("s_waitcnt lgkmcnt(0)" ::: "memory");
#pragma unroll
  for (int r = 0; r < 16; ++r) { const int orow = crow(r, hie); const float ra = __builtin_amdgcn_rcpf(wsl[orow]), rb = lam * __builtin_amdgcn_rcpf(wsl[32 + orow]);
#pragma unroll
    for (int d0 = 0; d0 < 4; ++d0) { unsigned short* sp = (unsigned short*)(stg + orow * STG_PITCH) + d0 * 32 + r32e; const float v = o0[d0][r] * ra - o1[d0][r] * rb;
      *sp = (unsigned short)(cvtpk(v, v) & 0xffffu); } }
  asm volatile("s_waitcnt lgkmcnt(0)" ::: "memory");
  { const char* rp = stg + r32e * STG_PITCH + hie * 128;
    u32x4 w[8];
#pragma unroll
    for (int i = 0; i < 8; ++i) w[i] = *(const u32x4*)(rp + i * 16);
    float ss = 0.f;
#pragma unroll
    for (int i = 0; i < 8; ++i)
#pragma unroll
      for (int k = 0; k < 4; ++k) { const float lo = __uint_as_float(w[i][k] << 16), hi_ = __uint_as_float(w[i][k] & 0xffff0000u); ss += lo * lo + hi_ * hi_; }
    { auto rr = __builtin_amdgcn_permlane32_swap(__float_as_uint(ss), __float_as_uint(ss), false, false); ss = __uint_as_float(rr[0]) + __uint_as_float(rr[1]); }
    const float sc2 = rsqrtf(ss * (1.0f / 128.0f) + 1e-6f) * (1.0f - A.lambda_init);
    const f32x4* gp = (const f32x4*)(A_subln + hie * 64);
    f32x4 gq[16];
#pragma unroll
    for (int i = 0; i < 16; ++i) gq[i] = gp[i];
#pragma unroll
    for (int i = 0; i < 8; ++i)
#pragma unroll
      for (int k = 0; k < 4; ++k) { const float lo = __uint_as_float(w[i][k] << 16) * sc2 * gq[2 * i + (k >> 1)][2 * (k & 1)], hi_ = __uint_as_float(w[i][k] & 0xffff0000u) * sc2 * gq[2 * i + (k >> 1)][2 * (k & 1) + 1]; w[i][k] = cvtpk(lo, hi_); }
    unsigned short* op = A_ycat + (rowb + q0 + wid * QBLK + r32e) * LDY + OCOL + hh * 128 + hie * 64;
#pragma unroll
    for (int i = 0; i < 8; ++i) *(u32x4*)(op + i * 8) = w[i];
  }
}
__device__ __forceinline__ void attn_swa_wave(const AttnArgs& A, int b, int hh, int qb, char* lds, int tid) {
  constexpr int QCOL = 0, KCOL = 768, VCOL = 1024, OCOL = 0;
  const float C = 0.088388347648318440f * LOG2E;
  const int lane = tid & 63, r32 = lane & 31, hi = lane >> 5; const int wid = __builtin_amdgcn_readfirstlane(tid >> 6);
  const int kvh = hh / 3;
  char* vpriv = lds + (wid < 4 ? wid * 16384 : OFF_STG + (wid - 4) * 16384);
  float* wsl = (float*)(lds + OFF_WS) + wid * 64; float* li_l = wsl; float* al_l = wsl + 32;
  const float* lut = (const float*)(lds + OFF_LUT);
  const int q0 = qb * 256, q0w = q0 + wid * QBLK, qpos = q0w + r32;
  const long rowb = (long)b * SEQL;
  const float cfar = lut[127];
  const unsigned short* Vh = A_proj + rowb * LDP + VCOL + kvh * 128;
  const unsigned short* Kh = A_proj + rowb * LDP + KCOL + kvh * 128 + hi * 8;
  const unsigned short* Qw = A_proj + (rowb + qpos) * LDP + QCOL + hh * 128 + hi * 8;
  bf16x8 qr[8];
#pragma unroll
  for (int d0 = 0; d0 < 8; ++d0) qr[d0] = *reinterpret_cast<const bf16x8*>(Qw + d0 * 16);
  float m_reg = A_sinks[hh] * LOG2E, l_reg = 1.f;
  f32x16 o[4] = {};
  const int vb = (int)(uintptr_t)vpriv + v_rd_base(lane);
  const int tfirst = (q0w >= 127) ? ((q0w - 127) >> 6) : 0, tlast = (q0w + 31) >> 6;
#pragma unroll 1
  for (int t = tfirst; t <= tlast; ++t) {
    const int kt = t * KVBLK;
    f32x16 p0 = {}, p1 = {};
    { bf16x8 kf0[8], kf1[8];
#pragma unroll
      for (int d0 = 0; d0 < 8; ++d0) { kf0[d0] = *reinterpret_cast<const bf16x8*>(Kh + (long)(kt + r32) * LDP + d0 * 16); kf1[d0] = *reinterpret_cast<const bf16x8*>(Kh + (long)(kt + 32 + r32) * LDP + d0 * 16); }
#pragma unroll
      for (int d0 = 0; d0 < 8; ++d0) { p0 = __builtin_amdgcn_mfma_f32_32x32x16_bf16(kf0[d0], qr[d0], p0, 0, 0, 0); p1 = __builtin_amdgcn_mfma_f32_32x32x16_bf16(kf1[d0], qr[d0], p1, 0, 0, 0); } }
    bf16x8 vs[16];
#pragma unroll
    for (int i = 0; i < 16; ++i) { const int q = lane + 64 * i; vs[i] = *reinterpret_cast<const bf16x8*>(Vh + (long)(kt + (q >> 4)) * LDP + (q & 15) * 8); }
    float al; bf16x8 pa0, pa1, pa2, pa3;
    tile_sm<0>(p0, p1, kt, qpos, q0w, hi, C, lut, cfar, 0u, qb, m_reg, al);
    finishSM(p0, p1, al, l_reg, pa0, pa1, pa2, pa3);
    if (__any(al < 1.f)) { if (hi == 0) al_l[r32] = al; asm volatile("s_waitcnt lgkmcnt(0)" ::: "memory");
#pragma unroll
      for (int d = 0; d < 4; ++d)
#pragma unroll
        for (int r = 0; r < 16; ++r) o[d][r] *= al_l[crow(r, hi)]; }
#pragma unroll
    for (int i = 0; i < 16; ++i) { const int q = lane + 64 * i; *(bf16x8*)(vpriv + v_st(q >> 4, (q & 15) * 8)) = vs[i]; }
    asm volatile("s_waitcnt lgkmcnt(0)" ::: "memory"); SBAR();
    pv_d0(o, vb, pa0, pa1, pa2, pa3);
    asm volatile("s_waitcnt lgkmcnt(0)" ::: "memory"); SBAR();
  }
  int r32e = r32, hie = hi; asm volatile("" : "+v"(r32e), "+v"(hie));
  if (hi == 0) li_l[r32] = l_reg; asm volatile("s_waitcnt lgkmcnt(0)" ::: "memory");
#pragma unroll
  for (int r = 0; r < 16; ++r) { const int orow = crow(r, hie); const float rli = __builtin_amdgcn_rcpf(li_l[orow]);
#pragma unroll
    for (int d0 = 0; d0 < 4; ++d0) { unsigned short* sp = (unsigned short*)(vpriv + orow * STG_PITCH) + d0 * 32 + r32e; const float v = o[d0][r] * rli; *sp = (unsigned short)(cvtpk(v, v) & 0xffffu); } }
  asm volatile("s_waitcnt lgkmcnt(0)" ::: "memory");
  { const char* rp = vpriv + r32e * STG_PITCH + hie * 128; u32x4 w[8];
#pragma unroll
    for (int i = 0; i < 8; ++i) w[i] = *(const u32x4*)(rp + i * 16);
    unsigned short* op = A_ycat + (rowb + q0w + r32e) * LDY + OCOL + hh * 128 + hie * 64;
#pragma unroll
    for (int i = 0; i < 8; ++i) *(u32x4*)(op + i * 8) = w[i]; }
}
template <int MODE>
__device__ __forceinline__ float attn_mode_setup(const AttnArgs& A, char* lds, const int wave_idx) {
  constexpr int HB0 = (MODE == 0) ? 0 : (MODE == 1) ? 6 : 10, NH = (MODE == 1) ? 4 : 6;
  const int lane = mk_lane(), tid = wave_idx * 64 + lane;
  __syncthreads();
  float* lh = (float*)(lds + OFF_LUTH);
#pragma unroll 1
  for (int i = tid; i < NH * 128; i += 512) lh[i] = A_rel_bias[(int)REL_BUCKET_TAB[i & 127] * 16 + HB0 + (i >> 7)] * LOG2E;
  float lam = 0.f;
  if (MODE == 2) { float a = A_lq1[lane] * A_lk1[lane], c2 = A_lq2[lane] * A_lk2[lane];
#pragma unroll
    for (int o_ = 1; o_ < 64; o_ <<= 1) { a += mk_shfl_xor(a, o_); c2 += mk_shfl_xor(c2, o_); }
    lam = __expf(a) - __expf(c2) + A.lambda_init; }
  __syncthreads();
  return __builtin_bit_cast(float, __builtin_amdgcn_readfirstlane(__builtin_bit_cast(int, lam)));
}
template <int MODE>
__device__ __forceinline__ void attn_unit(const AttnArgs& A, int b, int hh, int qb, char* lds, const int wave_idx, float lam) {
  constexpr int NPASS = (MODE == 2) ? 2 : 1;
  const int lane = mk_lane(), tid = wave_idx * 64 + lane;
  float* lut = (float*)(lds + OFF_LUT);
  __syncthreads();
  if (MODE == 1 && tid == 0) ((unsigned*)(lds + OFF_MISC))[4] = 0u;
  if (MODE == 1) { const float* kp_ = A_kpart + (size_t)((b * 4 + hh) * 16) * 128 + tid * 4; *(f32x4*)(lds + OFF_STG + tid * 16) = (*(const f32x4*)kp_ + *(const f32x4*)(kp_ + ATT_KP_N)) * (1.f / 256.f); }
  if (!(MODE == 2 && ATT_DIFF_FUSED)) { unit_luts<MODE>(lds, hh, tid); __syncthreads(); }
  asm volatile("" : "+v"(lam));
  if (MODE == 2 && ATT_DIFF_FUSED) { attn_diff_fused(A, b, hh, qb, lam, lds, wave_idx * 64 + mk_lane()); }
  else if (MODE == 0 && ATT_SWA_WAVE) { attn_swa_wave(A, b, hh, qb, lds, wave_idx * 64 + mk_lane()); }
  else {
#pragma unroll 1
  for (int pass = 0; pass < NPASS; ++pass) {
    attn_pass<MODE>(A, b, hh, qb, pass, lam, lds, wave_idx * 64 + mk_lane());
  }
  }
}
#undef SBAR
}
#undef A_proj
#undef A_ycat
#undef A_kmean
#undef A_kpart
#undef A_rel_bias
#undef A_sinks
#undef A_lq1
#undef A_lk1
#undef A_lq2
#undef A_lk2
#undef A_subln
#define GAS __attribute__((address_space(1)))
#define LAS __attribute__((address_space(3)))
typedef unsigned short bf16;
typedef unsigned v4u __attribute__((ext_vector_type(4)));
typedef float f32x4 __attribute__((ext_vector_type(4)));
typedef short bf16x8 __attribute__((ext_vector_type(8)));
typedef GAS unsigned gu32;
typedef GAS unsigned long long gu64;
#define RLX_AGENT __ATOMIC_RELAXED, __HIP_MEMORY_SCOPE_AGENT
#define LDS_WAIT() asm volatile("s_waitcnt lgkmcnt(0)" ::: "memory")
#define VM_WAIT() asm volatile("s_waitcnt vmcnt(0)" ::: "memory")
__device__ __forceinline__ unsigned long long rt() { return __builtin_amdgcn_s_memrealtime(); }
__device__ __forceinline__ unsigned f2bf(float f) { unsigned u = __builtin_bit_cast(unsigned, f); return (u + 0x7fffu + ((u >> 16) & 1u)) >> 16; }
__device__ __forceinline__ unsigned pk2(float lo, float hi) { return f2bf(lo) | (f2bf(hi) << 16); }

#define XB_TMO      128
#define XB_XCNT(j)  (256  + 64 * (j))
#define XB_XSUB(j)  (1280 + 64 * (j))
#define XB_XGEN(j)  (2304 + 64 * (j))
#define XB_TOP      3328
#define XB_TOPGEN   3392
#define XCD_BAR_WORDS 3456
#define XB_SPIN_CAP (1u << 18)

__device__ __forceinline__ unsigned xb_ld(unsigned* p)              { return __hip_atomic_load(p, __ATOMIC_RELAXED, __HIP_MEMORY_SCOPE_AGENT); }
__device__ __forceinline__ unsigned xb_add(unsigned* p, unsigned v) { return __hip_atomic_fetch_add(p, v, __ATOMIC_RELAXED, __HIP_MEMORY_SCOPE_AGENT); }
__device__ __forceinline__ unsigned xb_xcc_id() { return (unsigned)__builtin_amdgcn_s_getreg((3 << 11) | 20) & 0xFu; }
#define XB_SPIN(cond, bar) do { unsigned _sp = 0; while (cond) { __builtin_amdgcn_s_sleep(1); \
    if ((++_sp & 255u) == 0u) { if (xb_ld(&(bar)[XB_TMO])) break; if (_sp > XB_SPIN_CAP) { atomicAdd(&(bar)[XB_TMO], 1u); break; } } } } while (0)

struct XcdBarrier {
    unsigned* bar; unsigned x;
    volatile LAS unsigned* st;
};

__device__ __forceinline__ XcdBarrier xcd_barrier_post(unsigned* bar, volatile LAS unsigned* st) {
    XcdBarrier b; b.bar = bar; b.x = xb_xcc_id(); b.st = st;
    if (threadIdx.x == 0) (void)xb_add(&bar[XB_XCNT(b.x)], 1u);
    return b;
}
__device__ __forceinline__ void xcd_barrier_complete(unsigned* bar, unsigned x, unsigned& nloc, unsigned& nx) {
    const unsigned G = gridDim.x * gridDim.y * gridDim.z;
    unsigned sum, cnt, mine, sp = 0u;
    for (;;) {
        sum = 0u; cnt = 0u; mine = 0u;
#pragma unroll
        for (unsigned j = 0; j < 16; ++j) { const unsigned c = xb_ld(&bar[XB_XCNT(j)]); sum += c; cnt += (c > 0u) ? 1u : 0u; mine = (j == x) ? c : mine; }
        if (sum == G) break;
        __builtin_amdgcn_s_sleep(1);
        if ((++sp & 255u) == 0u) { if (xb_ld(&bar[XB_TMO])) break; if (sp > XB_SPIN_CAP) { atomicAdd(&bar[XB_TMO], 1u); break; } }
    }
    nloc = mine > 0u ? mine : 1u; nx = cnt > 0u ? cnt : 1u;
}

__device__ __forceinline__ void xcd_barrier(const XcdBarrier& b) {
    asm volatile("s_waitcnt vmcnt(0)" ::: "memory");
    __syncthreads();
    if (threadIdx.x == 0) {
        unsigned* bar = b.bar;
        __builtin_amdgcn_s_waitcnt(0);
        unsigned nloc = b.st[0], nx = b.st[1];
        if (nloc == 0u) { xcd_barrier_complete(bar, b.x, nloc, nx); b.st[0] = nloc; b.st[1] = nx; }
        const unsigned old = xb_add(&bar[XB_XSUB(b.x)], 1u);
        const unsigned gen = old / nloc;
        if (old + 1u == (gen + 1u) * nloc) {
            __builtin_amdgcn_fence(__ATOMIC_RELEASE, "agent");
            asm volatile("s_waitcnt vmcnt(0)" ::: "memory");
            const unsigned og = xb_add(&bar[XB_TOP], 1u);
            const unsigned tg = og / nx;
            if (og + 1u == (tg + 1u) * nx) xb_add(&bar[XB_TOPGEN], 1u);
            else XB_SPIN(xb_ld(&bar[XB_TOPGEN]) == tg, bar);
            __builtin_amdgcn_fence(__ATOMIC_ACQUIRE, "agent");
            xb_add(&bar[XB_XGEN(b.x)], 1u);
            asm volatile("s_waitcnt vmcnt(0)" ::: "memory");
        } else {
            XB_SPIN(xb_ld(&bar[XB_XGEN(b.x)]) == gen, bar);
            __builtin_amdgcn_fence(__ATOMIC_ACQUIRE, "agent");
            asm volatile("s_waitcnt vmcnt(0)" ::: "memory");
        }
    }
    __syncthreads();
}

constexpr int NWAVES = 8;
constexpr int BATCH = 8, SEQ = 4096, DM = 2048, DEPTH = 2, M = BATCH * SEQ, NIN = 5120, NEXP = 32, DEXP = 512, PLE = 256, NROUTE = 36;
constexpr int KB_OFF = 1792;
constexpr int RPAD = 73728;
constexpr float EPS = 1e-6f;
constexpr size_t MiB = 1u << 20;
constexpr size_t WS_CTL = 0, CTL_ZERO_BYTES = 1 * MiB;
constexpr size_t WS_KMEAN = 1 * MiB, WS_RSTD = WS_KMEAN + 256 * 1024, WS_TOKREC = WS_RSTD + 128 * 1024, WS_POS = WS_TOKREC + 1 * MiB, WS_WR = WS_POS + 256 * 1024;
constexpr size_t WS_WIN = 8 * MiB, WS_WOUT = 48 * MiB, WS_W13 = 64 * MiB, WS_W2 = 192 * MiB, WS_WG = 256 * MiB, WS_WP = 272 * MiB, WS_PB = 274 * MiB;
constexpr size_t WS_U = 306 * MiB, WS_PROJ = 434 * MiB, WS_YCAT = 754 * MiB, WS_PL = 882 * MiB, WS_HB = 1010 * MiB, WS_END = 1138 * MiB;
constexpr size_t WS_SSQ = WS_YCAT + 64 * MiB;
constexpr size_t WS_SRS = WS_YCAT + 72 * MiB;
constexpr size_t WS_LIST = 4 * MiB;
constexpr size_t WS_RSIN = WS_POS, WS_RSPLE = WS_POS + 128 * 1024;
constexpr size_t WS_XG = WS_PROJ, WS_HID = WS_PROJ + 288 * MiB, WS_Y = WS_XG;
static_assert(WS_WR + 2 * 2 * 48 * DM * 2 <= WS_LIST && WS_LIST + NEXP * 32768 * 4 <= WS_WIN && WS_HID + (size_t)RPAD * DEXP * 2 <= WS_PL && (size_t)RPAD * DM * 2 <= 288 * MiB && WS_W13 + (size_t)NEXP * 1024 * DM * 2 <= WS_W2 && WS_W2 + (size_t)NEXP * DM * DEXP * 2 <= WS_WG && WS_PB + (size_t)DEPTH * M * PLE * 2 <= WS_U, "d_ws map");
constexpr int CW_TMO = 0, CW_CODE = 1, CW_BAR = 4096, CW_CNT = 16384, CW_Q = 24576;
constexpr int PHASE_LDS = 139264;
constexpr int LDS_TILE_E = PHASE_LDS, LDS_OFFS = PHASE_LDS + 512, LDS_MISC = PHASE_LDS + 1024, LDSCTL_OFF = PHASE_LDS;
constexpr int LDS_BYTES = 147456 + att::LUT4_COPIES * att::LUT4_N * 4 + att::LUTH_BYTES;
static_assert(att::OFF_LUT4 == 147456 && LDS_BYTES <= 163840 && att::ATT_LDS <= PHASE_LDS && pg8::STAGE_BYTES <= PHASE_LDS && LDS_MISC + 128 + 8 * 32 <= LDS_BYTES, "LDS map");

__device__ __forceinline__ gu32* ctlptr() { return (gu32*)(wsptr() + WS_CTL); }
typedef float f32x2g __attribute__((ext_vector_type(2)));
typedef unsigned u32x2g __attribute__((ext_vector_type(2)));
__device__ __forceinline__ size_t hb_off(int k) { return (k & 1) ? WS_U : WS_HB; }
struct Frame {
    LAS unsigned char* lds;
    volatile LAS unsigned* MISC;
    int tid, lane, wave, G, gw, NGW;
};
struct Args { const float* in[22]; float* out; unsigned char* ws; int ph_lo, ph_hi, use_bar, pad; };
__device__ __forceinline__ Frame relaunder(const Frame& F0) {
    Frame F = F0; int w = F0.wave; asm volatile("" : "+s"(w)); F.wave = w; F.lane = mk_lane(); F.tid = w * 64 + F.lane; F.gw = blockIdx.x * NWAVES + w; return F;
}
__device__ __forceinline__ int opaque_i(int x) { asm volatile("" : "+s"(x)); return x; }
__device__ __forceinline__ float wave_sum(float v) {
#pragma unroll
    for (int o = 1; o < 64; o <<= 1) v += mk_shfl_xor(v, o);
    return v;
}
__device__ __forceinline__ unsigned pk2rne(float lo, float hi) { return pg8::cvt_pk_bf16(lo, hi); }
__device__ __forceinline__ float bfround(float x) { return __uint_as_float(pk2rne(x, x) << 16); }

struct ConvDesc { const float* W; int K, N; bf16* WT; int dst_row0, k0, n0; const float* gk; };
__device__ __forceinline__ void transpose_gains(const ConvDesc& d, float (&gv)[8], int lane) {
    const int rr = lane >> 3;
#pragma unroll
    for (int i = 0; i < 8; ++i) gv[i] = d.gk ? d.gk[d.k0 + 8 * i + rr] : 1.f;
}
__device__ __forceinline__ void transpose_load(const ConvDesc& d, f32x4 (&v)[8], int lane) {
    const int rr = lane >> 3, c4 = (lane & 7) * 4;
#pragma unroll
    for (int i = 0; i < 8; ++i) v[i] = __builtin_nontemporal_load((const GAS f32x4*)(d.W + (size_t)(d.k0 + 8 * i + rr) * d.N + d.n0 + c4));
}
__device__ __forceinline__ void transpose_store(const ConvDesc& d, f32x4 (&v)[8], float (&gv)[8], LAS float* scr, int lane, bool nt = false) {
    { const int rr = lane >> 3, c4 = (lane & 7) * 4;
#pragma unroll
      for (int i = 0; i < 8; ++i) { const f32x4 w = v[i] * gv[i]; LAS float* p = scr + (8 * i + rr) * 33 + c4; p[0] = w.x; p[1] = w.y; p[2] = w.z; p[3] = w.w; } }
    LDS_WAIT(); asm volatile("" ::: "memory");
    const int c = lane & 7;
#pragma unroll
    for (int j = 0; j < 4; ++j) { const int n = (lane >> 3) + 8 * j; const LAS float* s = scr + (8 * c) * 33 + n;
        v4u o; o.x = pk2rne(s[0 * 33], s[1 * 33]); o.y = pk2rne(s[2 * 33], s[3 * 33]); o.z = pk2rne(s[4 * 33], s[5 * 33]); o.w = pk2rne(s[6 * 33], s[7 * 33]);
        GAS v4u* dp = (GAS v4u*)(d.WT + (size_t)(d.dst_row0 + n) * d.K + d.k0 + 8 * c); if (nt) __builtin_nontemporal_store(o, dp); else *dp = o; }
    LDS_WAIT(); asm volatile("" ::: "memory");
}
__device__ __forceinline__ void p0_transpose_item(const float* W, int K, int N, bf16* WT, int dst_row0, LAS float* scr, int k0, int n0, int lane, const float* gk = nullptr) {
    const ConvDesc d{W, K, N, WT, dst_row0, k0, n0, gk}; f32x4 v[8]; float gv[8]; transpose_gains(d, gv, lane); transpose_load(d, v, lane); transpose_store(d, v, gv, scr, lane);
}
__device__ __forceinline__ void norm_row_bf16(const float* xrow, const float* g, bf16* orow, int lane) {
    const GAS f32x4* xr = (const GAS f32x4*)xrow + lane; const GAS f32x4* gr = (const GAS f32x4*)g + lane;
    f32x4 v[8]; float s = 0.f;
#pragma unroll
    for (int j = 0; j < 8; ++j) { v[j] = xr[64 * j]; s += (v[j].x * v[j].x + v[j].y * v[j].y) + (v[j].z * v[j].z + v[j].w * v[j].w); }
    const float rstd = rsqrtf(wave_sum(s) * (1.f / DM) + EPS);
    GAS unsigned long long* o8 = (GAS unsigned long long*)orow + lane;
#pragma unroll
    for (int j = 0; j < 8; ++j) { const f32x4 gv = gr[64 * j]; o8[64 * j] = (unsigned long long)pk2rne(v[j].x * rstd * gv.x, v[j].y * rstd * gv.y) | ((unsigned long long)pk2rne(v[j].z * rstd * gv.z, v[j].w * rstd * gv.w) << 32); }
}

__device__ __forceinline__ void convert_expert_weights(Frame& F, int L) {
    LAS float* scr = (LAS float*)(F.lds + F.wave * 16384);
    constexpr int I_W1 = 32 * 512, I_W2 = 32 * 512;
    bf16* W13 = (bf16*)(wsptr() + WS_W13); bf16* W2 = (bf16*)(wsptr() + WS_W2);
    for (int it = F.gw; it < 2 * I_W1 + I_W2; it += F.NGW) { int r = it;
        if (r < 2 * I_W1) { const int w3 = r >= I_W1; if (w3) r -= I_W1; const int e = r / 512, rr = r % 512, n0 = 32 * (rr % 16);
            p0_transpose_item((w3 ? inptr(17) : inptr(16)) + ((size_t)L * NEXP + e) * DM * DEXP, DM, DEXP, W13 + (size_t)e * 1024 * DM, 256 * (n0 / 128) + (n0 % 128) + (w3 ? 128 : 0), scr, 64 * (rr / 16), n0, F.lane, inptr(13) + (size_t)L * DM); continue; } r -= 2 * I_W1;
        const int e = r / 512, rr = r % 512;
        p0_transpose_item(inptr(18) + ((size_t)L * NEXP + e) * DEXP * DM, DEXP, DM, W2 + (size_t)e * DM * DEXP, 32 * (rr % 64), scr, 64 * (rr / 64), 32 * (rr % 64), F.lane); }
}
static_assert(true, "");
constexpr int CONV_NCH = 8, CONV_IE = 3 * 32 * 512, CONV_ID = 32 * 160 + 32 * 64 + 32 * 64 + 4 * 64;
__device__ __forceinline__ ConvDesc conv_desc(int job, int idx) {
    bf16* W13 = (bf16*)(wsptr() + WS_W13); bf16* W2 = (bf16*)(wsptr() + WS_W2);
    if (idx < CONV_IE) { const int L = job; int r = idx;
        if (r < 2 * 32 * 512) { const int w3 = r >= 32 * 512; if (w3) r -= 32 * 512; const int e = r / 512, rr = r % 512, n0 = 32 * (rr % 16);
            return ConvDesc{(w3 ? inptr(17) : inptr(16)) + ((size_t)L * NEXP + e) * DM * DEXP, DM, DEXP, W13 + (size_t)e * 1024 * DM, 256 * (n0 / 128) + (n0 % 128) + (w3 ? 128 : 0), 64 * (rr / 16), n0, inptr(13) + (size_t)L * DM}; }
        r -= 2 * 32 * 512; const int e = r / 512, rr = r % 512;
        return ConvDesc{inptr(18) + ((size_t)L * NEXP + e) * DEXP * DM, DEXP, DM, W2 + (size_t)e * DM * DEXP, 32 * (rr % 64), 64 * (rr / 64), 32 * (rr % 64), nullptr}; }
    int r = idx - CONV_IE; const int L = 1;
    bf16* WIN = (bf16*)(wsptr() + WS_WIN); bf16* WOUT = (bf16*)(wsptr() + WS_WOUT); bf16* WG = (bf16*)(wsptr() + WS_WG); bf16* WP = (bf16*)(wsptr() + WS_WP);
    if (r < 32 * 160) { return ConvDesc{inptr(5) + (size_t)L * DM * NIN, DM, NIN, WIN + (size_t)L * NIN * DM, 32 * (r % 160), 64 * (r / 160), 32 * (r % 160), inptr(4) + (size_t)L * DM}; } r -= 32 * 160;
    if (r < 32 * 64) { return ConvDesc{inptr(12) + (size_t)L * DM * DM, DM, DM, WOUT + (size_t)L * DM * DM, 32 * (r % 64), 64 * (r / 64), 32 * (r % 64), nullptr}; } r -= 32 * 64;
    if (r < 32 * 64) { return ConvDesc{inptr(20) + (size_t)L * DM * DM, DM, DM, WG + (size_t)L * DM * DM, 32 * (r % 64), 64 * (r / 64), 32 * (r % 64), inptr(19) + (size_t)L * DM}; } r -= 32 * 64;
    return ConvDesc{inptr(21) + (size_t)L * PLE * DM, PLE, DM, WP + (size_t)L * DM * PLE, 32 * (r % 64), 64 * (r / 64), 32 * (r % 64), nullptr};
}
__device__ __forceinline__ void conv_chunk(Frame& F0, int job, int k, gu32* tq = nullptr) {
    unsigned tk_ = 0u; const bool tkd = (tq != nullptr) && (F0.wave == 0) && (mk_lane() == 0);
    if (tkd) tk_ = __hip_atomic_fetch_add(tq, 1u, RLX_AGENT);
    __syncthreads();
    Frame F = relaunder(F0);
    LAS float* scr = (LAS float*)(F.lds + F.wave * 16384 + (F.wave >= 4 ? 8192 : 0));
    const int N = job == 0 ? CONV_IE + CONV_ID : CONV_IE, ipc = (N + F.G * CONV_NCH - 1) / (F.G * CONV_NCH), base = ((int)blockIdx.x * CONV_NCH + k) * ipc;
    f32x4 v[4][8]; ConvDesc d[4]; bool has[4];
#pragma unroll
    for (int t = 0; t < 4; ++t) { const int i = F.wave + NWAVES * t, idx = base + i; has[t] = (i < ipc) && (idx < N); d[t] = conv_desc(job, has[t] ? idx : 0); }
    float gA[8], gB[8];
    transpose_gains(d[0], gA, F.lane); transpose_gains(d[1], gB, F.lane);
#pragma unroll
    for (int t = 0; t < 4; ++t) if (has[t]) transpose_load(d[t], v[t], F.lane);
    if (has[0]) transpose_store(d[0], v[0], gA, scr, F.lane, true);
    transpose_gains(d[2], gA, F.lane); if (has[1]) transpose_store(d[1], v[1], gB, scr, F.lane, true);
    transpose_gains(d[3], gB, F.lane); if (has[2]) transpose_store(d[2], v[2], gA, scr, F.lane, true);
    if (has[3]) transpose_store(d[3], v[3], gB, scr, F.lane, true);
    if (tkd) ((volatile LAS int*)(F.lds + att::OFF_MISC))[0] = (int)tk_;
    __syncthreads();
}
__device__ __forceinline__ void p0_prologue(Frame& F0, const Args& AR) {
    Frame F = relaunder(F0);
    LAS float* scr = (LAS float*)(F.lds + F.wave * 16384);
    constexpr int I_IN = 32 * 160, I_OUT = 32 * 64, I_WG = 32 * 64, I_WP = 4 * 64, I_L = I_IN + I_OUT + I_WG + I_WP;
    bf16* WIN = (bf16*)(wsptr() + WS_WIN); bf16* WOUT = (bf16*)(wsptr() + WS_WOUT); bf16* WG = (bf16*)(wsptr() + WS_WG); bf16* WP = (bf16*)(wsptr() + WS_WP);
    for (int it = F.gw; it < I_L; it += F.NGW) {
        const int L = 0; int r = it;
        if (r < I_IN) { p0_transpose_item(inptr(5) + (size_t)L * DM * NIN, DM, NIN, WIN + (size_t)L * NIN * DM, 32 * (r % 160), scr, 64 * (r / 160), 32 * (r % 160), F.lane, inptr(4) + (size_t)L * DM); continue; } r -= I_IN;
        if (r < I_OUT) { p0_transpose_item(inptr(12) + (size_t)L * DM * DM, DM, DM, WOUT + (size_t)L * DM * DM, 32 * (r % 64), scr, 64 * (r / 64), 32 * (r % 64), F.lane); continue; } r -= I_OUT;
        if (r < I_WG) { p0_transpose_item(inptr(20) + (size_t)L * DM * DM, DM, DM, WG + (size_t)L * DM * DM, 32 * (r % 64), scr, 64 * (r / 64), 32 * (r % 64), F.lane, inptr(19) + (size_t)L * DM); continue; } r -= I_WG;
        p0_transpose_item(inptr(21) + (size_t)L * PLE * DM, PLE, DM, WP + (size_t)L * DM * PLE, 32 * (r % 64), scr, 64 * (r / 64), 32 * (r % 64), F.lane);
    }
    { GAS v4u* lz = (GAS v4u*)(wsptr() + WS_LIST); for (int i = F.gw * 64 + F.lane; i < NEXP * 32768 / 4; i += F.NGW * 64) lz[i] = (v4u){0u, 0u, 0u, 0u}; }
    { const GAS f32x4* src = (const GAS f32x4*)inptr(1); GAS v4u* dst = (GAS v4u*)(wsptr() + WS_PB); const long n8 = (long)DEPTH * M * PLE / 8;
      const long st = (long)F.NGW * 64;
      for (long i = (long)F.gw * 64 + F.lane; i < n8; i += 4 * st) {
        f32x4 a[4], b[4];
#pragma unroll
        for (int u = 0; u < 4; ++u) if (i + u * st < n8) { a[u] = __builtin_nontemporal_load(src + 2 * (i + u * st)); b[u] = __builtin_nontemporal_load(src + 2 * (i + u * st) + 1); }
#pragma unroll
        for (int u = 0; u < 4; ++u) if (i + u * st < n8) { v4u o; o.x = pk2rne(a[u].x, a[u].y); o.y = pk2rne(a[u].z, a[u].w); o.z = pk2rne(b[u].x, b[u].y); o.w = pk2rne(b[u].z, b[u].w); dst[i + u * st] = o; } } }

    { bf16* WRH = (bf16*)(wsptr() + WS_WR); bf16* WRL = WRH + DEPTH * 48 * DM;
      for (int i = F.gw * 64 + F.lane; i < DEPTH * 48 * DM; i += F.NGW * 64) { const int L = i / (48 * DM), n = (i / DM) % 48, k = i % DM;
        const float w = (n < 4 ? inptr(14)[((size_t)L * DM + k) * 4 + n] : n < NROUTE ? inptr(15)[((size_t)L * DM + k) * 32 + (n - 4)] : 0.f) * inptr(13)[(size_t)L * DM + k];
        const unsigned h = pk2rne(w, 0.f) & 0xffffu; const float r = w - __uint_as_float(h << 16);
        WRH[i] = (bf16)h; WRL[i] = (bf16)(pk2rne(r, 0.f) & 0xffffu); } }
    { float* rsin = (float*)(wsptr() + WS_RSIN); bf16* hb = (bf16*)(wsptr() + hb_off(0));
      for (int m4 = F.gw; m4 < M / 4; m4 += F.NGW) {
        f32x4 v[4][8];
#pragma unroll
        for (int r = 0; r < 4; ++r) { const GAS f32x4* xr = (const GAS f32x4*)(inptr(0) + (size_t)(4 * m4 + r) * DM) + F.lane;
#pragma unroll
          for (int j = 0; j < 8; ++j) v[r][j] = __builtin_nontemporal_load(xr + 64 * j); }
#pragma unroll
        for (int r = 0; r < 4; ++r) { GAS unsigned long long* o8 = (GAS unsigned long long*)(hb + (size_t)(4 * m4 + r) * DM) + F.lane; float s = 0.f;
#pragma unroll
          for (int j = 0; j < 8; ++j) { const f32x4 w = v[r][j]; s += (w.x * w.x + w.y * w.y) + (w.z * w.z + w.w * w.w); o8[64 * j] = (unsigned long long)pk2rne(w.x, w.y) | ((unsigned long long)pk2rne(w.z, w.w) << 32); }
          s = wave_sum(s); if (F.lane == 0) rsin[4 * m4 + r] = rsqrtf(s * (1.f / DM) + EPS); } } }
}
constexpr int LDS_RSTAB = 131072, LDS_RSVAL = 131072 + 64;
template <class Sched> __device__ __forceinline__ void rsin_table(Frame& F0, const Sched& S, bool from_parts) {
    Frame F = relaunder(F0);
    LAS int* tab = (LAS int*)(F.lds + LDS_RSTAB); LAS float* rs = (LAS float*)(F.lds + LDS_RSVAL);
    if (F.tid < 4) tab[F.tid] = -1;
    __syncthreads();
    int ns = 0; pg8::Unit u;
#pragma unroll 1
    for (int i = 0; S.next(i, u); ++i) {
        bool have = false;
#pragma unroll 1
        for (int k = 0; k < ns; ++k) have = have || (tab[k] == u.pm);
        if (have || ns >= 4) continue;
        const int row = F.tid >> 1, h = F.tid & 1; float v;
        if (from_parts) { const GAS f32x4* pp = (const GAS f32x4*)((const float*)(wsptr() + WS_SSQ) + ((size_t)u.pm * 256 + row) * 32 + 16 * h);
            const f32x4 a = pp[0], b = pp[1], c = pp[2], d = pp[3]; float s = ((a.x + a.y) + (a.z + a.w)) + ((b.x + b.y) + (b.z + b.w)) + (((c.x + c.y) + (c.z + c.w)) + ((d.x + d.y) + (d.z + d.w)));
            s += mk_shfl_xor(s, 1); v = rsqrtf(s * (1.f / DM) + EPS); }
        else v = ((const float*)(wsptr() + WS_RSIN))[u.pm * 256 + row];
        if (h == 0) rs[ns * 256 + row] = v;
        if (F.tid == 0) tab[ns] = u.pm;
        ++ns;
        __syncthreads();
    }
}
__device__ __forceinline__ void kmean_phase(Frame& F0, const Args& AR) {
    Frame F = relaunder(F0);
    const bf16* proj = (const bf16*)(wsptr() + WS_PROJ); float* km = (float*)(wsptr() + WS_KMEAN);
    LAS float* part = (LAS float*)F.lds;
    for (int w = blockIdx.x; w < BATCH * 4 * 16 / 2; w += F.G) {
        const int u = 2 * w + (F.wave >> 2), q = F.wave & 3, b = u >> 6, h = (u >> 4) & 3, blk = u & 15, rg = F.lane >> 4, c = F.lane & 15;
        const bf16* kp = proj + ((size_t)b * SEQ + blk * 256 + q * 64 + rg) * NIN + KB_OFF + h * 128 + 8 * c;
        float s[8] = {0.f, 0.f, 0.f, 0.f, 0.f, 0.f, 0.f, 0.f};
#pragma unroll
        for (int i = 0; i < 16; ++i) { const v4u v = *(const GAS v4u*)(kp + (size_t)(4 * i) * NIN);
            s[0] += __uint_as_float(v.x << 16); s[1] += __uint_as_float(v.x & 0xffff0000u); s[2] += __uint_as_float(v.y << 16); s[3] += __uint_as_float(v.y & 0xffff0000u);
            s[4] += __uint_as_float(v.z << 16); s[5] += __uint_as_float(v.z & 0xffff0000u); s[6] += __uint_as_float(v.w << 16); s[7] += __uint_as_float(v.w & 0xffff0000u); }
#pragma unroll
        for (int j = 0; j < 8; ++j) { s[j] += mk_shfl_xor(s[j], 16); s[j] += mk_shfl_xor(s[j], 32); }
        __syncthreads();
        if (F.lane < 16) {
#pragma unroll
            for (int j = 0; j < 8; ++j) part[F.wave * 128 + 8 * c + j] = s[j]; }
        __syncthreads();
        if (F.tid < 256) { const int uu = F.tid >> 7, d = F.tid & 127; const LAS float* pp = part + uu * 512 + d;
            km[(size_t)(2 * w + uu) * 128 + d] = ((pp[0] + pp[128]) + (pp[256] + pp[384])) * (1.f / 256.f); }
    }
    __syncthreads();
}
struct TokRec { int e0, e1, s0, s1; float w0, w1; int pad0, pad1; };
__device__ __forceinline__ void router_phase(Frame& F0, const Args& AR, int layer) {
    Frame F = relaunder(F0);
    typedef float f32x4r __attribute__((ext_vector_type(4)));
    const bf16* h = (const bf16*)(wsptr() + hb_off(layer));
    const bf16* WRH = (const bf16*)(wsptr() + WS_WR) + (size_t)layer * 48 * DM; const bf16* WRL = WRH + DEPTH * 48 * DM;
    float* rstd_o = (float*)(wsptr() + WS_RSTD); TokRec* rec = (TokRec*)(wsptr() + WS_TOKREC); gu32* cnt = ctlptr() + CW_CNT + layer * 32 * 64;
    int* list = (int*)(wsptr() + WS_LIST);
    constexpr int KC = 512, NCH = DM / KC, WB_BYTES = 96 * KC * 2;
    LAS float* lg = (LAS float*)(F.lds + WB_BYTES) + F.wave * (16 * 49);
    LAS int* lc = (LAS int*)(F.lds + WB_BYTES + 8 * (16 * 49) * 4);
    static_assert(WB_BYTES + 8 * 16 * 49 * 4 + 64 * 4 <= PHASE_LDS, "router LDS");
    const int row = F.lane & 15, kg = F.lane >> 4;
    constexpr int NTASK = M / 128;
    typedef __attribute__((address_space(3))) unsigned las_u32r;
#pragma unroll 1
    for (int tk = (int)blockIdx.x; tk < NTASK; tk += F.G) {
        if (F.tid < 32) lc[F.tid] = 0;
        const bf16* hp = h + (size_t)(128 * tk + 16 * F.wave + row) * DM + 8 * kg;
        f32x4r acc[3]; float ss = 0.f;
#pragma unroll
        for (int t = 0; t < 3; ++t) acc[t] = (f32x4r){0.f, 0.f, 0.f, 0.f};
        v4u hq[2][16];
#pragma unroll
        for (int s = 0; s < 16; ++s) hq[0][s] = *(const GAS v4u*)(hp + 32 * s);
#pragma unroll
        for (int c = 0; c < NCH; ++c) {
            __syncthreads();
#pragma unroll
            for (int q = 0; q < 9; ++q) { const int r72 = q * 8 + F.wave, rc = r72 < NROUTE ? r72 : r72 + (48 - NROUTE), n = rc < 48 ? rc : rc - 48; const bf16* src = (rc < 48 ? WRH : WRL) + (size_t)n * DM + c * KC;
                int ll = F.lane; asm volatile("" : "+v"(ll));
                __builtin_amdgcn_global_load_lds((const unsigned*)((const char*)src + ((ll ^ (n & 15)) << 4)), (las_u32r*)(F.lds + rc * (KC * 2)), 16, 0, 0); }
            asm volatile("s_waitcnt vmcnt(0)" ::: "memory");
            __syncthreads();
            if (c + 1 < NCH) {
#pragma unroll
                for (int s = 0; s < 16; ++s) hq[(c + 1) & 1][s] = *(const GAS v4u*)(hp + (c + 1) * KC + 32 * s); }
#pragma unroll
            for (int s = 0; s < 16; ++s) { const v4u q = hq[c & 1][s];
                const float a0 = __uint_as_float(q.x << 16), a1 = __uint_as_float(q.x & 0xffff0000u), a2 = __uint_as_float(q.y << 16), a3 = __uint_as_float(q.y & 0xffff0000u);
                const float a4 = __uint_as_float(q.z << 16), a5 = __uint_as_float(q.z & 0xffff0000u), a6 = __uint_as_float(q.w << 16), a7 = __uint_as_float(q.w & 0xffff0000u);
                ss += (a0 * a0 + a1 * a1) + (a2 * a2 + a3 * a3) + (a4 * a4 + a5 * a5) + (a6 * a6 + a7 * a7);
                const bf16x8 Ah = __builtin_bit_cast(bf16x8, q);
                const int piece = ((4 * s + kg) ^ row) << 4;
#pragma unroll
                for (int t = 0; t < 3; ++t) { const bf16x8 Bh = *(const LAS bf16x8*)(F.lds + (16 * t + row) * (KC * 2) + piece), Bl = *(const LAS bf16x8*)(F.lds + (48 + 16 * t + row) * (KC * 2) + piece);
                    acc[t] = __builtin_amdgcn_mfma_f32_16x16x32_bf16(Ah, Bh, acc[t], 0, 0, 0); acc[t] = __builtin_amdgcn_mfma_f32_16x16x32_bf16(Ah, Bl, acc[t], 0, 0, 0); } }
        }
        { float s2 = ss; s2 += mk_shfl_xor(s2, 16); s2 += mk_shfl_xor(s2, 32); if (kg == 0) lg[row * 49 + 48] = s2;
#pragma unroll
            for (int t = 0; t < 3; ++t)
#pragma unroll
                for (int i = 0; i < 4; ++i) lg[(4 * kg + i) * 49 + 16 * t + row] = acc[t][i]; }
        LDS_WAIT(); asm volatile("" ::: "memory");
        int e0 = 0, e1 = 0, sl0 = 0, sl1 = 0; float w0 = 0.f, w1 = 0.f, rs = 0.f;
        if (F.lane < 16) {
            const LAS float* lr = lg + F.lane * 49;
            const float rs_ = rsqrtf(lr[48] * (1.f / DM) + EPS);
            float gl[4];
#pragma unroll
            for (int i = 0; i < 4; ++i) gl[i] = lr[i] * rs_;
            int grp = 0; float gm = gl[0];
#pragma unroll
            for (int i = 1; i < 4; ++i) if (gl[i] > gm) { gm = gl[i]; grp = i; }
            float gs = 0.f;
#pragma unroll
            for (int i = 0; i < 4; ++i) gs += __expf(gl[i] - gm);
            const float gw_ = 1.f / gs;
            float el[8];
#pragma unroll
            for (int i = 0; i < 8; ++i) el[i] = lr[4 + grp * 8 + i] * rs_;
            int i1 = 0; float t1 = el[0];
#pragma unroll
            for (int i = 1; i < 8; ++i) if (el[i] > t1) { t1 = el[i]; i1 = i; }
            int i2 = -1; float t2 = -INFINITY;
#pragma unroll
            for (int i = 0; i < 8; ++i) if (i != i1 && el[i] > t2) { t2 = el[i]; i2 = i; }
            const float ex = __expf(t2 - t1), w0_ = gw_ / (1.f + ex), w1_ = gw_ * ex / (1.f + ex);
            e0 = grp * 8 + i1; e1 = grp * 8 + i2; w0 = w0_; w1 = w1_; rs = rs_;
            sl0 = __hip_atomic_fetch_add(lc + e0, 1, __ATOMIC_RELAXED, __HIP_MEMORY_SCOPE_WORKGROUP); sl1 = __hip_atomic_fetch_add(lc + e1, 1, __ATOMIC_RELAXED, __HIP_MEMORY_SCOPE_WORKGROUP);
        }
        LDS_WAIT(); asm volatile("" ::: "memory");
        __syncthreads();
        if (F.tid < 32) { const int c = lc[F.tid]; lc[32 + F.tid] = c > 0 ? (int)__hip_atomic_fetch_add(cnt + F.tid * 64, (unsigned)c, RLX_AGENT) : 0; }
        __syncthreads();
        if (F.lane < 16) { const int rowg = 128 * tk + 16 * F.wave + F.lane; const int s0 = lc[32 + e0] + sl0, s1 = lc[32 + e1] + sl1;
            TokRec t; t.e0 = e0; t.e1 = e1; t.s0 = s0; t.s1 = s1; t.w0 = w0; t.w1 = w1; t.pad0 = 0; t.pad1 = 0; rec[rowg] = t; rstd_o[rowg] = rs;
            list[e0 * 32768 + s0] = rowg; list[e1 * 32768 + s1] = rowg; float* srs = (float*)(wsptr() + WS_SRS); srs[e0 * 32768 + s0] = rs; srs[e1 * 32768 + s1] = rs; }
        __syncthreads();
    }
}
constexpr int PL_UNITS = (M / 256) * (DM / 256), PL_R = 5;
__device__ __forceinline__ int build_tiles(Frame& F0, int layer) {
    Frame F = relaunder(F0);
    gu32* cnt = ctlptr() + CW_CNT + layer * 32 * 64; LAS int* offs = (LAS int*)(F.lds + LDS_OFFS); LAS unsigned char* te = F.lds + LDS_TILE_E;
    __syncthreads();
    if (F.tid < NEXP) offs[40 + F.tid] = (int)__hip_atomic_load(cnt + F.tid * 64, RLX_AGENT);
    __syncthreads();
    if (F.tid == 0) { int acc = 0;
#pragma unroll 1
        for (int e = 0; e < NEXP; ++e) { const int c = offs[40 + e]; offs[e] = acc * 256; const int nt = (c + 255) >> 8; for (int t = 0; t < nt && acc + t < RPAD / 256; ++t) te[acc + t] = (unsigned char)e; acc += nt; }
        offs[32] = acc < RPAD / 256 ? acc : RPAD / 256;
        const int nTl = offs[32], per = F.G >> 3, x = (int)blockIdx.x & 7, s = (int)blockIdx.x >> 3; int gmax = 0;
#pragma unroll 1
        for (int xx = 0; xx < 8; ++xx) { int n = 0;
#pragma unroll 1
            for (int k = 0; k < 4; ++k) { const int e = xx + 8 * k; const int t0 = offs[e] >> 8, t1 = (e == 31) ? nTl : (offs[e + 1] >> 8); n += (t1 > t0 ? t1 - t0 : 0) * 4; }
            offs[72 + xx] = n; const int gh = (n + per - 1) / per; gmax = gh > gmax ? gh : gmax; }
        int Dtot = 0, Dbefore = 0, dme = 0, dpre = 0;
#pragma unroll 1
        for (int xx = 0; xx < 8; ++xx) { const int n = offs[72 + xx], gh = (n + per - 1) / per, r = n > 0 ? n - (gh - 1) * per : per; const int D = per * (gmax - gh) + (per - r);
            if (xx < x) Dbefore += D; Dtot += D;
            if (xx == x) { dme = (gmax - gh) + (s >= r ? 1 : 0); dpre = s * (gmax - gh) + (s > r ? s - r : 0); } }
        int base = (PL_UNITS - PL_R * Dtot + F.G - 1) / F.G; base = base > 0 ? base : 0;
        int start = PL_R * (Dbefore + dpre) + (x * per + s) * base, count = PL_R * dme + base;
        if ((F.G & 7) || per == 0) { start = (int)blockIdx.x * ((PL_UNITS + F.G - 1) / F.G); count = (PL_UNITS + F.G - 1) / F.G; }
        if (start > PL_UNITS) start = PL_UNITS; if (start + count > PL_UNITS) count = PL_UNITS - start;
        offs[33] = start; offs[34] = count; }
    __syncthreads();
    return offs[32];
}
struct ListOrder {
    static constexpr bool B_NT = false;
    int start, count;
    __device__ __forceinline__ bool next(int i, pg8::Unit& u) const { if (i >= count) return false; const int L = start + i; u.pm = L >> 3; u.pn = L & 7; return true; }
    __device__ __forceinline__ void a_ready(const pg8::Unit&) const {}
    __device__ __forceinline__ void done(const pg8::Unit&) const {}
};
__device__ __forceinline__ void combine_phase(Frame& F0, const Args& AR, int layer) {
#if MK_PER_PHASE
    (void)build_tiles(F0, layer);
#endif
    Frame F = relaunder(F0);
    const LAS int* offs = (const LAS int*)(F.lds + LDS_OFFS);
    bf16* hb = (bf16*)(wsptr() + hb_off(layer)); const TokRec* rec = (const TokRec*)(wsptr() + WS_TOKREC);
    const bf16* y = (const bf16*)(wsptr() + WS_Y); float* rsple = (float*)(wsptr() + WS_RSPLE);
    TokRec tn[2];
    if (F.gw < M / 2) {
#pragma unroll
        for (int r = 0; r < 2; ++r) tn[r] = rec[F.gw + r * (M / 2)]; }
    for (int m2 = F.gw; m2 < M / 2; m2 += F.NGW) {
        TokRec t[2]; int p0[2], p1[2];
#pragma unroll
        for (int r = 0; r < 2; ++r) t[r] = tn[r];
        if (m2 + F.NGW < M / 2) {
#pragma unroll
            for (int r = 0; r < 2; ++r) tn[r] = rec[m2 + F.NGW + r * (M / 2)]; }
#pragma unroll
        for (int r = 0; r < 2; ++r) { p0[r] = offs[t[r].e0] + t[r].s0; p1[r] = offs[t[r].e1] + t[r].s1; }
        v4u hq[2][4], ya[2][4], yb[2][4];
#pragma unroll
        for (int r = 0; r < 2; ++r) { const GAS v4u* xr = (const GAS v4u*)(hb + (size_t)(m2 + r * (M / 2)) * DM) + F.lane;
            const GAS v4u* y0 = (const GAS v4u*)(y + (size_t)p0[r] * DM) + F.lane; const GAS v4u* y1 = (const GAS v4u*)(y + (size_t)p1[r] * DM) + F.lane;
#pragma unroll
            for (int j = 0; j < 4; ++j) { hq[r][j] = xr[64 * j]; ya[r][j] = __builtin_nontemporal_load(y0 + 64 * j); yb[r][j] = __builtin_nontemporal_load(y1 + 64 * j); } }
#pragma unroll
        for (int r = 0; r < 2; ++r) { const int m = m2 + r * (M / 2); GAS v4u* xw = (GAS v4u*)(hb + (size_t)m * DM) + F.lane; float s = 0.f; const float w0 = t[r].w0, w1 = t[r].w1;
#pragma unroll
            for (int j = 0; j < 4; ++j) { const v4u q = hq[r][j], a = ya[r][j], b = yb[r][j]; v4u o;
#define CMB(QW, AW, BW, OW) do { const float lo_ = __uint_as_float((QW) << 16) + w0 * __uint_as_float((AW) << 16) + w1 * __uint_as_float((BW) << 16), hi_ = __uint_as_float((QW) & 0xffff0000u) + w0 * __uint_as_float((AW) & 0xffff0000u) + w1 * __uint_as_float((BW) & 0xffff0000u); \
                    OW = pk2rne(lo_, hi_); s += lo_ * lo_ + hi_ * hi_; } while (0)
                CMB(q.x, a.x, b.x, o.x); CMB(q.y, a.y, b.y, o.y); CMB(q.z, a.z, b.z, o.z); CMB(q.w, a.w, b.w, o.w);
#undef CMB
                xw[64 * j] = o; }
            s = wave_sum(s); if (F.lane == 0) rsple[m] = rsqrtf(s * (1.f / DM) + EPS); }
    }
}
__device__ __forceinline__ void endnorm_phase(Frame& F0, const Args& AR, int layer) {
    Frame F = relaunder(F0);
    const bf16* hb = (const bf16*)(wsptr() + hb_off(layer + 1));
    const bool last = layer + 1 >= DEPTH;
    float* rsin = (float*)(wsptr() + WS_RSIN);
    f32x4 g8[8];
#pragma unroll
    for (int j = 0; j < 8; ++j) g8[j] = last ? ((const GAS f32x4*)inptr(3) + F.lane)[64 * j] : (f32x4){0.f, 0.f, 0.f, 0.f};
    for (int m4 = F.gw; m4 < M / 4; m4 += F.NGW) {
        u32x2g q[4][8];
#pragma unroll
        for (int r = 0; r < 4; ++r) { const GAS u32x2g* xr = (const GAS u32x2g*)(hb + (size_t)(4 * m4 + r) * DM) + F.lane;
#pragma unroll
            for (int j = 0; j < 8; ++j) q[r][j] = last ? __builtin_nontemporal_load(xr + 64 * j) : xr[64 * j]; }
#pragma unroll
        for (int r = 0; r < 4; ++r) { const int m = 4 * m4 + r; float s = 0.f;
#pragma unroll
            for (int j = 0; j < 8; ++j) { const float a = __uint_as_float(q[r][j].x << 16), b = __uint_as_float(q[r][j].x & 0xffff0000u), c = __uint_as_float(q[r][j].y << 16), d = __uint_as_float(q[r][j].y & 0xffff0000u); s += (a * a + b * b) + (c * c + d * d); }
            const float rstd = rsqrtf(wave_sum(s) * (1.f / DM) + EPS);
            if (last) { GAS f32x4* o = (GAS f32x4*)(outptr() + (size_t)m * DM) + F.lane;
#pragma unroll
                for (int j = 0; j < 8; ++j) { const f32x4 v = (f32x4){__uint_as_float(q[r][j].x << 16), __uint_as_float(q[r][j].x & 0xffff0000u), __uint_as_float(q[r][j].y << 16), __uint_as_float(q[r][j].y & 0xffff0000u)}; __builtin_nontemporal_store(v * rstd * g8[j], o + 64 * j); } }
            else if (F.lane == 0) rsin[m] = rstd; }
    }
}
template <int MODE> __device__ __forceinline__ void attn_queue(Frame& F0, const att::AttnArgs& A, gu32* qbase, int& cc) {
    Frame F = relaunder(F0);
    volatile LAS int* mb = (volatile LAS int*)(F.lds + att::OFF_MISC);
    constexpr int NPER = (MODE == 2) ? 96 : (MODE == 1) ? 64 : 96;
    const int myx = (int)(xb_xcc_id() & 7u);
    const float lam = att::attn_mode_setup<MODE>(A, (char*)F.lds, F.wave);
#pragma unroll 1
    for (int xs = 0; xs < 8; ++xs) {
        const int x = (myx + xs) & 7;
        if (xs == 1) {
            __syncthreads();
            { const int t8 = mk_lane(); if (F.wave == 0 && t8 < 8) mb[32 + t8] = (int)__hip_atomic_load(qbase + t8 * 64, RLX_AGENT); }
            __syncthreads(); }
        if (xs >= 1 && mb[32 + x] >= NPER) continue;
        bool have = false;
        for (;;) {
            if (!have) { __syncthreads();
                if (F.tid == 0) mb[0] = (int)__hip_atomic_fetch_add(qbase + x * 64, 1u, RLX_AGENT);
                __syncthreads(); }
            have = false;
            const int idx = __builtin_amdgcn_readfirstlane(mb[0]);
            if (idx >= NPER) break;
            int b, hh, qb;
            if (MODE == 2) { const int p = (idx % 6) * 8 + x; b = p / 6; hh = p % 6; qb = 15 - idx / 6; }
            else if (MODE == 1) { const int p = (idx & 3) * 8 + x; b = p >> 2; hh = p & 3; qb = 15 - (idx >> 2); }
            else { const int kvp = (idx / 48) * 8 + x, r = idx % 48; b = kvp >> 1; hh = (kvp & 1) * 3 + r % 3; qb = r / 3; }
            att::attn_unit<MODE>(A, b, hh, qb, (char*)F.lds, F.wave, lam);
            if (cc < CONV_NCH) { conv_chunk(F0, A.layer, cc, qbase + x * 64); ++cc; have = true; }
        }
    }
}
__device__ __forceinline__ att::AttnArgs make_attn_args(int layer) { att::AttnArgs A{}; A.layer = layer; A.lambda_init = 0.8f - 0.6f * __expf(-0.3f * (float)layer); return A; }
static_assert(NROUTE == 36 && 2 * NROUTE == 72, "router staging: 72 row chunks over 8 waves");
static_assert(att::ATT_WS_KP == WS_PL && KB_OFF % 256 == 0 && SEQ % 256 == 0 && SEQ / 256 == 16, "block means from the projection epilogue");
static_assert(att::ATT_WS_PROJ == WS_PROJ && att::ATT_WS_YCAT == WS_YCAT && att::ATT_WS_KMEAN == WS_KMEAN, "attention body's workspace offsets");

#ifndef MK_PH_MASK
#define MK_PH_MASK 0xFFFFFFFFu
#endif
#ifndef MK_ATT_MASK
#define MK_ATT_MASK 7
#endif
#define ATM(k) ((MK_ATT_MASK >> (k)) & 1)
#define PHM(k) ((MK_PH_MASK >> (k)) & 1u)
constexpr int NPH_LAYER = 11, NPHASES = 1 + DEPTH * NPH_LAYER;
__global__ void __launch_bounds__(NWAVES * 64, 2) mk_fwd(Args args) {
    extern __shared__ __attribute__((aligned(16))) unsigned char lds[];
    Frame F;
    F.lds = (LAS unsigned char*)lds; F.MISC = (volatile LAS unsigned*)(F.lds + LDS_MISC);
    F.wave = __builtin_amdgcn_readfirstlane((int)threadIdx.x >> 6); F.lane = mk_lane(); F.tid = F.wave * 64 + F.lane; F.G = gridDim.x;
    F.gw = blockIdx.x * NWAVES + F.wave; F.NGW = F.G * NWAVES;
    for (int u = F.tid; u < (LDS_BYTES - LDSCTL_OFF) / 4; u += NWAVES * 64) ((LAS unsigned*)(F.lds + LDSCTL_OFF))[u] = 0u;
    __syncthreads();
    XcdBarrier bar; bar.bar = (unsigned*)(ctlptr() + CW_BAR); bar.x = 0; bar.st = nullptr;
    if (args.use_bar) bar = xcd_barrier_post((unsigned*)(ctlptr() + CW_BAR), F.MISC + 8);
    const int lo = args.ph_lo, hi = args.ph_hi;
#define IN(k) (lo <= (k) && (k) < hi)
#define SEAM(k) do { if (IN(k) && IN((k) + 1)) xcd_barrier(bar); } while (0)
    if (PHM(0) && IN(0)) { p0_prologue(F, args); } SEAM(0);
#pragma unroll 1
    for (int layer = 0; layer < DEPTH; ++layer) {
        const int pb = 1 + layer * NPH_LAYER;
        const bool fuse_norm = (F.G == 256);
        if (PHM(1) && IN(pb + 0)) { pg8::Gemm g{(const bf16*)(wsptr() + hb_off(layer)), (const bf16*)(wsptr() + WS_WIN) + (size_t)layer * NIN * DM, M, NIN, DM}; pg8::StaticOrder S; S.init(M, NIN, F.G, (int)blockIdx.x);
            rsin_table(F, S, fuse_norm && layer > 0);
            pg8::EpiProj E{(bf16*)(wsptr() + WS_PROJ), NIN, (const LAS int*)(F.lds + LDS_RSTAB), (const LAS float*)(F.lds + LDS_RSVAL), (float*)(wsptr() + WS_PL), KB_OFF / 256, att::ATT_KP_N, (const float*)(wsptr() + WS_RSIN)};
            pg8::gemm_phase<pg8::EpiProj, pg8::StaticOrder, true, true>(F.lds, g, S, E, F.wave);
            }
        SEAM(pb + 0);
        if (PHM(3) && IN(pb + 2)) { const att::AttnArgs A = make_attn_args(layer);
            int cc = 0;
            if (ATM(2)) attn_queue<2>(F, A, ctlptr() + CW_Q + ((layer * 3 + 0) * 8) * 64, cc);
            if (ATM(1)) attn_queue<1>(F, A, ctlptr() + CW_Q + ((layer * 3 + 1) * 8) * 64, cc);
            if (ATM(0)) attn_queue<0>(F, A, ctlptr() + CW_Q + ((layer * 3 + 2) * 8) * 64, cc);
#pragma unroll 1
            for (; cc < CONV_NCH; ++cc) conv_chunk(F, layer, cc);
            }
        SEAM(pb + 2);
        if (PHM(4) && IN(pb + 3)) { pg8::Gemm g{(const bf16*)(wsptr() + WS_YCAT), (const bf16*)(wsptr() + WS_WOUT) + (size_t)layer * DM * DM, M, DM, DM}; pg8::StaticOrder S; S.init(M, DM, F.G, (int)blockIdx.x);
            pg8::EpiRes E{(bf16*)(wsptr() + hb_off(layer)), DM};
            pg8::gemm_phase<pg8::EpiRes, pg8::StaticOrder, true, true>(F.lds, g, S, E, F.wave); }
        SEAM(pb + 3);
        if (PHM(5) && IN(pb + 4)) router_phase(F, args, layer);
        SEAM(pb + 4);
        if (PHM(7) && IN(pb + 6)) { const int nT = build_tiles(F, layer);
            pg8::Gemm g{(const bf16*)(wsptr() + hb_off(layer)), (const bf16*)(wsptr() + WS_W13), M, NEXP * 1024, DM};
            pg8::GroupedOrder S{(const LAS unsigned char*)(F.lds + LDS_TILE_E), nT, 4, F.G, (int)blockIdx.x, (const int*)(wsptr() + WS_LIST), (const LAS int*)(F.lds + LDS_OFFS), (const LAS int*)(F.lds + 131072)};
            { LAS int* lt = (LAS int*)(F.lds + 131072); pg8::Unit u;
              const int t_ = F.wave * 64 + mk_lane();
#pragma unroll 1
              for (int i = 0; i < pg8::GroupedOrder::LTAB_UNITS && S.next(i, u); ++i) if (t_ < 256) { const int e = u.pn / 4; lt[i * 256 + t_] = ((const int*)(wsptr() + WS_LIST))[e * 32768 + (u.pm * 256 - ((const LAS int*)(F.lds + LDS_OFFS))[e]) + t_]; }
              __syncthreads(); }
            pg8::EpiSiluMul E{(bf16*)(wsptr() + WS_HID), DEXP, (const int*)(wsptr() + WS_LIST), (const LAS int*)(F.lds + LDS_OFFS), (const float*)(wsptr() + WS_SRS)};
            pg8::gemm_phase<pg8::EpiSiluMul, pg8::GroupedOrder, true, true, true>(F.lds, g, S, E, F.wave);
            { const LAS int* offs = (const LAS int*)(F.lds + LDS_OFFS); ListOrder S2{offs[33], offs[34]};
              pg8::Gemm g2{(const bf16*)(wsptr() + WS_PB) + (size_t)layer * M * PLE, (const bf16*)(wsptr() + WS_WP) + (size_t)layer * DM * PLE, M, DM, opaque_i(PLE)};
              pg8::EpiBf16<0> E2{(bf16*)(wsptr() + WS_PL), DM, nullptr, 0, 0, 1.f, nullptr, 1};
              pg8::gemm_phase<pg8::EpiBf16<0>, ListOrder, true, true>(F.lds, g2, S2, E2, F.wave); }
            }
        SEAM(pb + 6);
        if (PHM(8) && IN(pb + 7)) {
#if MK_PER_PHASE
            (void)build_tiles(F, layer);
#endif
            const int nT = ((const LAS int*)(F.lds + LDS_OFFS))[32];
            pg8::Gemm g{(const bf16*)(wsptr() + WS_HID), (const bf16*)(wsptr() + WS_W2), RPAD, NEXP * DM, DEXP};
            pg8::GroupedOrder S{(const LAS unsigned char*)(F.lds + LDS_TILE_E), nT, 8, F.G, (int)blockIdx.x, nullptr, (const LAS int*)(F.lds + LDS_OFFS), nullptr};
            pg8::EpiBf16<0> E{(bf16*)(wsptr() + WS_Y), DM, nullptr, DM, 0, 1.f, nullptr, 1};
            pg8::gemm_phase<pg8::EpiBf16<0>, pg8::GroupedOrder, true, true>(F.lds, g, S, E, F.wave);
            }
        SEAM(pb + 7);
        if (PHM(9) && IN(pb + 8)) combine_phase(F, args, layer);
        SEAM(pb + 8);
        if (PHM(10) && IN(pb + 9)) { pg8::Gemm g{(const bf16*)(wsptr() + hb_off(layer)), (const bf16*)(wsptr() + WS_WG) + (size_t)layer * DM * DM, M, DM, DM}; pg8::StaticOrder S; S.init(M, DM, F.G, (int)blockIdx.x);
            pg8::EpiGate E{(const bf16*)(wsptr() + hb_off(layer)), (bf16*)(wsptr() + hb_off(layer + 1)), (const bf16*)(wsptr() + WS_PL), (const float*)(wsptr() + WS_RSPLE), DM, (fuse_norm && layer + 1 < DEPTH) ? (float*)(wsptr() + WS_SSQ) : nullptr};
            pg8::gemm_phase<pg8::EpiGate, pg8::StaticOrder, true, true>(F.lds, g, S, E, F.wave); }
        SEAM(pb + 9);
        if (!(fuse_norm && layer + 1 < DEPTH)) { if (PHM(11) && IN(pb + 10)) endnorm_phase(F, args, layer);
        SEAM(pb + 10); }
    }
#undef IN
#undef SEAM
}

extern "C" void kernel_launch(void* const* d_in, const int* in_sizes, int n_in, void* d_out, int out_size, void* d_ws, size_t ws_size, hipStream_t stream) {
    static int grid = 0;
    if (grid == 0) {
        if (n_in != 22 || in_sizes[0] != M * DM || out_size != M * DM || ws_size < WS_END) { fprintf(stderr, "kernel_launch: shape mismatch (n_in %d, in0 %d, out %d, ws %zu < %zu); nothing launched\n", n_in, n_in > 0 ? in_sizes[0] : -1, out_size, ws_size, (size_t)WS_END); grid = -1; return; }
        int dev = 0, cus = 0, per_cu = 0;
        if (hipGetDevice(&dev) != hipSuccess || hipDeviceGetAttribute(&cus, hipDeviceAttributeMultiprocessorCount, dev) != hipSuccess) { grid = -1; return; }
        if (hipFuncSetAttribute((const void*)mk_fwd, hipFuncAttributeMaxDynamicSharedMemorySize, LDS_BYTES) != hipSuccess) { fprintf(stderr, "kernel_launch: hipFuncSetAttribute failed\n"); grid = -1; return; }
        if (hipOccupancyMaxActiveBlocksPerMultiprocessor(&per_cu, (const void*)mk_fwd, NWAVES * 64, LDS_BYTES) != hipSuccess || per_cu < 1) { fprintf(stderr, "kernel_launch: occupancy query says %d blocks per CU\n", per_cu); }
        (void)hipGetLastError();
        grid = cus;
    }
    if (grid < 0) return;
    if (hipMemsetAsync((char*)d_ws + WS_CTL, 0, CTL_ZERO_BYTES, stream) != hipSuccess) return;
    Args a{};
    for (int i = 0; i < 22; ++i) a.in[i] = (const float*)d_in[i];
    a.out = (float*)d_out; a.ws = (unsigned char*)d_ws;
#if MK_PER_PHASE
    a.use_bar = 0;
    for (int ph = 0; ph < NPHASES; ++ph) {
        const int layer = ph > 0 ? (ph - 1) / NPH_LAYER : -1, k = ph > 0 ? (ph - 1) % NPH_LAYER : -1;
        a.ph_lo = ph; a.ph_hi = ph + 1;
        hipLaunchKernelGGL(mk_fwd, dim3(grid), dim3(NWAVES * 64), LDS_BYTES, stream, a);
    }
#else
    a.use_bar = 1; a.ph_lo = 0; a.ph_hi = NPHASES;
    hipLaunchKernelGGL(mk_fwd, dim3(grid), dim3(NWAVES * 64), LDS_BYTES, stream, a);
#endif
    const hipError_t le = hipPeekAtLastError();
    if (le != hipSuccess) fprintf(stderr, "kernel_launch: launch failed: %s\n", hipGetErrorName(le));
}
```

```cpp
#include <hip/hip_runtime.h>
#include <hip/hip_bf16.h>
#include <cstdio>
#include <cstdint>
#include <cmath>
#ifndef MK_PER_PHASE
#define MK_PER_PHASE 0
#endif
__device__ __forceinline__ int mk_lane() { unsigned m = ~0u; asm volatile("" : "+s"(m)); return (int)__builtin_amdgcn_mbcnt_hi(m, __builtin_amdgcn_mbcnt_lo(m, 0u)); }
__device__ __forceinline__ float mk_shfl_xor_l(float v, int o, int l) { return __uint_as_float((unsigned)__builtin_amdgcn_ds_bpermute((l ^ o) << 2, (int)__float_as_uint(v))); }
__device__ __forceinline__ float mk_shfl_xor(float v, int o) { return mk_shfl_xor_l(v, o, mk_lane()); }
#define CAS __attribute__((address_space(4)))
__device__ __forceinline__ const CAS char* kargs() { const CAS char* kp = (const CAS char*)__builtin_amdgcn_kernarg_segment_ptr(); asm volatile("" : "+s"(kp)); return kp; }
__device__ __forceinline__ const float* inptr(int k) { return *(const float* const CAS*)(kargs() + 8 * k); }
__device__ __forceinline__ float* outptr() { return *(float* const CAS*)(kargs() + 176); }
__device__ __forceinline__ unsigned char* wsptr() { return *(unsigned char* const CAS*)(kargs() + 184); }
namespace pg8 {
#define PG8_LAS __attribute__((address_space(3)))
typedef unsigned short bf16_t;
typedef short bf16x8 __attribute__((ext_vector_type(8)));
typedef float f32x4 __attribute__((ext_vector_type(4)));
typedef unsigned u32x4 __attribute__((ext_vector_type(4)));
constexpr int BM = 256, BK = 64, HALF = 128, HTB = HALF * BK * 2  , STAGE_BYTES = 8 * HTB, NXCD = 8, WGM = 8;

__host__ __device__ __forceinline__ int lds_byte(int r, int c) { const int st = (r >> 4) * 2 + (c >> 5), rr = r & 15, cc = c & 31, ob = rr * 64 + cc * 2; return st * 1024 + (ob ^ (((ob >> 9) & 1) << 5)); }
__host__ __device__ __forceinline__ void stage_rc(int b, int& R, int& C) { const int st = b / 1024, sb = b % 1024, swz = sb ^ (((sb >> 9) & 1) << 5); R = (st >> 1) * 16 + swz / 64; C = (st & 1) * 32 + (swz % 64) / 2; }
__host__ __device__ __forceinline__ int perm32(int rho) { const int n = rho >> 4, i = rho & 15; return 8 * (i >> 2) + 4 * n + (i & 3); }

struct Unit { int pm, pn; };
struct Gemm { const bf16_t* A; const bf16_t* Bt; int M, N, K; };

struct StaticOrder {
    static constexpr bool B_NT = false;
    int nM, nN, nwg, G, c;
    __host__ __device__ void init(int M, int N, int G_, int c_) { nM = M / BM; nN = N / BM; nwg = nM * nN; G = G_; c = c_; }
    __host__ __device__ bool next(int i, Unit& u) const {
        const long L = (long)i * G + c; if (L >= nwg) return false;
        int wgid = (int)L; { const int q = nwg / NXCD, r = nwg % NXCD, xcd = wgid % NXCD, off = wgid / NXCD; wgid = (xcd < r ? xcd * (q + 1) : r * (q + 1) + (xcd - r) * q) + off; }
        const int nig = WGM * nN, gid = wgid / nig, fm = gid * WGM, gsz = (nM - fm) < WGM ? (nM - fm) : WGM;
        u.pm = fm + ((wgid % nig) % gsz); u.pn = (wgid % nig) / gsz; return true;
    }
    __device__ __forceinline__ void a_ready(const Unit&) const {}
    __device__ __forceinline__ void done(const Unit&) const {}
    __device__ __forceinline__ int row_tok(const Unit&, int) const { return 0; }
};

__device__ __forceinline__ unsigned cvt_pk_bf16(float lo, float hi) { unsigned r; asm volatile("v_cvt_pk_bf16_f32 %0, %1, %2" : "=v"(r) : "v"(lo), "v"(hi)); return r; }
typedef float f32x2 __attribute__((ext_vector_type(2)));
template <int ACT  > struct EpiBf16 {
    static constexpr bool PERM = true, AFTER_DRAIN = false, PROBE = false; static_assert(ACT == 0 || ACT == 1, "EpiBf16: ACT is 0 (none) or 1 (gelu_pk)");
    bf16_t* O; int ldc; const float* bias; int split_cols; size_t split_stride; float scale0; const float* rowscale; int nt;
    __device__ __forceinline__ void operator()(const f32x4 (&acc)[2][2][4][2], const Unit& u, int wr, int wc, int fr, int fq) const {
        const int row0 = u.pm * BM + wr * 64 + fr; int colt = u.pn * BM; bf16_t* base = O;
        float sc = 1.f; if (split_cols) { const int t = colt / split_cols; base += (size_t)t * split_stride; colt -= t * split_cols; if (t == 0) sc = scale0; }
        const int col0 = colt + wc * 32 + 8 * fq, bcol0 = u.pn * BM + wc * 32 + 8 * fq;
        f32x4 bv[2][2];
#pragma unroll
        for (int bj = 0; bj < 2; ++bj)
#pragma unroll
            for (int n = 0; n < 2; ++n) bv[bj][n] = bias ? *(const f32x4*)(bias + bcol0 + bj * HALF + 4 * n) : (f32x4){0.f, 0.f, 0.f, 0.f};
#pragma unroll
        for (int ai = 0; ai < 2; ++ai)
#pragma unroll
            for (int m = 0; m < 4; ++m) { bf16_t* rowp = base + (size_t)(row0 + ai * HALF + m * 16) * ldc + col0; const float rsc = rowscale ? rowscale[row0 + ai * HALF + m * 16] * sc : sc;
#pragma unroll
                for (int bj = 0; bj < 2; ++bj) { f32x4 v0 = acc[ai][bj][m][0] + bv[bj][0], v1 = acc[ai][bj][m][1] + bv[bj][1];
                    v0 = v0 * rsc; v1 = v1 * rsc; u32x4 w; w.x = cvt_pk_bf16(v0[0], v0[1]); w.y = cvt_pk_bf16(v0[2], v0[3]); w.z = cvt_pk_bf16(v1[0], v1[1]); w.w = cvt_pk_bf16(v1[2], v1[3]);
                    if (nt) __builtin_nontemporal_store(w, (u32x4*)(rowp + bj * HALF)); else *(u32x4*)(rowp + bj * HALF) = w; } }
    }
};

__device__ __forceinline__ float bflo(unsigned w) { return __uint_as_float(w << 16); }
__device__ __forceinline__ float bfhi(unsigned w) { return __uint_as_float(w & 0xffff0000u); }
struct EpiRes {
    static constexpr bool PERM = true, AFTER_DRAIN = false, PROBE = true;
    bf16_t* hb; int ldc;
    __device__ __forceinline__ void operator()(const f32x4 (&acc)[2][2][4][2], const Unit& u, int wr, int wc, int fr, int fq) const {
        const int row0 = u.pm * BM + wr * 64 + fr, col0 = u.pn * BM + wc * 32 + 8 * fq;
        u32x4 q[2][4][2];
#pragma unroll
        for (int ai = 0; ai < 2; ++ai)
#pragma unroll
            for (int m = 0; m < 4; ++m)
#pragma unroll
                for (int bj = 0; bj < 2; ++bj) q[ai][m][bj] = *(const u32x4*)(hb + (size_t)(row0 + ai * HALF + m * 16) * ldc + col0 + bj * HALF);
#pragma unroll
        for (int ai = 0; ai < 2; ++ai)
#pragma unroll
            for (int m = 0; m < 4; ++m)
#pragma unroll
                for (int bj = 0; bj < 2; ++bj) { const u32x4 qq = q[ai][m][bj]; const f32x4 a0 = acc[ai][bj][m][0], a1 = acc[ai][bj][m][1];
                    u32x4 w; w.x = cvt_pk_bf16(bflo(qq.x) + a0[0], bfhi(qq.x) + a0[1]); w.y = cvt_pk_bf16(bflo(qq.y) + a0[2], bfhi(qq.y) + a0[3]); w.z = cvt_pk_bf16(bflo(qq.z) + a1[0], bfhi(qq.z) + a1[1]); w.w = cvt_pk_bf16(bflo(qq.w) + a1[2], bfhi(qq.w) + a1[3]);
                    *(u32x4*)(hb + (size_t)(row0 + ai * HALF + m * 16) * ldc + col0 + bj * HALF) = w; }
    }
};
__device__ __forceinline__ float sigmoidf_(float a) { return __builtin_amdgcn_rcpf(1.0f + __builtin_amdgcn_exp2f(-1.4426950408889634f * a)); }
struct EpiSiluMul {
    static constexpr bool PERM = true, AFTER_DRAIN = false, PROBE = false;
    bf16_t* O; int ldc; const int* list; const PG8_LAS int* offs; const float* rstd;
    __device__ __forceinline__ void operator()(const f32x4 (&acc)[2][2][4][2], const Unit& u, int wr, int wc, int fr, int fq) const {
        const int row0 = u.pm * BM + wr * 64 + fr, col0 = (u.pn & 3) * HALF + wc * 32 + 8 * fq;
        const int e = u.pn >> 2; const float* lp = rstd + e * 32768 + (u.pm * BM - offs[e]) + wr * 64 + fr;
        float rsv[2][4];
#pragma unroll
        for (int ai = 0; ai < 2; ++ai)
#pragma unroll
            for (int m = 0; m < 4; ++m) rsv[ai][m] = lp[ai * HALF + m * 16];
#pragma unroll
        for (int ai = 0; ai < 2; ++ai)
#pragma unroll
            for (int m = 0; m < 4; ++m) { bf16_t* rowp = O + (size_t)(row0 + ai * HALF + m * 16) * ldc + col0;
                const float rs = rsv[ai][m];
                f32x4 v0, v1;
#pragma unroll
                for (int i = 0; i < 4; ++i) { const float a0 = acc[ai][0][m][0][i] * rs, a1 = acc[ai][0][m][1][i] * rs;
                    v0[i] = a0 * sigmoidf_(a0) * (acc[ai][1][m][0][i] * rs); v1[i] = a1 * sigmoidf_(a1) * (acc[ai][1][m][1][i] * rs); }
                u32x4 w; w.x = cvt_pk_bf16(v0[0], v0[1]); w.y = cvt_pk_bf16(v0[2], v0[3]); w.z = cvt_pk_bf16(v1[0], v1[1]); w.w = cvt_pk_bf16(v1[2], v1[3]);
                *(u32x4*)rowp = w; }
    }
};
struct EpiGate {
    static constexpr bool PERM = true, AFTER_DRAIN = false, PROBE = false;
    const bf16_t* hin; bf16_t* hout; const bf16_t* PL; const float* rs; int ldc; float* part;
    __device__ __forceinline__ void operator()(const f32x4 (&acc)[2][2][4][2], const Unit& u, int wr, int wc, int fr, int fq) const {
        const int row0 = u.pm * BM + wr * 64 + fr, col0 = u.pn * BM + wc * 32 + 8 * fq;
#pragma unroll
        for (int ai = 0; ai < 2; ++ai) { u32x4 q[4][2], p[4][2]; float r_[4], ss[4];
#pragma unroll
            for (int m = 0; m < 4; ++m) { r_[m] = rs[row0 + ai * HALF + m * 16];
#pragma unroll
                for (int bj = 0; bj < 2; ++bj) { const size_t off = (size_t)(row0 + ai * HALF + m * 16) * ldc + col0 + bj * HALF; q[m][bj] = __builtin_nontemporal_load((const u32x4*)(hin + off)); p[m][bj] = __builtin_nontemporal_load((const u32x4*)(PL + off)); } }
#pragma unroll
            for (int m = 0; m < 4; ++m) { float s = 0.f;
#pragma unroll
                for (int bj = 0; bj < 2; ++bj) { const u32x4 qq = q[m][bj], pp = p[m][bj]; const f32x4 a0 = acc[ai][bj][m][0] * r_[m], a1 = acc[ai][bj][m][1] * r_[m];
                    const float v0 = bflo(qq.x) + sigmoidf_(a0[0]) * bflo(pp.x), v1 = bfhi(qq.x) + sigmoidf_(a0[1]) * bfhi(pp.x), v2 = bflo(qq.y) + sigmoidf_(a0[2]) * bflo(pp.y), v3 = bfhi(qq.y) + sigmoidf_(a0[3]) * bfhi(pp.y);
                    const float v4 = bflo(qq.z) + sigmoidf_(a1[0]) * bflo(pp.z), v5 = bfhi(qq.z) + sigmoidf_(a1[1]) * bfhi(pp.z), v6 = bflo(qq.w) + sigmoidf_(a1[2]) * bflo(pp.w), v7 = bfhi(qq.w) + sigmoidf_(a1[3]) * bfhi(pp.w);
                    u32x4 w; w.x = cvt_pk_bf16(v0, v1); w.y = cvt_pk_bf16(v2, v3); w.z = cvt_pk_bf16(v4, v5); w.w = cvt_pk_bf16(v6, v7);
                    s += ((v0 * v0 + v1 * v1) + (v2 * v2 + v3 * v3)) + ((v4 * v4 + v5 * v5) + (v6 * v6 + v7 * v7));
                    *(u32x4*)(hout + (size_t)(row0 + ai * HALF + m * 16) * ldc + col0 + bj * HALF) = w; }
                ss[m] = s; }
            if (part) { const int l = mk_lane();
#pragma unroll
                for (int m = 0; m < 4; ++m) { float s = ss[m]; s += mk_shfl_xor_l(s, 16, l); s += mk_shfl_xor_l(s, 32, l);
                    if (fq == 0) part[(size_t)(row0 + ai * HALF + m * 16) * 32 + 4 * u.pn + wc] = s; } }
            asm volatile("" ::: "memory"); }
    }
};
__device__ __forceinline__ float row_sum16(float v) {
    v += __int_as_float(__builtin_amdgcn_update_dpp(0, __float_as_int(v), 0x128, 0xf, 0xf, false));
    v += __int_as_float(__builtin_amdgcn_update_dpp(0, __float_as_int(v), 0x124, 0xf, 0xf, false));
    v += __int_as_float(__builtin_amdgcn_update_dpp(0, __float_as_int(v), 0x122, 0xf, 0xf, false));
    v += __int_as_float(__builtin_amdgcn_update_dpp(0, __float_as_int(v), 0x121, 0xf, 0xf, false));
    return v;
}
struct EpiProj {
    static constexpr bool PERM = true, AFTER_DRAIN = false, PROBE = false;
    bf16_t* O; int ldc; const PG8_LAS int* tab; const PG8_LAS float* rs; float* kp; int kt0, kpn; const float* rsg;
    __device__ __forceinline__ void operator()(const f32x4 (&acc)[2][2][4][2], const Unit& u, int wr, int wc, int fr, int fq) const {
        const int row0 = u.pm * BM + wr * 64 + fr, col0 = u.pn * BM + wc * 32 + 8 * fq;
        int s = -1;
#pragma unroll
        for (int k = 0; k < 4; ++k) s = (tab[k] == u.pm) ? k : s;
        s = __builtin_amdgcn_readfirstlane(s);
        float rsv[2][4];
        if (s >= 0) { const PG8_LAS float* r = rs + s * 256 + wr * 64 + fr;
#pragma unroll
            for (int ai = 0; ai < 2; ++ai)
#pragma unroll
                for (int m = 0; m < 4; ++m) rsv[ai][m] = r[ai * HALF + m * 16]; }
        else { const float* rg = rsg + row0;
#pragma unroll
            for (int ai = 0; ai < 2; ++ai)
#pragma unroll
                for (int m = 0; m < 4; ++m) { rsv[ai][m] = rg[ai * HALF + m * 16]; asm volatile("" : "+v"(rsv[ai][m])); } }
        if (u.pn == kt0 || u.pn == kt0 + 1) {
            float cs[2][8];
#pragma unroll
            for (int bj = 0; bj < 2; ++bj)
#pragma unroll
                for (int i = 0; i < 8; ++i) cs[bj][i] = 0.f;
#pragma unroll
            for (int ai = 0; ai < 2; ++ai)
#pragma unroll
                for (int m = 0; m < 4; ++m) { bf16_t* rowp = O + (size_t)(row0 + ai * HALF + m * 16) * ldc + col0; const float rsc = rsv[ai][m];
#pragma unroll
                    for (int bj = 0; bj < 2; ++bj) { const f32x4 v0 = acc[ai][bj][m][0] * rsc, v1 = acc[ai][bj][m][1] * rsc;
                        u32x4 w; w.x = cvt_pk_bf16(v0[0], v0[1]); w.y = cvt_pk_bf16(v0[2], v0[3]); w.z = cvt_pk_bf16(v1[0], v1[1]); w.w = cvt_pk_bf16(v1[2], v1[3]);
                        cs[bj][0] += bflo(w.x); cs[bj][1] += bfhi(w.x); cs[bj][2] += bflo(w.y); cs[bj][3] += bfhi(w.y); cs[bj][4] += bflo(w.z); cs[bj][5] += bfhi(w.z); cs[bj][6] += bflo(w.w); cs[bj][7] += bfhi(w.w);
                        *(u32x4*)(rowp + bj * HALF) = w; } }
#pragma unroll
            for (int bj = 0; bj < 2; ++bj) { f32x4 a, b;
#pragma unroll
                for (int i = 0; i < 4; ++i) { a[i] = row_sum16(cs[bj][i]); b[i] = row_sum16(cs[bj][4 + i]); }
                if (fr == 0) { float* dp = kp + (size_t)wr * kpn + (size_t)((((u.pm >> 4) * 4 + (u.pn - kt0) * 2 + bj) * 16 + (u.pm & 15)) * 128 + wc * 32 + 8 * fq); *(f32x4*)dp = a; *(f32x4*)(dp + 4) = b; } }
            return;
        }
#pragma unroll
        for (int ai = 0; ai < 2; ++ai)
#pragma unroll
            for (int m = 0; m < 4; ++m) { bf16_t* rowp = O + (size_t)(row0 + ai * HALF + m * 16) * ldc + col0; const float rsc = rsv[ai][m];
#pragma unroll
                for (int bj = 0; bj < 2; ++bj) { const f32x4 v0 = acc[ai][bj][m][0] * rsc, v1 = acc[ai][bj][m][1] * rsc;
                    u32x4 w; w.x = cvt_pk_bf16(v0[0], v0[1]); w.y = cvt_pk_bf16(v0[2], v0[3]); w.z = cvt_pk_bf16(v1[0], v1[1]); w.w = cvt_pk_bf16(v1[2], v1[3]);
                    *(u32x4*)(rowp + bj * HALF) = w; } }
    }
};
struct GroupedOrder {
    static constexpr bool B_NT = false;
    const PG8_LAS unsigned char* tile_e; int nTiles, nN, G, c;
    const int* list; const PG8_LAS int* offs;
    __device__ __forceinline__ bool next(int i, Unit& u) const {
        const int x = c & 7, slot = c >> 3, per = G >> 3; int L = i * per + slot;
#pragma unroll
        for (int k = 0; k < 4; ++k) { const int e = x + 8 * k; const int t0 = offs[e] >> 8, t1 = (e == 31) ? nTiles : (offs[e + 1] >> 8); const int n = (t1 - t0) * nN;
            if (L < n) { u.pm = __builtin_amdgcn_readfirstlane(t0 + L / nN); u.pn = __builtin_amdgcn_readfirstlane(e * nN + L % nN); return true; }
            L -= n; }
        return false;
    }
    __device__ __forceinline__ void a_ready(const Unit&) const {}
    __device__ __forceinline__ void done(const Unit&) const {}
    static constexpr int LTAB_UNITS = 8;
    const PG8_LAS int* ltab;
    __device__ __forceinline__ int row_tok(const Unit& u, int r, int ord) const { if (ltab != nullptr && ord < LTAB_UNITS) return ltab[ord * 256 + r]; const int e = u.pn / nN; int v = list[e * 32768 + (u.pm * BM - offs[e]) + r];
        asm volatile("" : "+v"(v)); return v; }
};
template <class Epi, class Sched, bool ALIGN_EPI = false, bool SP2 = false, bool GATHER = false>
__device__ __forceinline__ void gemm_phase(PG8_LAS unsigned char* lds, const Gemm g, const Sched& S, const Epi& E, const int wave_idx) {
    int wid_o = wave_idx; asm volatile("" : "+s"(wid_o));
    const int tid = wid_o * 64 + mk_lane(), wid = wid_o    , lane = tid & 63, wr = wid >> 2, wc = wid & 3, fr = lane & 15, fq = lane >> 4;
    const int K = g.K, nt = K / BK;
    unsigned voffA[2], voffB[2];
#pragma unroll
    for (int i = 0; i < 2; ++i) { int R, C; stage_rc(tid * 16 + i * 8192, R, C); const int Rb = Epi::PERM ? ((R & ~31) + perm32(R & 31)) : R;
        voffA[i] = (unsigned)(R * K + C) * 2u; voffB[i] = (unsigned)(Rb * K + C) * 2u; }
    const size_t kstep = (size_t)(BK * 2);
    const size_t hstep = (size_t)HALF * K * 2;
    const size_t tstep = 2 * hstep;
    const unsigned ldsw = (unsigned)wid * 1024u;
    const int aoff = lds_byte(wr * 64 + fr, fq * 8), boff = lds_byte(wc * 32 + fr, fq * 8);
#define PG8_SA(b, h) (((b) * 2 + (h)) * HTB)
#define PG8_SB(b, h) ((4 + (b) * 2 + (h)) * HTB)
#define PG8_STAGE(bufoff, gbase, voff) do { _Pragma("unroll") for (int _i = 0; _i < 2; ++_i) \
        __builtin_amdgcn_global_load_lds((const unsigned*)((const char*)(gbase) + (voff)[_i]), (PG8_LAS unsigned*)(lds + (bufoff) + ldsw + _i * 8192), 16, 0, 0); } while (0)
#define PG8_STAGE_B(bufoff, gbase, voff) do { _Pragma("unroll") for (int _i = 0; _i < 2; ++_i) \
        __builtin_amdgcn_global_load_lds((const unsigned*)((const char*)(gbase) + (voff)[_i]), (PG8_LAS unsigned*)(lds + (bufoff) + ldsw + _i * 8192), 16, 0, Sched::B_NT ? 2 : 0); } while (0)
#define PG8_STAGE_A(bufoff, base, hh_, nx_) do { if constexpr (GATHER) { unsigned og_[2] = {(nx_) ? offN[hh_][0] : offA[hh_][0], (nx_) ? offN[hh_][1] : offA[hh_][1]}; asm volatile("" : "+v"(og_[0]), "+v"(og_[1]));   PG8_STAGE(bufoff, base, og_); } \
        else PG8_STAGE(bufoff, (base) + ((hh_) ? hstep : 0), voffA); } while (0)
#define PG8_ROWOFFS(dst, un, ord) do { _Pragma("unroll") for (int h_ = 0; h_ < 2; ++h_) _Pragma("unroll") for (int i_ = 0; i_ < 2; ++i_) { int R_, C_; stage_rc(tid * 16 + i_ * 8192, R_, C_); \
        dst[h_][i_] = ((unsigned)S.row_tok(un, h_ * HALF + R_, ord) & 0x7fffu) * (unsigned)(K * 2) + (unsigned)(C_ * 2); } } while (0)
#define PG8_LDA(dst, b, h) do { _Pragma("unroll") for (int m = 0; m < 4; ++m) _Pragma("unroll") for (int k = 0; k < 2; ++k) dst[m][k] = *(const PG8_LAS bf16x8*)(lds + PG8_SA(b, h) + aoff + m * 2048 + k * 1024); } while (0)
#define PG8_LDB(dst, b, h) do { _Pragma("unroll") for (int n = 0; n < 2; ++n) _Pragma("unroll") for (int k = 0; k < 2; ++k) dst[n][k] = *(const PG8_LAS bf16x8*)(lds + PG8_SB(b, h) + boff + n * 2048 + k * 1024); } while (0)
#define PG8_MMA(ai, bj, At, Bt) do { __builtin_amdgcn_s_setprio(1); _Pragma("unroll") for (int m = 0; m < 4; ++m) _Pragma("unroll") for (int n = 0; n < 2; ++n) _Pragma("unroll") for (int k = 0; k < 2; ++k) \
        acc[ai][bj][m][n] = __builtin_amdgcn_mfma_f32_16x16x32_bf16(Bt[n][k], At[m][k], acc[ai][bj][m][n], 0, 0, 0); __builtin_amdgcn_s_setprio(0); } while (0)
#define PG8_WAIT_V(n) asm volatile("s_waitcnt vmcnt(" #n ")" ::: "memory")
#define PG8_WAIT_L(n) asm volatile("s_waitcnt lgkmcnt(" #n ")" ::: "memory")
#define PG8_BAR __builtin_amdgcn_s_barrier()
#define PG8_SCHED __builtin_amdgcn_sched_barrier(0)
    Unit cur, nxt; int ui = 0;
    if (!S.next(0, cur)) return;
    f32x4 acc[2][2][4][2];
#pragma unroll
    for (int a = 0; a < 2; ++a)
#pragma unroll
        for (int b = 0; b < 2; ++b)
#pragma unroll
            for (int m = 0; m < 4; ++m)
#pragma unroll
                for (int n = 0; n < 2; ++n) acc[a][b][m][n] = (f32x4){0.f, 0.f, 0.f, 0.f};
    bf16x8 At[4][2], B0[2][2], B1[2][2];
    const char* cA = (const char*)g.A + (GATHER ? (size_t)0 : (size_t)cur.pm * tstep);
    unsigned offA[2][2] = {{0u, 0u}, {0u, 0u}}, offN[2][2] = {{0u, 0u}, {0u, 0u}};
    if constexpr (GATHER) PG8_ROWOFFS(offA, cur, 0); const char* cB = (const char*)g.Bt + (size_t)cur.pn * tstep;
    S.a_ready(cur);
    if constexpr (SP2) {
        PG8_STAGE_B(PG8_SB(0, 0), cB, voffB); PG8_STAGE_B(PG8_SB(0, 1), cB + hstep, voffB); PG8_STAGE_A(PG8_SA(0, 0), cA, 0, false); PG8_STAGE_A(PG8_SA(0, 1), cA, 1, false);
        if (wr == 1) PG8_BAR;
        PG8_WAIT_V(2); PG8_BAR;
        PG8_STAGE_B(PG8_SB(1, 0), cB + kstep, voffB); PG8_STAGE_A(PG8_SA(1, 0), cA + kstep, 0, false); PG8_STAGE_B(PG8_SB(1, 1), cB + hstep + kstep, voffB);
        PG8_WAIT_V(6); PG8_BAR;
    } else {
        PG8_STAGE_B(PG8_SB(0, 0), cB, voffB); PG8_STAGE_A(PG8_SA(0, 0), cA, 0, false); PG8_STAGE_B(PG8_SB(0, 1), cB + hstep, voffB); PG8_STAGE_A(PG8_SA(0, 1), cA, 1, false);
        if (wr == 1) PG8_BAR;
        PG8_WAIT_V(4); PG8_BAR;
        PG8_STAGE_B(PG8_SB(1, 0), cB + kstep, voffB); PG8_STAGE_A(PG8_SA(1, 0), cA + kstep, 0, false); PG8_STAGE_B(PG8_SB(1, 1), cB + hstep + kstep, voffB);
        PG8_WAIT_V(6); PG8_BAR;
    }
    for (;;) {
        const bool has_next = S.next(ui + 1, nxt);
        const char* nA = (has_next && !GATHER) ? (const char*)g.A + (size_t)nxt.pm * tstep : cA;
        if constexpr (GATHER) { if (has_next) PG8_ROWOFFS(offN, nxt, ui + 1); else { offN[0][0] = offA[0][0]; offN[0][1] = offA[0][1]; offN[1][0] = offA[1][0]; offN[1][1] = offA[1][1]; } } const char* nB = has_next ? (const char*)g.Bt + (size_t)nxt.pn * tstep : cB;
        for (int t = 0; t < nt; t += 2) {
            const bool last = (t == nt - 2);
            const char* a1 = cA + (size_t)(t + 1) * kstep;
            const char* a2 = last ? nA : cA + (size_t)(t + 2) * kstep; const char* b2 = last ? nB : cB + (size_t)(t + 2) * kstep;
            const char* a3 = a2 + kstep; const char* b3 = b2 + kstep;
            if (last && has_next) S.a_ready(nxt);
            if constexpr (SP2) {
            PG8_LDB(B0, 0, 0); PG8_LDB(B1, 0, 1); PG8_SCHED; PG8_LDA(At, 0, 0); PG8_STAGE_A(PG8_SA(1, 1), a1, 1, false);
            PG8_WAIT_V(8); PG8_WAIT_L(0); PG8_BAR; PG8_MMA(0, 0, At, B0); PG8_MMA(0, 1, At, B1); PG8_BAR; PG8_SCHED;
            PG8_LDA(At, 0, 1); PG8_STAGE_B(PG8_SB(0, 0), b2, voffB); PG8_STAGE_B(PG8_SB(0, 1), b2 + hstep, voffB); PG8_STAGE_A(PG8_SA(0, 0), a2, 0, last);
            PG8_WAIT_V(8); PG8_WAIT_L(0); PG8_BAR; PG8_MMA(1, 0, At, B0); PG8_MMA(1, 1, At, B1); PG8_BAR; PG8_SCHED;
            PG8_LDB(B0, 1, 0); PG8_LDB(B1, 1, 1); PG8_SCHED; PG8_LDA(At, 1, 0); PG8_STAGE_A(PG8_SA(0, 1), a2, 1, last);
            PG8_WAIT_V(8); PG8_WAIT_L(0); PG8_BAR; PG8_MMA(0, 0, At, B0); PG8_MMA(0, 1, At, B1); PG8_BAR; PG8_SCHED;
            PG8_LDA(At, 1, 1); PG8_STAGE_B(PG8_SB(1, 0), b3, voffB); PG8_STAGE_B(PG8_SB(1, 1), b3 + hstep, voffB); PG8_STAGE_A(PG8_SA(1, 0), a3, 0, last);
            PG8_WAIT_V(8); PG8_WAIT_L(0); PG8_BAR; PG8_MMA(1, 0, At, B0); PG8_MMA(1, 1, At, B1); PG8_BAR; PG8_SCHED;
            } else {
            PG8_LDB(B0, 0, 0); PG8_SCHED; PG8_LDA(At, 0, 0); PG8_STAGE_A(PG8_SA(1, 1), a1, 1, false);
            PG8_WAIT_L(8); PG8_BAR; PG8_WAIT_L(0); PG8_MMA(0, 0, At, B0); PG8_BAR; PG8_SCHED;
            PG8_LDB(B1, 0, 1); PG8_STAGE_B(PG8_SB(0, 0), b2, voffB);
            PG8_BAR; PG8_WAIT_L(0); PG8_MMA(0, 1, At, B1); PG8_BAR;
            PG8_LDA(At, 0, 1); PG8_STAGE_A(PG8_SA(0, 0), a2, 0, last);
            PG8_BAR; PG8_WAIT_L(0); PG8_MMA(1, 0, At, B0); PG8_BAR; PG8_SCHED;
            PG8_STAGE_B(PG8_SB(0, 1), b2 + hstep, voffB);
            PG8_WAIT_V(6); PG8_BAR; PG8_MMA(1, 1, At, B1); PG8_BAR;
            PG8_LDB(B0, 1, 0); PG8_SCHED; PG8_LDA(At, 1, 0); PG8_STAGE_A(PG8_SA(0, 1), a2, 1, last);
            PG8_WAIT_L(8); PG8_BAR; PG8_WAIT_L(0); PG8_MMA(0, 0, At, B0); PG8_BAR; PG8_SCHED;
            PG8_LDB(B1, 1, 1); PG8_STAGE_B(PG8_SB(1, 0), b3, voffB);
            PG8_BAR; PG8_WAIT_L(0); PG8_MMA(0, 1, At, B1); PG8_BAR;
            PG8_LDA(At, 1, 1); PG8_STAGE_A(PG8_SA(1, 0), a3, 0, last);
            PG8_BAR; PG8_WAIT_L(0); PG8_MMA(1, 0, At, B0); PG8_BAR; PG8_SCHED;
            PG8_STAGE_B(PG8_SB(1, 1), b3 + hstep, voffB);
            PG8_WAIT_V(6); PG8_BAR; PG8_MMA(1, 1, At, B1); PG8_BAR;
            }
        }
        if constexpr (ALIGN_EPI) { if (wr == 0) PG8_BAR; }
#ifdef PG8_EPI_PROBE
        if constexpr (!Epi::AFTER_DRAIN) { unsigned long long t0_ = 0ull; if constexpr (Epi::PROBE) t0_ = __builtin_amdgcn_s_memrealtime();
            E(acc, cur, wr, wc, fr, fq); S.done(cur);
            if constexpr (Epi::PROBE) { if (blockIdx.x == 0 && wid == 0 && mk_lane() == 0) *(PG8_LAS unsigned long long*)(lds + PG8_EPI_PROBE) += __builtin_amdgcn_s_memrealtime() - t0_; } }
#else
        if constexpr (!Epi::AFTER_DRAIN) { E(acc, cur, wr, wc, fr, fq); S.done(cur); }
#endif
        if (!has_next) break;
#pragma unroll
        for (int a = 0; a < 2; ++a)
#pragma unroll
            for (int b = 0; b < 2; ++b)
#pragma unroll
                for (int m = 0; m < 4; ++m)
#pragma unroll
                    for (int n = 0; n < 2; ++n) acc[a][b][m][n] = (f32x4){0.f, 0.f, 0.f, 0.f};
        cur = nxt; cA = nA; cB = nB; ++ui;
        if constexpr (GATHER) { offA[0][0] = offN[0][0]; offA[0][1] = offN[0][1]; offA[1][0] = offN[1][0]; offA[1][1] = offN[1][1]; }
        if constexpr (ALIGN_EPI) { if (wr == 1) PG8_BAR; }
    }
    PG8_WAIT_V(0);
    if constexpr (!ALIGN_EPI) { if (wr == 0) PG8_BAR; }
    PG8_BAR;
    if constexpr (Epi::AFTER_DRAIN) { E.fused(acc, cur, wr, wc, fr, fq, lds, wid, lane); S.done(cur); }
#undef PG8_SA
#undef PG8_SB
#undef PG8_STAGE
#undef PG8_STAGE_B
#undef PG8_STAGE_A
#undef PG8_ROWOFFS
#undef PG8_LDA
#undef PG8_LDB
#undef PG8_MMA
#undef PG8_WAIT_V
#undef PG8_WAIT_L
#undef PG8_BAR
#undef PG8_SCHED
}
}

#ifndef ATT_SDEPTH
#define ATT_SDEPTH 1
#endif
#ifndef ATT_PRIO
#define ATT_PRIO 1
#endif
#ifndef ATT_SWA_WAVE
#define ATT_SWA_WAVE 1
#endif
#ifndef ATT_DIFF_FUSED
#define ATT_DIFF_FUSED 1
#endif
#ifndef ATT_SDEPTH_DIFF
#define ATT_SDEPTH_DIFF 2
#endif
namespace att {
using bf16x8 = __attribute__((ext_vector_type(8))) short;
using s16x4  = __attribute__((ext_vector_type(4))) short;
using f32x16 = __attribute__((ext_vector_type(16))) float;
using f32x4  = __attribute__((ext_vector_type(4))) float;
using u32x4  = __attribute__((ext_vector_type(4))) unsigned;
constexpr int NW = 8, QBLK = 32, KVBLK = 64, LDP = 5120, LDY = 2048, SEQL = 4096;
constexpr int SHM_V = 16384, SHM_K = 16384;
constexpr int OFF_V = 0, OFF_K = 2 * SHM_V, OFF_WS = OFF_K + 2 * SHM_K, OFF_LUT = OFF_WS + NW * 64 * 4, OFF_MISC = OFF_LUT + 512, OFF_STG = 69632, STG_PITCH = 272, STG_WAVE = 32 * STG_PITCH;
constexpr int ATT_LDS = OFF_STG + NW * STG_WAVE;
constexpr int OFF_LUT4 = 147456, LUT4_N = 528, LUT4_COPIES = 5, OFF_LUTH = OFF_LUT4 + LUT4_COPIES * LUT4_N * 4, LUTH_BYTES = 6 * 128 * 4;
static_assert(OFF_MISC + 256 <= OFF_STG, "attention LDS map");
constexpr float LOG2E = 1.4426950408889634f, NEGB = -1e30f, THR2 = 11.5f;
#define SBAR() __builtin_amdgcn_sched_barrier(0)
__device__ __forceinline__ int crow(int r, int hi) { return (r & 3) + 8 * (r >> 2) + 4 * hi; }
__device__ __forceinline__ unsigned cvtpk(float lo, float hi) { unsigned r; asm volatile("v_cvt_pk_bf16_f32 %0, %1, %2" : "=v"(r) : "v"(lo), "v"(hi)); return r; }
__device__ __forceinline__ float bf2f(short x) { return __uint_as_float(((unsigned)(unsigned short)x) << 16); }
template <int DQK> __device__ __forceinline__ int kswz(int row, int colB) { return row * (2 * DQK) + (colB ^ ((((DQK == 128) ? row : (row >> 1)) & 7) << 4)); }

template <int MODE>
__device__ __forceinline__ void bias_mask(f32x16& p0, f32x16& p1, int kt, int qpos, int wave_qmin, int hi, float C, const float* lut4, float cfar, unsigned sel, int jblk) {
  bool lane_off = false;
  if (MODE == 1) { const int blk = kt >> 8; if (blk < jblk) lane_off = !((sel >> blk) & 1u); }
  const bool nearT = (kt + 63 + 128 > wave_qmin);
  if (!nearT) {
    if (MODE == 0) {
#pragma unroll
      for (int r = 0; r < 16; ++r) { p0[r] = NEGB; p1[r] = NEGB; }
    } else {
#pragma unroll
      for (int r = 0; r < 16; ++r) { p0[r] = lane_off ? NEGB : fmaf(p0[r], C, cfar); p1[r] = lane_off ? NEGB : fmaf(p1[r], C, cfar); }
    }
  } else {
    const int kb = kt + 4 * hi, D = qpos - kb, c4 = qpos & 3;
    const float* Lc = lut4 + ((MODE == 1 && lane_off) ? 4 * LUT4_N + (256 + c4 - D) : c4 * LUT4_N + (256 + c4 - D));
#pragma unroll
    for (int g = 0; g < 4; ++g) {
      const f32x4 b0 = *(const f32x4*)(Lc + 8 * g), b1 = *(const f32x4*)(Lc + 8 * g + 32);
#pragma unroll
      for (int i = 0; i < 4; ++i) { const int r = 4 * g + i; p0[r] = fmaf(p0[r], C, b0[i]); p1[r] = fmaf(p1[r], C, b1[i]); }
      if (g & 1) SBAR();
    }
  }
}
__device__ __forceinline__ void partialSM(f32x16& p0, f32x16& p1, float& m_reg, float& alpha) {
  float pmax = p0[0];
#pragma unroll
  for (int r = 1; r < 16; ++r) pmax = fmaxf(pmax, p0[r]);
#pragma unroll
  for (int r = 0; r < 16; ++r) pmax = fmaxf(pmax, p1[r]);
  { auto rr = __builtin_amdgcn_permlane32_swap(__float_as_uint(pmax), __float_as_uint(pmax), false, false);
    pmax = fmaxf(__uint_as_float(rr[0]), __uint_as_float(rr[1])); }
  float mn;
  if (__builtin_expect(__all(pmax - m_reg <= THR2), 1)) { mn = m_reg; alpha = 1.f; }
  else { mn = fmaxf(m_reg, pmax); alpha = __builtin_amdgcn_exp2f(m_reg - mn); m_reg = mn; }
#pragma unroll
  for (int r = 0; r < 16; ++r) { p0[r] = __builtin_amdgcn_exp2f(p0[r] - mn); p1[r] = p1[r] - mn; }
}
template <int MODE>
__device__ __forceinline__ void tile_sm(f32x16& p0, f32x16& p1, int kt, int qpos, int wave_qmin, int hi, float C, const float* lut, float cfar, unsigned sel, int jblk, float& m_reg, float& alpha) {
  const bool nearT = (kt + 63 + 128 > wave_qmin);
  if (nearT) { bias_mask<MODE>(p0, p1, kt, qpos, wave_qmin, hi, C, (const float*)((const char*)lut + (OFF_LUT4 - OFF_LUT)), cfar, sel, jblk); partialSM(p0, p1, m_reg, alpha); return; }
  if (MODE == 0) {
#pragma unroll
    for (int r = 0; r < 16; ++r) { p0[r] = 0.f; p1[r] = NEGB; }
    alpha = 1.f; return;
  }
  bool lane_off = false;
  if (MODE == 1) { const int blk = kt >> 8; if (blk < jblk) lane_off = !((sel >> blk) & 1u); }
  float pmax = p0[0];
#pragma unroll
  for (int r = 1; r < 16; ++r) pmax = fmaxf(pmax, p0[r]);
#pragma unroll
  for (int r = 0; r < 16; ++r) pmax = fmaxf(pmax, p1[r]);
  { auto rr = __builtin_amdgcn_permlane32_swap(__float_as_uint(pmax), __float_as_uint(pmax), false, false);
    pmax = fmaxf(__uint_as_float(rr[0]), __uint_as_float(rr[1])); }
  const float tmax = lane_off ? NEGB : fmaf(pmax, C, cfar);
  float mn;
  if (__builtin_expect(__all(tmax - m_reg <= THR2), 1)) { mn = m_reg; alpha = 1.f; }
  else { mn = fmaxf(m_reg, tmax); alpha = __builtin_amdgcn_exp2f(m_reg - mn); m_reg = mn; }
  const float off = lane_off ? NEGB : cfar - mn;
#pragma unroll
  for (int r = 0; r < 16; ++r) { p0[r] = __builtin_amdgcn_exp2f(fmaf(p0[r], C, off)); p1[r] = fmaf(p1[r], C, off); }
}
__device__ __forceinline__ void finishSM(f32x16& p0, f32x16& p1, float alpha, float& l_reg, bf16x8& pa0, bf16x8& pa1, bf16x8& pa2, bf16x8& pa3) {
#pragma unroll
  for (int r = 0; r < 16; ++r) p1[r] = __builtin_amdgcn_exp2f(p1[r]);
  float ps = 0;
#pragma unroll
  for (int r = 0; r < 16; ++r) ps += p0[r];
#pragma unroll
  for (int r = 0; r < 16; ++r) ps += p1[r];
  { auto rr = __builtin_amdgcn_permlane32_swap(__float_as_uint(ps), __float_as_uint(ps), false, false);
    ps = __uint_as_float(rr[0]) + __uint_as_float(rr[1]); }
  l_reg = l_reg * alpha + ps;
#define PK4(P, BASE, OUT) do { unsigned a0 = cvtpk(P[BASE + 0], P[BASE + 1]), a1 = cvtpk(P[BASE + 2], P[BASE + 3]);   \
    unsigned b0 = cvtpk(P[BASE + 4], P[BASE + 5]), b1 = cvtpk(P[BASE + 6], P[BASE + 7]);                              \
    auto r0 = __builtin_amdgcn_permlane32_swap(a0, b0, false, false); auto r1 = __builtin_amdgcn_permlane32_swap(a1, b1, false, false); \
    u32x4 w = {r0[0], r1[0], r0[1], r1[1]}; OUT = *reinterpret_cast<bf16x8*>(&w); } while (0)
  PK4(p0, 0, pa0); PK4(p0, 8, pa1); PK4(p1, 0, pa2); PK4(p1, 8, pa3);
#undef PK4
}
template <int DQK>
__device__ __forceinline__ void qkt(f32x16& p0, f32x16& p1, const char* Ks, const bf16x8* qr, int r32, int hi) {
  p0 = f32x16{}; p1 = f32x16{};
#pragma unroll
  for (int d0 = 0; d0 < DQK / 16; ++d0) { const int cb = (d0 * 16 + hi * 8) * 2;
    const bf16x8 b0 = *reinterpret_cast<const bf16x8*>(Ks + kswz<DQK>(r32, cb));
    const bf16x8 b1 = *reinterpret_cast<const bf16x8*>(Ks + kswz<DQK>(32 + r32, cb));
    p0 = __builtin_amdgcn_mfma_f32_32x32x16_bf16(b0, qr[d0], p0, 0, 0, 0);
    p1 = __builtin_amdgcn_mfma_f32_32x32x16_bf16(b1, qr[d0], p1, 0, 0, 0); }
}
__device__ __forceinline__ int v_st(int k, int c) { const int kk = (k & ~0xC) | ((k & 4) << 1) | ((k & 8) >> 1); return ((kk >> 3) * 4 + (c >> 5)) * 512 + ((kk & 7) * 32 + (c & 31)) * 2; }
__device__ __forceinline__ int v_rd_base(int lane) { return ((lane & 3) << 3) | (((lane >> 2) & 3) << 6) | (((lane >> 4) & 1) << 5) | (((lane >> 5) & 1) << 8); }
constexpr int v_rd_off(int d0, int ks, int half) { return d0 * 512 + ks * 4096 + half * 2048; }
template <int OFF> __device__ __forceinline__ s16x4 tr_read(int vb) {
  s16x4 r; asm volatile("ds_read_b64_tr_b16 %0, %1 offset:%2" : "=&v"(r) : "v"(vb), "i"(OFF) : "memory"); return r;
}
template <int D0> __device__ __forceinline__ void pv_one(f32x16& od, int vb, bf16x8 pa0, bf16x8 pa1, bf16x8 pa2, bf16x8 pa3) {
  const s16x4 l0 = tr_read<v_rd_off(D0, 0, 0)>(vb), h0 = tr_read<v_rd_off(D0, 0, 1)>(vb), l1 = tr_read<v_rd_off(D0, 1, 0)>(vb), h1 = tr_read<v_rd_off(D0, 1, 1)>(vb);
  const s16x4 l2 = tr_read<v_rd_off(D0, 2, 0)>(vb), h2 = tr_read<v_rd_off(D0, 2, 1)>(vb), l3 = tr_read<v_rd_off(D0, 3, 0)>(vb), h3 = tr_read<v_rd_off(D0, 3, 1)>(vb);
  asm volatile("s_waitcnt lgkmcnt(0)" ::: "memory"); SBAR();
#if ATT_PRIO
  __builtin_amdgcn_s_setprio(ATT_PRIO);
#endif
#define PK(L, H) (bf16x8){L[0], L[1], L[2], L[3], H[0], H[1], H[2], H[3]}
  od = __builtin_amdgcn_mfma_f32_32x32x16_bf16(pa0, PK(l0, h0), od, 0, 0, 0);
  od = __builtin_amdgcn_mfma_f32_32x32x16_bf16(pa1, PK(l1, h1), od, 0, 0, 0);
  od = __builtin_amdgcn_mfma_f32_32x32x16_bf16(pa2, PK(l2, h2), od, 0, 0, 0);
  od = __builtin_amdgcn_mfma_f32_32x32x16_bf16(pa3, PK(l3, h3), od, 0, 0, 0);
#if ATT_PRIO
  __builtin_amdgcn_s_setprio(0);
#endif
#undef PK
}
__device__ __forceinline__ void pv_d0(f32x16* o, int vb, bf16x8 pa0, bf16x8 pa1, bf16x8 pa2, bf16x8 pa3) {
  pv_one<0>(o[0], vb, pa0, pa1, pa2, pa3); pv_one<1>(o[1], vb, pa0, pa1, pa2, pa3); pv_one<2>(o[2], vb, pa0, pa1, pa2, pa3); pv_one<3>(o[3], vb, pa0, pa1, pa2, pa3);
}

__device__ __forceinline__ void pv_all1(f32x16* o, int vb, bf16x8 pa0, bf16x8 pa1, bf16x8 pa2, bf16x8 pa3) {
  s16x4 va[8], vc[8];
#define TR8(D0, L) do { L[0] = tr_read<v_rd_off(D0, 0, 0)>(vb); L[1] = tr_read<v_rd_off(D0, 0, 1)>(vb); L[2] = tr_read<v_rd_off(D0, 1, 0)>(vb); L[3] = tr_read<v_rd_off(D0, 1, 1)>(vb); \
    L[4] = tr_read<v_rd_off(D0, 2, 0)>(vb); L[5] = tr_read<v_rd_off(D0, 2, 1)>(vb); L[6] = tr_read<v_rd_off(D0, 3, 0)>(vb); L[7] = tr_read<v_rd_off(D0, 3, 1)>(vb); } while (0)
#define PK(L, H) (bf16x8){L[0], L[1], L[2], L[3], H[0], H[1], H[2], H[3]}
#define MM4(OA, L) do { OA = __builtin_amdgcn_mfma_f32_32x32x16_bf16(pa0, PK(L[0], L[1]), OA, 0, 0, 0); OA = __builtin_amdgcn_mfma_f32_32x32x16_bf16(pa1, PK(L[2], L[3]), OA, 0, 0, 0); \
    OA = __builtin_amdgcn_mfma_f32_32x32x16_bf16(pa2, PK(L[4], L[5]), OA, 0, 0, 0); OA = __builtin_amdgcn_mfma_f32_32x32x16_bf16(pa3, PK(L[6], L[7]), OA, 0, 0, 0); } while (0)
  TR8(0, va); TR8(1, vc); asm volatile("s_waitcnt lgkmcnt(8)" ::: "memory"); SBAR(); MM4(o[0], va); SBAR();
  TR8(2, va); asm volatile("s_waitcnt lgkmcnt(8)" ::: "memory"); SBAR(); MM4(o[1], vc); SBAR();
  TR8(3, vc); asm volatile("s_waitcnt lgkmcnt(8)" ::: "memory"); SBAR(); MM4(o[2], va); SBAR();
  asm volatile("s_waitcnt lgkmcnt(0)" ::: "memory"); SBAR(); MM4(o[3], vc);
#undef MM4
#undef PK
#undef TR8
}

struct AttnArgs { int layer; float lambda_init; };
constexpr size_t ATT_WS_PROJ = (size_t)434 << 20, ATT_WS_YCAT = (size_t)754 << 20, ATT_WS_KMEAN = (size_t)1 << 20;
#define A_proj ((const unsigned short*)(wsptr() + ATT_WS_PROJ))
#define A_ycat ((unsigned short*)(wsptr() + ATT_WS_YCAT))
#define A_kmean ((const float*)(wsptr() + ATT_WS_KMEAN))
#define A_kpart ((const float*)(wsptr() + ATT_WS_KP))
constexpr size_t ATT_WS_KP = (size_t)882 << 20; constexpr int ATT_KP_N = 8 * 4 * 16 * 128;
#define A_rel_bias (inptr(2))
#define A_sinks (inptr(6) + A.layer * 6)
#define A_lq1 (inptr(7) + A.layer * 64)
#define A_lk1 (inptr(8) + A.layer * 64)
#define A_lq2 (inptr(9) + A.layer * 64)
#define A_lk2 (inptr(10) + A.layer * 64)
#define A_subln (inptr(11) + A.layer * 128)
__device__ const unsigned char REL_BUCKET_TAB[128] = {
  0, 1, 2, 3, 4, 5, 6, 7, 8, 9, 10, 11, 12, 13, 14, 15, 16, 16, 16, 17, 17, 18, 18, 18, 19, 19, 19, 20, 20, 20, 20, 21, 21, 21, 21, 22, 22, 22, 22, 22, 23, 23, 23, 23, 23, 23, 24, 24, 24, 24, 24, 24,
  25, 25, 25, 25, 25, 25, 25, 26, 26, 26, 26, 26, 26, 26, 26, 27, 27, 27, 27, 27, 27, 27, 27, 27, 27, 28, 28, 28, 28, 28, 28, 28, 28, 28, 28, 29, 29, 29, 29, 29, 29, 29, 29, 29, 29, 29, 29,
  30, 30, 30, 30, 30, 30, 30, 30, 30, 30, 30, 30, 30, 30, 31, 31, 31, 31, 31, 31, 31, 31, 31, 31, 31, 31, 31, 31, 31};

template <int MODE>
__device__ __forceinline__ void attn_pass(const AttnArgs& A, int b, int hh, int qb, int pass, float lam, char* lds, int tid) {
  constexpr int DQK = (MODE == 2) ? 64 : 128;
  constexpr int NPASS = (MODE == 2) ? 2 : 1;
  constexpr int SDEPTH = (MODE == 2) ? ATT_SDEPTH_DIFF : ATT_SDEPTH;
  constexpr int QCOL = (MODE == 0) ? 0 : (MODE == 1) ? 1280 : 2816;
  constexpr int KCOL = (MODE == 0) ? 768 : (MODE == 1) ? 1792 : 3584;
  constexpr int VCOL = (MODE == 0) ? 1024 : (MODE == 1) ? 2304 : 4352;
  constexpr int OCOL = (MODE == 0) ? 0 : (MODE == 1) ? 768 : 1280;
  const float C = ((MODE == 2) ? 0.125f : 0.088388347648318440f) * LOG2E;
  const int lane = tid & 63, r32 = lane & 31, hi = lane >> 5; const int wid = __builtin_amdgcn_readfirstlane(tid >> 6);
  const int kvh = (MODE == 0) ? hh / 3 : hh;
  char* V_lds = lds + OFF_V; char* K_lds = lds + OFF_K;
  float* wsl = (float*)(lds + OFF_WS) + wid * 64; float* li_l = wsl; float* al_l = wsl + 32;
  const float* lut = (const float*)(lds + OFF_LUT);
  char* stg = lds + OFF_STG + wid * STG_WAVE;
  const int q0 = qb * 256;
  const int qpos = q0 + wid * QBLK + r32, wave_qmin = q0 + wid * QBLK;
  const long rowb = (long)b * SEQL;
  const float cfar = lut[127];
  const int t0 = (MODE == 0) ? (qb == 0 ? 0 : 4 * qb - 2) : 0;
  const int NT = 4 * qb + 4 - t0;
  const int sr = tid >> 4, sc = (tid & 15) * 8, vst0 = v_st(sr, sc), vst1 = v_st(32 + sr, sc);
  const int vb0 = (int)(uintptr_t)V_lds + v_rd_base(lane);
  const unsigned short* Vh = A_proj + rowb * LDP + VCOL + kvh * 128;
  {

    const unsigned short* Qw = A_proj + (rowb + q0 + wid * QBLK + r32) * LDP + QCOL + hh * 128 + pass * 64 + hi * 8;
    const unsigned short* Kh = A_proj + rowb * LDP + KCOL + kvh * 128 + pass * 64;
    bf16x8 qr[DQK / 16];
#pragma unroll
    for (int d0 = 0; d0 < DQK / 16; ++d0) qr[d0] = *reinterpret_cast<const bf16x8*>(Qw + d0 * 16);
    unsigned sel = 0u;
    if (MODE == 1) {
      const int jb = qb;
      if (jb <= 3) sel = (1u << jb) - 1u;
      else {
        float g[15];
#pragma unroll
        for (int n = 0; n < 15; ++n) { g[n] = -INFINITY;
          if (n < jb) { const float* km = (const float*)(lds + OFF_STG) + n * 128 + hi * 8; float s = 0.f;
#pragma unroll
            for (int d0 = 0; d0 < 8; ++d0) { const f32x4 k0 = *(const f32x4*)(km + d0 * 16), k1 = *(const f32x4*)(km + d0 * 16 + 4);
              s += bf2f(qr[d0 % (DQK / 16)][0]) * k0[0] + bf2f(qr[d0 % (DQK / 16)][1]) * k0[1] + bf2f(qr[d0 % (DQK / 16)][2]) * k0[2] + bf2f(qr[d0 % (DQK / 16)][3]) * k0[3]
                 + bf2f(qr[d0 % (DQK / 16)][4]) * k1[0] + bf2f(qr[d0 % (DQK / 16)][5]) * k1[1] + bf2f(qr[d0 % (DQK / 16)][6]) * k1[2] + bf2f(qr[d0 % (DQK / 16)][7]) * k1[3]; }
            auto rr = __builtin_amdgcn_permlane32_swap(__float_as_uint(s), __float_as_uint(s), false, false);
            g[n] = __uint_as_float(rr[0]) + __uint_as_float(rr[1]); } }
#pragma unroll
        for (int pick = 0; pick < 3; ++pick) { float best = -INFINITY; int bi = 0;
#pragma unroll
          for (int n = 0; n < 15; ++n) { const bool take = (n < jb) && !((sel >> n) & 1u) && (g[n] > best); best = take ? g[n] : best; bi = take ? n : bi; }
          sel |= 1u << bi; }
      }
    }
    int NTm = NT;
    if (MODE == 1) {
      unsigned* mw = (unsigned*)(lds + OFF_MISC);
      if (qb > 3) { unsigned um = 0u;
#pragma unroll
        for (int n = 0; n < 15; ++n) if (__any((int)((sel >> n) & 1u))) um |= 1u << n;
        if (lane == 0) atomicOr(&mw[4], um); }
      __syncthreads();
      unsigned U = (qb <= 3) ? ((1u << qb) - 1u) : mw[4]; U |= 1u << qb;
      if (tid < 17) { unsigned rem = U; int bit = 0;
        for (int k = 0; k < tid; ++k) rem &= rem - 1u;
        bit = rem ? __builtin_ctz(rem) : 0; mw[8 + tid] = (unsigned)bit; }
      __syncthreads();
      NTm = 4 * __builtin_popcount(U);
    }
    const int NTT = __builtin_amdgcn_readfirstlane(NTm);
    float m_reg = NEGB, l_reg = 0.f;
    if (MODE == 0) { m_reg = A_sinks[hh] * LOG2E; l_reg = 1.f; }
    f32x16 o[4] = {};
#define KT(i) ((MODE == 1) ? (int)(__builtin_amdgcn_readfirstlane(((const unsigned*)(lds + OFF_MISC))[8 + ((i) >> 2)]) * 256u) + ((i) & 3) * KVBLK : (t0 + (i)) * KVBLK)
#define SLOAD(i, k0) do { sr_[i].vs0 = *reinterpret_cast<const bf16x8*>(&Vh[(long)((k0) + sr) * LDP + sc]); sr_[i].vs1 = *reinterpret_cast<const bf16x8*>(&Vh[(long)((k0) + 32 + sr) * LDP + sc]); \
    if (DQK == 128) { sr_[i].ks0 = *reinterpret_cast<const bf16x8*>(&Kh[(long)((k0) + sr) * LDP + sc]); sr_[i].ks1 = *reinterpret_cast<const bf16x8*>(&Kh[(long)((k0) + 32 + sr) * LDP + sc]); } \
    else { sr_[i].ks0 = *reinterpret_cast<const bf16x8*>(&Kh[(long)((k0) + (tid >> 3)) * LDP + (tid & 7) * 8]); } } while (0)
#define SWRITE(bb, i) do { *(bf16x8*)(V_lds + (bb) * SHM_V + vst0) = sr_[i].vs0; *(bf16x8*)(V_lds + (bb) * SHM_V + vst1) = sr_[i].vs1; \
    if (DQK == 128) { *(bf16x8*)(K_lds + (bb) * SHM_K + kswz<DQK>(sr, sc * 2)) = sr_[i].ks0; *(bf16x8*)(K_lds + (bb) * SHM_K + kswz<DQK>(32 + sr, sc * 2)) = sr_[i].ks1; } \
    else { *(bf16x8*)(K_lds + (bb) * SHM_K + kswz<DQK>(tid >> 3, (tid & 7) * 16)) = sr_[i].ks0; } } while (0)
#define SWAIT() do { if (SDEPTH == 1) asm volatile("s_waitcnt vmcnt(0)" ::: "memory"); else if (DQK == 128) asm volatile("s_waitcnt vmcnt(4)" ::: "memory"); else asm volatile("s_waitcnt vmcnt(3)" ::: "memory"); } while (0)
#define RESC(a) do { if (__any((a) < 1.f)) { if (hi == 0) al_l[r32] = (a); asm volatile("s_waitcnt lgkmcnt(0)" ::: "memory"); \
    _Pragma("unroll") for (int d = 0; d < 4; ++d) _Pragma("unroll") for (int r = 0; r < 16; ++r) o[d][r] *= al_l[crow(r, hi)]; } } while (0)
#define TSM(P0, P1, ti, AL) tile_sm<MODE>(P0, P1, KT(ti), qpos, wave_qmin, hi, C, lut, cfar, sel, qb, m_reg, AL)
    typedef __attribute__((address_space(3))) unsigned las_u32;
#define MLOAD2(k0, bb) do { const char* kg_ = (const char*)(Kh + (long)(k0) * LDP); const char* vg_ = (const char*)(Vh + (long)(k0) * LDP); \
    int ll_ = lane; asm volatile("" : "+v"(ll_));                 \
    _Pragma("unroll") for (int i_ = 0; i_ < 2; ++i_) { const int q_ = (i_ * 8 + wid) * 64 + ll_; \
      const int row_ = q_ >> 4, pos_ = q_ & 15; const unsigned koff_ = (unsigned)((row_ * LDP + ((pos_ ^ (row_ & 7)) << 3)) * 2); \
      const int st_ = q_ >> 5, kk_ = ((st_ >> 2) << 3) | ((q_ >> 2) & 7), c_ = ((st_ & 3) << 5) | ((q_ & 3) << 3), k_ = (kk_ & ~0xC) | ((kk_ & 4) << 1) | ((kk_ & 8) >> 1); const unsigned voff_ = (unsigned)((k_ * LDP + c_) * 2); \
      __builtin_amdgcn_global_load_lds((const unsigned*)(kg_ + koff_), (las_u32*)(K_lds + (bb) * SHM_K + (i_ * 8 + wid) * 1024), 16, 0, 0); \
      __builtin_amdgcn_global_load_lds((const unsigned*)(vg_ + voff_), (las_u32*)(V_lds + (bb) * SHM_V + (i_ * 8 + wid) * 1024), 16, 0, 0); } } while (0)
    __syncthreads();
    MLOAD2(KT(0), 0); asm volatile("s_waitcnt vmcnt(0)" ::: "memory"); __syncthreads();
#pragma unroll 1
    for (int j = 0; j < NTT; ++j) {
      const int bb = j & 1; const int kt = KT(j);
      if (j + 1 < NTT) MLOAD2(KT(j + 1), bb ^ 1);
      if (kt <= wave_qmin + QBLK - 1) {
        f32x16 p0, p1; float al; bf16x8 pa0, pa1, pa2, pa3;
        qkt<DQK>(p0, p1, K_lds + bb * SHM_K, qr, r32, hi);
        tile_sm<MODE>(p0, p1, kt, qpos, wave_qmin, hi, C, lut, cfar, sel, qb, m_reg, al);
        finishSM(p0, p1, al, l_reg, pa0, pa1, pa2, pa3); RESC(al);
        SBAR();
        pv_all1(o, vb0 + bb * SHM_V, pa0, pa1, pa2, pa3);
      }
      asm volatile("s_waitcnt vmcnt(0)" ::: "memory");
      __syncthreads();
    }
#undef MLOAD2
#undef KT
#undef SLOAD
#undef SWRITE
#undef SWAIT
#undef RESC
#undef TSM
    int r32e = r32, hie = hi; asm volatile("" : "+v"(r32e), "+v"(hie));
    if (hi == 0) li_l[r32] = l_reg; asm volatile("s_waitcnt lgkmcnt(0)" ::: "memory");
#pragma unroll
    for (int r = 0; r < 16; ++r) { const int orow = crow(r, hie); const float rli = __builtin_amdgcn_rcpf(li_l[orow]);
#pragma unroll
      for (int d0 = 0; d0 < 4; ++d0) { unsigned short* sp = (unsigned short*)(stg + orow * STG_PITCH) + d0 * 32 + r32e; float v = o[d0][r] * rli;
        if (MODE == 2 && pass == 1) v = __uint_as_float(((unsigned)*sp) << 16) - lam * v;
        *sp = (unsigned short)(cvtpk(v, v) & 0xffffu); } }
    asm volatile("s_waitcnt lgkmcnt(0)" ::: "memory");
    if (pass == NPASS - 1) {
      const char* rp = stg + r32e * STG_PITCH + hie * 128;
      u32x4 w[8];
#pragma unroll
      for (int i = 0; i < 8; ++i) w[i] = *(const u32x4*)(rp + i * 16);
      if (MODE == 2) {
        float ss = 0.f;
#pragma unroll
        for (int i = 0; i < 8; ++i)
#pragma unroll
          for (int k = 0; k < 4; ++k) { const float lo = __uint_as_float(w[i][k] << 16), hi_ = __uint_as_float(w[i][k] & 0xffff0000u); ss += lo * lo + hi_ * hi_; }
        { auto rr = __builtin_amdgcn_permlane32_swap(__float_as_uint(ss), __float_as_uint(ss), false, false); ss = __uint_as_float(rr[0]) + __uint_as_float(rr[1]); }
        const float sc2 = rsqrtf(ss * (1.0f / 128.0f) + 1e-6f) * (1.0f - A.lambda_init);
        const float* gp = A_subln + hie * 64;
#pragma unroll
        for (int i = 0; i < 8; ++i)
#pragma unroll
          for (int k = 0; k < 4; ++k) { const float lo = __uint_as_float(w[i][k] << 16) * sc2 * gp[i * 8 + 2 * k], hi_ = __uint_as_float(w[i][k] & 0xffff0000u) * sc2 * gp[i * 8 + 2 * k + 1]; w[i][k] = cvtpk(lo, hi_); }
      }
      unsigned short* op = A_ycat + (rowb + q0 + wid * QBLK + r32e) * LDY + OCOL + hh * 128 + hie * 64;
#pragma unroll
      for (int i = 0; i < 8; ++i) *(u32x4*)(op + i * 8) = w[i];
    }
  }
}
template <int MODE> __device__ __forceinline__ void unit_luts(char* lds, int hh, int tid) {
  float* lut = (float*)(lds + OFF_LUT); const float* lh = (const float*)(lds + OFF_LUTH) + hh * 128;
  if (tid < 128) lut[tid] = lh[tid];
  float* l4 = (float*)(lds + OFF_LUT4);
#pragma unroll 1
  for (int i = tid; i < LUT4_COPIES * LUT4_N; i += 512) { const int c = i / LUT4_N, j = i % LUT4_N, d = 256 + c - j;
    l4[i] = (c == 4 || d < 0 || (MODE == 0 && d >= 128)) ? NEGB : lh[d < 127 ? d : 127]; }
}
__device__ __forceinline__ void pv_sm_split(f32x16* o, int vb, bf16x8 pa0, bf16x8 pa1, bf16x8 pa2, bf16x8 pa3,
                                            f32x16& p0, f32x16& p1, float alpha, float& l_reg, bf16x8& pb0, bf16x8& pb1, bf16x8& pb2, bf16x8& pb3) {
  s16x4 va[8], vc[8]; float ps = 0.f;
#define TR8(D0, L) do { L[0] = tr_read<v_rd_off(D0, 0, 0)>(vb); L[1] = tr_read<v_rd_off(D0, 0, 1)>(vb); L[2] = tr_read<v_rd_off(D0, 1, 0)>(vb); L[3] = tr_read<v_rd_off(D0, 1, 1)>(vb); \
    L[4] = tr_read<v_rd_off(D0, 2, 0)>(vb); L[5] = tr_read<v_rd_off(D0, 2, 1)>(vb); L[6] = tr_read<v_rd_off(D0, 3, 0)>(vb); L[7] = tr_read<v_rd_off(D0, 3, 1)>(vb); } while (0)
#define PK(L, H) (bf16x8){L[0], L[1], L[2], L[3], H[0], H[1], H[2], H[3]}
#define MF(OA, PA, L, K) do { OA = __builtin_amdgcn_mfma_f32_32x32x16_bf16(PA, PK(L[2 * (K)], L[2 * (K) + 1]), OA, 0, 0, 0); SBAR(); } while (0)
#define FE(K) do { p1[2 * (K)] = __builtin_amdgcn_exp2f(p1[2 * (K)]); p1[2 * (K) + 1] = __builtin_amdgcn_exp2f(p1[2 * (K) + 1]); ps += p0[2 * (K)]; ps += p0[2 * (K) + 1]; SBAR(); } while (0)
#define FS(K) do { ps += p1[4 * (K)]; ps += p1[4 * (K) + 1]; ps += p1[4 * (K) + 2]; ps += p1[4 * (K) + 3]; SBAR(); } while (0)
#define PK4(P, BASE, OUT) do { unsigned a0 = cvtpk(P[BASE + 0], P[BASE + 1]), a1 = cvtpk(P[BASE + 2], P[BASE + 3]);   \
    unsigned b0 = cvtpk(P[BASE + 4], P[BASE + 5]), b1 = cvtpk(P[BASE + 6], P[BASE + 7]);                              \
    auto r0 = __builtin_amdgcn_permlane32_swap(a0, b0, false, false); auto r1 = __builtin_amdgcn_permlane32_swap(a1, b1, false, false); \
    u32x4 w = {r0[0], r1[0], r0[1], r1[1]}; OUT = *reinterpret_cast<bf16x8*>(&w); SBAR(); } while (0)
  TR8(0, va); TR8(1, vc); asm volatile("s_waitcnt lgkmcnt(8)" ::: "memory"); SBAR();
  MF(o[0], pa0, va, 0); FE(0); MF(o[0], pa1, va, 1); FE(1); MF(o[0], pa2, va, 2); FE(2); MF(o[0], pa3, va, 3); FE(3);
  TR8(2, va); asm volatile("s_waitcnt lgkmcnt(8)" ::: "memory"); SBAR();
  MF(o[1], pa0, vc, 0); FE(4); MF(o[1], pa1, vc, 1); FE(5); MF(o[1], pa2, vc, 2); FE(6); MF(o[1], pa3, vc, 3); FE(7);
  TR8(3, vc); asm volatile("s_waitcnt lgkmcnt(8)" ::: "memory"); SBAR();
  MF(o[2], pa0, va, 0); FS(0); MF(o[2], pa1, va, 1); FS(1); MF(o[2], pa2, va, 2); FS(2); MF(o[2], pa3, va, 3); FS(3);
  { auto rr = __builtin_amdgcn_permlane32_swap(__float_as_uint(ps), __float_as_uint(ps), false, false); ps = __uint_as_float(rr[0]) + __uint_as_float(rr[1]); }
  l_reg = l_reg * alpha + ps;
  asm volatile("s_waitcnt lgkmcnt(0)" ::: "memory"); SBAR();
  MF(o[3], pa0, vc, 0); PK4(p0, 0, pb0); MF(o[3], pa1, vc, 1); PK4(p0, 8, pb1); MF(o[3], pa2, vc, 2); PK4(p1, 0, pb2); MF(o[3], pa3, vc, 3); PK4(p1, 8, pb3);
#undef PK4
#undef FS
#undef FE
#undef MF
#undef PK
#undef TR8
}
__device__ __forceinline__ void qkt_half_sm_split(f32x16& q0, f32x16& q1, const char* Ks, const char* Qs, int r32, int hi,
                                                  f32x16& p0, f32x16& p1, float alpha, float& l_reg, bf16x8& pa0, bf16x8& pa1, bf16x8& pa2, bf16x8& pa3) {
  asm volatile("" : "+v"(r32));
  q0 = f32x16{}; q1 = f32x16{};
  float ps = 0.f;
  bf16x8 qfA, b0A, b1A, qfB, b0B, b1B;
#define LDF(D0, QF, B0, B1) do { const int cb_ = (64 + (D0) * 16 + hi * 8) * 2; QF = *reinterpret_cast<const bf16x8*>(Qs + kswz<128>(r32, cb_)); \
    B0 = *reinterpret_cast<const bf16x8*>(Ks + kswz<128>(r32, cb_)); B1 = *reinterpret_cast<const bf16x8*>(Ks + kswz<128>(32 + r32, cb_)); } while (0)
  LDF(0, qfA, b0A, b1A); LDF(1, qfB, b0B, b1B);
  SBAR();
#define FE4(K) do { p1[4 * (K)] = __builtin_amdgcn_exp2f(p1[4 * (K)]); p1[4 * (K) + 1] = __builtin_amdgcn_exp2f(p1[4 * (K) + 1]); p1[4 * (K) + 2] = __builtin_amdgcn_exp2f(p1[4 * (K) + 2]); p1[4 * (K) + 3] = __builtin_amdgcn_exp2f(p1[4 * (K) + 3]); \
    ps += p0[4 * (K)]; ps += p0[4 * (K) + 1]; ps += p0[4 * (K) + 2]; ps += p0[4 * (K) + 3]; SBAR(); } while (0)
#define FS8(K) do { ps += p1[8 * (K)]; ps += p1[8 * (K) + 1]; ps += p1[8 * (K) + 2]; ps += p1[8 * (K) + 3]; ps += p1[8 * (K) + 4]; ps += p1[8 * (K) + 5]; ps += p1[8 * (K) + 6]; ps += p1[8 * (K) + 7]; SBAR(); } while (0)
#define PK4(P, BASE, OUT) do { unsigned a0 = cvtpk(P[BASE + 0], P[BASE + 1]), a1 = cvtpk(P[BASE + 2], P[BASE + 3]);   \
    unsigned c0 = cvtpk(P[BASE + 4], P[BASE + 5]), c1 = cvtpk(P[BASE + 6], P[BASE + 7]);                              \
    auto r0 = __builtin_amdgcn_permlane32_swap(a0, c0, false, false); auto r1 = __builtin_amdgcn_permlane32_swap(a1, c1, false, false); \
    u32x4 w = {r0[0], r1[0], r0[1], r1[1]}; OUT = *reinterpret_cast<bf16x8*>(&w); SBAR(); } while (0)
  q0 = __builtin_amdgcn_mfma_f32_32x32x16_bf16(b0A, qfA, q0, 0, 0, 0); SBAR(); FE4(0);
  q1 = __builtin_amdgcn_mfma_f32_32x32x16_bf16(b1A, qfA, q1, 0, 0, 0); SBAR(); LDF(2, qfA, b0A, b1A); SBAR(); FE4(1);
  q0 = __builtin_amdgcn_mfma_f32_32x32x16_bf16(b0B, qfB, q0, 0, 0, 0); SBAR(); FE4(2);
  q1 = __builtin_amdgcn_mfma_f32_32x32x16_bf16(b1B, qfB, q1, 0, 0, 0); SBAR(); LDF(3, qfB, b0B, b1B); SBAR(); FE4(3);
  q0 = __builtin_amdgcn_mfma_f32_32x32x16_bf16(b0A, qfA, q0, 0, 0, 0); SBAR(); FS8(0);
  q1 = __builtin_amdgcn_mfma_f32_32x32x16_bf16(b1A, qfA, q1, 0, 0, 0); SBAR(); FS8(1);
  { auto rr = __builtin_amdgcn_permlane32_swap(__float_as_uint(ps), __float_as_uint(ps), false, false); ps = __uint_as_float(rr[0]) + __uint_as_float(rr[1]); }
  l_reg = l_reg * alpha + ps; SBAR();
  q0 = __builtin_amdgcn_mfma_f32_32x32x16_bf16(b0B, qfB, q0, 0, 0, 0); SBAR(); PK4(p0, 0, pa0); PK4(p0, 8, pa1);
  q1 = __builtin_amdgcn_mfma_f32_32x32x16_bf16(b1B, qfB, q1, 0, 0, 0); SBAR(); PK4(p1, 0, pa2); PK4(p1, 8, pa3);
#undef LDF
#undef PK4
#undef FS8
#undef FE4
}
template <int D0> __device__ __forceinline__ void pv_one2(f32x16& oa, f32x16& ob, int vb, bf16x8 pa0, bf16x8 pa1, bf16x8 pa2, bf16x8 pa3, bf16x8 pb0, bf16x8 pb1, bf16x8 pb2, bf16x8 pb3) {
  const s16x4 l0 = tr_read<v_rd_off(D0, 0, 0)>(vb), h0 = tr_read<v_rd_off(D0, 0, 1)>(vb), l1 = tr_read<v_rd_off(D0, 1, 0)>(vb), h1 = tr_read<v_rd_off(D0, 1, 1)>(vb);
  const s16x4 l2 = tr_read<v_rd_off(D0, 2, 0)>(vb), h2 = tr_read<v_rd_off(D0, 2, 1)>(vb), l3 = tr_read<v_rd_off(D0, 3, 0)>(vb), h3 = tr_read<v_rd_off(D0, 3, 1)>(vb);
  asm volatile("s_waitcnt lgkmcnt(0)" ::: "memory"); SBAR();
#if ATT_PRIO
  __builtin_amdgcn_s_setprio(ATT_PRIO);
#endif
#define PK(L, H) (bf16x8){L[0], L[1], L[2], L[3], H[0], H[1], H[2], H[3]}
  oa = __builtin_amdgcn_mfma_f32_32x32x16_bf16(pa0, PK(l0, h0), oa, 0, 0, 0); ob = __builtin_amdgcn_mfma_f32_32x32x16_bf16(pb0, PK(l0, h0), ob, 0, 0, 0);
  oa = __builtin_amdgcn_mfma_f32_32x32x16_bf16(pa1, PK(l1, h1), oa, 0, 0, 0); ob = __builtin_amdgcn_mfma_f32_32x32x16_bf16(pb1, PK(l1, h1), ob, 0, 0, 0);
  oa = __builtin_amdgcn_mfma_f32_32x32x16_bf16(pa2, PK(l2, h2), oa, 0, 0, 0); ob = __builtin_amdgcn_mfma_f32_32x32x16_bf16(pb2, PK(l2, h2), ob, 0, 0, 0);
  oa = __builtin_amdgcn_mfma_f32_32x32x16_bf16(pa3, PK(l3, h3), oa, 0, 0, 0); ob = __builtin_amdgcn_mfma_f32_32x32x16_bf16(pb3, PK(l3, h3), ob, 0, 0, 0);
#if ATT_PRIO
  __builtin_amdgcn_s_setprio(0);
#endif
#undef PK
}
__device__ __forceinline__ void qkt_half(f32x16& p0, f32x16& p1, const char* Ks, const char* Qs, int c, int r32, int hi) {
  asm volatile("" : "+v"(r32));
  p0 = f32x16{}; p1 = f32x16{};
#pragma unroll
  for (int d0 = 0; d0 < 4; ++d0) { const int cb = (c * 64 + d0 * 16 + hi * 8) * 2;
    const bf16x8 qf = *reinterpret_cast<const bf16x8*>(Qs + kswz<128>(r32, cb));
    const bf16x8 b0 = *reinterpret_cast<const bf16x8*>(Ks + kswz<128>(r32, cb));
    const bf16x8 b1 = *reinterpret_cast<const bf16x8*>(Ks + kswz<128>(32 + r32, cb));
    p0 = __builtin_amdgcn_mfma_f32_32x32x16_bf16(b0, qf, p0, 0, 0, 0);
    p1 = __builtin_amdgcn_mfma_f32_32x32x16_bf16(b1, qf, p1, 0, 0, 0); }
}
__device__ __forceinline__ void attn_diff_fused(const AttnArgs& A, int b, int hh, int qb, float lam, char* lds, int tid) {
  constexpr int QCOL = 2816, KCOL = 3584, VCOL = 4352, OCOL = 1280;
  const float C = 0.125f * LOG2E;
  const int lane = tid & 63, r32 = lane & 31, hi = lane >> 5; const int wid = __builtin_amdgcn_readfirstlane(tid >> 6);
  char* V_lds = lds + OFF_V; char* K_lds = lds + OFF_K;
  float* wsl = (float*)(lds + OFF_WS) + wid * 64;
  const float* lut = (const float*)(lds + OFF_LUT);
  char* stg = lds + OFF_STG + wid * STG_WAVE;
  const int q0 = qb * 256;
  const int qpos = q0 + wid * QBLK + r32, wave_qmin = q0 + wid * QBLK;
  const long rowb = (long)b * SEQL;
  const int NT = 4 * qb + 4;
  const int vb0 = (int)(uintptr_t)V_lds + v_rd_base(lane);
  const unsigned short* Vh = A_proj + rowb * LDP + VCOL + hh * 128;
  const unsigned short* Kh = A_proj + rowb * LDP + KCOL + hh * 128;
  float m0 = NEGB, l0 = 0.f, m1 = NEGB, l1 = 0.f;
  f32x16 o0[4] = {}, o1[4] = {};
  typedef __attribute__((address_space(3))) unsigned las_u32;
#define SLOAD2(k0, bb) do { const char* kg_ = (const char*)(Kh + (long)(k0) * LDP); const char* vg_ = (const char*)(Vh + (long)(k0) * LDP); \
    int ll_ = lane; asm volatile("" : "+v"(ll_));                 \
    _Pragma("unroll") for (int i_ = 0; i_ < 2; ++i_) { const int q_ = (i_ * 8 + wid) * 64 + ll_; \
      const int row_ = q_ >> 4, pos_ = q_ & 15; const unsigned koff_ = (unsigned)((row_ * LDP + ((pos_ ^ (row_ & 7)) << 3)) * 2); \
      const int st_ = q_ >> 5, kk_ = ((st_ >> 2) << 3) | ((q_ >> 2) & 7), c_ = ((st_ & 3) << 5) | ((q_ & 3) << 3), k_ = (kk_ & ~0xC) | ((kk_ & 4) << 1) | ((kk_ & 8) >> 1); const unsigned voff_ = (unsigned)((k_ * LDP + c_) * 2); \
      __builtin_amdgcn_global_load_lds((const unsigned*)(kg_ + koff_), (las_u32*)(K_lds + (bb) * SHM_K + (i_ * 8 + wid) * 1024), 16, 0, 0); \
      __builtin_amdgcn_global_load_lds((const unsigned*)(vg_ + voff_), (las_u32*)(V_lds + (bb) * SHM_V + (i_ * 8 + wid) * 1024), 16, 0, 0); } } while (0)
#define RESC2(a, oo, sl) do { if (__any((a) < 1.f)) { if (hi == 0) (sl)[r32] = (a); asm volatile("s_waitcnt lgkmcnt(0)" ::: "memory"); \
    _Pragma("unroll") for (int d = 0; d < 4; ++d) _Pragma("unroll") for (int r = 0; r < 16; ++r) oo[d][r] *= (sl)[crow(r, hi)]; } } while (0)
  SLOAD2(0, 0);
  { const unsigned short* Qg = A_proj + (rowb + q0 + wid * QBLK) * LDP + QCOL + hh * 128;
    bf16x8 qv[8];
#pragma unroll
    for (int i = 0; i < 8; ++i) { const int c = lane + 64 * i, row = c >> 4, cc = c & 15; qv[i] = *reinterpret_cast<const bf16x8*>(Qg + (long)row * LDP + cc * 8); }
    unit_luts<2>(lds, hh, tid);
#pragma unroll
    for (int i = 0; i < 8; ++i) { const int c = lane + 64 * i, row = c >> 4, cc = c & 15; *(bf16x8*)(stg + kswz<128>(row, cc * 16)) = qv[i]; } }
  asm volatile("s_waitcnt vmcnt(0)" ::: "memory"); __syncthreads();
  const float cfar = lut[127];
#pragma unroll 1
  for (int j = 0; j < NT; ++j) {
    const int bb = j & 1; const int kt = j * KVBLK;
    if (j + 1 < NT) SLOAD2((j + 1) * KVBLK, bb ^ 1);
    if (kt <= wave_qmin + QBLK - 1) {
    f32x16 p0, p1, q0, q1; float al0, al1; bf16x8 pa0, pa1, pa2, pa3, pb0, pb1, pb2, pb3;
    qkt_half(p0, p1, K_lds + bb * SHM_K, stg, 0, r32, hi);
    tile_sm<2>(p0, p1, kt, qpos, wave_qmin, hi, C, lut, cfar, 0u, qb, m0, al0);
    SBAR();
    qkt_half_sm_split(q0, q1, K_lds + bb * SHM_K, stg, r32, hi, p0, p1, al0, l0, pa0, pa1, pa2, pa3);
    RESC2(al0, o0, wsl);
    SBAR();
    tile_sm<2>(q0, q1, kt, qpos, wave_qmin, hi, C, lut, cfar, 0u, qb, m1, al1);
    RESC2(al1, o1, wsl + 32);
    SBAR();
    pv_sm_split(o0, vb0 + bb * SHM_V, pa0, pa1, pa2, pa3, q0, q1, al1, l1, pb0, pb1, pb2, pb3);
    SBAR();
    pv_all1(o1, vb0 + bb * SHM_V, pb0, pb1, pb2, pb3);
    }
    asm volatile("s_waitcnt vmcnt(0)" ::: "memory");
    __syncthreads();
  }
#undef SLOAD2
#undef RESC2
  int r32e = r32, hie = hi; asm volatile("" : "+v"(r32e), "+v"(hie));
  if (hi == 0) { wsl[r32] = l0; wsl[32 + r32] = l1; } asm volatile("s_waitcnt lgkmcnt(0)" ::: "memory");
#pragma unroll
  for (int r = 0; r < 16; ++r) { const int orow = crow(r, hie); const float ra = __builtin_amdgcn_rcpf(wsl[orow]), rb = lam * __builtin_amdgcn_rcpf(wsl[32 + orow]);
#pragma unroll
    for (int d0 = 0; d0 < 4; ++d0) { unsigned short* sp = (unsigned short*)(stg + orow * STG_PITCH) + d0 * 32 + r32e; const float v = o0[d0][r] * ra - o1[d0][r] * rb;
      *sp = (unsigned short)(cvtpk(v, v) & 0xffffu); } }
  asm volatile("s_waitcnt lgkmcnt(0)" ::: "memory");
  { const char* rp = stg + r32e * STG_PITCH + hie * 128;
    u32x4 w[8];
#pragma unroll
    for (int i = 0; i < 8; ++i) w[i] = *(const u32x4*)(rp + i * 16);
    float ss = 0.f;
#pragma unroll
    for (int i = 0; i < 8; ++i)
#pragma unroll
      for (int k = 0; k < 4; ++k) { const float lo = __uint_as_float(w[i][k] << 16), hi_ = __uint_as_float(w[i][k] & 0xffff0000u); ss += lo * lo + hi_ * hi_; }
    { auto rr = __builtin_amdgcn_permlane32_swap(__float_as_uint(ss), __float_as_uint(ss), false, false); ss = __uint_as_float(rr[0]) + __uint_as_float(rr[1]); }
    const float sc2 = rsqrtf(ss * (1.0f / 128.0f) + 1e-6f) * (1.0f - A.lambda_init);
    const f32x4* gp = (const f32x4*)(A_subln + hie * 64);
    f32x4 gq[16];
#pragma unroll
    for (int i = 0; i < 16; ++i) gq[i] = gp[i];
#pragma unroll
    for (int i = 0; i < 8; ++i)
#pragma unroll
      for (int k = 0; k < 4; ++k) { const float lo = __uint_as_float(w[i][k] << 16) * sc2 * gq[2 * i + (k >> 1)][2 * (k & 1)], hi_ = __uint_as_float(w[i][k] & 0xffff0000u) * sc2 * gq[2 * i + (k >> 1)][2 * (k & 1) + 1]; w[i][k] = cvtpk(lo, hi_); }
    unsigned short* op = A_ycat + (rowb + q0 + wid * QBLK + r32e) * LDY + OCOL + hh * 128 + hie * 64;
#pragma unroll
    for (int i = 0; i < 8; ++i) *(u32x4*)(op + i * 8) = w[i];
  }
}
__device__ __forceinline__ void attn_swa_wave(const AttnArgs& A, int b, int hh, int qb, char* lds, int tid) {
  constexpr int QCOL = 0, KCOL = 768, VCOL = 1024, OCOL = 0;
  const float C = 0.088388347648318440f * LOG2E;
  const int lane = tid & 63, r32 = lane & 31, hi = lane >> 5; const int wid = __builtin_amdgcn_readfirstlane(tid >> 6);
  const int kvh = hh / 3;
  char* vpriv = lds + (wid < 4 ? wid * 16384 : OFF_STG + (wid - 4) * 16384);
  float* wsl = (float*)(lds + OFF_WS) + wid * 64; float* li_l = wsl; float* al_l = wsl + 32;
  const float* lut = (const float*)(lds + OFF_LUT);
  const int q0 = qb * 256, q0w = q0 + wid * QBLK, qpos = q0w + r32;
  const long rowb = (long)b * SEQL;
  const float cfar = lut[127];
  const unsigned short* Vh = A_proj + rowb * LDP + VCOL + kvh * 128;
  const unsigned short* Kh = A_proj + rowb * LDP + KCOL + kvh * 128 + hi * 8;
  const unsigned short* Qw = A_proj + (rowb + qpos) * LDP + QCOL + hh * 128 + hi * 8;
  bf16x8 qr[8];
#pragma unroll
  for (int d0 = 0; d0 < 8; ++d0) qr[d0] = *reinterpret_cast<const bf16x8*>(Qw + d0 * 16);
  float m_reg = A_sinks[hh] * LOG2E, l_reg = 1.f;
  f32x16 o[4] = {};
  const int vb = (int)(uintptr_t)vpriv + v_rd_base(lane);
  const int tfirst = (q0w >= 127) ? ((q0w - 127) >> 6) : 0, tlast = (q0w + 31) >> 6;
#pragma unroll 1
  for (int t = tfirst; t <= tlast; ++t) {
    const int kt = t * KVBLK;
    f32x16 p0 = {}, p1 = {};
    { bf16x8 kf0[8], kf1[8];
#pragma unroll
      for (int d0 = 0; d0 < 8; ++d0) { kf0[d0] = *reinterpret_cast<const bf16x8*>(Kh + (long)(kt + r32) * LDP + d0 * 16); kf1[d0] = *reinterpret_cast<const bf16x8*>(Kh + (long)(kt + 32 + r32) * LDP + d0 * 16); }
#pragma unroll
      for (int d0 = 0; d0 < 8; ++d0) { p0 = __builtin_amdgcn_mfma_f32_32x32x16_bf16(kf0[d0], qr[d0], p0, 0, 0, 0); p1 = __builtin_amdgcn_mfma_f32_32x32x16_bf16(kf1[d0], qr[d0], p1, 0, 0, 0); } }
    bf16x8 vs[16];
#pragma unroll
    for (int i = 0; i < 16; ++i) { const int q = lane + 64 * i; vs[i] = *reinterpret_cast<const bf16x8*>(Vh + (long)(kt + (q >> 4)) * LDP + (q & 15) * 8); }
    float al; bf16x8 pa0, pa1, pa2, pa3;
    tile_sm<0>(p0, p1, kt, qpos, q0w, hi, C, lut, cfar, 0u, qb, m_reg, al);
    finishSM(p0, p1, al, l_reg, pa0, pa1, pa2, pa3);
    if (__any(al < 1.f)) { if (hi == 0) al_l[r32] = al; asm volatile("s_waitcnt lgkmcnt(0)" ::: "memory");
#pragma unroll
      for (int d = 0; d < 4; ++d)
#pragma unroll
        for (int r = 0; r < 16; ++r) o[d][r] *= al_l[crow(r, hi)]; }
#pragma unroll
    for (int i = 0; i < 16; ++i) { const int q = lane + 64 * i; *(bf16x8*)(vpriv + v_st(q >> 4, (q & 15) * 8)) = vs[i]; }
    asm volatile("s_waitcnt lgkmcnt(0)" ::: "memory"); SBAR();
    pv_d0(o, vb, pa0, pa1, pa2, pa3);
    asm volatile("s_waitcnt lgkmcnt(0)" ::: "memory"); SBAR();
  }
  int r32e = r32, hie = hi; asm volatile("" : "+v"(r32e), "+v"(hie));
  if (hi == 0) li_l[r32] = l_reg; asm volatile("s_waitcnt lgkmcnt(0)" ::: "memory");
#pragma unroll
  for (int r = 0; r < 16; ++r) { const int orow = crow(r, hie); const float rli = __builtin_amdgcn_rcpf(li_l[orow]);
#pragma unroll
    for (int d0 = 0; d0 < 4; ++d0) { unsigned short* sp = (unsigned short*)(vpriv + orow * STG_PITCH) + d0 * 32 + r32e; const float v = o[d0][r] * rli; *sp = (unsigned short)(cvtpk(v, v) & 0xffffu); } }
  asm volatile("s_waitcnt lgkmcnt(0)" ::: "memory");
  { const char* rp = vpriv + r32e * STG_PITCH + hie * 128; u32x4 w[8];
#pragma unroll
    for (int i = 0; i < 8; ++i) w[i] = *(const u32x4*)(rp + i * 16);
    unsigned short* op = A_ycat + (rowb + q0w + r32e) * LDY + OCOL + hh * 128 + hie * 64;
#pragma unroll
    for (int i = 0; i < 8; ++i) *(u32x4*)(op + i * 8) = w[i]; }
}
template <int MODE>
__device__ __forceinline__ float attn_mode_setup(const AttnArgs& A, char* lds, const int wave_idx) {
  constexpr int HB0 = (MODE == 0) ? 0 : (MODE == 1) ? 6 : 10, NH = (MODE == 1) ? 4 : 6;
  const int lane = mk_lane(), tid = wave_idx * 64 + lane;
  __syncthreads();
  float* lh = (float*)(lds + OFF_LUTH);
#pragma unroll 1
  for (int i = tid; i < NH * 128; i += 512) lh[i] = A_rel_bias[(int)REL_BUCKET_TAB[i & 127] * 16 + HB0 + (i >> 7)] * LOG2E;
  float lam = 0.f;
  if (MODE == 2) { float a = A_lq1[lane] * A_lk1[lane], c2 = A_lq2[lane] * A_lk2[lane];
#pragma unroll
    for (int o_ = 1; o_ < 64; o_ <<= 1) { a += mk_shfl_xor(a, o_); c2 += mk_shfl_xor(c2, o_); }
    lam = __expf(a) - __expf(c2) + A.lambda_init; }
  __syncthreads();
  return __builtin_bit_cast(float, __builtin_amdgcn_readfirstlane(__builtin_bit_cast(int, lam)));
}
template <int MODE>
__device__ __forceinline__ void attn_unit(const AttnArgs& A, int b, int hh, int qb, char* lds, const int wave_idx, float lam) {
  constexpr int NPASS = (MODE == 2) ? 2 : 1;
  const int lane = mk_lane(), tid = wave_idx * 64 + lane;
  float* lut = (float*)(lds + OFF_LUT);
  __syncthreads();
  if (MODE == 1 && tid == 0) ((unsigned*)(lds + OFF_MISC))[4] = 0u;
  if (MODE == 1) { const float* kp_ = A_kpart + (size_t)((b * 4 + hh) * 16) * 128 + tid * 4; *(f32x4*)(lds + OFF_STG + tid * 16) = (*(const f32x4*)kp_ + *(const f32x4*)(kp_ + ATT_KP_N)) * (1.f / 256.f); }
  if (!(MODE == 2 && ATT_DIFF_FUSED)) { unit_luts<MODE>(lds, hh, tid); __syncthreads(); }
  asm volatile("" : "+v"(lam));
  if (MODE == 2 && ATT_DIFF_FUSED) { attn_diff_fused(A, b, hh, qb, lam, lds, wave_idx * 64 + mk_lane()); }
  else if (MODE == 0 && ATT_SWA_WAVE) { attn_swa_wave(A, b, hh, qb, lds, wave_idx * 64 + mk_lane()); }
  else {
#pragma unroll 1
  for (int pass = 0; pass < NPASS; ++pass) {
    attn_pass<MODE>(A, b, hh, qb, pass, lam, lds, wave_idx * 64 + mk_lane());
  }
  }
}
#undef SBAR
}
#undef A_proj
#undef A_ycat
#undef A_kmean
#undef A_kpart
#undef A_rel_bias
#undef A_sinks
#undef A_lq1
#undef A_lk1
#undef A_lq2
#undef A_lk2
#undef A_subln
#define GAS __attribute__((address_space(1)))
#define LAS __attribute__((address_space(3)))
typedef unsigned short bf16;
typedef unsigned v4u __attribute__((ext_vector_type(4)));
typedef float f32x4 __attribute__((ext_vector_type(4)));
typedef short bf16x8 __attribute__((ext_vector_type(8)));
typedef GAS unsigned gu32;
typedef GAS unsigned long long gu64;
#define RLX_AGENT __ATOMIC_RELAXED, __HIP_MEMORY_SCOPE_AGENT
#define LDS_WAIT() asm volatile("s_waitcnt lgkmcnt(0)" ::: "memory")
#define VM_WAIT() asm volatile("s_waitcnt vmcnt(0)" ::: "memory")
__device__ __forceinline__ unsigned long long rt() { return __builtin_amdgcn_s_memrealtime(); }
__device__ __forceinline__ unsigned f2bf(float f) { unsigned u = __builtin_bit_cast(unsigned, f); return (u + 0x7fffu + ((u >> 16) & 1u)) >> 16; }
__device__ __forceinline__ unsigned pk2(float lo, float hi) { return f2bf(lo) | (f2bf(hi) << 16); }

#define XB_TMO      128
#define XB_XCNT(j)  (256  + 64 * (j))
#define XB_XSUB(j)  (1280 + 64 * (j))
#define XB_XGEN(j)  (2304 + 64 * (j))
#define XB_TOP      3328
#define XB_TOPGEN   3392
#define XCD_BAR_WORDS 3456
#define XB_SPIN_CAP (1u << 18)

__device__ __forceinline__ unsigned xb_ld(unsigned* p)              { return __hip_atomic_load(p, __ATOMIC_RELAXED, __HIP_MEMORY_SCOPE_AGENT); }
__device__ __forceinline__ unsigned xb_add(unsigned* p, unsigned v) { return __hip_atomic_fetch_add(p, v, __ATOMIC_RELAXED, __HIP_MEMORY_SCOPE_AGENT); }
__device__ __forceinline__ unsigned xb_xcc_id() { return (unsigned)__builtin_amdgcn_s_getreg((3 << 11) | 20) & 0xFu; }
#define XB_SPIN(cond, bar) do { unsigned _sp = 0; while (cond) { __builtin_amdgcn_s_sleep(1); \
    if ((++_sp & 255u) == 0u) { if (xb_ld(&(bar)[XB_TMO])) break; if (_sp > XB_SPIN_CAP) { atomicAdd(&(bar)[XB_TMO], 1u); break; } } } } while (0)

struct XcdBarrier {
    unsigned* bar; unsigned x;
    volatile LAS unsigned* st;
};

__device__ __forceinline__ XcdBarrier xcd_barrier_post(unsigned* bar, volatile LAS unsigned* st) {
    XcdBarrier b; b.bar = bar; b.x = xb_xcc_id(); b.st = st;
    if (threadIdx.x == 0) (void)xb_add(&bar[XB_XCNT(b.x)], 1u);
    return b;
}
__device__ __forceinline__ void xcd_barrier_complete(unsigned* bar, unsigned x, unsigned& nloc, unsigned& nx) {
    const unsigned G = gridDim.x * gridDim.y * gridDim.z;
    unsigned sum, cnt, mine, sp = 0u;
    for (;;) {
        sum = 0u; cnt = 0u; mine = 0u;
#pragma unroll
        for (unsigned j = 0; j < 16; ++j) { const unsigned c = xb_ld(&bar[XB_XCNT(j)]); sum += c; cnt += (c > 0u) ? 1u : 0u; mine = (j == x) ? c : mine; }
        if (sum == G) break;
        __builtin_amdgcn_s_sleep(1);
        if ((++sp & 255u) == 0u) { if (xb_ld(&bar[XB_TMO])) break; if (sp > XB_SPIN_CAP) { atomicAdd(&bar[XB_TMO], 1u); break; } }
    }
    nloc = mine > 0u ? mine : 1u; nx = cnt > 0u ? cnt : 1u;
}

__device__ __forceinline__ void xcd_barrier(const XcdBarrier& b) {
    asm volatile("s_waitcnt vmcnt(0)" ::: "memory");
    __syncthreads();
    if (threadIdx.x == 0) {
        unsigned* bar = b.bar;
        __builtin_amdgcn_s_waitcnt(0);
        unsigned nloc = b.st[0], nx = b.st[1];
        if (nloc == 0u) { xcd_barrier_complete(bar, b.x, nloc, nx); b.st[0] = nloc; b.st[1] = nx; }
        const unsigned old = xb_add(&bar[XB_XSUB(b.x)], 1u);
        const unsigned gen = old / nloc;
        if (old + 1u == (gen + 1u) * nloc) {
            __builtin_amdgcn_fence(__ATOMIC_RELEASE, "agent");
            asm volatile("s_waitcnt vmcnt(0)" ::: "memory");
            const unsigned og = xb_add(&bar[XB_TOP], 1u);
            const unsigned tg = og / nx;
            if (og + 1u == (tg + 1u) * nx) xb_add(&bar[XB_TOPGEN], 1u);
            else XB_SPIN(xb_ld(&bar[XB_TOPGEN]) == tg, bar);
            __builtin_amdgcn_fence(__ATOMIC_ACQUIRE, "agent");
            xb_add(&bar[XB_XGEN(b.x)], 1u);
            asm volatile("s_waitcnt vmcnt(0)" ::: "memory");
        } else {
            XB_SPIN(xb_ld(&bar[XB_XGEN(b.x)]) == gen, bar);
            __builtin_amdgcn_fence(__ATOMIC_ACQUIRE, "agent");
            asm volatile("s_waitcnt vmcnt(0)" ::: "memory");
        }
    }
    __syncthreads();
}

constexpr int NWAVES = 8;
constexpr int BATCH = 8, SEQ = 4096, DM = 2048, DEPTH = 2, M = BATCH * SEQ, NIN = 5120, NEXP = 32, DEXP = 512, PLE = 256, NROUTE = 36;
constexpr int KB_OFF = 1792;
constexpr int RPAD = 73728;
constexpr float EPS = 1e-6f;
constexpr size_t MiB = 1u << 20;
constexpr size_t WS_CTL = 0, CTL_ZERO_BYTES = 1 * MiB;
constexpr size_t WS_KMEAN = 1 * MiB, WS_RSTD = WS_KMEAN + 256 * 1024, WS_TOKREC = WS_RSTD + 128 * 1024, WS_POS = WS_TOKREC + 1 * MiB, WS_WR = WS_POS + 256 * 1024;
constexpr size_t WS_WIN = 8 * MiB, WS_WOUT = 48 * MiB, WS_W13 = 64 * MiB, WS_W2 = 192 * MiB, WS_WG = 256 * MiB, WS_WP = 272 * MiB, WS_PB = 274 * MiB;
constexpr size_t WS_U = 306 * MiB, WS_PROJ = 434 * MiB, WS_YCAT = 754 * MiB, WS_PL = 882 * MiB, WS_HB = 1010 * MiB, WS_END = 1138 * MiB;
constexpr size_t WS_SSQ = WS_YCAT + 64 * MiB;
constexpr size_t WS_SRS = WS_YCAT + 72 * MiB;
constexpr size_t WS_LIST = 4 * MiB;
constexpr size_t WS_RSIN = WS_POS, WS_RSPLE = WS_POS + 128 * 1024;
constexpr size_t WS_XG = WS_PROJ, WS_HID = WS_PROJ + 288 * MiB, WS_Y = WS_XG;
static_assert(WS_WR + 2 * 2 * 48 * DM * 2 <= WS_LIST && WS_LIST + NEXP * 32768 * 4 <= WS_WIN && WS_HID + (size_t)RPAD * DEXP * 2 <= WS_PL && (size_t)RPAD * DM * 2 <= 288 * MiB && WS_W13 + (size_t)NEXP * 1024 * DM * 2 <= WS_W2 && WS_W2 + (size_t)NEXP * DM * DEXP * 2 <= WS_WG && WS_PB + (size_t)DEPTH * M * PLE * 2 <= WS_U, "d_ws map");
constexpr int CW_TMO = 0, CW_CODE = 1, CW_BAR = 4096, CW_CNT = 16384, CW_Q = 24576;
constexpr int PHASE_LDS = 139264;
constexpr int LDS_TILE_E = PHASE_LDS, LDS_OFFS = PHASE_LDS + 512, LDS_MISC = PHASE_LDS + 1024, LDSCTL_OFF = PHASE_LDS;
constexpr int LDS_BYTES = 147456 + att::LUT4_COPIES * att::LUT4_N * 4 + att::LUTH_BYTES;
static_assert(att::OFF_LUT4 == 147456 && LDS_BYTES <= 163840 && att::ATT_LDS <= PHASE_LDS && pg8::STAGE_BYTES <= PHASE_LDS && LDS_MISC + 128 + 8 * 32 <= LDS_BYTES, "LDS map");

__device__ __forceinline__ gu32* ctlptr() { return (gu32*)(wsptr() + WS_CTL); }
typedef float f32x2g __attribute__((ext_vector_type(2)));
typedef unsigned u32x2g __attribute__((ext_vector_type(2)));
__device__ __forceinline__ size_t hb_off(int k) { return (k & 1) ? WS_U : WS_HB; }
struct Frame {
    LAS unsigned char* lds;
    volatile LAS unsigned* MISC;
    int tid, lane, wave, G, gw, NGW;
};
struct Args { const float* in[22]; float* out; unsigned char* ws; int ph_lo, ph_hi, use_bar, pad; };
__device__ __forceinline__ Frame relaunder(const Frame& F0) {
    Frame F = F0; int w = F0.wave; asm volatile("" : "+s"(w)); F.wave = w; F.lane = mk_lane(); F.tid = w * 64 + F.lane; F.gw = blockIdx.x * NWAVES + w; return F;
}
__device__ __forceinline__ int opaque_i(int x) { asm volatile("" : "+s"(x)); return x; }
__device__ __forceinline__ float wave_sum(float v) {
#pragma unroll
    for (int o = 1; o < 64; o <<= 1) v += mk_shfl_xor(v, o);
    return v;
}
__device__ __forceinline__ unsigned pk2rne(float lo, float hi) { return pg8::cvt_pk_bf16(lo, hi); }
__device__ __forceinline__ float bfround(float x) { return __uint_as_float(pk2rne(x, x) << 16); }

struct ConvDesc { const float* W; int K, N; bf16* WT; int dst_row0, k0, n0; const float* gk; };
__device__ __forceinline__ void transpose_gains(const ConvDesc& d, float (&gv)[8], int lane) {
    const int rr = lane >> 3;
#pragma unroll
    for (int i = 0; i < 8; ++i) gv[i] = d.gk ? d.gk[d.k0 + 8 * i + rr] : 1.f;
}
__device__ __forceinline__ void transpose_load(const ConvDesc& d, f32x4 (&v)[8], int lane) {
    const int rr = lane >> 3, c4 = (lane & 7) * 4;
#pragma unroll
    for (int i = 0; i < 8; ++i) v[i] = __builtin_nontemporal_load((const GAS f32x4*)(d.W + (size_t)(d.k0 + 8 * i + rr) * d.N + d.n0 + c4));
}
__device__ __forceinline__ void transpose_store(const ConvDesc& d, f32x4 (&v)[8], float (&gv)[8], LAS float* scr, int lane, bool nt = false) {
    { const int rr = lane >> 3, c4 = (lane & 7) * 4;
#pragma unroll
      for (int i = 0; i < 8; ++i) { const f32x4 w = v[i] * gv[i]; LAS float* p = scr + (8 * i + rr) * 33 + c4; p[0] = w.x; p[1] = w.y; p[2] = w.z; p[3] = w.w; } }
    LDS_WAIT(); asm volatile("" ::: "memory");
    const int c = lane & 7;
#pragma unroll
    for (int j = 0; j < 4; ++j) { const int n = (lane >> 3) + 8 * j; const LAS float* s = scr + (8 * c) * 33 + n;
        v4u o; o.x = pk2rne(s[0 * 33], s[1 * 33]); o.y = pk2rne(s[2 * 33], s[3 * 33]); o.z = pk2rne(s[4 * 33], s[5 * 33]); o.w = pk2rne(s[6 * 33], s[7 * 33]);
        GAS v4u* dp = (GAS v4u*)(d.WT + (size_t)(d.dst_row0 + n) * d.K + d.k0 + 8 * c); if (nt) __builtin_nontemporal_store(o, dp); else *dp = o; }
    LDS_WAIT(); asm volatile("" ::: "memory");
}
__device__ __forceinline__ void p0_transpose_item(const float* W, int K, int N, bf16* WT, int dst_row0, LAS float* scr, int k0, int n0, int lane, const float* gk = nullptr) {
    const ConvDesc d{W, K, N, WT, dst_row0, k0, n0, gk}; f32x4 v[8]; float gv[8]; transpose_gains(d, gv, lane); transpose_load(d, v, lane); transpose_store(d, v, gv, scr, lane);
}
__device__ __forceinline__ void norm_row_bf16(const float* xrow, const float* g, bf16* orow, int lane) {
    const GAS f32x4* xr = (const GAS f32x4*)xrow + lane; const GAS f32x4* gr = (const GAS f32x4*)g + lane;
    f32x4 v[8]; float s = 0.f;
#pragma unroll
    for (int j = 0; j < 8; ++j) { v[j] = xr[64 * j]; s += (v[j].x * v[j].x + v[j].y * v[j].y) + (v[j].z * v[j].z + v[j].w * v[j].w); }
    const float rstd = rsqrtf(wave_sum(s) * (1.f / DM) + EPS);
    GAS unsigned long long* o8 = (GAS unsigned long long*)orow + lane;
#pragma unroll
    for (int j = 0; j < 8; ++j) { const f32x4 gv = gr[64 * j]; o8[64 * j] = (unsigned long long)pk2rne(v[j].x * rstd * gv.x, v[j].y * rstd * gv.y) | ((unsigned long long)pk2rne(v[j].z * rstd * gv.z, v[j].w * rstd * gv.w) << 32); }
}

__device__ __forceinline__ void convert_expert_weights(Frame& F, int L) {
    LAS float* scr = (LAS float*)(F.lds + F.wave * 16384);
    constexpr int I_W1 = 32 * 512, I_W2 = 32 * 512;
    bf16* W13 = (bf16*)(wsptr() + WS_W13); bf16* W2 = (bf16*)(wsptr() + WS_W2);
    for (int it = F.gw; it < 2 * I_W1 + I_W2; it += F.NGW) { int r = it;
        if (r < 2 * I_W1) { const int w3 = r >= I_W1; if (w3) r -= I_W1; const int e = r / 512, rr = r % 512, n0 = 32 * (rr % 16);
            p0_transpose_item((w3 ? inptr(17) : inptr(16)) + ((size_t)L * NEXP + e) * DM * DEXP, DM, DEXP, W13 + (size_t)e * 1024 * DM, 256 * (n0 / 128) + (n0 % 128) + (w3 ? 128 : 0), scr, 64 * (rr / 16), n0, F.lane, inptr(13) + (size_t)L * DM); continue; } r -= 2 * I_W1;
        const int e = r / 512, rr = r % 512;
        p0_transpose_item(inptr(18) + ((size_t)L * NEXP + e) * DEXP * DM, DEXP, DM, W2 + (size_t)e * DM * DEXP, 32 * (rr % 64), scr, 64 * (rr / 64), 32 * (rr % 64), F.lane); }
}
static_assert(true, "");
constexpr int CONV_NCH = 8, CONV_IE = 3 * 32 * 512, CONV_ID = 32 * 160 + 32 * 64 + 32 * 64 + 4 * 64;
__device__ __forceinline__ ConvDesc conv_desc(int job, int idx) {
    bf16* W13 = (bf16*)(wsptr() + WS_W13); bf16* W2 = (bf16*)(wsptr() + WS_W2);
    if (idx < CONV_IE) { const int L = job; int r = idx;
        if (r < 2 * 32 * 512) { const int w3 = r >= 32 * 512; if (w3) r -= 32 * 512; const int e = r / 512, rr = r % 512, n0 = 32 * (rr % 16);
            return ConvDesc{(w3 ? inptr(17) : inptr(16)) + ((size_t)L * NEXP + e) * DM * DEXP, DM, DEXP, W13 + (size_t)e * 1024 * DM, 256 * (n0 / 128) + (n0 % 128) + (w3 ? 128 : 0), 64 * (rr / 16), n0, inptr(13) + (size_t)L * DM}; }
        r -= 2 * 32 * 512; const int e = r / 512, rr = r % 512;
        return ConvDesc{inptr(18) + ((size_t)L * NEXP + e) * DEXP * DM, DEXP, DM, W2 + (size_t)e * DM * DEXP, 32 * (rr % 64), 64 * (rr / 64), 32 * (rr % 64), nullptr}; }
    int r = idx - CONV_IE; const int L = 1;
    bf16* WIN = (bf16*)(wsptr() + WS_WIN); bf16* WOUT = (bf16*)(wsptr() + WS_WOUT); bf16* WG = (bf16*)(wsptr() + WS_WG); bf16* WP = (bf16*)(wsptr() + WS_WP);
    if (r < 32 * 160) { return ConvDesc{inptr(5) + (size_t)L * DM * NIN, DM, NIN, WIN + (size_t)L * NIN * DM, 32 * (r % 160), 64 * (r / 160), 32 * (r % 160), inptr(4) + (size_t)L * DM}; } r -= 32 * 160;
    if (r < 32 * 64) { return ConvDesc{inptr(12) + (size_t)L * DM * DM, DM, DM, WOUT + (size_t)L * DM * DM, 32 * (r % 64), 64 * (r / 64), 32 * (r % 64), nullptr}; } r -= 32 * 64;
    if (r < 32 * 64) { return ConvDesc{inptr(20) + (size_t)L * DM * DM, DM, DM, WG + (size_t)L * DM * DM, 32 * (r % 64), 64 * (r / 64), 32 * (r % 64), inptr(19) + (size_t)L * DM}; } r -= 32 * 64;
    return ConvDesc{inptr(21) + (size_t)L * PLE * DM, PLE, DM, WP + (size_t)L * DM * PLE, 32 * (r % 64), 64 * (r / 64), 32 * (r % 64), nullptr};
}
__device__ __forceinline__ void conv_chunk(Frame& F0, int job, int k, gu32* tq = nullptr) {
    unsigned tk_ = 0u; const bool tkd = (tq != nullptr) && (F0.wave == 0) && (mk_lane() == 0);
    if (tkd) tk_ = __hip_atomic_fetch_add(tq, 1u, RLX_AGENT);
    __syncthreads();
    Frame F = relaunder(F0);
    LAS float* scr = (LAS float*)(F.lds + F.wave * 16384 + (F.wave >= 4 ? 8192 : 0));
    const int N = job == 0 ? CONV_IE + CONV_ID : CONV_IE, ipc = (N + F.G * CONV_NCH - 1) / (F.G * CONV_NCH), base = ((int)blockIdx.x * CONV_NCH + k) * ipc;
    f32x4 v[4][8]; ConvDesc d[4]; bool has[4];
#pragma unroll
    for (int t = 0; t < 4; ++t) { const int i = F.wave + NWAVES * t, idx = base + i; has[t] = (i < ipc) && (idx < N); d[t] = conv_desc(job, has[t] ? idx : 0); }
    float gA[8], gB[8];
    transpose_gains(d[0], gA, F.lane); transpose_gains(d[1], gB, F.lane);
#pragma unroll
    for (int t = 0; t < 4; ++t) if (has[t]) transpose_load(d[t], v[t], F.lane);
    if (has[0]) transpose_store(d[0], v[0], gA, scr, F.lane, true);
    transpose_gains(d[2], gA, F.lane); if (has[1]) transpose_store(d[1], v[1], gB, scr, F.lane, true);
    transpose_gains(d[3], gB, F.lane); if (has[2]) transpose_store(d[2], v[2], gA, scr, F.lane, true);
    if (has[3]) transpose_store(d[3], v[3], gB, scr, F.lane, true);
    if (tkd) ((volatile LAS int*)(F.lds + att::OFF_MISC))[0] = (int)tk_;
    __syncthreads();
}
__device__ __forceinline__ void p0_prologue(Frame& F0, const Args& AR) {
    Frame F = relaunder(F0);
    LAS float* scr = (LAS float*)(F.lds + F.wave * 16384);
    constexpr int I_IN = 32 * 160, I_OUT = 32 * 64, I_WG = 32 * 64, I_WP = 4 * 64, I_L = I_IN + I_OUT + I_WG + I_WP;
    bf16* WIN = (bf16*)(wsptr() + WS_WIN); bf16* WOUT = (bf16*)(wsptr() + WS_WOUT); bf16* WG = (bf16*)(wsptr() + WS_WG); bf16* WP = (bf16*)(wsptr() + WS_WP);
    for (int it = F.gw; it < I_L; it += F.NGW) {
        const int L = 0; int r = it;
        if (r < I_IN) { p0_transpose_item(inptr(5) + (size_t)L * DM * NIN, DM, NIN, WIN + (size_t)L * NIN * DM, 32 * (r % 160), scr, 64 * (r / 160), 32 * (r % 160), F.lane, inptr(4) + (size_t)L * DM); continue; } r -= I_IN;
        if (r < I_OUT) { p0_transpose_item(inptr(12) + (size_t)L * DM * DM, DM, DM, WOUT + (size_t)L * DM * DM, 32 * (r % 64), scr, 64 * (r / 64), 32 * (r % 64), F.lane); continue; } r -= I_OUT;
        if (r < I_WG) { p0_transpose_item(inptr(20) + (size_t)L * DM * DM, DM, DM, WG + (size_t)L * DM * DM, 32 * (r % 64), scr, 64 * (r / 64), 32 * (r % 64), F.lane, inptr(19) + (size_t)L * DM); continue; } r -= I_WG;
        p0_transpose_item(inptr(21) + (size_t)L * PLE * DM, PLE, DM, WP + (size_t)L * DM * PLE, 32 * (r % 64), scr, 64 * (r / 64), 32 * (r % 64), F.lane);
    }
    { GAS v4u* lz = (GAS v4u*)(wsptr() + WS_LIST); for (int i = F.gw * 64 + F.lane; i < NEXP * 32768 / 4; i += F.NGW * 64) lz[i] = (v4u){0u, 0u, 0u, 0u}; }
    { const GAS f32x4* src = (const GAS f32x4*)inptr(1); GAS v4u* dst = (GAS v4u*)(wsptr() + WS_PB); const long n8 = (long)DEPTH * M * PLE / 8;
      const long st = (long)F.NGW * 64;
      for (long i = (long)F.gw * 64 + F.lane; i < n8; i += 4 * st) {
        f32x4 a[4], b[4];
#pragma unroll
        for (int u = 0; u < 4; ++u) if (i + u * st < n8) { a[u] = __builtin_nontemporal_load(src + 2 * (i + u * st)); b[u] = __builtin_nontemporal_load(src + 2 * (i + u * st) + 1); }
#pragma unroll
        for (int u = 0; u < 4; ++u) if (i + u * st < n8) { v4u o; o.x = pk2rne(a[u].x, a[u].y); o.y = pk2rne(a[u].z, a[u].w); o.z = pk2rne(b[u].x, b[u].y); o.w = pk2rne(b[u].z, b[u].w); dst[i + u * st] = o; } } }

    { bf16* WRH = (bf16*)(wsptr() + WS_WR); bf16* WRL = WRH + DEPTH * 48 * DM;
      for (int i = F.gw * 64 + F.lane; i < DEPTH * 48 * DM; i += F.NGW * 64) { const int L = i / (48 * DM), n = (i / DM) % 48, k = i % DM;
        const float w = (n < 4 ? inptr(14)[((size_t)L * DM + k) * 4 + n] : n < NROUTE ? inptr(15)[((size_t)L * DM + k) * 32 + (n - 4)] : 0.f) * inptr(13)[(size_t)L * DM + k];
        const unsigned h = pk2rne(w, 0.f) & 0xffffu; const float r = w - __uint_as_float(h << 16);
        WRH[i] = (bf16)h; WRL[i] = (bf16)(pk2rne(r, 0.f) & 0xffffu); } }
    { float* rsin = (float*)(wsptr() + WS_RSIN); bf16* hb = (bf16*)(wsptr() + hb_off(0));
      for (int m4 = F.gw; m4 < M / 4; m4 += F.NGW) {
        f32x4 v[4][8];
#pragma unroll
        for (int r = 0; r < 4; ++r) { const GAS f32x4* xr = (const GAS f32x4*)(inptr(0) + (size_t)(4 * m4 + r) * DM) + F.lane;
#pragma unroll
          for (int j = 0; j < 8; ++j) v[r][j] = __builtin_nontemporal_load(xr + 64 * j); }
#pragma unroll
        for (int r = 0; r < 4; ++r) { GAS unsigned long long* o8 = (GAS unsigned long long*)(hb + (size_t)(4 * m4 + r) * DM) + F.lane; float s = 0.f;
#pragma unroll
          for (int j = 0; j < 8; ++j) { const f32x4 w = v[r][j]; s += (w.x * w.x + w.y * w.y) + (w.z * w.z + w.w * w.w); o8[64 * j] = (unsigned long long)pk2rne(w.x, w.y) | ((unsigned long long)pk2rne(w.z, w.w) << 32); }
          s = wave_sum(s); if (F.lane == 0) rsin[4 * m4 + r] = rsqrtf(s * (1.f / DM) + EPS); } } }
}
constexpr int LDS_RSTAB = 131072, LDS_RSVAL = 131072 + 64;
template <class Sched> __device__ __forceinline__ void rsin_table(Frame& F0, const Sched& S, bool from_parts) {
    Frame F = relaunder(F0);
    LAS int* tab = (LAS int*)(F.lds + LDS_RSTAB); LAS float* rs = (LAS float*)(F.lds + LDS_RSVAL);
    if (F.tid < 4) tab[F.tid] = -1;
    __syncthreads();
    int ns = 0; pg8::Unit u;
#pragma unroll 1
    for (int i = 0; S.next(i, u); ++i) {
        bool have = false;
#pragma unroll 1
        for (int k = 0; k < ns; ++k) have = have || (tab[k] == u.pm);
        if (have || ns >= 4) continue;
        const int row = F.tid >> 1, h = F.tid & 1; float v;
        if (from_parts) { const GAS f32x4* pp = (const GAS f32x4*)((const float*)(wsptr() + WS_SSQ) + ((size_t)u.pm * 256 + row) * 32 + 16 * h);
            const f32x4 a = pp[0], b = pp[1], c = pp[2], d = pp[3]; float s = ((a.x + a.y) + (a.z + a.w)) + ((b.x + b.y) + (b.z + b.w)) + (((c.x + c.y) + (c.z + c.w)) + ((d.x + d.y) + (d.z + d.w)));
            s += mk_shfl_xor(s, 1); v = rsqrtf(s * (1.f / DM) + EPS); }
        else v = ((const float*)(wsptr() + WS_RSIN))[u.pm * 256 + row];
        if (h == 0) rs[ns * 256 + row] = v;
        if (F.tid == 0) tab[ns] = u.pm;
        ++ns;
        __syncthreads();
    }
}
__device__ __forceinline__ void kmean_phase(Frame& F0, const Args& AR) {
    Frame F = relaunder(F0);
    const bf16* proj = (const bf16*)(wsptr() + WS_PROJ); float* km = (float*)(wsptr() + WS_KMEAN);
    LAS float* part = (LAS float*)F.lds;
    for (int w = blockIdx.x; w < BATCH * 4 * 16 / 2; w += F.G) {
        const int u = 2 * w + (F.wave >> 2), q = F.wave & 3, b = u >> 6, h = (u >> 4) & 3, blk = u & 15, rg = F.lane >> 4, c = F.lane & 15;
        const bf16* kp = proj + ((size_t)b * SEQ + blk * 256 + q * 64 + rg) * NIN + KB_OFF + h * 128 + 8 * c;
        float s[8] = {0.f, 0.f, 0.f, 0.f, 0.f, 0.f, 0.f, 0.f};
#pragma unroll
        for (int i = 0; i < 16; ++i) { const v4u v = *(const GAS v4u*)(kp + (size_t)(4 * i) * NIN);
            s[0] += __uint_as_float(v.x << 16); s[1] += __uint_as_float(v.x & 0xffff0000u); s[2] += __uint_as_float(v.y << 16); s[3] += __uint_as_float(v.y & 0xffff0000u);
            s[4] += __uint_as_float(v.z << 16); s[5] += __uint_as_float(v.z & 0xffff0000u); s[6] += __uint_as_float(v.w << 16); s[7] += __uint_as_float(v.w & 0xffff0000u); }
#pragma unroll
        for (int j = 0; j < 8; ++j) { s[j] += mk_shfl_xor(s[j], 16); s[j] += mk_shfl_xor(s[j], 32); }
        __syncthreads();
        if (F.lane < 16) {
#pragma unroll
            for (int j = 0; j < 8; ++j) part[F.wave * 128 + 8 * c + j] = s[j]; }
        __syncthreads();
        if (F.tid < 256) { const int uu = F.tid >> 7, d = F.tid & 127; const LAS float* pp = part + uu * 512 + d;
            km[(size_t)(2 * w + uu) * 128 + d] = ((pp[0] + pp[128]) + (pp[256] + pp[384])) * (1.f / 256.f); }
    }
    __syncthreads();
}
struct TokRec { int e0, e1, s0, s1; float w0, w1; int pad0, pad1; };
__device__ __forceinline__ void router_phase(Frame& F0, const Args& AR, int layer) {
    Frame F = relaunder(F0);
    typedef float f32x4r __attribute__((ext_vector_type(4)));
    const bf16* h = (const bf16*)(wsptr() + hb_off(layer));
    const bf16* WRH = (const bf16*)(wsptr() + WS_WR) + (size_t)layer * 48 * DM; const bf16* WRL = WRH + DEPTH * 48 * DM;
    float* rstd_o = (float*)(wsptr() + WS_RSTD); TokRec* rec = (TokRec*)(wsptr() + WS_TOKREC); gu32* cnt = ctlptr() + CW_CNT + layer * 32 * 64;
    int* list = (int*)(wsptr() + WS_LIST);
    constexpr int KC = 512, NCH = DM / KC, WB_BYTES = 96 * KC * 2;
    LAS float* lg = (LAS float*)(F.lds + WB_BYTES) + F.wave * (16 * 49);
    LAS int* lc = (LAS int*)(F.lds + WB_BYTES + 8 * (16 * 49) * 4);
    static_assert(WB_BYTES + 8 * 16 * 49 * 4 + 64 * 4 <= PHASE_LDS, "router LDS");
    const int row = F.lane & 15, kg = F.lane >> 4;
    constexpr int NTASK = M / 128;
    typedef __attribute__((address_space(3))) unsigned las_u32r;
#pragma unroll 1
    for (int tk = (int)blockIdx.x; tk < NTASK; tk += F.G) {
        if (F.tid < 32) lc[F.tid] = 0;
        const bf16* hp = h + (size_t)(128 * tk + 16 * F.wave + row) * DM + 8 * kg;
        f32x4r acc[3]; float ss = 0.f;
#pragma unroll
        for (int t = 0; t < 3; ++t) acc[t] = (f32x4r){0.f, 0.f, 0.f, 0.f};
        v4u hq[2][16];
#pragma unroll
        for (int s = 0; s < 16; ++s) hq[0][s] = *(const GAS v4u*)(hp + 32 * s);
#pragma unroll
        for (int c = 0; c < NCH; ++c) {
            __syncthreads();
#pragma unroll
            for (int q = 0; q < 9; ++q) { const int r72 = q * 8 + F.wave, rc = r72 < NROUTE ? r72 : r72 + (48 - NROUTE), n = rc < 48 ? rc : rc - 48; const bf16* src = (rc < 48 ? WRH : WRL) + (size_t)n * DM + c * KC;
                int ll = F.lane; asm volatile("" : "+v"(ll));
                __builtin_amdgcn_global_load_lds((const unsigned*)((const char*)src + ((ll ^ (n & 15)) << 4)), (las_u32r*)(F.lds + rc * (KC * 2)), 16, 0, 0); }
            asm volatile("s_waitcnt vmcnt(0)" ::: "memory");
            __syncthreads();
            if (c + 1 < NCH) {
#pragma unroll
                for (int s = 0; s < 16; ++s) hq[(c + 1) & 1][s] = *(const GAS v4u*)(hp + (c + 1) * KC + 32 * s); }
#pragma unroll
            for (int s = 0; s < 16; ++s) { const v4u q = hq[c & 1][s];
                const float a0 = __uint_as_float(q.x << 16), a1 = __uint_as_float(q.x & 0xffff0000u), a2 = __uint_as_float(q.y << 16), a3 = __uint_as_float(q.y & 0xffff0000u);
                const float a4 = __uint_as_float(q.z << 16), a5 = __uint_as_float(q.z & 0xffff0000u), a6 = __uint_as_float(q.w << 16), a7 = __uint_as_float(q.w & 0xffff0000u);
                ss += (a0 * a0 + a1 * a1) + (a2 * a2 + a3 * a3) + (a4 * a4 + a5 * a5) + (a6 * a6 + a7 * a7);
                const bf16x8 Ah = __builtin_bit_cast(bf16x8, q);
                const int piece = ((4 * s + kg) ^ row) << 4;
#pragma unroll
                for (int t = 0; t < 3; ++t) { const bf16x8 Bh = *(const LAS bf16x8*)(F.lds + (16 * t + row) * (KC * 2) + piece), Bl = *(const LAS bf16x8*)(F.lds + (48 + 16 * t + row) * (KC * 2) + piece);
                    acc[t] = __builtin_amdgcn_mfma_f32_16x16x32_bf16(Ah, Bh, acc[t], 0, 0, 0); acc[t] = __builtin_amdgcn_mfma_f32_16x16x32_bf16(Ah, Bl, acc[t], 0, 0, 0); } }
        }
        { float s2 = ss; s2 += mk_shfl_xor(s2, 16); s2 += mk_shfl_xor(s2, 32); if (kg == 0) lg[row * 49 + 48] = s2;
#pragma unroll
            for (int t = 0; t < 3; ++t)
#pragma unroll
                for (int i = 0; i < 4; ++i) lg[(4 * kg + i) * 49 + 16 * t + row] = acc[t][i]; }
        LDS_WAIT(); asm volatile("" ::: "memory");
        int e0 = 0, e1 = 0, sl0 = 0, sl1 = 0; float w0 = 0.f, w1 = 0.f, rs = 0.f;
        if (F.lane < 16) {
            const LAS float* lr = lg + F.lane * 49;
            const float rs_ = rsqrtf(lr[48] * (1.f / DM) + EPS);
            float gl[4];
#pragma unroll
            for (int i = 0; i < 4; ++i) gl[i] = lr[i] * rs_;
            int grp = 0; float gm = gl[0];
#pragma unroll
            for (int i = 1; i < 4; ++i) if (gl[i] > gm) { gm = gl[i]; grp = i; }
            float gs = 0.f;
#pragma unroll
            for (int i = 0; i < 4; ++i) gs += __expf(gl[i] - gm);
            const float gw_ = 1.f / gs;
            float el[8];
#pragma unroll
            for (int i = 0; i < 8; ++i) el[i] = lr[4 + grp * 8 + i] * rs_;
            int i1 = 0; float t1 = el[0];
#pragma unroll
            for (int i = 1; i < 8; ++i) if (el[i] > t1) { t1 = el[i]; i1 = i; }
            int i2 = -1; float t2 = -INFINITY;
#pragma unroll
            for (int i = 0; i < 8; ++i) if (i != i1 && el[i] > t2) { t2 = el[i]; i2 = i; }
            const float ex = __expf(t2 - t1), w0_ = gw_ / (1.f + ex), w1_ = gw_ * ex / (1.f + ex);
            e0 = grp * 8 + i1; e1 = grp * 8 + i2; w0 = w0_; w1 = w1_; rs = rs_;
            sl0 = __hip_atomic_fetch_add(lc + e0, 1, __ATOMIC_RELAXED, __HIP_MEMORY_SCOPE_WORKGROUP); sl1 = __hip_atomic_fetch_add(lc + e1, 1, __ATOMIC_RELAXED, __HIP_MEMORY_SCOPE_WORKGROUP);
        }
        LDS_WAIT(); asm volatile("" ::: "memory");
        __syncthreads();
        if (F.tid < 32) { const int c = lc[F.tid]; lc[32 + F.tid] = c > 0 ? (int)__hip_atomic_fetch_add(cnt + F.tid * 64, (unsigned)c, RLX_AGENT) : 0; }
        __syncthreads();
        if (F.lane < 16) { const int rowg = 128 * tk + 16 * F.wave + F.lane; const int s0 = lc[32 + e0] + sl0, s1 = lc[32 + e1] + sl1;
            TokRec t; t.e0 = e0; t.e1 = e1; t.s0 = s0; t.s1 = s1; t.w0 = w0; t.w1 = w1; t.pad0 = 0; t.pad1 = 0; rec[rowg] = t; rstd_o[rowg] = rs;
            list[e0 * 32768 + s0] = rowg; list[e1 * 32768 + s1] = rowg; float* srs = (float*)(wsptr() + WS_SRS); srs[e0 * 32768 + s0] = rs; srs[e1 * 32768 + s1] = rs; }
        __syncthreads();
    }
}
constexpr int PL_UNITS = (M / 256) * (DM / 256), PL_R = 5;
__device__ __forceinline__ int build_tiles(Frame& F0, int layer) {
    Frame F = relaunder(F0);
    gu32* cnt = ctlptr() + CW_CNT + layer * 32 * 64; LAS int* offs = (LAS int*)(F.lds + LDS_OFFS); LAS unsigned char* te = F.lds + LDS_TILE_E;
    __syncthreads();
    if (F.tid < NEXP) offs[40 + F.tid] = (int)__hip_atomic_load(cnt + F.tid * 64, RLX_AGENT);
    __syncthreads();
    if (F.tid == 0) { int acc = 0;
#pragma unroll 1
        for (int e = 0; e < NEXP; ++e) { const int c = offs[40 + e]; offs[e] = acc * 256; const int nt = (c + 255) >> 8; for (int t = 0; t < nt && acc + t < RPAD / 256; ++t) te[acc + t] = (unsigned char)e; acc += nt; }
        offs[32] = acc < RPAD / 256 ? acc : RPAD / 256;
        const int nTl = offs[32], per = F.G >> 3, x = (int)blockIdx.x & 7, s = (int)blockIdx.x >> 3; int gmax = 0;
#pragma unroll 1
        for (int xx = 0; xx < 8; ++xx) { int n = 0;
#pragma unroll 1
            for (int k = 0; k < 4; ++k) { const int e = xx + 8 * k; const int t0 = offs[e] >> 8, t1 = (e == 31) ? nTl : (offs[e + 1] >> 8); n += (t1 > t0 ? t1 - t0 : 0) * 4; }
            offs[72 + xx] = n; const int gh = (n + per - 1) / per; gmax = gh > gmax ? gh : gmax; }
        int Dtot = 0, Dbefore = 0, dme = 0, dpre = 0;
#pragma unroll 1
        for (int xx = 0; xx < 8; ++xx) { const int n = offs[72 + xx], gh = (n + per - 1) / per, r = n > 0 ? n - (gh - 1) * per : per; const int D = per * (gmax - gh) + (per - r);
            if (xx < x) Dbefore += D; Dtot += D;
            if (xx == x) { dme = (gmax - gh) + (s >= r ? 1 : 0); dpre = s * (gmax - gh) + (s > r ? s - r : 0); } }
        int base = (PL_UNITS - PL_R * Dtot + F.G - 1) / F.G; base = base > 0 ? base : 0;
        int start = PL_R * (Dbefore + dpre) + (x * per + s) * base, count = PL_R * dme + base;
        if ((F.G & 7) || per == 0) { start = (int)blockIdx.x * ((PL_UNITS + F.G - 1) / F.G); count = (PL_UNITS + F.G - 1) / F.G; }
        if (start > PL_UNITS) start = PL_UNITS; if (start + count > PL_UNITS) count = PL_UNITS - start;
        offs[33] = start; offs[34] = count; }
    __syncthreads();
    return offs[32];
}
struct ListOrder {
    static constexpr bool B_NT = false;
    int start, count;
    __device__ __forceinline__ bool next(int i, pg8::Unit& u) const { if (i >= count) return false; const int L = start + i; u.pm = L >> 3; u.pn = L & 7; return true; }
    __device__ __forceinline__ void a_ready(const pg8::Unit&) const {}
    __device__ __forceinline__ void done(const pg8::Unit&) const {}
};
__device__ __forceinline__ void combine_phase(Frame& F0, const Args& AR, int layer) {
#if MK_PER_PHASE
    (void)build_tiles(F0, layer);
#endif
    Frame F = relaunder(F0);
    const LAS int* offs = (const LAS int*)(F.lds + LDS_OFFS);
    bf16* hb = (bf16*)(wsptr() + hb_off(layer)); const TokRec* rec = (const TokRec*)(wsptr() + WS_TOKREC);
    const bf16* y = (const bf16*)(wsptr() + WS_Y); float* rsple = (float*)(wsptr() + WS_RSPLE);
    TokRec tn[2];
    if (F.gw < M / 2) {
#pragma unroll
        for (int r = 0; r < 2; ++r) tn[r] = rec[F.gw + r * (M / 2)]; }
    for (int m2 = F.gw; m2 < M / 2; m2 += F.NGW) {
        TokRec t[2]; int p0[2], p1[2];
#pragma unroll
        for (int r = 0; r < 2; ++r) t[r] = tn[r];
        if (m2 + F.NGW < M / 2) {
#pragma unroll
            for (int r = 0; r < 2; ++r) tn[r] = rec[m2 + F.NGW + r * (M / 2)]; }
#pragma unroll
        for (int r = 0; r < 2; ++r) { p0[r] = offs[t[r].e0] + t[r].s0; p1[r] = offs[t[r].e1] + t[r].s1; }
        v4u hq[2][4], ya[2][4], yb[2][4];
#pragma unroll
        for (int r = 0; r < 2; ++r) { const GAS v4u* xr = (const GAS v4u*)(hb + (size_t)(m2 + r * (M / 2)) * DM) + F.lane;
            const GAS v4u* y0 = (const GAS v4u*)(y + (size_t)p0[r] * DM) + F.lane; const GAS v4u* y1 = (const GAS v4u*)(y + (size_t)p1[r] * DM) + F.lane;
#pragma unroll
            for (int j = 0; j < 4; ++j) { hq[r][j] = xr[64 * j]; ya[r][j] = __builtin_nontemporal_load(y0 + 64 * j); yb[r][j] = __builtin_nontemporal_load(y1 + 64 * j); } }
#pragma unroll
        for (int r = 0; r < 2; ++r) { const int m = m2 + r * (M / 2); GAS v4u* xw = (GAS v4u*)(hb + (size_t)m * DM) + F.lane; float s = 0.f; const float w0 = t[r].w0, w1 = t[r].w1;
#pragma unroll
            for (int j = 0; j < 4; ++j) { const v4u q = hq[r][j], a = ya[r][j], b = yb[r][j]; v4u o;
#define CMB(QW, AW, BW, OW) do { const float lo_ = __uint_as_float((QW) << 16) + w0 * __uint_as_float((AW) << 16) + w1 * __uint_as_float((BW) << 16), hi_ = __uint_as_float((QW) & 0xffff0000u) + w0 * __uint_as_float((AW) & 0xffff0000u) + w1 * __uint_as_float((BW) & 0xffff0000u); \
                    OW = pk2rne(lo_, hi_); s += lo_ * lo_ + hi_ * hi_; } while (0)
                CMB(q.x, a.x, b.x, o.x); CMB(q.y, a.y, b.y, o.y); CMB(q.z, a.z, b.z, o.z); CMB(q.w, a.w, b.w, o.w);
#undef CMB
                xw[64 * j] = o; }
            s = wave_sum(s); if (F.lane == 0) rsple[m] = rsqrtf(s * (1.f / DM) + EPS); }
    }
}
__device__ __forceinline__ void endnorm_phase(Frame& F0, const Args& AR, int layer) {
    Frame F = relaunder(F0);
    const bf16* hb = (const bf16*)(wsptr() + hb_off(layer + 1));
    const bool last = layer + 1 >= DEPTH;
    float* rsin = (float*)(wsptr() + WS_RSIN);
    f32x4 g8[8];
#pragma unroll
    for (int j = 0; j < 8; ++j) g8[j] = last ? ((const GAS f32x4*)inptr(3) + F.lane)[64 * j] : (f32x4){0.f, 0.f, 0.f, 0.f};
    for (int m4 = F.gw; m4 < M / 4; m4 += F.NGW) {
        u32x2g q[4][8];
#pragma unroll
        for (int r = 0; r < 4; ++r) { const GAS u32x2g* xr = (const GAS u32x2g*)(hb + (size_t)(4 * m4 + r) * DM) + F.lane;
#pragma unroll
            for (int j = 0; j < 8; ++j) q[r][j] = last ? __builtin_nontemporal_load(xr + 64 * j) : xr[64 * j]; }
#pragma unroll
        for (int r = 0; r < 4; ++r) { const int m = 4 * m4 + r; float s = 0.f;
#pragma unroll
            for (int j = 0; j < 8; ++j) { const float a = __uint_as_float(q[r][j].x << 16), b = __uint_as_float(q[r][j].x & 0xffff0000u), c = __uint_as_float(q[r][j].y << 16), d = __uint_as_float(q[r][j].y & 0xffff0000u); s += (a * a + b * b) + (c * c + d * d); }
            const float rstd = rsqrtf(wave_sum(s) * (1.f / DM) + EPS);
            if (last) { GAS f32x4* o = (GAS f32x4*)(outptr() + (size_t)m * DM) + F.lane;
#pragma unroll
                for (int j = 0; j < 8; ++j) { const f32x4 v = (f32x4){__uint_as_float(q[r][j].x << 16), __uint_as_float(q[r][j].x & 0xffff0000u), __uint_as_float(q[r][j].y << 16), __uint_as_float(q[r][j].y & 0xffff0000u)}; __builtin_nontemporal_store(v * rstd * g8[j], o + 64 * j); } }
            else if (F.lane == 0) rsin[m] = rstd; }
    }
}
template <int MODE> __device__ __forceinline__ void attn_queue(Frame& F0, const att::AttnArgs& A, gu32* qbase, int& cc) {
    Frame F = relaunder(F0);
    volatile LAS int* mb = (volatile LAS int*)(F.lds + att::OFF_MISC);
    constexpr int NPER = (MODE == 2) ? 96 : (MODE == 1) ? 64 : 96;
    const int myx = (int)(xb_xcc_id() & 7u);
    const float lam = att::attn_mode_setup<MODE>(A, (char*)F.lds, F.wave);
#pragma unroll 1
    for (int xs = 0; xs < 8; ++xs) {
        const int x = (myx + xs) & 7;
        if (xs == 1) {
            __syncthreads();
            { const int t8 = mk_lane(); if (F.wave == 0 && t8 < 8) mb[32 + t8] = (int)__hip_atomic_load(qbase + t8 * 64, RLX_AGENT); }
            __syncthreads(); }
        if (xs >= 1 && mb[32 + x] >= NPER) continue;
        bool have = false;
        for (;;) {
            if (!have) { __syncthreads();
                if (F.tid == 0) mb[0] = (int)__hip_atomic_fetch_add(qbase + x * 64, 1u, RLX_AGENT);
                __syncthreads(); }
            have = false;
            const int idx = __builtin_amdgcn_readfirstlane(mb[0]);
            if (idx >= NPER) break;
            int b, hh, qb;
            if (MODE == 2) { const int p = (idx % 6) * 8 + x; b = p / 6; hh = p % 6; qb = 15 - idx / 6; }
            else if (MODE == 1) { const int p = (idx & 3) * 8 + x; b = p >> 2; hh = p & 3; qb = 15 - (idx >> 2); }
            else { const int kvp = (idx / 48) * 8 + x, r = idx % 48; b = kvp >> 1; hh = (kvp & 1) * 3 + r % 3; qb = r / 3; }
            att::attn_unit<MODE>(A, b, hh, qb, (char*)F.lds, F.wave, lam);
            if (cc < CONV_NCH) { conv_chunk(F0, A.layer, cc, qbase + x * 64); ++cc; have = true; }
        }
    }
}
__device__ __forceinline__ att::AttnArgs make_attn_args(int layer) { att::AttnArgs A{}; A.layer = layer; A.lambda_init = 0.8f - 0.6f * __expf(-0.3f * (float)layer); return A; }
static_assert(NROUTE == 36 && 2 * NROUTE == 72, "router staging: 72 row chunks over 8 waves");
static_assert(att::ATT_WS_KP == WS_PL && KB_OFF % 256 == 0 && SEQ % 256 == 0 && SEQ / 256 == 16, "block means from the projection epilogue");
static_assert(att::ATT_WS_PROJ == WS_PROJ && att::ATT_WS_YCAT == WS_YCAT && att::ATT_WS_KMEAN == WS_KMEAN, "attention body's workspace offsets");

#ifndef MK_PH_MASK
#define MK_PH_MASK 0xFFFFFFFFu
#endif
#ifndef MK_ATT_MASK
#define MK_ATT_MASK 7
#endif
#define ATM(k) ((MK_ATT_MASK >> (k)) & 1)
#define PHM(k) ((MK_PH_MASK >> (k)) & 1u)
constexpr int NPH_LAYER = 11, NPHASES = 1 + DEPTH * NPH_LAYER;
__global__ void __launch_bounds__(NWAVES * 64, 2) mk_fwd(Args args) {
    extern __shared__ __attribute__((aligned(16))) unsigned char lds[];
    Frame F;
    F.lds = (LAS unsigned char*)lds; F.MISC = (volatile LAS unsigned*)(F.lds + LDS_MISC);
    F.wave = __builtin_amdgcn_readfirstlane((int)threadIdx.x >> 6); F.lane = mk_lane(); F.tid = F.wave * 64 + F.lane; F.G = gridDim.x;
    F.gw = blockIdx.x * NWAVES + F.wave; F.NGW = F.G * NWAVES;
    for (int u = F.tid; u < (LDS_BYTES - LDSCTL_OFF) / 4; u += NWAVES * 64) ((LAS unsigned*)(F.lds + LDSCTL_OFF))[u] = 0u;
    __syncthreads();
    XcdBarrier bar; bar.bar = (unsigned*)(ctlptr() + CW_BAR); bar.x = 0; bar.st = nullptr;
    if (args.use_bar) bar = xcd_barrier_post((unsigned*)(ctlptr() + CW_BAR), F.MISC + 8);
    const int lo = args.ph_lo, hi = args.ph_hi;
#define IN(k) (lo <= (k) && (k) < hi)
#define SEAM(k) do { if (IN(k) && IN((k) + 1)) xcd_barrier(bar); } while (0)
    if (PHM(0) && IN(0)) { p0_prologue(F, args); } SEAM(0);
#pragma unroll 1
    for (int layer = 0; layer < DEPTH; ++layer) {
        const int pb = 1 + layer * NPH_LAYER;
        const bool fuse_norm = (F.G == 256);
        if (PHM(1) && IN(pb + 0)) { pg8::Gemm g{(const bf16*)(wsptr() + hb_off(layer)), (const bf16*)(wsptr() + WS_WIN) + (size_t)layer * NIN * DM, M, NIN, DM}; pg8::StaticOrder S; S.init(M, NIN, F.G, (int)blockIdx.x);
            rsin_table(F, S, fuse_norm && layer > 0);
            pg8::EpiProj E{(bf16*)(wsptr() + WS_PROJ), NIN, (const LAS int*)(F.lds + LDS_RSTAB), (const LAS float*)(F.lds + LDS_RSVAL), (float*)(wsptr() + WS_PL), KB_OFF / 256, att::ATT_KP_N, (const float*)(wsptr() + WS_RSIN)};
            pg8::gemm_phase<pg8::EpiProj, pg8::StaticOrder, true, true>(F.lds, g, S, E, F.wave);
            }
        SEAM(pb + 0);
        if (PHM(3) && IN(pb + 2)) { const att::AttnArgs A = make_attn_args(layer);
            int cc = 0;
            if (ATM(2)) attn_queue<2>(F, A, ctlptr() + CW_Q + ((layer * 3 + 0) * 8) * 64, cc);
            if (ATM(1)) attn_queue<1>(F, A, ctlptr() + CW_Q + ((layer * 3 + 1) * 8) * 64, cc);
            if (ATM(0)) attn_queue<0>(F, A, ctlptr() + CW_Q + ((layer * 3 + 2) * 8) * 64, cc);
#pragma unroll 1
            for (; cc < CONV_NCH; ++cc) conv_chunk(F, layer, cc);
            }
        SEAM(pb + 2);
        if (PHM(4) && IN(pb + 3)) { pg8::Gemm g{(const bf16*)(wsptr() + WS_YCAT), (const bf16*)(wsptr() + WS_WOUT) + (size_t)layer * DM * DM, M, DM, DM}; pg8::StaticOrder S; S.init(M, DM, F.G, (int)blockIdx.x);
            pg8::EpiRes E{(bf16*)(wsptr() + hb_off(layer)), DM};
            pg8::gemm_phase<pg8::EpiRes, pg8::StaticOrder, true, true>(F.lds, g, S, E, F.wave); }
        SEAM(pb + 3);
        if (PHM(5) && IN(pb + 4)) router_phase(F, args, layer);
        SEAM(pb + 4);
        if (PHM(7) && IN(pb + 6)) { const int nT = build_tiles(F, layer);
            pg8::Gemm g{(const bf16*)(wsptr() + hb_off(layer)), (const bf16*)(wsptr() + WS_W13), M, NEXP * 1024, DM};
            pg8::GroupedOrder S{(const LAS unsigned char*)(F.lds + LDS_TILE_E), nT, 4, F.G, (int)blockIdx.x, (const int*)(wsptr() + WS_LIST), (const LAS int*)(F.lds + LDS_OFFS), (const LAS int*)(F.lds + 131072)};
            { LAS int* lt = (LAS int*)(F.lds + 131072); pg8::Unit u;
              const int t_ = F.wave * 64 + mk_lane();
#pragma unroll 1
              for (int i = 0; i < pg8::GroupedOrder::LTAB_UNITS && S.next(i, u); ++i) if (t_ < 256) { const int e = u.pn / 4; lt[i * 256 + t_] = ((const int*)(wsptr() + WS_LIST))[e * 32768 + (u.pm * 256 - ((const LAS int*)(F.lds + LDS_OFFS))[e]) + t_]; }
              __syncthreads(); }
            pg8::EpiSiluMul E{(bf16*)(wsptr() + WS_HID), DEXP, (const int*)(wsptr() + WS_LIST), (const LAS int*)(F.lds + LDS_OFFS), (const float*)(wsptr() + WS_SRS)};
            pg8::gemm_phase<pg8::EpiSiluMul, pg8::GroupedOrder, true, true, true>(F.lds, g, S, E, F.wave);
            { const LAS int* offs = (const LAS int*)(F.lds + LDS_OFFS); ListOrder S2{offs[33], offs[34]};
              pg8::Gemm g2{(const bf16*)(wsptr() + WS_PB) + (size_t)layer * M * PLE, (const bf16*)(wsptr() + WS_WP) + (size_t)layer * DM * PLE, M, DM, opaque_i(PLE)};
              pg8::EpiBf16<0> E2{(bf16*)(wsptr() + WS_PL), DM, nullptr, 0, 0, 1.f, nullptr, 1};
              pg8::gemm_phase<pg8::EpiBf16<0>, ListOrder, true, true>(F.lds, g2, S2, E2, F.wave); }
            }
        SEAM(pb + 6);
        if (PHM(8) && IN(pb + 7)) {
#if MK_PER_PHASE
            (void)build_tiles(F, layer);
#endif
            const int nT = ((const LAS int*)(F.lds + LDS_OFFS))[32];
            pg8::Gemm g{(const bf16*)(wsptr() + WS_HID), (const bf16*)(wsptr() + WS_W2), RPAD, NEXP * DM, DEXP};
            pg8::GroupedOrder S{(const LAS unsigned char*)(F.lds + LDS_TILE_E), nT, 8, F.G, (int)blockIdx.x, nullptr, (const LAS int*)(F.lds + LDS_OFFS), nullptr};
            pg8::EpiBf16<0> E{(bf16*)(wsptr() + WS_Y), DM, nullptr, DM, 0, 1.f, nullptr, 1};
            pg8::gemm_phase<pg8::EpiBf16<0>, pg8::GroupedOrder, true, true>(F.lds, g, S, E, F.wave);
            }
        SEAM(pb + 7);
        if (PHM(9) && IN(pb + 8)) combine_phase(F, args, layer);
        SEAM(pb + 8);
        if (PHM(10) && IN(pb + 9)) { pg8::Gemm g{(const bf16*)(wsptr() + hb_off(layer)), (const bf16*)(wsptr() + WS_WG) + (size_t)layer * DM * DM, M, DM, DM}; pg8::StaticOrder S; S.init(M, DM, F.G, (int)blockIdx.x);
            pg8::EpiGate E{(const bf16*)(wsptr() + hb_off(layer)), (bf16*)(wsptr() + hb_off(layer + 1)), (const bf16*)(wsptr() + WS_PL), (const float*)(wsptr() + WS_RSPLE), DM, (fuse_norm && layer + 1 < DEPTH) ? (float*)(wsptr() + WS_SSQ) : nullptr};
            pg8::gemm_phase<pg8::EpiGate, pg8::StaticOrder, true, true>(F.lds, g, S, E, F.wave); }
        SEAM(pb + 9);
        if (!(fuse_norm && layer + 1 < DEPTH)) { if (PHM(11) && IN(pb + 10)) endnorm_phase(F, args, layer);
        SEAM(pb + 10); }
    }
#undef IN
#undef SEAM
}

extern "C" void kernel_launch(void* const* d_in, const int* in_sizes, int n_in, void* d_out, int out_size, void* d_ws, size_t ws_size, hipStream_t stream) {
    static int grid = 0;
    if (grid == 0) {
        if (n_in != 22 || in_sizes[0] != M * DM || out_size != M * DM || ws_size < WS_END) { fprintf(stderr, "kernel_launch: shape mismatch (n_in %d, in0 %d, out %d, ws %zu < %zu); nothing launched\n", n_in, n_in > 0 ? in_sizes[0] : -1, out_size, ws_size, (size_t)WS_END); grid = -1; return; }
        int dev = 0, cus = 0, per_cu = 0;
        if (hipGetDevice(&dev) != hipSuccess || hipDeviceGetAttribute(&cus, hipDeviceAttributeMultiprocessorCount, dev) != hipSuccess) { grid = -1; return; }
        if (hipFuncSetAttribute((const void*)mk_fwd, hipFuncAttributeMaxDynamicSharedMemorySize, LDS_BYTES) != hipSuccess) { fprintf(stderr, "kernel_launch: hipFuncSetAttribute failed\n"); grid = -1; return; }
        if (hipOccupancyMaxActiveBlocksPerMultiprocessor(&per_cu, (const void*)mk_fwd, NWAVES * 64, LDS_BYTES) != hipSuccess || per_cu < 1) { fprintf(stderr, "kernel_launch: occupancy query says %d blocks per CU\n", per_cu); }
        (void)hipGetLastError();
        grid = cus;
    }
    if (grid < 0) return;
    if (hipMemsetAsync((char*)d_ws + WS_CTL, 0, CTL_ZERO_BYTES, stream) != hipSuccess) return;
    Args a{};
    for (int i = 0; i < 22; ++i) a.in[i] = (const float*)d_in[i];
    a.out = (float*)d_out; a.ws = (unsigned char*)d_ws;
#if MK_PER_PHASE
    a.use_bar = 0;
    for (int ph = 0; ph < NPHASES; ++ph) {
        const int layer = ph > 0 ? (ph - 1) / NPH_LAYER : -1, k = ph > 0 ? (ph - 1) % NPH_LAYER : -1;
        a.ph_lo = ph; a.ph_hi = ph + 1;
        hipLaunchKernelGGL(mk_fwd, dim3(grid), dim3(NWAVES * 64), LDS_BYTES, stream, a);
    }
#else
    a.use_bar = 1; a.ph_lo = 0; a.ph_hi = NPHASES;
    hipLaunchKernelGGL(mk_fwd, dim3(grid), dim3(NWAVES * 64), LDS_BYTES, stream, a);
#endif
    const hipError_t le = hipPeekAtLastError();
    if (le != hipSuccess) fprintf(stderr, "kernel_launch: launch failed: %s\n", hipGetErrorName(le));
}
```

```cpp
#include <hip/hip_runtime.h>
#include <hip/hip_bf16.h>
#include <cstdio>
#include <cstdint>
#include <cmath>
#ifndef MK_PER_PHASE
#define MK_PER_PHASE 0
#endif
__device__ __forceinline__ int mk_lane() { unsigned m = ~0u; asm volatile("" : "+s"(m)); return (int)__builtin_amdgcn_mbcnt_hi(m, __builtin_amdgcn_mbcnt_lo(m, 0u)); }
__device__ __forceinline__ float mk_shfl_xor_l(float v, int o, int l) { return __uint_as_float((unsigned)__builtin_amdgcn_ds_bpermute((l ^ o) << 2, (int)__float_as_uint(v))); }
__device__ __forceinline__ float mk_shfl_xor(float v, int o) { return mk_shfl_xor_l(v, o, mk_lane()); }
#define CAS __attribute__((address_space(4)))
__device__ __forceinline__ const CAS char* kargs() { const CAS char* kp = (const CAS char*)__builtin_amdgcn_kernarg_segment_ptr(); asm volatile("" : "+s"(kp)); return kp; }
__device__ __forceinline__ const float* inptr(int k) { return *(const float* const CAS*)(kargs() + 8 * k); }
__device__ __forceinline__ float* outptr() { return *(float* const CAS*)(kargs() + 176); }
__device__ __forceinline__ unsigned char* wsptr() { return *(unsigned char* const CAS*)(kargs() + 184); }
namespace pg8 {
#define PG8_LAS __attribute__((address_space(3)))
typedef unsigned short bf16_t;
typedef short bf16x8 __attribute__((ext_vector_type(8)));
typedef float f32x4 __attribute__((ext_vector_type(4)));
typedef unsigned u32x4 __attribute__((ext_vector_type(4)));
constexpr int BM = 256, BK = 64, HALF = 128, HTB = HALF * BK * 2  , STAGE_BYTES = 8 * HTB, NXCD = 8, WGM = 8;

__host__ __device__ __forceinline__ int lds_byte(int r, int c) { const int st = (r >> 4) * 2 + (c >> 5), rr = r & 15, cc = c & 31, ob = rr * 64 + cc * 2; return st * 1024 + (ob ^ (((ob >> 9) & 1) << 5)); }
__host__ __device__ __forceinline__ void stage_rc(int b, int& R, int& C) { const int st = b / 1024, sb = b % 1024, swz = sb ^ (((sb >> 9) & 1) << 5); R = (st >> 1) * 16 + swz / 64; C = (st & 1) * 32 + (swz % 64) / 2; }
__host__ __device__ __forceinline__ int perm32(int rho) { const int n = rho >> 4, i = rho & 15; return 8 * (i >> 2) + 4 * n + (i & 3); }

struct Unit { int pm, pn; };
struct Gemm { const bf16_t* A; const bf16_t* Bt; int M, N, K; };

struct StaticOrder {
    static constexpr bool B_NT = false;
    int nM, nN, nwg, G, c;
    __host__ __device__ void init(int M, int N, int G_, int c_) { nM = M / BM; nN = N / BM; nwg = nM * nN; G = G_; c = c_; }
    __host__ __device__ bool next(int i, Unit& u) const {
        const long L = (long)i * G + c; if (L >= nwg) return false;
        int wgid = (int)L; { const int q = nwg / NXCD, r = nwg % NXCD, xcd = wgid % NXCD, off = wgid / NXCD; wgid = (xcd < r ? xcd * (q + 1) : r * (q + 1) + (xcd - r) * q) + off; }
        const int nig = WGM * nN, gid = wgid / nig, fm = gid * WGM, gsz = (nM - fm) < WGM ? (nM - fm) : WGM;
        u.pm = fm + ((wgid % nig) % gsz); u.pn = (wgid % nig) / gsz; return true;
    }
    __device__ __forceinline__ void a_ready(const Unit&) const {}
    __device__ __forceinline__ void done(const Unit&) const {}
    __device__ __forceinline__ int row_tok(const Unit&, int) const { return 0; }
};

__device__ __forceinline__ unsigned cvt_pk_bf16(float lo, float hi) { unsigned r; asm volatile("v_cvt_pk_bf16_f32 %0, %1, %2" : "=v"(r) : "v"(lo), "v"(hi)); return r; }
typedef float f32x2 __attribute__((ext_vector_type(2)));
template <int ACT  > struct EpiBf16 {
    static constexpr bool PERM = true, AFTER_DRAIN = false, PROBE = false; static_assert(ACT == 0 || ACT == 1, "EpiBf16: ACT is 0 (none) or 1 (gelu_pk)");
    bf16_t* O; int ldc; const float* bias; int split_cols; size_t split_stride; float scale0; const float* rowscale; int nt;
    __device__ __forceinline__ void operator()(const f32x4 (&acc)[2][2][4][2], const Unit& u, int wr, int wc, int fr, int fq) const {
        const int row0 = u.pm * BM + wr * 64 + fr; int colt = u.pn * BM; bf16_t* base = O;
        float sc = 1.f; if (split_cols) { const int t = colt / split_cols; base += (size_t)t * split_stride; colt -= t * split_cols; if (t == 0) sc = scale0; }
        const int col0 = colt + wc * 32 + 8 * fq, bcol0 = u.pn * BM + wc * 32 + 8 * fq;
        f32x4 bv[2][2];
#pragma unroll
        for (int bj = 0; bj < 2; ++bj)
#pragma unroll
            for (int n = 0; n < 2; ++n) bv[bj][n] = bias ? *(const f32x4*)(bias + bcol0 + bj * HALF + 4 * n) : (f32x4){0.f, 0.f, 0.f, 0.f};
#pragma unroll
        for (int ai = 0; ai < 2; ++ai)
#pragma unroll
            for (int m = 0; m < 4; ++m) { bf16_t* rowp = base + (size_t)(row0 + ai * HALF + m * 16) * ldc + col0; const float rsc = rowscale ? rowscale[row0 + ai * HALF + m * 16] * sc : sc;
#pragma unroll
                for (int bj = 0; bj < 2; ++bj) { f32x4 v0 = acc[ai][bj][m][0] + bv[bj][0], v1 = acc[ai][bj][m][1] + bv[bj][1];
                    v0 = v0 * rsc; v1 = v1 * rsc; u32x4 w; w.x = cvt_pk_bf16(v0[0], v0[1]); w.y = cvt_pk_bf16(v0[2], v0[3]); w.z = cvt_pk_bf16(v1[0], v1[1]); w.w = cvt_pk_bf16(v1[2], v1[3]);
                    if (nt) __builtin_nontemporal_store(w, (u32x4*)(rowp + bj * HALF)); else *(u32x4*)(rowp + bj * HALF) = w; } }
    }
};

__device__ __forceinline__ float bflo(unsigned w) { return __uint_as_float(w << 16); }
__device__ __forceinline__ float bfhi(unsigned w) { return __uint_as_float(w & 0xffff0000u); }
struct EpiRes {
    static constexpr bool PERM = true, AFTER_DRAIN = false, PROBE = true;
    bf16_t* hb; int ldc;
    __device__ __forceinline__ void operator()(const f32x4 (&acc)[2][2][4][2], const Unit& u, int wr, int wc, int fr, int fq) const {
        const int row0 = u.pm * BM + wr * 64 + fr, col0 = u.pn * BM + wc * 32 + 8 * fq;
        u32x4 q[2][4][2];
#pragma unroll
        for (int ai = 0; ai < 2; ++ai)
#pragma unroll
            for (int m = 0; m < 4; ++m)
#pragma unroll
                for (int bj = 0; bj < 2; ++bj) q[ai][m][bj] = *(const u32x4*)(hb + (size_t)(row0 + ai * HALF + m * 16) * ldc + col0 + bj * HALF);
#pragma unroll
        for (int ai = 0; ai < 2; ++ai)
#pragma unroll
            for (int m = 0; m < 4; ++m)
#pragma unroll
                for (int bj = 0; bj < 2; ++bj) { const u32x4 qq = q[ai][m][bj]; const f32x4 a0 = acc[ai][bj][m][0], a1 = acc[ai][bj][m][1];
                    u32x4 w; w.x = cvt_pk_bf16(bflo(qq.x) + a0[0], bfhi(qq.x) + a0[1]); w.y = cvt_pk_bf16(bflo(qq.y) + a0[2], bfhi(qq.y) + a0[3]); w.z = cvt_pk_bf16(bflo(qq.z) + a1[0], bfhi(qq.z) + a1[1]); w.w = cvt_pk_bf16(bflo(qq.w) + a1[2], bfhi(qq.w) + a1[3]);
                    *(u32x4*)(hb + (size_t)(row0 + ai * HALF + m * 16) * ldc + col0 + bj * HALF) = w; }
    }
};
__device__ __forceinline__ float sigmoidf_(float a) { return __builtin_amdgcn_rcpf(1.0f + __builtin_amdgcn_exp2f(-1.4426950408889634f * a)); }
struct EpiSiluMul {
    static constexpr bool PERM = true, AFTER_DRAIN = false, PROBE = false;
    bf16_t* O; int ldc; const int* list; const PG8_LAS int* offs; const float* rstd;
    __device__ __forceinline__ void operator()(const f32x4 (&acc)[2][2][4][2], const Unit& u, int wr, int wc, int fr, int fq) const {
        const int row0 = u.pm * BM + wr * 64 + fr, col0 = (u.pn & 3) * HALF + wc * 32 + 8 * fq;
        const int e = u.pn >> 2; const float* lp = rstd + e * 32768 + (u.pm * BM - offs[e]) + wr * 64 + fr;
        float rsv[2][4];
#pragma unroll
        for (int ai = 0; ai < 2; ++ai)
#pragma unroll
            for (int m = 0; m < 4; ++m) rsv[ai][m] = lp[ai * HALF + m * 16];
#pragma unroll
        for (int ai = 0; ai < 2; ++ai)
#pragma unroll
            for (int m = 0; m < 4; ++m) { bf16_t* rowp = O + (size_t)(row0 + ai * HALF + m * 16) * ldc + col0;
                const float rs = rsv[ai][m];
                f32x4 v0, v1;
#pragma unroll
                for (int i = 0; i < 4; ++i) { const float a0 = acc[ai][0][m][0][i] * rs, a1 = acc[ai][0][m][1][i] * rs;
                    v0[i] = a0 * sigmoidf_(a0) * (acc[ai][1][m][0][i] * rs); v1[i] = a1 * sigmoidf_(a1) * (acc[ai][1][m][1][i] * rs); }
                u32x4 w; w.x = cvt_pk_bf16(v0[0], v0[1]); w.y = cvt_pk_bf16(v0[2], v0[3]); w.z = cvt_pk_bf16(v1[0], v1[1]); w.w = cvt_pk_bf16(v1[2], v1[3]);
                *(u32x4*)rowp = w; }
    }
};
struct EpiGate {
    static constexpr bool PERM = true, AFTER_DRAIN = false, PROBE = false;
    const bf16_t* hin; bf16_t* hout; const bf16_t* PL; const float* rs; int ldc; float* part;
    __device__ __forceinline__ void operator()(const f32x4 (&acc)[2][2][4][2], const Unit& u, int wr, int wc, int fr, int fq) const {
        const int row0 = u.pm * BM + wr * 64 + fr, col0 = u.pn * BM + wc * 32 + 8 * fq;
#pragma unroll
        for (int ai = 0; ai < 2; ++ai) { u32x4 q[4][2], p[4][2]; float r_[4], ss[4];
#pragma unroll
            for (int m = 0; m < 4; ++m) { r_[m] = rs[row0 + ai * HALF + m * 16];
#pragma unroll
                for (int bj = 0; bj < 2; ++bj) { const size_t off = (size_t)(row0 + ai * HALF + m * 16) * ldc + col0 + bj * HALF; q[m][bj] = __builtin_nontemporal_load((const u32x4*)(hin + off)); p[m][bj] = __builtin_nontemporal_load((const u32x4*)(PL + off)); } }
#pragma unroll
            for (int m = 0; m < 4; ++m) { float s = 0.f;
#pragma unroll
                for (int bj = 0; bj < 2; ++bj) { const u32x4 qq = q[m][bj], pp = p[m][bj]; const f32x4 a0 = acc[ai][bj][m][0] * r_[m], a1 = acc[ai][bj][m][1] * r_[m];
                    const float v0 = bflo(qq.x) + sigmoidf_(a0[0]) * bflo(pp.x), v1 = bfhi(qq.x) + sigmoidf_(a0[1]) * bfhi(pp.x), v2 = bflo(qq.y) + sigmoidf_(a0[2]) * bflo(pp.y), v3 = bfhi(qq.y) + sigmoidf_(a0[3]) * bfhi(pp.y);
                    const float v4 = bflo(qq.z) + sigmoidf_(a1[0]) * bflo(pp.z), v5 = bfhi(qq.z) + sigmoidf_(a1[1]) * bfhi(pp.z), v6 = bflo(qq.w) + sigmoidf_(a1[2]) * bflo(pp.w), v7 = bfhi(qq.w) + sigmoidf_(a1[3]) * bfhi(pp.w);
                    u32x4 w; w.x = cvt_pk_bf16(v0, v1); w.y = cvt_pk_bf16(v2, v3); w.z = cvt_pk_bf16(v4, v5); w.w = cvt_pk_bf16(v6, v7);
                    s += ((v0 * v0 + v1 * v1) + (v2 * v2 + v3 * v3)) + ((v4 * v4 + v5 * v5) + (v6 * v6 + v7 * v7));
                    *(u32x4*)(hout + (size_t)(row0 + ai * HALF + m * 16) * ldc + col0 + bj * HALF) = w; }
                ss[m] = s; }
            if (part) { const int l = mk_lane();
#pragma unroll
                for (int m = 0; m < 4; ++m) { float s = ss[m]; s += mk_shfl_xor_l(s, 16, l); s += mk_shfl_xor_l(s, 32, l);
                    if (fq == 0) part[(size_t)(row0 + ai * HALF + m * 16) * 32 + 4 * u.pn + wc] = s; } }
            asm volatile("" ::: "memory"); }
    }
};
__device__ __forceinline__ float row_sum16(float v) {
    v += __int_as_float(__builtin_amdgcn_update_dpp(0, __float_as_int(v), 0x128, 0xf, 0xf, false));
    v += __int_as_float(__builtin_amdgcn_update_dpp(0, __float_as_int(v), 0x124, 0xf, 0xf, false));
    v += __int_as_float(__builtin_amdgcn_update_dpp(0, __float_as_int(v), 0x122, 0xf, 0xf, false));
    v += __int_as_float(__builtin_amdgcn_update_dpp(0, __float_as_int(v), 0x121, 0xf, 0xf, false));
    return v;
}
struct EpiProj {
    static constexpr bool PERM = true, AFTER_DRAIN = false, PROBE = false;
    bf16_t* O; int ldc; const PG8_LAS int* tab; const PG8_LAS float* rs; float* kp; int kt0, kpn; const float* rsg;
    __device__ __forceinline__ void operator()(const f32x4 (&acc)[2][2][4][2], const Unit& u, int wr, int wc, int fr, int fq) const {
        const int row0 = u.pm * BM + wr * 64 + fr, col0 = u.pn * BM + wc * 32 + 8 * fq;
        int s = -1;
#pragma unroll
        for (int k = 0; k < 4; ++k) s = (tab[k] == u.pm) ? k : s;
        s = __builtin_amdgcn_readfirstlane(s);
        float rsv[2][4];
        if (s >= 0) { const PG8_LAS float* r = rs + s * 256 + wr * 64 + fr;
#pragma unroll
            for (int ai = 0; ai < 2; ++ai)
#pragma unroll
                for (int m = 0; m < 4; ++m) rsv[ai][m] = r[ai * HALF + m * 16]; }
        else { const float* rg = rsg + row0;
#pragma unroll
            for (int ai = 0; ai < 2; ++ai)
#pragma unroll
                for (int m = 0; m < 4; ++m) { rsv[ai][m] = rg[ai * HALF + m * 16]; asm volatile("" : "+v"(rsv[ai][m])); } }
        if (u.pn == kt0 || u.pn == kt0 + 1) {
            float cs[2][8];
#pragma unroll
            for (int bj = 0; bj < 2; ++bj)
#pragma unroll
                for (int i = 0; i < 8; ++i) cs[bj][i] = 0.f;
#pragma unroll
            for (int ai = 0; ai < 2; ++ai)
#pragma unroll
                for (int m = 0; m < 4; ++m) { bf16_t* rowp = O + (size_t)(row0 + ai * HALF + m * 16) * ldc + col0; const float rsc = rsv[ai][m];
#pragma unroll
                    for (int bj = 0; bj < 2; ++bj) { const f32x4 v0 = acc[ai][bj][m][0] * rsc, v1 = acc[ai][bj][m][1] * rsc;
                        u32x4 w; w.x = cvt_pk_bf16(v0[0], v0[1]); w.y = cvt_pk_bf16(v0[2], v0[3]); w.z = cvt_pk_bf16(v1[0], v1[1]); w.w = cvt_pk_bf16(v1[2], v1[3]);
                        cs[bj][0] += bflo(w.x); cs[bj][1] += bfhi(w.x); cs[bj][2] += bflo(w.y); cs[bj][3] += bfhi(w.y); cs[bj][4] += bflo(w.z); cs[bj][5] += bfhi(w.z); cs[bj][6] += bflo(w.w); cs[bj][7] += bfhi(w.w);
                        *(u32x4*)(rowp + bj * HALF) = w; } }
#pragma unroll
            for (int bj = 0; bj < 2; ++bj) { f32x4 a, b;
#pragma unroll
                for (int i = 0; i < 4; ++i) { a[i] = row_sum16(cs[bj][i]); b[i] = row_sum16(cs[bj][4 + i]); }
                if (fr == 0) { float* dp = kp + (size_t)wr * kpn + (size_t)((((u.pm >> 4) * 4 + (u.pn - kt0) * 2 + bj) * 16 + (u.pm & 15)) * 128 + wc * 32 + 8 * fq); *(f32x4*)dp = a; *(f32x4*)(dp + 4) = b; } }
            return;
        }
#pragma unroll
        for (int ai = 0; ai < 2; ++ai)
#pragma unroll
            for (int m = 0; m < 4; ++m) { bf16_t* rowp = O + (size_t)(row0 + ai * HALF + m * 16) * ldc + col0; const float rsc = rsv[ai][m];
#pragma unroll
                for (int bj = 0; bj < 2; ++bj) { const f32x4 v0 = acc[ai][bj][m][0] * rsc, v1 = acc[ai][bj][m][1] * rsc;
                    u32x4 w; w.x = cvt_pk_bf16(v0[0], v0[1]); w.y = cvt_pk_bf16(v0[2], v0[3]); w.z = cvt_pk_bf16(v1[0], v1[1]); w.w = cvt_pk_bf16(v1[2], v1[3]);
                    *(u32x4*)(rowp + bj * HALF) = w; } }
    }
};
struct GroupedOrder {
    static constexpr bool B_NT = false;
    const PG8_LAS unsigned char* tile_e; int nTiles, nN, G, c;
    const int* list; const PG8_LAS int* offs;
    __device__ __forceinline__ bool next(int i, Unit& u) const {
        const int x = c & 7, slot = c >> 3, per = G >> 3; int L = i * per + slot;
#pragma unroll
        for (int k = 0; k < 4; ++k) { const int e = x + 8 * k; const int t0 = offs[e] >> 8, t1 = (e == 31) ? nTiles : (offs[e + 1] >> 8); const int n = (t1 - t0) * nN;
            if (L < n) { u.pm = __builtin_amdgcn_readfirstlane(t0 + L / nN); u.pn = __builtin_amdgcn_readfirstlane(e * nN + L % nN); return true; }
            L -= n; }
        return false;
    }
    __device__ __forceinline__ void a_ready(const Unit&) const {}
    __device__ __forceinline__ void done(const Unit&) const {}
    static constexpr int LTAB_UNITS = 8;
    const PG8_LAS int* ltab;
    __device__ __forceinline__ int row_tok(const Unit& u, int r, int ord) const { if (ltab != nullptr && ord < LTAB_UNITS) return ltab[ord * 256 + r]; const int e = u.pn / nN; int v = list[e * 32768 + (u.pm * BM - offs[e]) + r];
        asm volatile("" : "+v"(v)); return v; }
};
template <class Epi, class Sched, bool ALIGN_EPI = false, bool SP2 = false, bool GATHER = false>
__device__ __forceinline__ void gemm_phase(PG8_LAS unsigned char* lds, const Gemm g, const Sched& S, const Epi& E, const int wave_idx) {
    int wid_o = wave_idx; asm volatile("" : "+s"(wid_o));
    const int tid = wid_o * 64 + mk_lane(), wid = wid_o    , lane = tid & 63, wr = wid >> 2, wc = wid & 3, fr = lane & 15, fq = lane >> 4;
    const int K = g.K, nt = K / BK;
    unsigned voffA[2], voffB[2];
#pragma unroll
    for (int i = 0; i < 2; ++i) { int R, C; stage_rc(tid * 16 + i * 8192, R, C); const int Rb = Epi::PERM ? ((R & ~31) + perm32(R & 31)) : R;
        voffA[i] = (unsigned)(R * K + C) * 2u; voffB[i] = (unsigned)(Rb * K + C) * 2u; }
    const size_t kstep = (size_t)(BK * 2);
    const size_t hstep = (size_t)HALF * K * 2;
    const size_t tstep = 2 * hstep;
    const unsigned ldsw = (unsigned)wid * 1024u;
    const int aoff = lds_byte(wr * 64 + fr, fq * 8), boff = lds_byte(wc * 32 + fr, fq * 8);
#define PG8_SA(b, h) (((b) * 2 + (h)) * HTB)
#define PG8_SB(b, h) ((4 + (b) * 2 + (h)) * HTB)
#define PG8_STAGE(bufoff, gbase, voff) do { _Pragma("unroll") for (int _i = 0; _i < 2; ++_i) \
        __builtin_amdgcn_global_load_lds((const unsigned*)((const char*)(gbase) + (voff)[_i]), (PG8_LAS unsigned*)(lds + (bufoff) + ldsw + _i * 8192), 16, 0, 0); } while (0)
#define PG8_STAGE_B(bufoff, gbase, voff) do { _Pragma("unroll") for (int _i = 0; _i < 2; ++_i) \
        __builtin_amdgcn_global_load_lds((const unsigned*)((const char*)(gbase) + (voff)[_i]), (PG8_LAS unsigned*)(lds + (bufoff) + ldsw + _i * 8192), 16, 0, Sched::B_NT ? 2 : 0); } while (0)
#define PG8_STAGE_A(bufoff, base, hh_, nx_) do { if constexpr (GATHER) { unsigned og_[2] = {(nx_) ? offN[hh_][0] : offA[hh_][0], (nx_) ? offN[hh_][1] : offA[hh_][1]}; asm volatile("" : "+v"(og_[0]), "+v"(og_[1]));   PG8_STAGE(bufoff, base, og_); } \
        else PG8_STAGE(bufoff, (base) + ((hh_) ? hstep : 0), voffA); } while (0)
#define PG8_ROWOFFS(dst, un, ord) do { _Pragma("unroll") for (int h_ = 0; h_ < 2; ++h_) _Pragma("unroll") for (int i_ = 0; i_ < 2; ++i_) { int R_, C_; stage_rc(tid * 16 + i_ * 8192, R_, C_); \
        dst[h_][i_] = ((unsigned)S.row_tok(un, h_ * HALF + R_, ord) & 0x7fffu) * (unsigned)(K * 2) + (unsigned)(C_ * 2); } } while (0)
#define PG8_LDA(dst, b, h) do { _Pragma("unroll") for (int m = 0; m < 4; ++m) _Pragma("unroll") for (int k = 0; k < 2; ++k) dst[m][k] = *(const PG8_LAS bf16x8*)(lds + PG8_SA(b, h) + aoff + m * 2048 + k * 1024); } while (0)
#define PG8_LDB(dst, b, h) do { _Pragma("unroll") for (int n = 0; n < 2; ++n) _Pragma("unroll") for (int k = 0; k < 2; ++k) dst[n][k] = *(const PG8_LAS bf16x8*)(lds + PG8_SB(b, h) + boff + n * 2048 + k * 1024); } while (0)
#define PG8_MMA(ai, bj, At, Bt) do { __builtin_amdgcn_s_setprio(1); _Pragma("unroll") for (int m = 0; m < 4; ++m) _Pragma("unroll") for (int n = 0; n < 2; ++n) _Pragma("unroll") for (int k = 0; k < 2; ++k) \
        acc[ai][bj][m][n] = __builtin_amdgcn_mfma_f32_16x16x32_bf16(Bt[n][k], At[m][k], acc[ai][bj][m][n], 0, 0, 0); __builtin_amdgcn_s_setprio(0); } while (0)
#define PG8_WAIT_V(n) asm volatile("s_waitcnt vmcnt(" #n ")" ::: "memory")
#define PG8_WAIT_L(n) asm volatile("s_waitcnt lgkmcnt(" #n ")" ::: "memory")
#define PG8_BAR __builtin_amdgcn_s_barrier()
#define PG8_SCHED __builtin_amdgcn_sched_barrier(0)
    Unit cur, nxt; int ui = 0;
    if (!S.next(0, cur)) return;
    f32x4 acc[2][2][4][2];
#pragma unroll
    for (int a = 0; a < 2; ++a)
#pragma unroll
        for (int b = 0; b < 2; ++b)
#pragma unroll
            for (int m = 0; m < 4; ++m)
#pragma unroll
                for (int n = 0; n < 2; ++n) acc[a][b][m][n] = (f32x4){0.f, 0.f, 0.f, 0.f};
    bf16x8 At[4][2], B0[2][2], B1[2][2];
    const char* cA = (const char*)g.A + (GATHER ? (size_t)0 : (size_t)cur.pm * tstep);
    unsigned offA[2][2] = {{0u, 0u}, {0u, 0u}}, offN[2][2] = {{0u, 0u}, {0u, 0u}};
    if constexpr (GATHER) PG8_ROWOFFS(offA, cur, 0); const char* cB = (const char*)g.Bt + (size_t)cur.pn * tstep;
    S.a_ready(cur);
    if constexpr (SP2) {
        PG8_STAGE_B(PG8_SB(0, 0), cB, voffB); PG8_STAGE_B(PG8_SB(0, 1), cB + hstep, voffB); PG8_STAGE_A(PG8_SA(0, 0), cA, 0, false); PG8_STAGE_A(PG8_SA(0, 1), cA, 1, false);
        if (wr == 1) PG8_BAR;
        PG8_WAIT_V(2); PG8_BAR;
        PG8_STAGE_B(PG8_SB(1, 0), cB + kstep, voffB); PG8_STAGE_A(PG8_SA(1, 0), cA + kstep, 0, false); PG8_STAGE_B(PG8_SB(1, 1), cB + hstep + kstep, voffB);
        PG8_WAIT_V(6); PG8_BAR;
    } else {
        PG8_STAGE_B(PG8_SB(0, 0), cB, voffB); PG8_STAGE_A(PG8_SA(0, 0), cA, 0, false); PG8_STAGE_B(PG8_SB(0, 1), cB + hstep, voffB); PG8_STAGE_A(PG8_SA(0, 1), cA, 1, false);
        if (wr == 1) PG8_BAR;
        PG8_WAIT_V(4); PG8_BAR;
        PG8_STAGE_B(PG8_SB(1, 0), cB + kstep, voffB); PG8_STAGE_A(PG8_SA(1, 0), cA + kstep, 0, false); PG8_STAGE_B(PG8_SB(1, 1), cB + hstep + kstep, voffB);
        PG8_WAIT_V(6); PG8_BAR;
    }
    for (;;) {
        const bool has_next = S.next(ui + 1, nxt);
        const char* nA = (has_next && !GATHER) ? (const char*)g.A + (size_t)nxt.pm * tstep : cA;
        if constexpr (GATHER) { if (has_next) PG8_ROWOFFS(offN, nxt, ui + 1); else { offN[0][0] = offA[0][0]; offN[0][1] = offA[0][1]; offN[1][0] = offA[1][0]; offN[1][1] = offA[1][1]; } } const char* nB = has_next ? (const char*)g.Bt + (size_t)nxt.pn * tstep : cB;
        for (int t = 0; t < nt; t += 2) {
            const bool last = (t == nt - 2);
            const char* a1 = cA + (size_t)(t + 1) * kstep;
            const char* a2 = last ? nA : cA + (size_t)(t + 2) * kstep; const char* b2 = last ? nB : cB + (size_t)(t + 2) * kstep;
            const char* a3 = a2 + kstep; const char* b3 = b2 + kstep;
            if (last && has_next) S.a_ready(nxt);
            if constexpr (SP2) {
            PG8_LDB(B0, 0, 0); PG8_LDB(B1, 0, 1); PG8_SCHED; PG8_LDA(At, 0, 0); PG8_STAGE_A(PG8_SA(1, 1), a1, 1, false);
            PG8_WAIT_V(8); PG8_WAIT_L(0); PG8_BAR; PG8_MMA(0, 0, At, B0); PG8_MMA(0, 1, At, B1); PG8_BAR; PG8_SCHED;
            PG8_LDA(At, 0, 1); PG8_STAGE_B(PG8_SB(0, 0), b2, voffB); PG8_STAGE_B(PG8_SB(0, 1), b2 + hstep, voffB); PG8_STAGE_A(PG8_SA(0, 0), a2, 0, last);
            PG8_WAIT_V(8); PG8_WAIT_L(0); PG8_BAR; PG8_MMA(1, 0, At, B0); PG8_MMA(1, 1, At, B1); PG8_BAR; PG8_SCHED;
            PG8_LDB(B0, 1, 0); PG8_LDB(B1, 1, 1); PG8_SCHED; PG8_LDA(At, 1, 0); PG8_STAGE_A(PG8_SA(0, 1), a2, 1, last);
            PG8_WAIT_V(8); PG8_WAIT_L(0); PG8_BAR; PG8_MMA(0, 0, At, B0); PG8_MMA(0, 1, At, B1); PG8_BAR; PG8_SCHED;
            PG8_LDA(At, 1, 1); PG8_STAGE_B(PG8_SB(1, 0), b3, voffB); PG8_STAGE_B(PG8_SB(1, 1), b3 + hstep, voffB); PG8_STAGE_A(PG8_SA(1, 0), a3, 0, last);
            PG8_WAIT_V(8); PG8_WAIT_L(0); PG8_BAR; PG8_MMA(1, 0, At, B0); PG8_MMA(1, 1, At, B1); PG8_BAR; PG8_SCHED;
            } else {
            PG8_LDB(B0, 0, 0); PG8_SCHED; PG8_LDA(At, 0, 0); PG8_STAGE_A(PG8_SA(1, 1), a1, 1, false);
            PG8_WAIT_L(8); PG8_BAR; PG8_WAIT_L(0); PG8_MMA(0, 0, At, B0); PG8_BAR; PG8_SCHED;
            PG8_LDB(B1, 0, 1); PG8_STAGE_B(PG8_SB(0, 0), b2, voffB);
            PG8_BAR; PG8_WAIT_L(0); PG8_MMA(0, 1, At, B1); PG8_BAR;
            PG8_LDA(At, 0, 1); PG8_STAGE_A(PG8_SA(0, 0), a2, 0, last);
            PG8_BAR; PG8_WAIT_L(0); PG8_MMA(1, 0, At, B0); PG8_BAR; PG8_SCHED;
            PG8_STAGE_B(PG8_SB(0, 1), b2 + hstep, voffB);
            PG8_WAIT_V(6); PG8_BAR; PG8_MMA(1, 1, At, B1); PG8_BAR;
            PG8_LDB(B0, 1, 0); PG8_SCHED; PG8_LDA(At, 1, 0); PG8_STAGE_A(PG8_SA(0, 1), a2, 1, last);
            PG8_WAIT_L(8); PG8_BAR; PG8_WAIT_L(0); PG8_MMA(0, 0, At, B0); PG8_BAR; PG8_SCHED;
            PG8_LDB(B1, 1, 1); PG8_STAGE_B(PG8_SB(1, 0), b3, voffB);
            PG8_BAR; PG8_WAIT_L(0); PG8_MMA(0, 1, At, B1); PG8_BAR;
            PG8_LDA(At, 1, 1); PG8_STAGE_A(PG8_SA(1, 0), a3, 0, last);
            PG8_BAR; PG8_WAIT_L(0); PG8_MMA(1, 0, At, B0); PG8_BAR; PG8_SCHED;
            PG8_STAGE_B(PG8_SB(1, 1), b3 + hstep, voffB);
            PG8_WAIT_V(6); PG8_BAR; PG8_MMA(1, 1, At, B1); PG8_BAR;
            }
        }
        if constexpr (ALIGN_EPI) { if (wr == 0) PG8_BAR; }
#ifdef PG8_EPI_PROBE
        if constexpr (!Epi::AFTER_DRAIN) { unsigned long long t0_ = 0ull; if constexpr (Epi::PROBE) t0_ = __builtin_amdgcn_s_memrealtime();
            E(acc, cur, wr, wc, fr, fq); S.done(cur);
            if constexpr (Epi::PROBE) { if (blockIdx.x == 0 && wid == 0 && mk_lane() == 0) *(PG8_LAS unsigned long long*)(lds + PG8_EPI_PROBE) += __builtin_amdgcn_s_memrealtime() - t0_; } }
#else
        if constexpr (!Epi::AFTER_DRAIN) { E(acc, cur, wr, wc, fr, fq); S.done(cur); }
#endif
        if (!has_next) break;
#pragma unroll
        for (int a = 0; a < 2; ++a)
#pragma unroll
            for (int b = 0; b < 2; ++b)
#pragma unroll
                for (int m = 0; m < 4; ++m)
#pragma unroll
                    for (int n = 0; n < 2; ++n) acc[a][b][m][n] = (f32x4){0.f, 0.f, 0.f, 0.f};
        cur = nxt; cA = nA; cB = nB; ++ui;
        if constexpr (GATHER) { offA[0][0] = offN[0][0]; offA[0][1] = offN[0][1]; offA[1][0] = offN[1][0]; offA[1][1] = offN[1][1]; }
        if constexpr (ALIGN_EPI) { if (wr == 1) PG8_BAR; }
    }
    PG8_WAIT_V(0);
    if constexpr (!ALIGN_EPI) { if (wr == 0) PG8_BAR; }
    PG8_BAR;
    if constexpr (Epi::AFTER_DRAIN) { E.fused(acc, cur, wr, wc, fr, fq, lds, wid, lane); S.done(cur); }
#undef PG8_SA
#undef PG8_SB
#undef PG8_STAGE
#undef PG8_STAGE_B
#undef PG8_STAGE_A
#undef PG8_ROWOFFS
#undef PG8_LDA
#undef PG8_LDB
#undef PG8_MMA
#undef PG8_WAIT_V
#undef PG8_WAIT_L
#undef PG8_BAR
#undef PG8_SCHED
}
}

#ifndef ATT_SDEPTH
#define ATT_SDEPTH 1
#endif
#ifndef ATT_PRIO
#define ATT_PRIO 1
#endif
#ifndef ATT_SWA_WAVE
#define ATT_SWA_WAVE 1
#endif
#ifndef ATT_DIFF_FUSED
#define ATT_DIFF_FUSED 1
#endif
#ifndef ATT_SDEPTH_DIFF
#define ATT_SDEPTH_DIFF 2
#endif
namespace att {
using bf16x8 = __attribute__((ext_vector_type(8))) short;
using s16x4  = __attribute__((ext_vector_type(4))) short;
using f32x16 = __attribute__((ext_vector_type(16))) float;
using f32x4  = __attribute__((ext_vector_type(4))) float;
using u32x4  = __attribute__((ext_vector_type(4))) unsigned;
constexpr int NW = 8, QBLK = 32, KVBLK = 64, LDP = 5120, LDY = 2048, SEQL = 4096;
constexpr int SHM_V = 16384, SHM_K = 16384;
constexpr int OFF_V = 0, OFF_K = 2 * SHM_V, OFF_WS = OFF_K + 2 * SHM_K, OFF_LUT = OFF_WS + NW * 64 * 4, OFF_MISC = OFF_LUT + 512, OFF_STG = 69632, STG_PITCH = 272, STG_WAVE = 32 * STG_PITCH;
constexpr int ATT_LDS = OFF_STG + NW * STG_WAVE;
constexpr int OFF_LUT4 = 147456, LUT4_N = 528, LUT4_COPIES = 5, OFF_LUTH = OFF_LUT4 + LUT4_COPIES * LUT4_N * 4, LUTH_BYTES = 6 * 128 * 4;
static_assert(OFF_MISC + 256 <= OFF_STG, "attention LDS map");
constexpr float LOG2E = 1.4426950408889634f, NEGB = -1e30f, THR2 = 11.5f;
#define SBAR() __builtin_amdgcn_sched_barrier(0)
__device__ __forceinline__ int crow(int r, int hi) { return (r & 3) + 8 * (r >> 2) + 4 * hi; }
__device__ __forceinline__ unsigned cvtpk(float lo, float hi) { unsigned r; asm volatile("v_cvt_pk_bf16_f32 %0, %1, %2" : "=v"(r) : "v"(lo), "v"(hi)); return r; }
__device__ __forceinline__ float bf2f(short x) { return __uint_as_float(((unsigned)(unsigned short)x) << 16); }
template <int DQK> __device__ __forceinline__ int kswz(int row, int colB) { return row * (2 * DQK) + (colB ^ ((((DQK == 128) ? row : (row >> 1)) & 7) << 4)); }

template <int MODE>
__device__ __forceinline__ void bias_mask(f32x16& p0, f32x16& p1, int kt, int qpos, int wave_qmin, int hi, float C, const float* lut4, float cfar, unsigned sel, int jblk) {
  bool lane_off = false;
  if (MODE == 1) { const int blk = kt >> 8; if (blk < jblk) lane_off = !((sel >> blk) & 1u); }
  const bool nearT = (kt + 63 + 128 > wave_qmin);
  if (!nearT) {
    if (MODE == 0) {
#pragma unroll
      for (int r = 0; r < 16; ++r) { p0[r] = NEGB; p1[r] = NEGB; }
    } else {
#pragma unroll
      for (int r = 0; r < 16; ++r) { p0[r] = lane_off ? NEGB : fmaf(p0[r], C, cfar); p1[r] = lane_off ? NEGB : fmaf(p1[r], C, cfar); }
    }
  } else {
    const int kb = kt + 4 * hi, D = qpos - kb, c4 = qpos & 3;
    const float* Lc = lut4 + ((MODE == 1 && lane_off) ? 4 * LUT4_N + (256 + c4 - D) : c4 * LUT4_N + (256 + c4 - D));
#pragma unroll
    for (int g = 0; g < 4; ++g) {
      const f32x4 b0 = *(const f32x4*)(Lc + 8 * g), b1 = *(const f32x4*)(Lc + 8 * g + 32);
#pragma unroll
      for (int i = 0; i < 4; ++i) { const int r = 4 * g + i; p0[r] = fmaf(p0[r], C, b0[i]); p1[r] = fmaf(p1[r], C, b1[i]); }
      if (g & 1) SBAR();
    }
  }
}
__device__ __forceinline__ void partialSM(f32x16& p0, f32x16& p1, float& m_reg, float& alpha) {
  float pmax = p0[0];
#pragma unroll
  for (int r = 1; r < 16; ++r) pmax = fmaxf(pmax, p0[r]);
#pragma unroll
  for (int r = 0; r < 16; ++r) pmax = fmaxf(pmax, p1[r]);
  { auto rr = __builtin_amdgcn_permlane32_swap(__float_as_uint(pmax), __float_as_uint(pmax), false, false);
    pmax = fmaxf(__uint_as_float(rr[0]), __uint_as_float(rr[1])); }
  float mn;
  if (__builtin_expect(__all(pmax - m_reg <= THR2), 1)) { mn = m_reg; alpha = 1.f; }
  else { mn = fmaxf(m_reg, pmax); alpha = __builtin_amdgcn_exp2f(m_reg - mn); m_reg = mn; }
#pragma unroll
  for (int r = 0; r < 16; ++r) { p0[r] = __builtin_amdgcn_exp2f(p0[r] - mn); p1[r] = p1[r] - mn; }
}
template <int MODE>
__device__ __forceinline__ void tile_sm(f32x16& p0, f32x16& p1, int kt, int qpos, int wave_qmin, int hi, float C, const float* lut, float cfar, unsigned sel, int jblk, float& m_reg, float& alpha) {
  const bool nearT = (kt + 63 + 128 > wave_qmin);
  if (nearT) { bias_mask<MODE>(p0, p1, kt, qpos, wave_qmin, hi, C, (const float*)((const char*)lut + (OFF_LUT4 - OFF_LUT)), cfar, sel, jblk); partialSM(p0, p1, m_reg, alpha); return; }
  if (MODE == 0) {
#pragma unroll
    for (int r = 0; r < 16; ++r) { p0[r] = 0.f; p1[r] = NEGB; }
    alpha = 1.f; return;
  }
  bool lane_off = false;
  if (MODE == 1) { const int blk = kt >> 8; if (blk < jblk) lane_off = !((sel >> blk) & 1u); }
  float pmax = p0[0];
#pragma unroll
  for (int r = 1; r < 16; ++r) pmax = fmaxf(pmax, p0[r]);
#pragma unroll
  for (int r = 0; r < 16; ++r) pmax = fmaxf(pmax, p1[r]);
  { auto rr = __builtin_amdgcn_permlane32_swap(__float_as_uint(pmax), __float_as_uint(pmax), false, false);
    pmax = fmaxf(__uint_as_float(rr[0]), __uint_as_float(rr[1])); }
  const float tmax = lane_off ? NEGB : fmaf(pmax, C, cfar);
  float mn;
  if (__builtin_expect(__all(tmax - m_reg <= THR2), 1)) { mn = m_reg; alpha = 1.f; }
  else { mn = fmaxf(m_reg, tmax); alpha = __builtin_amdgcn_exp2f(m_reg - mn); m_reg = mn; }
  const float off = lane_off ? NEGB : cfar - mn;
#pragma unroll
  for (int r = 0; r < 16; ++r) { p0[r] = __builtin_amdgcn_exp2f(fmaf(p0[r], C, off)); p1[r] = fmaf(p1[r], C, off); }
}
__device__ __forceinline__ void finishSM(f32x16& p0, f32x16& p1, float alpha, float& l_reg, bf16x8& pa0, bf16x8& pa1, bf16x8& pa2, bf16x8& pa3) {
#pragma unroll
  for (int r = 0; r < 16; ++r) p1[r] = __builtin_amdgcn_exp2f(p1[r]);
  float ps = 0;
#pragma unroll
  for (int r = 0; r < 16; ++r) ps += p0[r];
#pragma unroll
  for (int r = 0; r < 16; ++r) ps += p1[r];
  { auto rr = __builtin_amdgcn_permlane32_swap(__float_as_uint(ps), __float_as_uint(ps), false, false);
    ps = __uint_as_float(rr[0]) + __uint_as_float(rr[1]); }
  l_reg = l_reg * alpha + ps;
#define PK4(P, BASE, OUT) do { unsigned a0 = cvtpk(P[BASE + 0], P[BASE + 1]), a1 = cvtpk(P[BASE + 2], P[BASE + 3]);   \
    unsigned b0 = cvtpk(P[BASE + 4], P[BASE + 5]), b1 = cvtpk(P[BASE + 6], P[BASE + 7]);                              \
    auto r0 = __builtin_amdgcn_permlane32_swap(a0, b0, false, false); auto r1 = __builtin_amdgcn_permlane32_swap(a1, b1, false, false); \
    u32x4 w = {r0[0], r1[0], r0[1], r1[1]}; OUT = *reinterpret_cast<bf16x8*>(&w); } while (0)
  PK4(p0, 0, pa0); PK4(p0, 8, pa1); PK4(p1, 0, pa2); PK4(p1, 8, pa3);
#undef PK4
}
template <int DQK>
__device__ __forceinline__ void qkt(f32x16& p0, f32x16& p1, const char* Ks, const bf16x8* qr, int r32, int hi) {
  p0 = f32x16{}; p1 = f32x16{};
#pragma unroll
  for (int d0 = 0; d0 < DQK / 16; ++d0) { const int cb = (d0 * 16 + hi * 8) * 2;
    const bf16x8 b0 = *reinterpret_cast<const bf16x8*>(Ks + kswz<DQK>(r32, cb));
    const bf16x8 b1 = *reinterpret_cast<const bf16x8*>(Ks + kswz<DQK>(32 + r32, cb));
    p0 = __builtin_amdgcn_mfma_f32_32x32x16_bf16(b0, qr[d0], p0, 0, 0, 0);
    p1 = __builtin_amdgcn_mfma_f32_32x32x16_bf16(b1, qr[d0], p1, 0, 0, 0); }
}
__device__ __forceinline__ int v_st(int k, int c) { const int kk = (k & ~0xC) | ((k & 4) << 1) | ((k & 8) >> 1); return ((kk >> 3) * 4 + (c >> 5)) * 512 + ((kk & 7) * 32 + (c & 31)) * 2; }
__device__ __forceinline__ int v_rd_base(int lane) { return ((lane & 3) << 3) | (((lane >> 2) & 3) << 6) | (((lane >> 4) & 1) << 5) | (((lane >> 5) & 1) << 8); }
constexpr int v_rd_off(int d0, int ks, int half) { return d0 * 512 + ks * 4096 + half * 2048; }
template <int OFF> __device__ __forceinline__ s16x4 tr_read(int vb) {
  s16x4 r; asm volatile("ds_read_b64_tr_b16 %0, %1 offset:%2" : "=&v"(r) : "v"(vb), "i"(OFF) : "memory"); return r;
}
template <int D0> __device__ __forceinline__ void pv_one(f32x16& od, int vb, bf16x8 pa0, bf16x8 pa1, bf16x8 pa2, bf16x8 pa3) {
  const s16x4 l0 = tr_read<v_rd_off(D0, 0, 0)>(vb), h0 = tr_read<v_rd_off(D0, 0, 1)>(vb), l1 = tr_read<v_rd_off(D0, 1, 0)>(vb), h1 = tr_read<v_rd_off(D0, 1, 1)>(vb);
  const s16x4 l2 = tr_read<v_rd_off(D0, 2, 0)>(vb), h2 = tr_read<v_rd_off(D0, 2, 1)>(vb), l3 = tr_read<v_rd_off(D0, 3, 0)>(vb), h3 = tr_read<v_rd_off(D0, 3, 1)>(vb);
  asm volatile("s_waitcnt lgkmcnt(0)" ::: "memory"); SBAR();
#if ATT_PRIO
  __builtin_amdgcn_s_setprio(ATT_PRIO);
#endif
#define PK(L, H) (bf16x8){L[0], L[1], L[2], L[3], H[0], H[1], H[2], H[3]}
  od = __builtin_amdgcn_mfma_f32_32x32x16_bf16(pa0, PK(l0, h0), od, 0, 0, 0);
  od = __builtin_amdgcn_mfma_f32_32x32x16_bf16(pa1, PK(l1, h1), od, 0, 0, 0);
  od = __builtin_amdgcn_mfma_f32_32x32x16_bf16(pa2, PK(l2, h2), od, 0, 0, 0);
  od = __builtin_amdgcn_mfma_f32_32x32x16_bf16(pa3, PK(l3, h3), od, 0, 0, 0);
#if ATT_PRIO
  __builtin_amdgcn_s_setprio(0);
#endif
#undef PK
}
__device__ __forceinline__ void pv_d0(f32x16* o, int vb, bf16x8 pa0, bf16x8 pa1, bf16x8 pa2, bf16x8 pa3) {
  pv_one<0>(o[0], vb, pa0, pa1, pa2, pa3); pv_one<1>(o[1], vb, pa0, pa1, pa2, pa3); pv_one<2>(o[2], vb, pa0, pa1, pa2, pa3); pv_one<3>(o[3], vb, pa0, pa1, pa2, pa3);
}

__device__ __forceinline__ void pv_all1(f32x16* o, int vb, bf16x8 pa0, bf16x8 pa1, bf16x8 pa2, bf16x8 pa3) {
  s16x4 va[8], vc[8];
#define TR8(D0, L) do { L[0] = tr_read<v_rd_off(D0, 0, 0)>(vb); L[1] = tr_read<v_rd_off(D0, 0, 1)>(vb); L[2] = tr_read<v_rd_off(D0, 1, 0)>(vb); L[3] = tr_read<v_rd_off(D0, 1, 1)>(vb); \
    L[4] = tr_read<v_rd_off(D0, 2, 0)>(vb); L[5] = tr_read<v_rd_off(D0, 2, 1)>(vb); L[6] = tr_read<v_rd_off(D0, 3, 0)>(vb); L[7] = tr_read<v_rd_off(D0, 3, 1)>(vb); } while (0)
#define PK(L, H) (bf16x8){L[0], L[1], L[2], L[3], H[0], H[1], H[2], H[3]}
#define MM4(OA, L) do { OA = __builtin_amdgcn_mfma_f32_32x32x16_bf16(pa0, PK(L[0], L[1]), OA, 0, 0, 0); OA = __builtin_amdgcn_mfma_f32_32x32x16_bf16(pa1, PK(L[2], L[3]), OA, 0, 0, 0); \
    OA = __builtin_amdgcn_mfma_f32_32x32x16_bf16(pa2, PK(L[4], L[5]), OA, 0, 0, 0); OA = __builtin_amdgcn_mfma_f32_32x32x16_bf16(pa3, PK(L[6], L[7]), OA, 0, 0, 0); } while (0)
  TR8(0, va); TR8(1, vc); asm volatile("s_waitcnt lgkmcnt(8)" ::: "memory"); SBAR(); MM4(o[0], va); SBAR();
  TR8(2, va); asm volatile("s_waitcnt lgkmcnt(8)" ::: "memory"); SBAR(); MM4(o[1], vc); SBAR();
  TR8(3, vc); asm volatile("s_waitcnt lgkmcnt(8)" ::: "memory"); SBAR(); MM4(o[2], va); SBAR();
  asm volatile("s_waitcnt lgkmcnt(0)" ::: "memory"); SBAR(); MM4(o[3], vc);
#undef MM4
#undef PK
#undef TR8
}

template <int MODE>
__device__ __forceinline__ float far_head(const f32x16& p0, const f32x16& p1, int kt, float C, float cfar, unsigned sel, int jblk, float& m_reg, float& alpha) {
  bool lane_off = false;
  if (MODE == 1) { const int blk = kt >> 8; if (blk < jblk) lane_off = !((sel >> blk) & 1u); }
  float pmax = p0[0];
#pragma unroll
  for (int r = 1; r < 16; ++r) pmax = fmaxf(pmax, p0[r]);
#pragma unroll
  for (int r = 0; r < 16; ++r) pmax = fmaxf(pmax, p1[r]);
  { auto rr = __builtin_amdgcn_permlane32_swap(__float_as_uint(pmax), __float_as_uint(pmax), false, false);
    pmax = fmaxf(__uint_as_float(rr[0]), __uint_as_float(rr[1])); }
  const float tmax = lane_off ? NEGB : fmaf(pmax, C, cfar);
  float mn;
  if (__builtin_expect(__all(tmax - m_reg <= THR2), 1)) { mn = m_reg; alpha = 1.f; }
  else { mn = fmaxf(m_reg, tmax); alpha = __builtin_amdgcn_exp2f(m_reg - mn); m_reg = mn; }
  return lane_off ? NEGB : cfar - mn;
}
__device__ __forceinline__ float near_head(const f32x16& p0, const f32x16& p1, float& m_reg, float& alpha) {
  float pmax = p0[0];
#pragma unroll
  for (int r = 1; r < 16; ++r) pmax = fmaxf(pmax, p0[r]);
#pragma unroll
  for (int r = 0; r < 16; ++r) pmax = fmaxf(pmax, p1[r]);
  { auto rr = __builtin_amdgcn_permlane32_swap(__float_as_uint(pmax), __float_as_uint(pmax), false, false);
    pmax = fmaxf(__uint_as_float(rr[0]), __uint_as_float(rr[1])); }
  float mn;
  if (__builtin_expect(__all(pmax - m_reg <= THR2), 1)) { mn = m_reg; alpha = 1.f; }
  else { mn = fmaxf(m_reg, pmax); alpha = __builtin_amdgcn_exp2f(m_reg - mn); m_reg = mn; }
  return -mn;
}
__device__ __forceinline__ void far_tail(f32x16* o, int vb, f32x16& p0, f32x16& p1, float C, float off, float alpha, float& l_reg) {
  s16x4 va[8], vc[8]; float ps = 0.f; bf16x8 pa, pn;
#define TRK(KS, L) do { L[0] = tr_read<v_rd_off(0, KS, 0)>(vb); L[1] = tr_read<v_rd_off(0, KS, 1)>(vb); L[2] = tr_read<v_rd_off(1, KS, 0)>(vb); L[3] = tr_read<v_rd_off(1, KS, 1)>(vb); \
    L[4] = tr_read<v_rd_off(2, KS, 0)>(vb); L[5] = tr_read<v_rd_off(2, KS, 1)>(vb); L[6] = tr_read<v_rd_off(3, KS, 0)>(vb); L[7] = tr_read<v_rd_off(3, KS, 1)>(vb); } while (0)
#define PK(L, H) (bf16x8){L[0], L[1], L[2], L[3], H[0], H[1], H[2], H[3]}
#define EX2(P, I) do { P[I] = __builtin_amdgcn_exp2f(fmaf(P[I], C, off)); P[(I) + 1] = __builtin_amdgcn_exp2f(fmaf(P[(I) + 1], C, off)); } while (0)
#define PK4(P, BASE, OUT) do { unsigned a0 = cvtpk(P[BASE + 0], P[BASE + 1]), a1 = cvtpk(P[BASE + 2], P[BASE + 3]);   \
    unsigned c0 = cvtpk(P[BASE + 4], P[BASE + 5]), c1 = cvtpk(P[BASE + 6], P[BASE + 7]);                              \
    auto r0 = __builtin_amdgcn_permlane32_swap(a0, c0, false, false); auto r1 = __builtin_amdgcn_permlane32_swap(a1, c1, false, false); \
    u32x4 w = {r0[0], r1[0], r0[1], r1[1]}; OUT = *reinterpret_cast<bf16x8*>(&w); } while (0)
#define GRP(PA, L, P, BASE, PN, SUMP, SB) do { \
    o[0] = __builtin_amdgcn_mfma_f32_32x32x16_bf16(PA, PK(L[0], L[1]), o[0], 0, 0, 0); SBAR(); EX2(P, BASE); ps += SUMP[SB]; ps += SUMP[SB + 1]; SBAR(); \
    o[1] = __builtin_amdgcn_mfma_f32_32x32x16_bf16(PA, PK(L[2], L[3]), o[1], 0, 0, 0); SBAR(); EX2(P, BASE + 2); ps += SUMP[SB + 2]; ps += SUMP[SB + 3]; SBAR(); \
    o[2] = __builtin_amdgcn_mfma_f32_32x32x16_bf16(PA, PK(L[4], L[5]), o[2], 0, 0, 0); SBAR(); EX2(P, BASE + 4); ps += SUMP[SB + 4]; ps += SUMP[SB + 5]; SBAR(); \
    o[3] = __builtin_amdgcn_mfma_f32_32x32x16_bf16(PA, PK(L[6], L[7]), o[3], 0, 0, 0); SBAR(); EX2(P, BASE + 6); ps += SUMP[SB + 6]; ps += SUMP[SB + 7]; PK4(P, BASE, PN); SBAR(); } while (0)
  TRK(0, va); TRK(1, vc);
  EX2(p0, 0); EX2(p0, 2); EX2(p0, 4); EX2(p0, 6); PK4(p0, 0, pa);
  asm volatile("s_waitcnt lgkmcnt(8)" ::: "memory"); SBAR();
  GRP(pa, va, p0, 8, pn, p0, 0);
  TRK(2, va); asm volatile("s_waitcnt lgkmcnt(8)" ::: "memory"); SBAR();
  GRP(pn, vc, p1, 0, pa, p0, 8);
  TRK(3, vc); asm volatile("s_waitcnt lgkmcnt(8)" ::: "memory"); SBAR();
  GRP(pa, va, p1, 8, pn, p1, 0);
  asm volatile("s_waitcnt lgkmcnt(0)" ::: "memory"); SBAR();
  o[0] = __builtin_amdgcn_mfma_f32_32x32x16_bf16(pn, PK(vc[0], vc[1]), o[0], 0, 0, 0); SBAR(); ps += p1[8]; ps += p1[9]; ps += p1[10]; ps += p1[11]; SBAR();
  o[1] = __builtin_amdgcn_mfma_f32_32x32x16_bf16(pn, PK(vc[2], vc[3]), o[1], 0, 0, 0); SBAR(); ps += p1[12]; ps += p1[13]; ps += p1[14]; ps += p1[15]; SBAR();
  o[2] = __builtin_amdgcn_mfma_f32_32x32x16_bf16(pn, PK(vc[4], vc[5]), o[2], 0, 0, 0); SBAR();
  { auto rr = __builtin_amdgcn_permlane32_swap(__float_as_uint(ps), __float_as_uint(ps), false, false); ps = __uint_as_float(rr[0]) + __uint_as_float(rr[1]); }
  l_reg = l_reg * alpha + ps; SBAR();
  o[3] = __builtin_amdgcn_mfma_f32_32x32x16_bf16(pn, PK(vc[6], vc[7]), o[3], 0, 0, 0);
#undef GRP
#undef PK4
#undef EX2
#undef PK
#undef TRK
}

struct AttnArgs { int layer; float lambda_init; };
constexpr size_t ATT_WS_PROJ = (size_t)434 << 20, ATT_WS_YCAT = (size_t)754 << 20, ATT_WS_KMEAN = (size_t)1 << 20;
#define A_proj ((const unsigned short*)(wsptr() + ATT_WS_PROJ))
#define A_ycat ((unsigned short*)(wsptr() + ATT_WS_YCAT))
#define A_kmean ((const float*)(wsptr() + ATT_WS_KMEAN))
#define A_kpart ((const float*)(wsptr() + ATT_WS_KP))
constexpr size_t ATT_WS_KP = (size_t)882 << 20; constexpr int ATT_KP_N = 8 * 4 * 16 * 128;
#define A_rel_bias (inptr(2))
#define A_sinks (inptr(6) + A.layer * 6)
#define A_lq1 (inptr(7) + A.layer * 64)
#define A_lk1 (inptr(8) + A.layer * 64)
#define A_lq2 (inptr(9) + A.layer * 64)
#define A_lk2 (inptr(10) + A.layer * 64)
#define A_subln (inptr(11) + A.layer * 128)
__device__ const unsigned char REL_BUCKET_TAB[128] = {
  0, 1, 2, 3, 4, 5, 6, 7, 8, 9, 10, 11, 12, 13, 14, 15, 16, 16, 16, 17, 17, 18, 18, 18, 19, 19, 19, 20, 20, 20, 20, 21, 21, 21, 21, 22, 22, 22, 22, 22, 23, 23, 23, 23, 23, 23, 24, 24, 24, 24, 24, 24,
  25, 25, 25, 25, 25, 25, 25, 26, 26, 26, 26, 26, 26, 26, 26, 27, 27, 27, 27, 27, 27, 27, 27, 27, 27, 28, 28, 28, 28, 28, 28, 28, 28, 28, 28, 29, 29, 29, 29, 29, 29, 29, 29, 29, 29, 29, 29,
  30, 30, 30, 30, 30, 30, 30, 30, 30, 30, 30, 30, 30, 30, 31, 31, 31, 31, 31, 31, 31, 31, 31, 31, 31, 31, 31, 31, 31};

template <int MODE>
__device__ __forceinline__ void attn_pass(const AttnArgs& A, int b, int hh, int qb, int pass, float lam, char* lds, int tid) {
  constexpr int DQK = (MODE == 2) ? 64 : 128;
  constexpr int NPASS = (MODE == 2) ? 2 : 1;
  constexpr int SDEPTH = (MODE == 2) ? ATT_SDEPTH_DIFF : ATT_SDEPTH;
  constexpr int QCOL = (MODE == 0) ? 0 : (MODE == 1) ? 1280 : 2816;
  constexpr int KCOL = (MODE == 0) ? 768 : (MODE == 1) ? 1792 : 3584;
  constexpr int VCOL = (MODE == 0) ? 1024 : (MODE == 1) ? 2304 : 4352;
  constexpr int OCOL = (MODE == 0) ? 0 : (MODE == 1) ? 768 : 1280;
  const float C = ((MODE == 2) ? 0.125f : 0.088388347648318440f) * LOG2E;
  const int lane = tid & 63, r32 = lane & 31, hi = lane >> 5; const int wid = __builtin_amdgcn_readfirstlane(tid >> 6);
  const int kvh = (MODE == 0) ? hh / 3 : hh;
  char* V_lds = lds + OFF_V; char* K_lds = lds + OFF_K;
  float* wsl = (float*)(lds + OFF_WS) + wid * 64; float* li_l = wsl; float* al_l = wsl + 32;
  const float* lut = (const float*)(lds + OFF_LUT);
  char* stg = lds + OFF_STG + wid * STG_WAVE;
  const int q0 = qb * 256;
  const int qpos = q0 + wid * QBLK + r32, wave_qmin = q0 + wid * QBLK;
  const long rowb = (long)b * SEQL;
  const float cfar = lut[127];
  const int t0 = (MODE == 0) ? (qb == 0 ? 0 : 4 * qb - 2) : 0;
  const int NT = 4 * qb + 4 - t0;
  const int sr = tid >> 4, sc = (tid & 15) * 8, vst0 = v_st(sr, sc), vst1 = v_st(32 + sr, sc);
  const int vb0 = (int)(uintptr_t)V_lds + v_rd_base(lane);
  const unsigned short* Vh = A_proj + rowb * LDP + VCOL + kvh * 128;
  {

    const unsigned short* Qw = A_proj + (rowb + q0 + wid * QBLK + r32) * LDP + QCOL + hh * 128 + pass * 64 + hi * 8;
    const unsigned short* Kh = A_proj + rowb * LDP + KCOL + kvh * 128 + pass * 64;
    bf16x8 qr[DQK / 16];
#pragma unroll
    for (int d0 = 0; d0 < DQK / 16; ++d0) qr[d0] = *reinterpret_cast<const bf16x8*>(Qw + d0 * 16);
    unsigned sel = 0u;
    if (MODE == 1) {
      const int jb = qb;
      if (jb <= 3) sel = (1u << jb) - 1u;
      else {
        float g[15];
#pragma unroll
        for (int n = 0; n < 15; ++n) { g[n] = -INFINITY;
          if (n < jb) { const float* km = (const float*)(lds + OFF_STG) + n * 128 + hi * 8; float s = 0.f;
#pragma unroll
            for (int d0 = 0; d0 < 8; ++d0) { const f32x4 k0 = *(const f32x4*)(km + d0 * 16), k1 = *(const f32x4*)(km + d0 * 16 + 4);
              s += bf2f(qr[d0 % (DQK / 16)][0]) * k0[0] + bf2f(qr[d0 % (DQK / 16)][1]) * k0[1] + bf2f(qr[d0 % (DQK / 16)][2]) * k0[2] + bf2f(qr[d0 % (DQK / 16)][3]) * k0[3]
                 + bf2f(qr[d0 % (DQK / 16)][4]) * k1[0] + bf2f(qr[d0 % (DQK / 16)][5]) * k1[1] + bf2f(qr[d0 % (DQK / 16)][6]) * k1[2] + bf2f(qr[d0 % (DQK / 16)][7]) * k1[3]; }
            auto rr = __builtin_amdgcn_permlane32_swap(__float_as_uint(s), __float_as_uint(s), false, false);
            g[n] = __uint_as_float(rr[0]) + __uint_as_float(rr[1]); } }
#pragma unroll
        for (int pick = 0; pick < 3; ++pick) { float best = -INFINITY; int bi = 0;
#pragma unroll
          for (int n = 0; n < 15; ++n) { const bool take = (n < jb) && !((sel >> n) & 1u) && (g[n] > best); best = take ? g[n] : best; bi = take ? n : bi; }
          sel |= 1u << bi; }
      }
    }
    int NTm = NT;
    if (MODE == 1) {
      unsigned* mw = (unsigned*)(lds + OFF_MISC);
      if (qb > 3) { unsigned um = 0u;
#pragma unroll
        for (int n = 0; n < 15; ++n) if (__any((int)((sel >> n) & 1u))) um |= 1u << n;
        if (lane == 0) atomicOr(&mw[4], um); }
      __syncthreads();
      unsigned U = (qb <= 3) ? ((1u << qb) - 1u) : mw[4]; U |= 1u << qb;
      if (tid < 17) { unsigned rem = U; int bit = 0;
        for (int k = 0; k < tid; ++k) rem &= rem - 1u;
        bit = rem ? __builtin_ctz(rem) : 0; mw[8 + tid] = (unsigned)bit; }
      __syncthreads();
      NTm = 4 * __builtin_popcount(U);
    }
    const int NTT = __builtin_amdgcn_readfirstlane(NTm);
    float m_reg = NEGB, l_reg = 0.f;
    if (MODE == 0) { m_reg = A_sinks[hh] * LOG2E; l_reg = 1.f; }
    f32x16 o[4] = {};
#define KT(i) ((MODE == 1) ? (int)(__builtin_amdgcn_readfirstlane(((const unsigned*)(lds + OFF_MISC))[8 + ((i) >> 2)]) * 256u) + ((i) & 3) * KVBLK : (t0 + (i)) * KVBLK)
#define SLOAD(i, k0) do { sr_[i].vs0 = *reinterpret_cast<const bf16x8*>(&Vh[(long)((k0) + sr) * LDP + sc]); sr_[i].vs1 = *reinterpret_cast<const bf16x8*>(&Vh[(long)((k0) + 32 + sr) * LDP + sc]); \
    if (DQK == 128) { sr_[i].ks0 = *reinterpret_cast<const bf16x8*>(&Kh[(long)((k0) + sr) * LDP + sc]); sr_[i].ks1 = *reinterpret_cast<const bf16x8*>(&Kh[(long)((k0) + 32 + sr) * LDP + sc]); } \
    else { sr_[i].ks0 = *reinterpret_cast<const bf16x8*>(&Kh[(long)((k0) + (tid >> 3)) * LDP + (tid & 7) * 8]); } } while (0)
#define SWRITE(bb, i) do { *(bf16x8*)(V_lds + (bb) * SHM_V + vst0) = sr_[i].vs0; *(bf16x8*)(V_lds + (bb) * SHM_V + vst1) = sr_[i].vs1; \
    if (DQK == 128) { *(bf16x8*)(K_lds + (bb) * SHM_K + kswz<DQK>(sr, sc * 2)) = sr_[i].ks0; *(bf16x8*)(K_lds + (bb) * SHM_K + kswz<DQK>(32 + sr, sc * 2)) = sr_[i].ks1; } \
    else { *(bf16x8*)(K_lds + (bb) * SHM_K + kswz<DQK>(tid >> 3, (tid & 7) * 16)) = sr_[i].ks0; } } while (0)
#define SWAIT() do { if (SDEPTH == 1) asm volatile("s_waitcnt vmcnt(0)" ::: "memory"); else if (DQK == 128) asm volatile("s_waitcnt vmcnt(4)" ::: "memory"); else asm volatile("s_waitcnt vmcnt(3)" ::: "memory"); } while (0)
#define RESC(a) do { if (__any((a) < 1.f)) { if (hi == 0) al_l[r32] = (a); asm volatile("s_waitcnt lgkmcnt(0)" ::: "memory"); \
    _Pragma("unroll") for (int d = 0; d < 4; ++d) _Pragma("unroll") for (int r = 0; r < 16; ++r) o[d][r] *= al_l[crow(r, hi)]; } } while (0)
#define TSM(P0, P1, ti, AL) tile_sm<MODE>(P0, P1, KT(ti), qpos, wave_qmin, hi, C, lut, cfar, sel, qb, m_reg, AL)
    typedef __attribute__((address_space(3))) unsigned las_u32;
#define MLOAD2(k0, bb) do { const char* kg_ = (const char*)(Kh + (long)(k0) * LDP); const char* vg_ = (const char*)(Vh + (long)(k0) * LDP); \
    int ll_ = lane; asm volatile("" : "+v"(ll_));                 \
    _Pragma("unroll") for (int i_ = 0; i_ < 2; ++i_) { const int q_ = (i_ * 8 + wid) * 64 + ll_; \
      const int row_ = q_ >> 4, pos_ = q_ & 15; const unsigned koff_ = (unsigned)((row_ * LDP + ((pos_ ^ (row_ & 7)) << 3)) * 2); \
      const int st_ = q_ >> 5, kk_ = ((st_ >> 2) << 3) | ((q_ >> 2) & 7), c_ = ((st_ & 3) << 5) | ((q_ & 3) << 3), k_ = (kk_ & ~0xC) | ((kk_ & 4) << 1) | ((kk_ & 8) >> 1); const unsigned voff_ = (unsigned)((k_ * LDP + c_) * 2); \
      __builtin_amdgcn_global_load_lds((const unsigned*)(kg_ + koff_), (las_u32*)(K_lds + (bb) * SHM_K + (i_ * 8 + wid) * 1024), 16, 0, 0); \
      __builtin_amdgcn_global_load_lds((const unsigned*)(vg_ + voff_), (las_u32*)(V_lds + (bb) * SHM_V + (i_ * 8 + wid) * 1024), 16, 0, 0); } } while (0)
    __syncthreads();
    MLOAD2(KT(0), 0); asm volatile("s_waitcnt vmcnt(0)" ::: "memory"); __syncthreads();
#pragma unroll 1
    for (int j = 0; j < NTT; ++j) {
      const int bb = j & 1; const int kt = KT(j);
      if (j + 1 < NTT) MLOAD2(KT(j + 1), bb ^ 1);
      if (kt <= wave_qmin + QBLK - 1) {
        f32x16 p0, p1; float al;
        qkt<DQK>(p0, p1, K_lds + bb * SHM_K, qr, r32, hi);
        float Ce, off;
        if (kt + 63 + 128 > wave_qmin) { bias_mask<MODE>(p0, p1, kt, qpos, wave_qmin, hi, C, (const float*)((const char*)lut + (OFF_LUT4 - OFF_LUT)), cfar, sel, qb); off = near_head(p0, p1, m_reg, al); Ce = 1.f; }
        else { off = far_head<MODE>(p0, p1, kt, C, cfar, sel, qb, m_reg, al); Ce = C; }
        RESC(al);
        SBAR();
        far_tail(o, vb0 + bb * SHM_V, p0, p1, Ce, off, al, l_reg);
      }
      asm volatile("s_waitcnt vmcnt(0)" ::: "memory");
      __syncthreads();
    }
#undef MLOAD2
#undef KT
#undef SLOAD
#undef SWRITE
#undef SWAIT
#undef RESC
#undef TSM
    int r32e = r32, hie = hi; asm volatile("" : "+v"(r32e), "+v"(hie));
    if (hi == 0) li_l[r32] = l_reg; asm volatile("s_waitcnt lgkmcnt(0)" ::: "memory");
#pragma unroll
    for (int r = 0; r < 16; ++r) { const int orow = crow(r, hie); const float rli = __builtin_amdgcn_rcpf(li_l[orow]);
#pragma unroll
      for (int d0 = 0; d0 < 4; ++d0) { unsigned short* sp = (unsigned short*)(stg + orow * STG_PITCH) + d0 * 32 + r32e; float v = o[d0][r] * rli;
        if (MODE == 2 && pass == 1) v = __uint_as_float(((unsigned)*sp) << 16) - lam * v;
        *sp = (unsigned short)(cvtpk(v, v) & 0xffffu); } }
    asm volatile("s_waitcnt lgkmcnt(0)" ::: "memory");
    if (pass == NPASS - 1) {
      const char* rp = stg + r32e * STG_PITCH + hie * 128;
      u32x4 w[8];
#pragma unroll
      for (int i = 0; i < 8; ++i) w[i] = *(const u32x4*)(rp + i * 16);
      if (MODE == 2) {
        float ss = 0.f;
#pragma unroll
        for (int i = 0; i < 8; ++i)
#pragma unroll
          for (int k = 0; k < 4; ++k) { const float lo = __uint_as_float(w[i][k] << 16), hi_ = __uint_as_float(w[i][k] & 0xffff0000u); ss += lo * lo + hi_ * hi_; }
        { auto rr = __builtin_amdgcn_permlane32_swap(__float_as_uint(ss), __float_as_uint(ss), false, false); ss = __uint_as_float(rr[0]) + __uint_as_float(rr[1]); }
        const float sc2 = rsqrtf(ss * (1.0f / 128.0f) + 1e-6f) * (1.0f - A.lambda_init);
        const float* gp = A_subln + hie * 64;
#pragma unroll
        for (int i = 0; i < 8; ++i)
#pragma unroll
          for (int k = 0; k < 4; ++k) { const float lo = __uint_as_float(w[i][k] << 16) * sc2 * gp[i * 8 + 2 * k], hi_ = __uint_as_float(w[i][k] & 0xffff0000u) * sc2 * gp[i * 8 + 2 * k + 1]; w[i][k] = cvtpk(lo, hi_); }
      }
      unsigned short* op = A_ycat + (rowb + q0 + wid * QBLK + r32e) * LDY + OCOL + hh * 128 + hie * 64;
#pragma unroll
      for (int i = 0; i < 8; ++i) *(u32x4*)(op + i * 8) = w[i];
    }
  }
}
template <int MODE> __device__ __forceinline__ void unit_luts(char* lds, int hh, int tid) {
  float* lut = (float*)(lds + OFF_LUT); const float* lh = (const float*)(lds + OFF_LUTH) + hh * 128;
  if (tid < 128) lut[tid] = lh[tid];
  float* l4 = (float*)(lds + OFF_LUT4);
#pragma unroll 1
  for (int i = tid; i < LUT4_COPIES * LUT4_N; i += 512) { const int c = i / LUT4_N, j = i % LUT4_N, d = 256 + c - j;
    l4[i] = (c == 4 || d < 0 || (MODE == 0 && d >= 128)) ? NEGB : lh[d < 127 ? d : 127]; }
}
__device__ __forceinline__ void pv_sm_split(f32x16* o, int vb, bf16x8 pa0, bf16x8 pa1, bf16x8 pa2, bf16x8 pa3,
                                            f32x16& p0, f32x16& p1, float alpha, float& l_reg, bf16x8& pb0, bf16x8& pb1, bf16x8& pb2, bf16x8& pb3) {
  s16x4 va[8], vc[8]; float ps = 0.f;
#define TR8(D0, L) do { L[0] = tr_read<v_rd_off(D0, 0, 0)>(vb); L[1] = tr_read<v_rd_off(D0, 0, 1)>(vb); L[2] = tr_read<v_rd_off(D0, 1, 0)>(vb); L[3] = tr_read<v_rd_off(D0, 1, 1)>(vb); \
    L[4] = tr_read<v_rd_off(D0, 2, 0)>(vb); L[5] = tr_read<v_rd_off(D0, 2, 1)>(vb); L[6] = tr_read<v_rd_off(D0, 3, 0)>(vb); L[7] = tr_read<v_rd_off(D0, 3, 1)>(vb); } while (0)
#define PK(L, H) (bf16x8){L[0], L[1], L[2], L[3], H[0], H[1], H[2], H[3]}
#define MF(OA, PA, L, K) do { OA = __builtin_amdgcn_mfma_f32_32x32x16_bf16(PA, PK(L[2 * (K)], L[2 * (K) + 1]), OA, 0, 0, 0); SBAR(); } while (0)
#define FE(K) do { p1[2 * (K)] = __builtin_amdgcn_exp2f(p1[2 * (K)]); p1[2 * (K) + 1] = __builtin_amdgcn_exp2f(p1[2 * (K) + 1]); ps += p0[2 * (K)]; ps += p0[2 * (K) + 1]; SBAR(); } while (0)
#define FS(K) do { ps += p1[4 * (K)]; ps += p1[4 * (K) + 1]; ps += p1[4 * (K) + 2]; ps += p1[4 * (K) + 3]; SBAR(); } while (0)
#define PK4(P, BASE, OUT) do { unsigned a0 = cvtpk(P[BASE + 0], P[BASE + 1]), a1 = cvtpk(P[BASE + 2], P[BASE + 3]);   \
    unsigned b0 = cvtpk(P[BASE + 4], P[BASE + 5]), b1 = cvtpk(P[BASE + 6], P[BASE + 7]);                              \
    auto r0 = __builtin_amdgcn_permlane32_swap(a0, b0, false, false); auto r1 = __builtin_amdgcn_permlane32_swap(a1, b1, false, false); \
    u32x4 w = {r0[0], r1[0], r0[1], r1[1]}; OUT = *reinterpret_cast<bf16x8*>(&w); SBAR(); } while (0)
  TR8(0, va); TR8(1, vc); asm volatile("s_waitcnt lgkmcnt(8)" ::: "memory"); SBAR();
  MF(o[0], pa0, va, 0); FE(0); MF(o[0], pa1, va, 1); FE(1); MF(o[0], pa2, va, 2); FE(2); MF(o[0], pa3, va, 3); FE(3);
  TR8(2, va); asm volatile("s_waitcnt lgkmcnt(8)" ::: "memory"); SBAR();
  MF(o[1], pa0, vc, 0); FE(4); MF(o[1], pa1, vc, 1); FE(5); MF(o[1], pa2, vc, 2); FE(6); MF(o[1], pa3, vc, 3); FE(7);
  TR8(3, vc); asm volatile("s_waitcnt lgkmcnt(8)" ::: "memory"); SBAR();
  MF(o[2], pa0, va, 0); FS(0); MF(o[2], pa1, va, 1); FS(1); MF(o[2], pa2, va, 2); FS(2); MF(o[2], pa3, va, 3); FS(3);
  { auto rr = __builtin_amdgcn_permlane32_swap(__float_as_uint(ps), __float_as_uint(ps), false, false); ps = __uint_as_float(rr[0]) + __uint_as_float(rr[1]); }
  l_reg = l_reg * alpha + ps;
  asm volatile("s_waitcnt lgkmcnt(0)" ::: "memory"); SBAR();
  MF(o[3], pa0, vc, 0); PK4(p0, 0, pb0); MF(o[3], pa1, vc, 1); PK4(p0, 8, pb1); MF(o[3], pa2, vc, 2); PK4(p1, 0, pb2); MF(o[3], pa3, vc, 3); PK4(p1, 8, pb3);
#undef PK4
#undef FS
#undef FE
#undef MF
#undef PK
#undef TR8
}
__device__ __forceinline__ void qkt_half_sm_split(f32x16& q0, f32x16& q1, const char* Ks, const char* Qs, int r32, int hi,
                                                  f32x16& p0, f32x16& p1, float alpha, float& l_reg, bf16x8& pa0, bf16x8& pa1, bf16x8& pa2, bf16x8& pa3) {
  asm volatile("" : "+v"(r32));
  q0 = f32x16{}; q1 = f32x16{};
  float ps = 0.f;
  bf16x8 qfA, b0A, b1A, qfB, b0B, b1B;
#define LDF(D0, QF, B0, B1) do { const int cb_ = (64 + (D0) * 16 + hi * 8) * 2; QF = *reinterpret_cast<const bf16x8*>(Qs + kswz<128>(r32, cb_)); \
    B0 = *reinterpret_cast<const bf16x8*>(Ks + kswz<128>(r32, cb_)); B1 = *reinterpret_cast<const bf16x8*>(Ks + kswz<128>(32 + r32, cb_)); } while (0)
  LDF(0, qfA, b0A, b1A); LDF(1, qfB, b0B, b1B);
  SBAR();
#define FE4(K) do { p1[4 * (K)] = __builtin_amdgcn_exp2f(p1[4 * (K)]); p1[4 * (K) + 1] = __builtin_amdgcn_exp2f(p1[4 * (K) + 1]); p1[4 * (K) + 2] = __builtin_amdgcn_exp2f(p1[4 * (K) + 2]); p1[4 * (K) + 3] = __builtin_amdgcn_exp2f(p1[4 * (K) + 3]); \
    ps += p0[4 * (K)]; ps += p0[4 * (K) + 1]; ps += p0[4 * (K) + 2]; ps += p0[4 * (K) + 3]; SBAR(); } while (0)
#define FS8(K) do { ps += p1[8 * (K)]; ps += p1[8 * (K) + 1]; ps += p1[8 * (K) + 2]; ps += p1[8 * (K) + 3]; ps += p1[8 * (K) + 4]; ps += p1[8 * (K) + 5]; ps += p1[8 * (K) + 6]; ps += p1[8 * (K) + 7]; SBAR(); } while (0)
#define PK4(P, BASE, OUT) do { unsigned a0 = cvtpk(P[BASE + 0], P[BASE + 1]), a1 = cvtpk(P[BASE + 2], P[BASE + 3]);   \
    unsigned c0 = cvtpk(P[BASE + 4], P[BASE + 5]), c1 = cvtpk(P[BASE + 6], P[BASE + 7]);                              \
    auto r0 = __builtin_amdgcn_permlane32_swap(a0, c0, false, false); auto r1 = __builtin_amdgcn_permlane32_swap(a1, c1, false, false); \
    u32x4 w = {r0[0], r1[0], r0[1], r1[1]}; OUT = *reinterpret_cast<bf16x8*>(&w); SBAR(); } while (0)
  q0 = __builtin_amdgcn_mfma_f32_32x32x16_bf16(b0A, qfA, q0, 0, 0, 0); SBAR(); FE4(0);
  q1 = __builtin_amdgcn_mfma_f32_32x32x16_bf16(b1A, qfA, q1, 0, 0, 0); SBAR(); LDF(2, qfA, b0A, b1A); SBAR(); FE4(1);
  q0 = __builtin_amdgcn_mfma_f32_32x32x16_bf16(b0B, qfB, q0, 0, 0, 0); SBAR(); FE4(2);
  q1 = __builtin_amdgcn_mfma_f32_32x32x16_bf16(b1B, qfB, q1, 0, 0, 0); SBAR(); LDF(3, qfB, b0B, b1B); SBAR(); FE4(3);
  q0 = __builtin_amdgcn_mfma_f32_32x32x16_bf16(b0A, qfA, q0, 0, 0, 0); SBAR(); FS8(0);
  q1 = __builtin_amdgcn_mfma_f32_32x32x16_bf16(b1A, qfA, q1, 0, 0, 0); SBAR(); FS8(1);
  { auto rr = __builtin_amdgcn_permlane32_swap(__float_as_uint(ps), __float_as_uint(ps), false, false); ps = __uint_as_float(rr[0]) + __uint_as_float(rr[1]); }
  l_reg = l_reg * alpha + ps; SBAR();
  q0 = __builtin_amdgcn_mfma_f32_32x32x16_bf16(b0B, qfB, q0, 0, 0, 0); SBAR(); PK4(p0, 0, pa0); PK4(p0, 8, pa1);
  q1 = __builtin_amdgcn_mfma_f32_32x32x16_bf16(b1B, qfB, q1, 0, 0, 0); SBAR(); PK4(p1, 0, pa2); PK4(p1, 8, pa3);
#undef LDF
#undef PK4
#undef FS8
#undef FE4
}
template <int D0> __device__ __forceinline__ void pv_one2(f32x16& oa, f32x16& ob, int vb, bf16x8 pa0, bf16x8 pa1, bf16x8 pa2, bf16x8 pa3, bf16x8 pb0, bf16x8 pb1, bf16x8 pb2, bf16x8 pb3) {
  const s16x4 l0 = tr_read<v_rd_off(D0, 0, 0)>(vb), h0 = tr_read<v_rd_off(D0, 0, 1)>(vb), l1 = tr_read<v_rd_off(D0, 1, 0)>(vb), h1 = tr_read<v_rd_off(D0, 1, 1)>(vb);
  const s16x4 l2 = tr_read<v_rd_off(D0, 2, 0)>(vb), h2 = tr_read<v_rd_off(D0, 2, 1)>(vb), l3 = tr_read<v_rd_off(D0, 3, 0)>(vb), h3 = tr_read<v_rd_off(D0, 3, 1)>(vb);
  asm volatile("s_waitcnt lgkmcnt(0)" ::: "memory"); SBAR();
#if ATT_PRIO
  __builtin_amdgcn_s_setprio(ATT_PRIO);
#endif
#define PK(L, H) (bf16x8){L[0], L[1], L[2], L[3], H[0], H[1], H[2], H[3]}
  oa = __builtin_amdgcn_mfma_f32_32x32x16_bf16(pa0, PK(l0, h0), oa, 0, 0, 0); ob = __builtin_amdgcn_mfma_f32_32x32x16_bf16(pb0, PK(l0, h0), ob, 0, 0, 0);
  oa = __builtin_amdgcn_mfma_f32_32x32x16_bf16(pa1, PK(l1, h1), oa, 0, 0, 0); ob = __builtin_amdgcn_mfma_f32_32x32x16_bf16(pb1, PK(l1, h1), ob, 0, 0, 0);
  oa = __builtin_amdgcn_mfma_f32_32x32x16_bf16(pa2, PK(l2, h2), oa, 0, 0, 0); ob = __builtin_amdgcn_mfma_f32_32x32x16_bf16(pb2, PK(l2, h2), ob, 0, 0, 0);
  oa = __builtin_amdgcn_mfma_f32_32x32x16_bf16(pa3, PK(l3, h3), oa, 0, 0, 0); ob = __builtin_amdgcn_mfma_f32_32x32x16_bf16(pb3, PK(l3, h3), ob, 0, 0, 0);
#if ATT_PRIO
  __builtin_amdgcn_s_setprio(0);
#endif
#undef PK
}
__device__ __forceinline__ void qkt_half(f32x16& p0, f32x16& p1, const char* Ks, const char* Qs, int c, int r32, int hi) {
  asm volatile("" : "+v"(r32));
  p0 = f32x16{}; p1 = f32x16{};
#pragma unroll
  for (int d0 = 0; d0 < 4; ++d0) { const int cb = (c * 64 + d0 * 16 + hi * 8) * 2;
    const bf16x8 qf = *reinterpret_cast<const bf16x8*>(Qs + kswz<128>(r32, cb));
    const bf16x8 b0 = *reinterpret_cast<const bf16x8*>(Ks + kswz<128>(r32, cb));
    const bf16x8 b1 = *reinterpret_cast<const bf16x8*>(Ks + kswz<128>(32 + r32, cb));
    p0 = __builtin_amdgcn_mfma_f32_32x32x16_bf16(b0, qf, p0, 0, 0, 0);
    p1 = __builtin_amdgcn_mfma_f32_32x32x16_bf16(b1, qf, p1, 0, 0, 0); }
}
__device__ __forceinline__ void attn_diff_fused(const AttnArgs& A, int b, int hh, int qb, float lam, char* lds, int tid) {
  constexpr int QCOL = 2816, KCOL = 3584, VCOL = 4352, OCOL = 1280;
  const float C = 0.125f * LOG2E;
  const int lane = tid & 63, r32 = lane & 31, hi = lane >> 5; const int wid = __builtin_amdgcn_readfirstlane(tid >> 6);
  char* V_lds = lds + OFF_V; char* K_lds = lds + OFF_K;
  float* wsl = (float*)(lds + OFF_WS) + wid * 64;
  const float* lut = (const float*)(lds + OFF_LUT);
  char* stg = lds + OFF_STG + wid * STG_WAVE;
  const int q0 = qb * 256;
  const int qpos = q0 + wid * QBLK + r32, wave_qmin = q0 + wid * QBLK;
  const long rowb = (long)b * SEQL;
  const int NT = 4 * qb + 4;
  const int vb0 = (int)(uintptr_t)V_lds + v_rd_base(lane);
  const unsigned short* Vh = A_proj + rowb * LDP + VCOL + hh * 128;
  const unsigned short* Kh = A_proj + rowb * LDP + KCOL + hh * 128;
  float m0 = NEGB, l0 = 0.f, m1 = NEGB, l1 = 0.f;
  f32x16 o0[4] = {}, o1[4] = {};
  typedef __attribute__((address_space(3))) unsigned las_u32;
#define SLOAD2(k0, bb) do { const char* kg_ = (const char*)(Kh + (long)(k0) * LDP); const char* vg_ = (const char*)(Vh + (long)(k0) * LDP); \
    int ll_ = lane; asm volatile("" : "+v"(ll_));                 \
    _Pragma("unroll") for (int i_ = 0; i_ < 2; ++i_) { const int q_ = (i_ * 8 + wid) * 64 + ll_; \
      const int row_ = q_ >> 4, pos_ = q_ & 15; const unsigned koff_ = (unsigned)((row_ * LDP + ((pos_ ^ (row_ & 7)) << 3)) * 2); \
      const int st_ = q_ >> 5, kk_ = ((st_ >> 2) << 3) | ((q_ >> 2) & 7), c_ = ((st_ & 3) << 5) | ((q_ & 3) << 3), k_ = (kk_ & ~0xC) | ((kk_ & 4) << 1) | ((kk_ & 8) >> 1); const unsigned voff_ = (unsigned)((k_ * LDP + c_) * 2); \
      __builtin_amdgcn_global_load_lds((const unsigned*)(kg_ + koff_), (las_u32*)(K_lds + (bb) * SHM_K + (i_ * 8 + wid) * 1024), 16, 0, 0); \
      __builtin_amdgcn_global_load_lds((const unsigned*)(vg_ + voff_), (las_u32*)(V_lds + (bb) * SHM_V + (i_ * 8 + wid) * 1024), 16, 0, 0); } } while (0)
#define RESC2(a, oo, sl) do { if (__any((a) < 1.f)) { if (hi == 0) (sl)[r32] = (a); asm volatile("s_waitcnt lgkmcnt(0)" ::: "memory"); \
    _Pragma("unroll") for (int d = 0; d < 4; ++d) _Pragma("unroll") for (int r = 0; r < 16; ++r) oo[d][r] *= (sl)[crow(r, hi)]; } } while (0)
  SLOAD2(0, 0);
  { const unsigned short* Qg = A_proj + (rowb + q0 + wid * QBLK) * LDP + QCOL + hh * 128;
    bf16x8 qv[8];
#pragma unroll
    for (int i = 0; i < 8; ++i) { const int c = lane + 64 * i, row = c >> 4, cc = c & 15; qv[i] = *reinterpret_cast<const bf16x8*>(Qg + (long)row * LDP + cc * 8); }
    unit_luts<2>(lds, hh, tid);
#pragma unroll
    for (int i = 0; i < 8; ++i) { const int c = lane + 64 * i, row = c >> 4, cc = c & 15; *(bf16x8*)(stg + kswz<128>(row, cc * 16)) = qv[i]; } }
  asm volatile("s_waitcnt vmcnt(0)" ::: "memory"); __syncthreads();
  const float cfar = lut[127];
#pragma unroll 1
  for (int j = 0; j < NT; ++j) {
    const int bb = j & 1; const int kt = j * KVBLK;
    if (j + 1 < NT) SLOAD2((j + 1) * KVBLK, bb ^ 1);
    if (kt <= wave_qmin + QBLK - 1) {
    f32x16 p0, p1, q0, q1; float al0, al1; bf16x8 pa0, pa1, pa2, pa3, pb0, pb1, pb2, pb3;
    qkt_half(p0, p1, K_lds + bb * SHM_K, stg, 0, r32, hi);
    tile_sm<2>(p0, p1, kt, qpos, wave_qmin, hi, C, lut, cfar, 0u, qb, m0, al0);
    SBAR();
    qkt_half_sm_split(q0, q1, K_lds + bb * SHM_K, stg, r32, hi, p0, p1, al0, l0, pa0, pa1, pa2, pa3);
    RESC2(al0, o0, wsl);
    SBAR();
    tile_sm<2>(q0, q1, kt, qpos, wave_qmin, hi, C, lut, cfar, 0u, qb, m1, al1);
    RESC2(al1, o1, wsl + 32);
    SBAR();
    pv_sm_split(o0, vb0 + bb * SHM_V, pa0, pa1, pa2, pa3, q0, q1, al1, l1, pb0, pb1, pb2, pb3);
    SBAR();
    pv_all1(o1, vb0 + bb * SHM_V, pb0, pb1, pb2, pb3);
    }
    asm volatile("s_waitcnt vmcnt(0)" ::: "memory");
    __syncthreads();
  }
#undef SLOAD2
#undef RESC2
  int r32e = r32, hie = hi; asm volatile("" : "+v"(r32e), "+v"(hie));
  if (hi == 0) { wsl[r32] = l0; wsl[32 + r32] = l1; } asm volatile("s_waitcnt lgkmcnt(0)" ::: "memory");
#pragma unroll
  for (int r = 0; r < 16; ++r) { const int orow = crow(r, hie); const float ra = __builtin_amdgcn_rcpf(wsl[orow]), rb = lam * __builtin_amdgcn_rcpf(wsl[32 + orow]);
#pragma unroll
    for (int d0 = 0; d0 < 4; ++d0) { unsigned short* sp = (unsigned short*)(stg + orow * STG_PITCH) + d0 * 32 + r32e; const float v = o0[d0][r] * ra - o1[d0][r] * rb;
      *sp = (unsigned short)(cvtpk(v, v) & 0xffffu); } }
  asm volatile("s_waitcnt lgkmcnt(0)" ::: "memory");
  { const char* rp = stg + r32e * STG_PITCH + hie * 128;
    u32x4 w[8];
#pragma unroll
    for (int i = 0; i < 8; ++i) w[i] = *(const u32x4*)(rp + i * 16);
    float ss = 0.f;
#pragma unroll
    for (int i = 0; i < 8; ++i)
#pragma unroll
      for (int k = 0; k < 4; ++k) { const float lo = __uint_as_float(w[i][k] << 16), hi_ = __uint_as_float(w[i][k] & 0xffff0000u); ss += lo * lo + hi_ * hi_; }
    { auto rr = __builtin_amdgcn_permlane32_swap(__float_as_uint(ss), __float_as_uint(ss), false, false); ss = __uint_as_float(rr[0]) + __uint_as_float(rr[1]); }
    const float sc2 = rsqrtf(ss * (1.0f / 128.0f) + 1e-6f) * (1.0f - A.lambda_init);
    const f32x4* gp = (const f32x4*)(A_subln + hie * 64);
    f32x4 gq[16];
#pragma unroll
    for (int i = 0; i < 16; ++i) gq[i] = gp[i];
#pragma unroll
    for (int i = 0; i < 8; ++i)
#pragma unroll
      for (int k = 0; k < 4; ++k) { const float lo = __uint_as_float(w[i][k] << 16) * sc2 * gq[2 * i + (k >> 1)][2 * (k & 1)], hi_ = __uint_as_float(w[i][k] & 0xffff0000u) * sc2 * gq[2 * i + (k >> 1)][2 * (k & 1) + 1]; w[i][k] = cvtpk(lo, hi_); }
    unsigned short* op = A_ycat + (rowb + q0 + wid * QBLK + r32e) * LDY + OCOL + hh * 128 + hie * 64;
#pragma unroll
    for (int i = 0; i < 8; ++i) *(u32x4*)(op + i * 8) = w[i];
  }
}
__device__ __forceinline__ void attn_swa_wave(const AttnArgs& A, int b, int hh, int qb, char* lds, int tid) {
  constexpr int QCOL = 0, KCOL = 768, VCOL = 1024, OCOL = 0;
  const float C = 0.088388347648318440f * LOG2E;
  const int lane = tid & 63, r32 = lane & 31, hi = lane >> 5; const int wid = __builtin_amdgcn_readfirstlane(tid >> 6);
  const int kvh = hh / 3;
  char* vpriv = lds + (wid < 4 ? wid * 16384 : OFF_STG + (wid - 4) * 16384);
  float* wsl = (float*)(lds + OFF_WS) + wid * 64; float* li_l = wsl; float* al_l = wsl + 32;
  const float* lut = (const float*)(lds + OFF_LUT);
  const int q0 = qb * 256, q0w = q0 + wid * QBLK, qpos = q0w + r32;
  const long rowb = (long)b * SEQL;
  const float cfar = lut[127];
  const unsigned short* Vh = A_proj + rowb * LDP + VCOL + kvh * 128;
  const unsigned short* Kh = A_proj + rowb * LDP + KCOL + kvh * 128 + hi * 8;
  const unsigned short* Qw = A_proj + (rowb + qpos) * LDP + QCOL + hh * 128 + hi * 8;
  bf16x8 qr[8];
#pragma unroll
  for (int d0 = 0; d0 < 8; ++d0) qr[d0] = *reinterpret_cast<const bf16x8*>(Qw + d0 * 16);
  float m_reg = A_sinks[hh] * LOG2E, l_reg = 1.f;
  f32x16 o[4] = {};
  const int vb = (int)(uintptr_t)vpriv + v_rd_base(lane);
  const int tfirst = (q0w >= 127) ? ((q0w - 127) >> 6) : 0, tlast = (q0w + 31) >> 6;
#pragma unroll 1
  for (int t = tfirst; t <= tlast; ++t) {
    const int kt = t * KVBLK;
    f32x16 p0 = {}, p1 = {};
    { bf16x8 kf0[8], kf1[8];
#pragma unroll
      for (int d0 = 0; d0 < 8; ++d0) { kf0[d0] = *reinterpret_cast<const bf16x8*>(Kh + (long)(kt + r32) * LDP + d0 * 16); kf1[d0] = *reinterpret_cast<const bf16x8*>(Kh + (long)(kt + 32 + r32) * LDP + d0 * 16); }
#pragma unroll
      for (int d0 = 0; d0 < 8; ++d0) { p0 = __builtin_amdgcn_mfma_f32_32x32x16_bf16(kf0[d0], qr[d0], p0, 0, 0, 0); p1 = __builtin_amdgcn_mfma_f32_32x32x16_bf16(kf1[d0], qr[d0], p1, 0, 0, 0); } }
    bf16x8 vs[16];
#pragma unroll
    for (int i = 0; i < 16; ++i) { const int q = lane + 64 * i; vs[i] = *reinterpret_cast<const bf16x8*>(Vh + (long)(kt + (q >> 4)) * LDP + (q & 15) * 8); }
    float al; bf16x8 pa0, pa1, pa2, pa3;
    tile_sm<0>(p0, p1, kt, qpos, q0w, hi, C, lut, cfar, 0u, qb, m_reg, al);
    finishSM(p0, p1, al, l_reg, pa0, pa1, pa2, pa3);
    if (__any(al < 1.f)) { if (hi == 0) al_l[r32] = al; asm volatile("s_waitcnt lgkmcnt(0)" ::: "memory");
#pragma unroll
      for (int d = 0; d < 4; ++d)
#pragma unroll
        for (int r = 0; r < 16; ++r) o[d][r] *= al_l[crow(r, hi)]; }
#pragma unroll
    for (int i = 0; i < 16; ++i) { const int q = lane + 64 * i; *(bf16x8*)(vpriv + v_st(q >> 4, (q & 15) * 8)) = vs[i]; }
    asm volatile("s_waitcnt lgkmcnt(0)" ::: "memory"); SBAR();
    pv_d0(o, vb, pa0, pa1, pa2, pa3);
    asm volatile("s_waitcnt lgkmcnt(0)" ::: "memory"); SBAR();
  }
  int r32e = r32, hie = hi; asm volatile("" : "+v"(r32e), "+v"(hie));
  if (hi == 0) li_l[r32] = l_reg; asm volatile("s_waitcnt lgkmcnt(0)" ::: "memory");
#pragma unroll
  for (int r = 0; r < 16; ++r) { const int orow = crow(r, hie); const float rli = __builtin_amdgcn_rcpf(li_l[orow]);
#pragma unroll
    for (int d0 = 0; d0 < 4; ++d0) { unsigned short* sp = (unsigned short*)(vpriv + orow * STG_PITCH) + d0 * 32 + r32e; const float v = o[d0][r] * rli; *sp = (unsigned short)(cvtpk(v, v) & 0xffffu); } }
  asm volatile("s_waitcnt lgkmcnt(0)" ::: "memory");
  { const char* rp = vpriv + r32e * STG_PITCH + hie * 128; u32x4 w[8];
#pragma unroll
    for (int i = 0; i < 8; ++i) w[i] = *(const u32x4*)(rp + i * 16);
    unsigned short* op = A_ycat + (rowb + q0w + r32e) * LDY + OCOL + hh * 128 + hie * 64;
#pragma unroll
    for (int i = 0; i < 8; ++i) *(u32x4*)(op + i * 8) = w[i]; }
}
template <int MODE>
__device__ __forceinline__ float attn_mode_setup(const AttnArgs& A, char* lds, const int wave_idx) {
  constexpr int HB0 = (MODE == 0) ? 0 : (MODE == 1) ? 6 : 10, NH = (MODE == 1) ? 4 : 6;
  const int lane = mk_lane(), tid = wave_idx * 64 + lane;
  __syncthreads();
  float* lh = (float*)(lds + OFF_LUTH);
#pragma unroll 1
  for (int i = tid; i < NH * 128; i += 512) lh[i] = A_rel_bias[(int)REL_BUCKET_TAB[i & 127] * 16 + HB0 + (i >> 7)] * LOG2E;
  float lam = 0.f;
  if (MODE == 2) { float a = A_lq1[lane] * A_lk1[lane], c2 = A_lq2[lane] * A_lk2[lane];
#pragma unroll
    for (int o_ = 1; o_ < 64; o_ <<= 1) { a += mk_shfl_xor(a, o_); c2 += mk_shfl_xor(c2, o_); }
    lam = __expf(a) - __expf(c2) + A.lambda_init; }
  __syncthreads();
  return __builtin_bit_cast(float, __builtin_amdgcn_readfirstlane(__builtin_bit_cast(int, lam)));
}
template <int MODE>
__device__ __forceinline__ void attn_unit(const AttnArgs& A, int b, int hh, int qb, char* lds, const int wave_idx, float lam) {
  constexpr int NPASS = (MODE == 2) ? 2 : 1;
  const int lane = mk_lane(), tid = wave_idx * 64 + lane;
  float* lut = (float*)(lds + OFF_LUT);
  __syncthreads();
  if (MODE == 1 && tid == 0) ((unsigned*)(lds + OFF_MISC))[4] = 0u;
  if (MODE == 1) { const float* kp_ = A_kpart + (size_t)((b * 4 + hh) * 16) * 128 + tid * 4; *(f32x4*)(lds + OFF_STG + tid * 16) = (*(const f32x4*)kp_ + *(const f32x4*)(kp_ + ATT_KP_N)) * (1.f / 256.f); }
  if (!(MODE == 2 && ATT_DIFF_FUSED)) { unit_luts<MODE>(lds, hh, tid); __syncthreads(); }
  asm volatile("" : "+v"(lam));
  if (MODE == 2 && ATT_DIFF_FUSED) { attn_diff_fused(A, b, hh, qb, lam, lds, wave_idx * 64 + mk_lane()); }
  else if (MODE == 0 && ATT_SWA_WAVE) { attn_swa_wave(A, b, hh, qb, lds, wave_idx * 64 + mk_lane()); }
  else {
#pragma unroll 1
  for (int pass = 0; pass < NPASS; ++pass) {
    attn_pass<MODE>(A, b, hh, qb, pass, lam, lds, wave_idx * 64 + mk_lane());
  }
  }
}
#undef SBAR
}
#undef A_proj
#undef A_ycat
#undef A_kmean
#undef A_kpart
#undef A_rel_bias
#undef A_sinks
#undef A_lq1
#undef A_lk1
#undef A_lq2
#undef A_lk2
#undef A_subln
#define GAS __attribute__((address_space(1)))
#define LAS __attribute__((address_space(3)))
typedef unsigned short bf16;
typedef unsigned v4u __attribute__((ext_vector_type(4)));
typedef float f32x4 __attribute__((ext_vector_type(4)));
typedef short bf16x8 __attribute__((ext_vector_type(8)));
typedef GAS unsigned gu32;
typedef GAS unsigned long long gu64;
#define RLX_AGENT __ATOMIC_RELAXED, __HIP_MEMORY_SCOPE_AGENT
#define LDS_WAIT() asm volatile("s_waitcnt lgkmcnt(0)" ::: "memory")
#define VM_WAIT() asm volatile("s_waitcnt vmcnt(0)" ::: "memory")
__device__ __forceinline__ unsigned long long rt() { return __builtin_amdgcn_s_memrealtime(); }
__device__ __forceinline__ unsigned f2bf(float f) { unsigned u = __builtin_bit_cast(unsigned, f); return (u + 0x7fffu + ((u >> 16) & 1u)) >> 16; }
__device__ __forceinline__ unsigned pk2(float lo, float hi) { return f2bf(lo) | (f2bf(hi) << 16); }

#define XB_TMO      128
#define XB_XCNT(j)  (256  + 64 * (j))
#define XB_XSUB(j)  (1280 + 64 * (j))
#define XB_XGEN(j)  (2304 + 64 * (j))
#define XB_TOP      3328
#define XB_TOPGEN   3392
#define XCD_BAR_WORDS 3456
#define XB_SPIN_CAP (1u << 18)

__device__ __forceinline__ unsigned xb_ld(unsigned* p)              { return __hip_atomic_load(p, __ATOMIC_RELAXED, __HIP_MEMORY_SCOPE_AGENT); }
__device__ __forceinline__ unsigned xb_add(unsigned* p, unsigned v) { return __hip_atomic_fetch_add(p, v, __ATOMIC_RELAXED, __HIP_MEMORY_SCOPE_AGENT); }
__device__ __forceinline__ unsigned xb_xcc_id() { return (unsigned)__builtin_amdgcn_s_getreg((3 << 11) | 20) & 0xFu; }
#define XB_SPIN(cond, bar) do { unsigned _sp = 0; while (cond) { __builtin_amdgcn_s_sleep(1); \
    if ((++_sp & 255u) == 0u) { if (xb_ld(&(bar)[XB_TMO])) break; if (_sp > XB_SPIN_CAP) { atomicAdd(&(bar)[XB_TMO], 1u); break; } } } } while (0)

struct XcdBarrier {
    unsigned* bar; unsigned x;
    volatile LAS unsigned* st;
};

__device__ __forceinline__ XcdBarrier xcd_barrier_post(unsigned* bar, volatile LAS unsigned* st) {
    XcdBarrier b; b.bar = bar; b.x = xb_xcc_id(); b.st = st;
    if (threadIdx.x == 0) (void)xb_add(&bar[XB_XCNT(b.x)], 1u);
    return b;
}
__device__ __forceinline__ void xcd_barrier_complete(unsigned* bar, unsigned x, unsigned& nloc, unsigned& nx) {
    const unsigned G = gridDim.x * gridDim.y * gridDim.z;
    unsigned sum, cnt, mine, sp = 0u;
    for (;;) {
        sum = 0u; cnt = 0u; mine = 0u;
#pragma unroll
        for (unsigned j = 0; j < 16; ++j) { const unsigned c = xb_ld(&bar[XB_XCNT(j)]); sum += c; cnt += (c > 0u) ? 1u : 0u; mine = (j == x) ? c : mine; }
        if (sum == G) break;
        __builtin_amdgcn_s_sleep(1);
        if ((++sp & 255u) == 0u) { if (xb_ld(&bar[XB_TMO])) break; if (sp > XB_SPIN_CAP) { atomicAdd(&bar[XB_TMO], 1u); break; } }
    }
    nloc = mine > 0u ? mine : 1u; nx = cnt > 0u ? cnt : 1u;
}

__device__ __forceinline__ void xcd_barrier(const XcdBarrier& b) {
    asm volatile("s_waitcnt vmcnt(0)" ::: "memory");
    __syncthreads();
    if (threadIdx.x == 0) {
        unsigned* bar = b.bar;
        __builtin_amdgcn_s_waitcnt(0);
        unsigned nloc = b.st[0], nx = b.st[1];
        if (nloc == 0u) { xcd_barrier_complete(bar, b.x, nloc, nx); b.st[0] = nloc; b.st[1] = nx; }
        const unsigned old = xb_add(&bar[XB_XSUB(b.x)], 1u);
        const unsigned gen = old / nloc;
        if (old + 1u == (gen + 1u) * nloc) {
            __builtin_amdgcn_fence(__ATOMIC_RELEASE, "agent");
            asm volatile("s_waitcnt vmcnt(0)" ::: "memory");
            const unsigned og = xb_add(&bar[XB_TOP], 1u);
            const unsigned tg = og / nx;
            if (og + 1u == (tg + 1u) * nx) xb_add(&bar[XB_TOPGEN], 1u);
            else XB_SPIN(xb_ld(&bar[XB_TOPGEN]) == tg, bar);
            __builtin_amdgcn_fence(__ATOMIC_ACQUIRE, "agent");
            xb_add(&bar[XB_XGEN(b.x)], 1u);
            asm volatile("s_waitcnt vmcnt(0)" ::: "memory");
        } else {
            XB_SPIN(xb_ld(&bar[XB_XGEN(b.x)]) == gen, bar);
            __builtin_amdgcn_fence(__ATOMIC_ACQUIRE, "agent");
            asm volatile("s_waitcnt vmcnt(0)" ::: "memory");
        }
    }
    __syncthreads();
}

constexpr int NWAVES = 8;
constexpr int BATCH = 8, SEQ = 4096, DM = 2048, DEPTH = 2, M = BATCH * SEQ, NIN = 5120, NEXP = 32, DEXP = 512, PLE = 256, NROUTE = 36;
constexpr int KB_OFF = 1792;
constexpr int RPAD = 73728;
constexpr float EPS = 1e-6f;
constexpr size_t MiB = 1u << 20;
constexpr size_t WS_CTL = 0, CTL_ZERO_BYTES = 1 * MiB;
constexpr size_t WS_KMEAN = 1 * MiB, WS_RSTD = WS_KMEAN + 256 * 1024, WS_TOKREC = WS_RSTD + 128 * 1024, WS_POS = WS_TOKREC + 1 * MiB, WS_WR = WS_POS + 256 * 1024;
constexpr size_t WS_WIN = 8 * MiB, WS_WOUT = 48 * MiB, WS_W13 = 64 * MiB, WS_W2 = 192 * MiB, WS_WG = 256 * MiB, WS_WP = 272 * MiB, WS_PB = 274 * MiB;
constexpr size_t WS_U = 306 * MiB, WS_PROJ = 434 * MiB, WS_YCAT = 754 * MiB, WS_PL = 882 * MiB, WS_HB = 1010 * MiB, WS_END = 1138 * MiB;
constexpr size_t WS_SSQ = WS_YCAT + 64 * MiB;
constexpr size_t WS_SRS = WS_YCAT + 72 * MiB;
constexpr size_t WS_LIST = 4 * MiB;
constexpr size_t WS_RSIN = WS_POS, WS_RSPLE = WS_POS + 128 * 1024;
constexpr size_t WS_XG = WS_PROJ, WS_HID = WS_PROJ + 288 * MiB, WS_Y = WS_XG;
static_assert(WS_WR + 2 * 2 * 48 * DM * 2 <= WS_LIST && WS_LIST + NEXP * 32768 * 4 <= WS_WIN && WS_HID + (size_t)RPAD * DEXP * 2 <= WS_PL && (size_t)RPAD * DM * 2 <= 288 * MiB && WS_W13 + (size_t)NEXP * 1024 * DM * 2 <= WS_W2 && WS_W2 + (size_t)NEXP * DM * DEXP * 2 <= WS_WG && WS_PB + (size_t)DEPTH * M * PLE * 2 <= WS_U, "d_ws map");
constexpr int CW_TMO = 0, CW_CODE = 1, CW_BAR = 4096, CW_CNT = 16384, CW_Q = 24576;
constexpr int PHASE_LDS = 139264;
constexpr int LDS_TILE_E = PHASE_LDS, LDS_OFFS = PHASE_LDS + 512, LDS_MISC = PHASE_LDS + 1024, LDSCTL_OFF = PHASE_LDS;
constexpr int LDS_BYTES = 147456 + att::LUT4_COPIES * att::LUT4_N * 4 + att::LUTH_BYTES;
static_assert(att::OFF_LUT4 == 147456 && LDS_BYTES <= 163840 && att::ATT_LDS <= PHASE_LDS && pg8::STAGE_BYTES <= PHASE_LDS && LDS_MISC + 128 + 8 * 32 <= LDS_BYTES, "LDS map");

__device__ __forceinline__ gu32* ctlptr() { return (gu32*)(wsptr() + WS_CTL); }
typedef float f32x2g __attribute__((ext_vector_type(2)));
typedef unsigned u32x2g __attribute__((ext_vector_type(2)));
__device__ __forceinline__ size_t hb_off(int k) { return (k & 1) ? WS_U : WS_HB; }
struct Frame {
    LAS unsigned char* lds;
    volatile LAS unsigned* MISC;
    int tid, lane, wave, G, gw, NGW;
};
struct Args { const float* in[22]; float* out; unsigned char* ws; int ph_lo, ph_hi, use_bar, pad; };
__device__ __forceinline__ Frame relaunder(const Frame& F0) {
    Frame F = F0; int w = F0.wave; asm volatile("" : "+s"(w)); F.wave = w; F.lane = mk_lane(); F.tid = w * 64 + F.lane; F.gw = blockIdx.x * NWAVES + w; return F;
}
__device__ __forceinline__ int opaque_i(int x) { asm volatile("" : "+s"(x)); return x; }
__device__ __forceinline__ float wave_sum(float v) {
#pragma unroll
    for (int o = 1; o < 64; o <<= 1) v += mk_shfl_xor(v, o);
    return v;
}
__device__ __forceinline__ unsigned pk2rne(float lo, float hi) { return pg8::cvt_pk_bf16(lo, hi); }
__device__ __forceinline__ float bfround(float x) { return __uint_as_float(pk2rne(x, x) << 16); }

struct ConvDesc { const float* W; int K, N; bf16* WT; int dst_row0, k0, n0; const float* gk; };
__device__ __forceinline__ void transpose_gains(const ConvDesc& d, float (&gv)[8], int lane) {
    const int rr = lane >> 3;
#pragma unroll
    for (int i = 0; i < 8; ++i) gv[i] = d.gk ? d.gk[d.k0 + 8 * i + rr] : 1.f;
}
__device__ __forceinline__ void transpose_load(const ConvDesc& d, f32x4 (&v)[8], int lane) {
    const int rr = lane >> 3, c4 = (lane & 7) * 4;
#pragma unroll
    for (int i = 0; i < 8; ++i) v[i] = __builtin_nontemporal_load((const GAS f32x4*)(d.W + (size_t)(d.k0 + 8 * i + rr) * d.N + d.n0 + c4));
}
__device__ __forceinline__ void transpose_store(const ConvDesc& d, f32x4 (&v)[8], float (&gv)[8], LAS float* scr, int lane, bool nt = false) {
    { const int rr = lane >> 3, c4 = (lane & 7) * 4;
#pragma unroll
      for (int i = 0; i < 8; ++i) { const f32x4 w = v[i] * gv[i]; LAS float* p = scr + (8 * i + rr) * 33 + c4; p[0] = w.x; p[1] = w.y; p[2] = w.z; p[3] = w.w; } }
    LDS_WAIT(); asm volatile("" ::: "memory");
    const int c = lane & 7;
#pragma unroll
    for (int j = 0; j < 4; ++j) { const int n = (lane >> 3) + 8 * j; const LAS float* s = scr + (8 * c) * 33 + n;
        v4u o; o.x = pk2rne(s[0 * 33], s[1 * 33]); o.y = pk2rne(s[2 * 33], s[3 * 33]); o.z = pk2rne(s[4 * 33], s[5 * 33]); o.w = pk2rne(s[6 * 33], s[7 * 33]);
        GAS v4u* dp = (GAS v4u*)(d.WT + (size_t)(d.dst_row0 + n) * d.K + d.k0 + 8 * c); if (nt) __builtin_nontemporal_store(o, dp); else *dp = o; }
    LDS_WAIT(); asm volatile("" ::: "memory");
}
__device__ __forceinline__ void p0_transpose_item(const float* W, int K, int N, bf16* WT, int dst_row0, LAS float* scr, int k0, int n0, int lane, const float* gk = nullptr) {
    const ConvDesc d{W, K, N, WT, dst_row0, k0, n0, gk}; f32x4 v[8]; float gv[8]; transpose_gains(d, gv, lane); transpose_load(d, v, lane); transpose_store(d, v, gv, scr, lane);
}
__device__ __forceinline__ void norm_row_bf16(const float* xrow, const float* g, bf16* orow, int lane) {
    const GAS f32x4* xr = (const GAS f32x4*)xrow + lane; const GAS f32x4* gr = (const GAS f32x4*)g + lane;
    f32x4 v[8]; float s = 0.f;
#pragma unroll
    for (int j = 0; j < 8; ++j) { v[j] = xr[64 * j]; s += (v[j].x * v[j].x + v[j].y * v[j].y) + (v[j].z * v[j].z + v[j].w * v[j].w); }
    const float rstd = rsqrtf(wave_sum(s) * (1.f / DM) + EPS);
    GAS unsigned long long* o8 = (GAS unsigned long long*)orow + lane;
#pragma unroll
    for (int j = 0; j < 8; ++j) { const f32x4 gv = gr[64 * j]; o8[64 * j] = (unsigned long long)pk2rne(v[j].x * rstd * gv.x, v[j].y * rstd * gv.y) | ((unsigned long long)pk2rne(v[j].z * rstd * gv.z, v[j].w * rstd * gv.w) << 32); }
}

__device__ __forceinline__ void convert_expert_weights(Frame& F, int L) {
    LAS float* scr = (LAS float*)(F.lds + F.wave * 16384);
    constexpr int I_W1 = 32 * 512, I_W2 = 32 * 512;
    bf16* W13 = (bf16*)(wsptr() + WS_W13); bf16* W2 = (bf16*)(wsptr() + WS_W2);
    for (int it = F.gw; it < 2 * I_W1 + I_W2; it += F.NGW) { int r = it;
        if (r < 2 * I_W1) { const int w3 = r >= I_W1; if (w3) r -= I_W1; const int e = r / 512, rr = r % 512, n0 = 32 * (rr % 16);
            p0_transpose_item((w3 ? inptr(17) : inptr(16)) + ((size_t)L * NEXP + e) * DM * DEXP, DM, DEXP, W13 + (size_t)e * 1024 * DM, 256 * (n0 / 128) + (n0 % 128) + (w3 ? 128 : 0), scr, 64 * (rr / 16), n0, F.lane, inptr(13) + (size_t)L * DM); continue; } r -= 2 * I_W1;
        const int e = r / 512, rr = r % 512;
        p0_transpose_item(inptr(18) + ((size_t)L * NEXP + e) * DEXP * DM, DEXP, DM, W2 + (size_t)e * DM * DEXP, 32 * (rr % 64), scr, 64 * (rr / 64), 32 * (rr % 64), F.lane); }
}
static_assert(true, "");
constexpr int CONV_NCH = 8, CONV_IE = 3 * 32 * 512, CONV_ID = 32 * 160 + 32 * 64 + 32 * 64 + 4 * 64;
__device__ __forceinline__ ConvDesc conv_desc(int job, int idx) {
    bf16* W13 = (bf16*)(wsptr() + WS_W13); bf16* W2 = (bf16*)(wsptr() + WS_W2);
    if (idx < CONV_IE) { const int L = job; int r = idx;
        if (r < 2 * 32 * 512) { const int w3 = r >= 32 * 512; if (w3) r -= 32 * 512; const int e = r / 512, rr = r % 512, n0 = 32 * (rr % 16);
            return ConvDesc{(w3 ? inptr(17) : inptr(16)) + ((size_t)L * NEXP + e) * DM * DEXP, DM, DEXP, W13 + (size_t)e * 1024 * DM, 256 * (n0 / 128) + (n0 % 128) + (w3 ? 128 : 0), 64 * (rr / 16), n0, inptr(13) + (size_t)L * DM}; }
        r -= 2 * 32 * 512; const int e = r / 512, rr = r % 512;
        return ConvDesc{inptr(18) + ((size_t)L * NEXP + e) * DEXP * DM, DEXP, DM, W2 + (size_t)e * DM * DEXP, 32 * (rr % 64), 64 * (rr / 64), 32 * (rr % 64), nullptr}; }
    int r = idx - CONV_IE; const int L = 1;
    bf16* WIN = (bf16*)(wsptr() + WS_WIN); bf16* WOUT = (bf16*)(wsptr() + WS_WOUT); bf16* WG = (bf16*)(wsptr() + WS_WG); bf16* WP = (bf16*)(wsptr() + WS_WP);
    if (r < 32 * 160) { return ConvDesc{inptr(5) + (size_t)L * DM * NIN, DM, NIN, WIN + (size_t)L * NIN * DM, 32 * (r % 160), 64 * (r / 160), 32 * (r % 160), inptr(4) + (size_t)L * DM}; } r -= 32 * 160;
    if (r < 32 * 64) { return ConvDesc{inptr(12) + (size_t)L * DM * DM, DM, DM, WOUT + (size_t)L * DM * DM, 32 * (r % 64), 64 * (r / 64), 32 * (r % 64), nullptr}; } r -= 32 * 64;
    if (r < 32 * 64) { return ConvDesc{inptr(20) + (size_t)L * DM * DM, DM, DM, WG + (size_t)L * DM * DM, 32 * (r % 64), 64 * (r / 64), 32 * (r % 64), inptr(19) + (size_t)L * DM}; } r -= 32 * 64;
    return ConvDesc{inptr(21) + (size_t)L * PLE * DM, PLE, DM, WP + (size_t)L * DM * PLE, 32 * (r % 64), 64 * (r / 64), 32 * (r % 64), nullptr};
}
__device__ __forceinline__ void conv_chunk(Frame& F0, int job, int k, gu32* tq = nullptr) {
    unsigned tk_ = 0u; const bool tkd = (tq != nullptr) && (F0.wave == 0) && (mk_lane() == 0);
    if (tkd) tk_ = __hip_atomic_fetch_add(tq, 1u, RLX_AGENT);
    __syncthreads();
    Frame F = relaunder(F0);
    LAS float* scr = (LAS float*)(F.lds + F.wave * 16384 + (F.wave >= 4 ? 8192 : 0));
    const int N = job == 0 ? CONV_IE + CONV_ID : CONV_IE, ipc = (N + F.G * CONV_NCH - 1) / (F.G * CONV_NCH), base = ((int)blockIdx.x * CONV_NCH + k) * ipc;
    f32x4 v[4][8]; ConvDesc d[4]; bool has[4];
#pragma unroll
    for (int t = 0; t < 4; ++t) { const int i = F.wave + NWAVES * t, idx = base + i; has[t] = (i < ipc) && (idx < N); d[t] = conv_desc(job, has[t] ? idx : 0); }
    float gA[8], gB[8];
    transpose_gains(d[0], gA, F.lane); transpose_gains(d[1], gB, F.lane);
#pragma unroll
    for (int t = 0; t < 4; ++t) if (has[t]) transpose_load(d[t], v[t], F.lane);
    if (has[0]) transpose_store(d[0], v[0], gA, scr, F.lane, true);
    transpose_gains(d[2], gA, F.lane); if (has[1]) transpose_store(d[1], v[1], gB, scr, F.lane, true);
    transpose_gains(d[3], gB, F.lane); if (has[2]) transpose_store(d[2], v[2], gA, scr, F.lane, true);
    if (has[3]) transpose_store(d[3], v[3], gB, scr, F.lane, true);
    if (tkd) ((volatile LAS int*)(F.lds + att::OFF_MISC))[0] = (int)tk_;
    __syncthreads();
}
__device__ __forceinline__ void p0_prologue(Frame& F0, const Args& AR) {
    Frame F = relaunder(F0);
    LAS float* scr = (LAS float*)(F.lds + F.wave * 16384);
    constexpr int I_IN = 32 * 160, I_OUT = 32 * 64, I_WG = 32 * 64, I_WP = 4 * 64, I_L = I_IN + I_OUT + I_WG + I_WP;
    bf16* WIN = (bf16*)(wsptr() + WS_WIN); bf16* WOUT = (bf16*)(wsptr() + WS_WOUT); bf16* WG = (bf16*)(wsptr() + WS_WG); bf16* WP = (bf16*)(wsptr() + WS_WP);
    for (int it = F.gw; it < I_L; it += F.NGW) {
        const int L = 0; int r = it;
        if (r < I_IN) { p0_transpose_item(inptr(5) + (size_t)L * DM * NIN, DM, NIN, WIN + (size_t)L * NIN * DM, 32 * (r % 160), scr, 64 * (r / 160), 32 * (r % 160), F.lane, inptr(4) + (size_t)L * DM); continue; } r -= I_IN;
        if (r < I_OUT) { p0_transpose_item(inptr(12) + (size_t)L * DM * DM, DM, DM, WOUT + (size_t)L * DM * DM, 32 * (r % 64), scr, 64 * (r / 64), 32 * (r % 64), F.lane); continue; } r -= I_OUT;
        if (r < I_WG) { p0_transpose_item(inptr(20) + (size_t)L * DM * DM, DM, DM, WG + (size_t)L * DM * DM, 32 * (r % 64), scr, 64 * (r / 64), 32 * (r % 64), F.lane, inptr(19) + (size_t)L * DM); continue; } r -= I_WG;
        p0_transpose_item(inptr(21) + (size_t)L * PLE * DM, PLE, DM, WP + (size_t)L * DM * PLE, 32 * (r % 64), scr, 64 * (r / 64), 32 * (r % 64), F.lane);
    }
    { GAS v4u* lz = (GAS v4u*)(wsptr() + WS_LIST); for (int i = F.gw * 64 + F.lane; i < NEXP * 32768 / 4; i += F.NGW * 64) lz[i] = (v4u){0u, 0u, 0u, 0u}; }
    { const GAS f32x4* src = (const GAS f32x4*)inptr(1); GAS v4u* dst = (GAS v4u*)(wsptr() + WS_PB); const long n8 = (long)DEPTH * M * PLE / 8;
      const long st = (long)F.NGW * 64;
      for (long i = (long)F.gw * 64 + F.lane; i < n8; i += 4 * st) {
        f32x4 a[4], b[4];
#pragma unroll
        for (int u = 0; u < 4; ++u) if (i + u * st < n8) { a[u] = __builtin_nontemporal_load(src + 2 * (i + u * st)); b[u] = __builtin_nontemporal_load(src + 2 * (i + u * st) + 1); }
#pragma unroll
        for (int u = 0; u < 4; ++u) if (i + u * st < n8) { v4u o; o.x = pk2rne(a[u].x, a[u].y); o.y = pk2rne(a[u].z, a[u].w); o.z = pk2rne(b[u].x, b[u].y); o.w = pk2rne(b[u].z, b[u].w); dst[i + u * st] = o; } } }

    { bf16* WRH = (bf16*)(wsptr() + WS_WR); bf16* WRL = WRH + DEPTH * 48 * DM;
      for (int i = F.gw * 64 + F.lane; i < DEPTH * 48 * DM; i += F.NGW * 64) { const int L = i / (48 * DM), n = (i / DM) % 48, k = i % DM;
        const float w = (n < 4 ? inptr(14)[((size_t)L * DM + k) * 4 + n] : n < NROUTE ? inptr(15)[((size_t)L * DM + k) * 32 + (n - 4)] : 0.f) * inptr(13)[(size_t)L * DM + k];
        const unsigned h = pk2rne(w, 0.f) & 0xffffu; const float r = w - __uint_as_float(h << 16);
        WRH[i] = (bf16)h; WRL[i] = (bf16)(pk2rne(r, 0.f) & 0xffffu); } }
    { float* rsin = (float*)(wsptr() + WS_RSIN); bf16* hb = (bf16*)(wsptr() + hb_off(0));
      for (int m4 = F.gw; m4 < M / 4; m4 += F.NGW) {
        f32x4 v[4][8];
#pragma unroll
        for (int r = 0; r < 4; ++r) { const GAS f32x4* xr = (const GAS f32x4*)(inptr(0) + (size_t)(4 * m4 + r) * DM) + F.lane;
#pragma unroll
          for (int j = 0; j < 8; ++j) v[r][j] = __builtin_nontemporal_load(xr + 64 * j); }
#pragma unroll
        for (int r = 0; r < 4; ++r) { GAS unsigned long long* o8 = (GAS unsigned long long*)(hb + (size_t)(4 * m4 + r) * DM) + F.lane; float s = 0.f;
#pragma unroll
          for (int j = 0; j < 8; ++j) { const f32x4 w = v[r][j]; s += (w.x * w.x + w.y * w.y) + (w.z * w.z + w.w * w.w); o8[64 * j] = (unsigned long long)pk2rne(w.x, w.y) | ((unsigned long long)pk2rne(w.z, w.w) << 32); }
          s = wave_sum(s); if (F.lane == 0) rsin[4 * m4 + r] = rsqrtf(s * (1.f / DM) + EPS); } } }
}
constexpr int LDS_RSTAB = 131072, LDS_RSVAL = 131072 + 64;
template <class Sched> __device__ __forceinline__ void rsin_table(Frame& F0, const Sched& S, bool from_parts) {
    Frame F = relaunder(F0);
    LAS int* tab = (LAS int*)(F.lds + LDS_RSTAB); LAS float* rs = (LAS float*)(F.lds + LDS_RSVAL);
    if (F.tid < 4) tab[F.tid] = -1;
    __syncthreads();
    int ns = 0; pg8::Unit u;
#pragma unroll 1
    for (int i = 0; S.next(i, u); ++i) {
        bool have = false;
#pragma unroll 1
        for (int k = 0; k < ns; ++k) have = have || (tab[k] == u.pm);
        if (have || ns >= 4) continue;
        const int row = F.tid >> 1, h = F.tid & 1; float v;
        if (from_parts) { const GAS f32x4* pp = (const GAS f32x4*)((const float*)(wsptr() + WS_SSQ) + ((size_t)u.pm * 256 + row) * 32 + 16 * h);
            const f32x4 a = pp[0], b = pp[1], c = pp[2], d = pp[3]; float s = ((a.x + a.y) + (a.z + a.w)) + ((b.x + b.y) + (b.z + b.w)) + (((c.x + c.y) + (c.z + c.w)) + ((d.x + d.y) + (d.z + d.w)));
            s += mk_shfl_xor(s, 1); v = rsqrtf(s * (1.f / DM) + EPS); }
        else v = ((const float*)(wsptr() + WS_RSIN))[u.pm * 256 + row];
        if (h == 0) rs[ns * 256 + row] = v;
        if (F.tid == 0) tab[ns] = u.pm;
        ++ns;
        __syncthreads();
    }
}
__device__ __forceinline__ void kmean_phase(Frame& F0, const Args& AR) {
    Frame F = relaunder(F0);
    const bf16* proj = (const bf16*)(wsptr() + WS_PROJ); float* km = (float*)(wsptr() + WS_KMEAN);
    LAS float* part = (LAS float*)F.lds;
    for (int w = blockIdx.x; w < BATCH * 4 * 16 / 2; w += F.G) {
        const int u = 2 * w + (F.wave >> 2), q = F.wave & 3, b = u >> 6, h = (u >> 4) & 3, blk = u & 15, rg = F.lane >> 4, c = F.lane & 15;
        const bf16* kp = proj + ((size_t)b * SEQ + blk * 256 + q * 64 + rg) * NIN + KB_OFF + h * 128 + 8 * c;
        float s[8] = {0.f, 0.f, 0.f, 0.f, 0.f, 0.f, 0.f, 0.f};
#pragma unroll
        for (int i = 0; i < 16; ++i) { const v4u v = *(const GAS v4u*)(kp + (size_t)(4 * i) * NIN);
            s[0] += __uint_as_float(v.x << 16); s[1] += __uint_as_float(v.x & 0xffff0000u); s[2] += __uint_as_float(v.y << 16); s[3] += __uint_as_float(v.y & 0xffff0000u);
            s[4] += __uint_as_float(v.z << 16); s[5] += __uint_as_float(v.z & 0xffff0000u); s[6] += __uint_as_float(v.w << 16); s[7] += __uint_as_float(v.w & 0xffff0000u); }
#pragma unroll
        for (int j = 0; j < 8; ++j) { s[j] += mk_shfl_xor(s[j], 16); s[j] += mk_shfl_xor(s[j], 32); }
        __syncthreads();
        if (F.lane < 16) {
#pragma unroll
            for (int j = 0; j < 8; ++j) part[F.wave * 128 + 8 * c + j] = s[j]; }
        __syncthreads();
        if (F.tid < 256) { const int uu = F.tid >> 7, d = F.tid & 127; const LAS float* pp = part + uu * 512 + d;
            km[(size_t)(2 * w + uu) * 128 + d] = ((pp[0] + pp[128]) + (pp[256] + pp[384])) * (1.f / 256.f); }
    }
    __syncthreads();
}
struct TokRec { int e0, e1, s0, s1; float w0, w1; int pad0, pad1; };
__device__ __forceinline__ void router_phase(Frame& F0, const Args& AR, int layer) {
    Frame F = relaunder(F0);
    typedef float f32x4r __attribute__((ext_vector_type(4)));
    const bf16* h = (const bf16*)(wsptr() + hb_off(layer));
    const bf16* WRH = (const bf16*)(wsptr() + WS_WR) + (size_t)layer * 48 * DM; const bf16* WRL = WRH + DEPTH * 48 * DM;
    float* rstd_o = (float*)(wsptr() + WS_RSTD); TokRec* rec = (TokRec*)(wsptr() + WS_TOKREC); gu32* cnt = ctlptr() + CW_CNT + layer * 32 * 64;
    int* list = (int*)(wsptr() + WS_LIST);
    constexpr int KC = 512, NCH = DM / KC, WB_BYTES = 96 * KC * 2;
    LAS float* lg = (LAS float*)(F.lds + WB_BYTES) + F.wave * (16 * 49);
    LAS int* lc = (LAS int*)(F.lds + WB_BYTES + 8 * (16 * 49) * 4);
    static_assert(WB_BYTES + 8 * 16 * 49 * 4 + 64 * 4 <= PHASE_LDS, "router LDS");
    const int row = F.lane & 15, kg = F.lane >> 4;
    constexpr int NTASK = M / 128;
    typedef __attribute__((address_space(3))) unsigned las_u32r;
#pragma unroll 1
    for (int tk = (int)blockIdx.x; tk < NTASK; tk += F.G) {
        if (F.tid < 32) lc[F.tid] = 0;
        const bf16* hp = h + (size_t)(128 * tk + 16 * F.wave + row) * DM + 8 * kg;
        f32x4r acc[3]; float ss = 0.f;
#pragma unroll
        for (int t = 0; t < 3; ++t) acc[t] = (f32x4r){0.f, 0.f, 0.f, 0.f};
        v4u hq[2][16];
#pragma unroll
        for (int s = 0; s < 16; ++s) hq[0][s] = *(const GAS v4u*)(hp + 32 * s);
#pragma unroll
        for (int c = 0; c < NCH; ++c) {
            __syncthreads();
#pragma unroll
            for (int q = 0; q < 9; ++q) { const int r72 = q * 8 + F.wave, rc = r72 < NROUTE ? r72 : r72 + (48 - NROUTE), n = rc < 48 ? rc : rc - 48; const bf16* src = (rc < 48 ? WRH : WRL) + (size_t)n * DM + c * KC;
                int ll = F.lane; asm volatile("" : "+v"(ll));
                __builtin_amdgcn_global_load_lds((const unsigned*)((const char*)src + ((ll ^ (n & 15)) << 4)), (las_u32r*)(F.lds + rc * (KC * 2)), 16, 0, 0); }
            asm volatile("s_waitcnt vmcnt(0)" ::: "memory");
            __syncthreads();
            if (c + 1 < NCH) {
#pragma unroll
                for (int s = 0; s < 16; ++s) hq[(c + 1) & 1][s] = *(const GAS v4u*)(hp + (c + 1) * KC + 32 * s); }
#pragma unroll
            for (int s = 0; s < 16; ++s) { const v4u q = hq[c & 1][s];
                const float a0 = __uint_as_float(q.x << 16), a1 = __uint_as_float(q.x & 0xffff0000u), a2 = __uint_as_float(q.y << 16), a3 = __uint_as_float(q.y & 0xffff0000u);
                const float a4 = __uint_as_float(q.z << 16), a5 = __uint_as_float(q.z & 0xffff0000u), a6 = __uint_as_float(q.w << 16), a7 = __uint_as_float(q.w & 0xffff0000u);
                ss += (a0 * a0 + a1 * a1) + (a2 * a2 + a3 * a3) + (a4 * a4 + a5 * a5) + (a6 * a6 + a7 * a7);
                const bf16x8 Ah = __builtin_bit_cast(bf16x8, q);
                const int piece = ((4 * s + kg) ^ row) << 4;
#pragma unroll
                for (int t = 0; t < 3; ++t) { const bf16x8 Bh = *(const LAS bf16x8*)(F.lds + (16 * t + row) * (KC * 2) + piece), Bl = *(const LAS bf16x8*)(F.lds + (48 + 16 * t + row) * (KC * 2) + piece);
                    acc[t] = __builtin_amdgcn_mfma_f32_16x16x32_bf16(Ah, Bh, acc[t], 0, 0, 0); acc[t] = __builtin_amdgcn_mfma_f32_16x16x32_bf16(Ah, Bl, acc[t], 0, 0, 0); } }
        }
        { float s2 = ss; s2 += mk_shfl_xor(s2, 16); s2 += mk_shfl_xor(s2, 32); if (kg == 0) lg[row * 49 + 48] = s2;
#pragma unroll
            for (int t = 0; t < 3; ++t)
#pragma unroll
                for (int i = 0; i < 4; ++i) lg[(4 * kg + i) * 49 + 16 * t + row] = acc[t][i]; }
        LDS_WAIT(); asm volatile("" ::: "memory");
        int e0 = 0, e1 = 0, sl0 = 0, sl1 = 0; float w0 = 0.f, w1 = 0.f, rs = 0.f;
        if (F.lane < 16) {
            const LAS float* lr = lg + F.lane * 49;
            const float rs_ = rsqrtf(lr[48] * (1.f / DM) + EPS);
            float gl[4];
#pragma unroll
            for (int i = 0; i < 4; ++i) gl[i] = lr[i] * rs_;
            int grp = 0; float gm = gl[0];
#pragma unroll
            for (int i = 1; i < 4; ++i) if (gl[i] > gm) { gm = gl[i]; grp = i; }
            float gs = 0.f;
#pragma unroll
            for (int i = 0; i < 4; ++i) gs += __expf(gl[i] - gm);
            const float gw_ = 1.f / gs;
            float el[8];
#pragma unroll
            for (int i = 0; i < 8; ++i) el[i] = lr[4 + grp * 8 + i] * rs_;
            int i1 = 0; float t1 = el[0];
#pragma unroll
            for (int i = 1; i < 8; ++i) if (el[i] > t1) { t1 = el[i]; i1 = i; }
            int i2 = -1; float t2 = -INFINITY;
#pragma unroll
            for (int i = 0; i < 8; ++i) if (i != i1 && el[i] > t2) { t2 = el[i]; i2 = i; }
            const float ex = __expf(t2 - t1), w0_ = gw_ / (1.f + ex), w1_ = gw_ * ex / (1.f + ex);
            e0 = grp * 8 + i1; e1 = grp * 8 + i2; w0 = w0_; w1 = w1_; rs = rs_;
            sl0 = __hip_atomic_fetch_add(lc + e0, 1, __ATOMIC_RELAXED, __HIP_MEMORY_SCOPE_WORKGROUP); sl1 = __hip_atomic_fetch_add(lc + e1, 1, __ATOMIC_RELAXED, __HIP_MEMORY_SCOPE_WORKGROUP);
        }
        LDS_WAIT(); asm volatile("" ::: "memory");
        __syncthreads();
        if (F.tid < 32) { const int c = lc[F.tid]; lc[32 + F.tid] = c > 0 ? (int)__hip_atomic_fetch_add(cnt + F.tid * 64, (unsigned)c, RLX_AGENT) : 0; }
        __syncthreads();
        if (F.lane < 16) { const int rowg = 128 * tk + 16 * F.wave + F.lane; const int s0 = lc[32 + e0] + sl0, s1 = lc[32 + e1] + sl1;
            TokRec t; t.e0 = e0; t.e1 = e1; t.s0 = s0; t.s1 = s1; t.w0 = w0; t.w1 = w1; t.pad0 = 0; t.pad1 = 0; rec[rowg] = t; rstd_o[rowg] = rs;
            list[e0 * 32768 + s0] = rowg; list[e1 * 32768 + s1] = rowg; float* srs = (float*)(wsptr() + WS_SRS); srs[e0 * 32768 + s0] = rs; srs[e1 * 32768 + s1] = rs; }
        __syncthreads();
    }
}
constexpr int PL_UNITS = (M / 256) * (DM / 256), PL_R = 5;
__device__ __forceinline__ int build_tiles(Frame& F0, int layer) {
    Frame F = relaunder(F0);
    gu32* cnt = ctlptr() + CW_CNT + layer * 32 * 64; LAS int* offs = (LAS int*)(F.lds + LDS_OFFS); LAS unsigned char* te = F.lds + LDS_TILE_E;
    __syncthreads();
    if (F.tid < NEXP) offs[40 + F.tid] = (int)__hip_atomic_load(cnt + F.tid * 64, RLX_AGENT);
    __syncthreads();
    if (F.tid == 0) { int acc = 0;
#pragma unroll 1
        for (int e = 0; e < NEXP; ++e) { const int c = offs[40 + e]; offs[e] = acc * 256; const int nt = (c + 255) >> 8; for (int t = 0; t < nt && acc + t < RPAD / 256; ++t) te[acc + t] = (unsigned char)e; acc += nt; }
        offs[32] = acc < RPAD / 256 ? acc : RPAD / 256;
        const int nTl = offs[32], per = F.G >> 3, x = (int)blockIdx.x & 7, s = (int)blockIdx.x >> 3; int gmax = 0;
#pragma unroll 1
        for (int xx = 0; xx < 8; ++xx) { int n = 0;
#pragma unroll 1
            for (int k = 0; k < 4; ++k) { const int e = xx + 8 * k; const int t0 = offs[e] >> 8, t1 = (e == 31) ? nTl : (offs[e + 1] >> 8); n += (t1 > t0 ? t1 - t0 : 0) * 4; }
            offs[72 + xx] = n; const int gh = (n + per - 1) / per; gmax = gh > gmax ? gh : gmax; }
        int Dtot = 0, Dbefore = 0, dme = 0, dpre = 0;
#pragma unroll 1
        for (int xx = 0; xx < 8; ++xx) { const int n = offs[72 + xx], gh = (n + per - 1) / per, r = n > 0 ? n - (gh - 1) * per : per; const int D = per * (gmax - gh) + (per - r);
            if (xx < x) Dbefore += D; Dtot += D;
            if (xx == x) { dme = (gmax - gh) + (s >= r ? 1 : 0); dpre = s * (gmax - gh) + (s > r ? s - r : 0); } }
        int base = (PL_UNITS - PL_R * Dtot + F.G - 1) / F.G; base = base > 0 ? base : 0;
        int start = PL_R * (Dbefore + dpre) + (x * per + s) * base, count = PL_R * dme + base;
        if ((F.G & 7) || per == 0) { start = (int)blockIdx.x * ((PL_UNITS + F.G - 1) / F.G); count = (PL_UNITS + F.G - 1) / F.G; }
        if (start > PL_UNITS) start = PL_UNITS; if (start + count > PL_UNITS) count = PL_UNITS - start;
        offs[33] = start; offs[34] = count; }
    __syncthreads();
    return offs[32];
}
struct ListOrder {
    static constexpr bool B_NT = false;
    int start, count;
    __device__ __forceinline__ bool next(int i, pg8::Unit& u) const { if (i >= count) return false; const int L = start + i; u.pm = L >> 3; u.pn = L & 7; return true; }
    __device__ __forceinline__ void a_ready(const pg8::Unit&) const {}
    __device__ __forceinline__ void done(const pg8::Unit&) const {}
};
__device__ __forceinline__ void combine_phase(Frame& F0, const Args& AR, int layer) {
#if MK_PER_PHASE
    (void)build_tiles(F0, layer);
#endif
    Frame F = relaunder(F0);
    const LAS int* offs = (const LAS int*)(F.lds + LDS_OFFS);
    bf16* hb = (bf16*)(wsptr() + hb_off(layer)); const TokRec* rec = (const TokRec*)(wsptr() + WS_TOKREC);
    const bf16* y = (const bf16*)(wsptr() + WS_Y); float* rsple = (float*)(wsptr() + WS_RSPLE);
    TokRec tn[2];
    if (F.gw < M / 2) {
#pragma unroll
        for (int r = 0; r < 2; ++r) tn[r] = rec[F.gw + r * (M / 2)]; }
    for (int m2 = F.gw; m2 < M / 2; m2 += F.NGW) {
        TokRec t[2]; int p0[2], p1[2];
#pragma unroll
        for (int r = 0; r < 2; ++r) t[r] = tn[r];
        if (m2 + F.NGW < M / 2) {
#pragma unroll
            for (int r = 0; r < 2; ++r) tn[r] = rec[m2 + F.NGW + r * (M / 2)]; }
#pragma unroll
        for (int r = 0; r < 2; ++r) { p0[r] = offs[t[r].e0] + t[r].s0; p1[r] = offs[t[r].e1] + t[r].s1; }
        v4u hq[2][4], ya[2][4], yb[2][4];
#pragma unroll
        for (int r = 0; r < 2; ++r) { const GAS v4u* xr = (const GAS v4u*)(hb + (size_t)(m2 + r * (M / 2)) * DM) + F.lane;
            const GAS v4u* y0 = (const GAS v4u*)(y + (size_t)p0[r] * DM) + F.lane; const GAS v4u* y1 = (const GAS v4u*)(y + (size_t)p1[r] * DM) + F.lane;
#pragma unroll
            for (int j = 0; j < 4; ++j) { hq[r][j] = xr[64 * j]; ya[r][j] = __builtin_nontemporal_load(y0 + 64 * j); yb[r][j] = __builtin_nontemporal_load(y1 + 64 * j); } }
#pragma unroll
        for (int r = 0; r < 2; ++r) { const int m = m2 + r * (M / 2); GAS v4u* xw = (GAS v4u*)(hb + (size_t)m * DM) + F.lane; float s = 0.f; const float w0 = t[r].w0, w1 = t[r].w1;
#pragma unroll
            for (int j = 0; j < 4; ++j) { const v4u q = hq[r][j], a = ya[r][j], b = yb[r][j]; v4u o;
#define CMB(QW, AW, BW, OW) do { const float lo_ = __uint_as_float((QW) << 16) + w0 * __uint_as_float((AW) << 16) + w1 * __uint_as_float((BW) << 16), hi_ = __uint_as_float((QW) & 0xffff0000u) + w0 * __uint_as_float((AW) & 0xffff0000u) + w1 * __uint_as_float((BW) & 0xffff0000u); \
                    OW = pk2rne(lo_, hi_); s += lo_ * lo_ + hi_ * hi_; } while (0)
                CMB(q.x, a.x, b.x, o.x); CMB(q.y, a.y, b.y, o.y); CMB(q.z, a.z, b.z, o.z); CMB(q.w, a.w, b.w, o.w);
#undef CMB
                xw[64 * j] = o; }
            s = wave_sum(s); if (F.lane == 0) rsple[m] = rsqrtf(s * (1.f / DM) + EPS); }
    }
}
__device__ __forceinline__ void endnorm_phase(Frame& F0, const Args& AR, int layer) {
    Frame F = relaunder(F0);
    const bf16* hb = (const bf16*)(wsptr() + hb_off(layer + 1));
    const bool last = layer + 1 >= DEPTH;
    float* rsin = (float*)(wsptr() + WS_RSIN);
    f32x4 g8[8];
#pragma unroll
    for (int j = 0; j < 8; ++j) g8[j] = last ? ((const GAS f32x4*)inptr(3) + F.lane)[64 * j] : (f32x4){0.f, 0.f, 0.f, 0.f};
    for (int m4 = F.gw; m4 < M / 4; m4 += F.NGW) {
        u32x2g q[4][8];
#pragma unroll
        for (int r = 0; r < 4; ++r) { const GAS u32x2g* xr = (const GAS u32x2g*)(hb + (size_t)(4 * m4 + r) * DM) + F.lane;
#pragma unroll
            for (int j = 0; j < 8; ++j) q[r][j] = last ? __builtin_nontemporal_load(xr + 64 * j) : xr[64 * j]; }
#pragma unroll
        for (int r = 0; r < 4; ++r) { const int m = 4 * m4 + r; float s = 0.f;
#pragma unroll
            for (int j = 0; j < 8; ++j) { const float a = __uint_as_float(q[r][j].x << 16), b = __uint_as_float(q[r][j].x & 0xffff0000u), c = __uint_as_float(q[r][j].y << 16), d = __uint_as_float(q[r][j].y & 0xffff0000u); s += (a * a + b * b) + (c * c + d * d); }
            const float rstd = rsqrtf(wave_sum(s) * (1.f / DM) + EPS);
            if (last) { GAS f32x4* o = (GAS f32x4*)(outptr() + (size_t)m * DM) + F.lane;
#pragma unroll
                for (int j = 0; j < 8; ++j) { const f32x4 v = (f32x4){__uint_as_float(q[r][j].x << 16), __uint_as_float(q[r][j].x & 0xffff0000u), __uint_as_float(q[r][j].y << 16), __uint_as_float(q[r][j].y & 0xffff0000u)}; __builtin_nontemporal_store(v * rstd * g8[j], o + 64 * j); } }
            else if (F.lane == 0) rsin[m] = rstd; }
    }
}
template <int MODE> __device__ __forceinline__ void attn_queue(Frame& F0, const att::AttnArgs& A, gu32* qbase, int& cc) {
    Frame F = relaunder(F0);
    volatile LAS int* mb = (volatile LAS int*)(F.lds + att::OFF_MISC);
    constexpr int NPER = (MODE == 2) ? 96 : (MODE == 1) ? 64 : 96;
    const int myx = (int)(xb_xcc_id() & 7u);
    const float lam = att::attn_mode_setup<MODE>(A, (char*)F.lds, F.wave);
#pragma unroll 1
    for (int xs = 0; xs < 8; ++xs) {
        const int x = (myx + xs) & 7;
        if (xs == 1) {
            __syncthreads();
            { const int t8 = mk_lane(); if (F.wave == 0 && t8 < 8) mb[32 + t8] = (int)__hip_atomic_load(qbase + t8 * 64, RLX_AGENT); }
            __syncthreads(); }
        if (xs >= 1 && mb[32 + x] >= NPER) continue;
        bool have = false;
        for (;;) {
            if (!have) { __syncthreads();
                if (F.tid == 0) mb[0] = (int)__hip_atomic_fetch_add(qbase + x * 64, 1u, RLX_AGENT);
                __syncthreads(); }
            have = false;
            const int idx = __builtin_amdgcn_readfirstlane(mb[0]);
            if (idx >= NPER) break;
            int b, hh, qb;
            if (MODE == 2) { const int p = (idx % 6) * 8 + x; b = p / 6; hh = p % 6; qb = 15 - idx / 6; }
            else if (MODE == 1) { const int p = (idx & 3) * 8 + x; b = p >> 2; hh = p & 3; qb = 15 - (idx >> 2); }
            else { const int kvp = (idx / 48) * 8 + x, r = idx % 48; b = kvp >> 1; hh = (kvp & 1) * 3 + r % 3; qb = r / 3; }
            att::attn_unit<MODE>(A, b, hh, qb, (char*)F.lds, F.wave, lam);
            if (cc < CONV_NCH) { conv_chunk(F0, A.layer, cc, qbase + x * 64); ++cc; have = true; }
        }
    }
}
__device__ __forceinline__ att::AttnArgs make_attn_args(int layer) { att::AttnArgs A{}; A.layer = layer; A.lambda_init = 0.8f - 0.6f * __expf(-0.3f * (float)layer); return A; }
static_assert(NROUTE == 36 && 2 * NROUTE == 72, "router staging: 72 row chunks over 8 waves");
static_assert(att::ATT_WS_KP == WS_PL && KB_OFF % 256 == 0 && SEQ % 256 == 0 && SEQ / 256 == 16, "block means from the projection epilogue");
static_assert(att::ATT_WS_PROJ == WS_PROJ && att::ATT_WS_YCAT == WS_YCAT && att::ATT_WS_KMEAN == WS_KMEAN, "attention body's workspace offsets");

#ifndef MK_PH_MASK
#define MK_PH_MASK 0xFFFFFFFFu
#endif
#ifndef MK_ATT_MASK
#define MK_ATT_MASK 7
#endif
#define ATM(k) ((MK_ATT_MASK >> (k)) & 1)
#define PHM(k) ((MK_PH_MASK >> (k)) & 1u)
constexpr int NPH_LAYER = 11, NPHASES = 1 + DEPTH * NPH_LAYER;
__global__ void __launch_bounds__(NWAVES * 64, 2) mk_fwd(Args args) {
    extern __shared__ __attribute__((aligned(16))) unsigned char lds[];
    Frame F;
    F.lds = (LAS unsigned char*)lds; F.MISC = (volatile LAS unsigned*)(F.lds + LDS_MISC);
    F.wave = __builtin_amdgcn_readfirstlane((int)threadIdx.x >> 6); F.lane = mk_lane(); F.tid = F.wave * 64 + F.lane; F.G = gridDim.x;
    F.gw = blockIdx.x * NWAVES + F.wave; F.NGW = F.G * NWAVES;
    for (int u = F.tid; u < (LDS_BYTES - LDSCTL_OFF) / 4; u += NWAVES * 64) ((LAS unsigned*)(F.lds + LDSCTL_OFF))[u] = 0u;
    __syncthreads();
    XcdBarrier bar; bar.bar = (unsigned*)(ctlptr() + CW_BAR); bar.x = 0; bar.st = nullptr;
    if (args.use_bar) bar = xcd_barrier_post((unsigned*)(ctlptr() + CW_BAR), F.MISC + 8);
    const int lo = args.ph_lo, hi = args.ph_hi;
#define IN(k) (lo <= (k) && (k) < hi)
#define SEAM(k) do { if (IN(k) && IN((k) + 1)) xcd_barrier(bar); } while (0)
    if (PHM(0) && IN(0)) { p0_prologue(F, args); } SEAM(0);
#pragma unroll 1
    for (int layer = 0; layer < DEPTH; ++layer) {
        const int pb = 1 + layer * NPH_LAYER;
        const bool fuse_norm = (F.G == 256);
        if (PHM(1) && IN(pb + 0)) { pg8::Gemm g{(const bf16*)(wsptr() + hb_off(layer)), (const bf16*)(wsptr() + WS_WIN) + (size_t)layer * NIN * DM, M, NIN, DM}; pg8::StaticOrder S; S.init(M, NIN, F.G, (int)blockIdx.x);
            rsin_table(F, S, fuse_norm && layer > 0);
            pg8::EpiProj E{(bf16*)(wsptr() + WS_PROJ), NIN, (const LAS int*)(F.lds + LDS_RSTAB), (const LAS float*)(F.lds + LDS_RSVAL), (float*)(wsptr() + WS_PL), KB_OFF / 256, att::ATT_KP_N, (const float*)(wsptr() + WS_RSIN)};
            pg8::gemm_phase<pg8::EpiProj, pg8::StaticOrder, true, true>(F.lds, g, S, E, F.wave);
            }
        SEAM(pb + 0);
        if (PHM(3) && IN(pb + 2)) { const att::AttnArgs A = make_attn_args(layer);
            int cc = 0;
            if (ATM(2)) attn_queue<2>(F, A, ctlptr() + CW_Q + ((layer * 3 + 0) * 8) * 64, cc);
            if (ATM(1)) attn_queue<1>(F, A, ctlptr() + CW_Q + ((layer * 3 + 1) * 8) * 64, cc);
            if (ATM(0)) attn_queue<0>(F, A, ctlptr() + CW_Q + ((layer * 3 + 2) * 8) * 64, cc);
#pragma unroll 1
            for (; cc < CONV_NCH; ++cc) conv_chunk(F, layer, cc);
            }
        SEAM(pb + 2);
        if (PHM(4) && IN(pb + 3)) { pg8::Gemm g{(const bf16*)(wsptr() + WS_YCAT), (const bf16*)(wsptr() + WS_WOUT) + (size_t)layer * DM * DM, M, DM, DM}; pg8::StaticOrder S; S.init(M, DM, F.G, (int)blockIdx.x);
            pg8::EpiRes E{(bf16*)(wsptr() + hb_off(layer)), DM};
            pg8::gemm_phase<pg8::EpiRes, pg8::StaticOrder, true, true>(F.lds, g, S, E, F.wave); }
        SEAM(pb + 3);
        if (PHM(5) && IN(pb + 4)) router_phase(F, args, layer);
        SEAM(pb + 4);
        if (PHM(7) && IN(pb + 6)) { const int nT = build_tiles(F, layer);
            pg8::Gemm g{(const bf16*)(wsptr() + hb_off(layer)), (const bf16*)(wsptr() + WS_W13), M, NEXP * 1024, DM};
            pg8::GroupedOrder S{(const LAS unsigned char*)(F.lds + LDS_TILE_E), nT, 4, F.G, (int)blockIdx.x, (const int*)(wsptr() + WS_LIST), (const LAS int*)(F.lds + LDS_OFFS), (const LAS int*)(F.lds + 131072)};
            { LAS int* lt = (LAS int*)(F.lds + 131072); pg8::Unit u;
              const int t_ = F.wave * 64 + mk_lane();
#pragma unroll 1
              for (int i = 0; i < pg8::GroupedOrder::LTAB_UNITS && S.next(i, u); ++i) if (t_ < 256) { const int e = u.pn / 4; lt[i * 256 + t_] = ((const int*)(wsptr() + WS_LIST))[e * 32768 + (u.pm * 256 - ((const LAS int*)(F.lds + LDS_OFFS))[e]) + t_]; }
              __syncthreads(); }
            pg8::EpiSiluMul E{(bf16*)(wsptr() + WS_HID), DEXP, (const int*)(wsptr() + WS_LIST), (const LAS int*)(F.lds + LDS_OFFS), (const float*)(wsptr() + WS_SRS)};
            pg8::gemm_phase<pg8::EpiSiluMul, pg8::GroupedOrder, true, true, true>(F.lds, g, S, E, F.wave);
            { const LAS int* offs = (const LAS int*)(F.lds + LDS_OFFS); ListOrder S2{offs[33], offs[34]};
              pg8::Gemm g2{(const bf16*)(wsptr() + WS_PB) + (size_t)layer * M * PLE, (const bf16*)(wsptr() + WS_WP) + (size_t)layer * DM * PLE, M, DM, opaque_i(PLE)};
              pg8::EpiBf16<0> E2{(bf16*)(wsptr() + WS_PL), DM, nullptr, 0, 0, 1.f, nullptr, 1};
              pg8::gemm_phase<pg8::EpiBf16<0>, ListOrder, true, true>(F.lds, g2, S2, E2, F.wave); }
            }
        SEAM(pb + 6);
        if (PHM(8) && IN(pb + 7)) {
#if MK_PER_PHASE
            (void)build_tiles(F, layer);
#endif
            const int nT = ((const LAS int*)(F.lds + LDS_OFFS))[32];
            pg8::Gemm g{(const bf16*)(wsptr() + WS_HID), (const bf16*)(wsptr() + WS_W2), RPAD, NEXP * DM, DEXP};
            pg8::GroupedOrder S{(const LAS unsigned char*)(F.lds + LDS_TILE_E), nT, 8, F.G, (int)blockIdx.x, nullptr, (const LAS int*)(F.lds + LDS_OFFS), nullptr};
            pg8::EpiBf16<0> E{(bf16*)(wsptr() + WS_Y), DM, nullptr, DM, 0, 1.f, nullptr, 1};
            pg8::gemm_phase<pg8::EpiBf16<0>, pg8::GroupedOrder, true, true>(F.lds, g, S, E, F.wave);
            }
        SEAM(pb + 7);
        if (PHM(9) && IN(pb + 8)) combine_phase(F, args, layer);
        SEAM(pb + 8);
        if (PHM(10) && IN(pb + 9)) { pg8::Gemm g{(const bf16*)(wsptr() + hb_off(layer)), (const bf16*)(wsptr() + WS_WG) + (size_t)layer * DM * DM, M, DM, DM}; pg8::StaticOrder S; S.init(M, DM, F.G, (int)blockIdx.x);
            pg8::EpiGate E{(const bf16*)(wsptr() + hb_off(layer)), (bf16*)(wsptr() + hb_off(layer + 1)), (const bf16*)(wsptr() + WS_PL), (const float*)(wsptr() + WS_RSPLE), DM, (fuse_norm && layer + 1 < DEPTH) ? (float*)(wsptr() + WS_SSQ) : nullptr};
            pg8::gemm_phase<pg8::EpiGate, pg8::StaticOrder, true, true>(F.lds, g, S, E, F.wave); }
        SEAM(pb + 9);
        if (!(fuse_norm && layer + 1 < DEPTH)) { if (PHM(11) && IN(pb + 10)) endnorm_phase(F, args, layer);
        SEAM(pb + 10); }
    }
#undef IN
#undef SEAM
}

extern "C" void kernel_launch(void* const* d_in, const int* in_sizes, int n_in, void* d_out, int out_size, void* d_ws, size_t ws_size, hipStream_t stream) {
    static int grid = 0;
    if (grid == 0) {
        if (n_in != 22 || in_sizes[0] != M * DM || out_size != M * DM || ws_size < WS_END) { fprintf(stderr, "kernel_launch: shape mismatch (n_in %d, in0 %d, out %d, ws %zu < %zu); nothing launched\n", n_in, n_in > 0 ? in_sizes[0] : -1, out_size, ws_size, (size_t)WS_END); grid = -1; return; }
        int dev = 0, cus = 0, per_cu = 0;
        if (hipGetDevice(&dev) != hipSuccess || hipDeviceGetAttribute(&cus, hipDeviceAttributeMultiprocessorCount, dev) != hipSuccess) { grid = -1; return; }
        if (hipFuncSetAttribute((const void*)mk_fwd, hipFuncAttributeMaxDynamicSharedMemorySize, LDS_BYTES) != hipSuccess) { fprintf(stderr, "kernel_launch: hipFuncSetAttribute failed\n"); grid = -1; return; }
        if (hipOccupancyMaxActiveBlocksPerMultiprocessor(&per_cu, (const void*)mk_fwd, NWAVES * 64, LDS_BYTES) != hipSuccess || per_cu < 1) { fprintf(stderr, "kernel_launch: occupancy query says %d blocks per CU\n", per_cu); }
        (void)hipGetLastError();
        grid = cus;
    }
    if (grid < 0) return;
    if (hipMemsetAsync((char*)d_ws + WS_CTL, 0, CTL_ZERO_BYTES, stream) != hipSuccess) return;
    Args a{};
    for (int i = 0; i < 22; ++i) a.in[i] = (const float*)d_in[i];
    a.out = (float*)d_out; a.ws = (unsigned char*)d_ws;
#if MK_PER_PHASE
    a.use_bar = 0;
    for (int ph = 0; ph < NPHASES; ++ph) {
        const int layer = ph > 0 ? (ph - 1) / NPH_LAYER : -1, k = ph > 0 ? (ph - 1) % NPH_LAYER : -1;
        a.ph_lo = ph; a.ph_hi = ph + 1;
        hipLaunchKernelGGL(mk_fwd, dim3(grid), dim3(NWAVES * 64), LDS_BYTES, stream, a);
    }
#else
    a.use_bar = 1; a.ph_lo = 0; a.ph_hi = NPHASES;
    hipLaunchKernelGGL(mk_fwd, dim3(grid), dim3(NWAVES * 64), LDS_BYTES, stream, a);
#endif
    const hipError_t le = hipPeekAtLastError();
    if (le != hipSuccess) fprintf(stderr, "kernel_launch: launch failed: %s\n", hipGetErrorName(le));
}
```

```cpp
#include <hip/hip_runtime.h>
#include <hip/hip_bf16.h>
#include <cstdio>
#include <cstdint>
#include <cmath>
#ifndef MK_PER_PHASE
#define MK_PER_PHASE 0
#endif
__device__ __forceinline__ int mk_lane() { unsigned m = ~0u; asm volatile("" : "+s"(m)); return (int)__builtin_amdgcn_mbcnt_hi(m, __builtin_amdgcn_mbcnt_lo(m, 0u)); }
__device__ __forceinline__ float mk_shfl_xor_l(float v, int o, int l) { return __uint_as_float((unsigned)__builtin_amdgcn_ds_bpermute((l ^ o) << 2, (int)__float_as_uint(v))); }
__device__ __forceinline__ float mk_shfl_xor(float v, int o) { return mk_shfl_xor_l(v, o, mk_lane()); }
#define CAS __attribute__((address_space(4)))
__device__ __forceinline__ const CAS char* kargs() { const CAS char* kp = (const CAS char*)__builtin_amdgcn_kernarg_segment_ptr(); asm volatile("" : "+s"(kp)); return kp; }
__device__ __forceinline__ const float* inptr(int k) { return *(const float* const CAS*)(kargs() + 8 * k); }
__device__ __forceinline__ float* outptr() { return *(float* const CAS*)(kargs() + 176); }
__device__ __forceinline__ unsigned char* wsptr() { return *(unsigned char* const CAS*)(kargs() + 184); }
namespace pg8 {
#define PG8_LAS __attribute__((address_space(3)))
typedef unsigned short bf16_t;
typedef short bf16x8 __attribute__((ext_vector_type(8)));
typedef float f32x4 __attribute__((ext_vector_type(4)));
typedef unsigned u32x4 __attribute__((ext_vector_type(4)));
constexpr int BM = 256, BK = 64, HALF = 128, HTB = HALF * BK * 2  , STAGE_BYTES = 8 * HTB, NXCD = 8, WGM = 8;

__host__ __device__ __forceinline__ int lds_byte(int r, int c) { const int st = (r >> 4) * 2 + (c >> 5), rr = r & 15, cc = c & 31, ob = rr * 64 + cc * 2; return st * 1024 + (ob ^ (((ob >> 9) & 1) << 5)); }
__host__ __device__ __forceinline__ void stage_rc(int b, int& R, int& C) { const int st = b / 1024, sb = b % 1024, swz = sb ^ (((sb >> 9) & 1) << 5); R = (st >> 1) * 16 + swz / 64; C = (st & 1) * 32 + (swz % 64) / 2; }
__host__ __device__ __forceinline__ int perm32(int rho) { const int n = rho >> 4, i = rho & 15; return 8 * (i >> 2) + 4 * n + (i & 3); }

struct Unit { int pm, pn; };
struct Gemm { const bf16_t* A; const bf16_t* Bt; int M, N, K; };

struct StaticOrder {
    static constexpr bool B_NT = false;
    int nM, nN, nwg, G, c;
    __host__ __device__ void init(int M, int N, int G_, int c_) { nM = M / BM; nN = N / BM; nwg = nM * nN; G = G_; c = c_; }
    __host__ __device__ bool next(int i, Unit& u) const {
        const long L = (long)i * G + c; if (L >= nwg) return false;
        int wgid = (int)L; { const int q = nwg / NXCD, r = nwg % NXCD, xcd = wgid % NXCD, off = wgid / NXCD; wgid = (xcd < r ? xcd * (q + 1) : r * (q + 1) + (xcd - r) * q) + off; }
        const int nig = WGM * nN, gid = wgid / nig, fm = gid * WGM, gsz = (nM - fm) < WGM ? (nM - fm) : WGM;
        u.pm = fm + ((wgid % nig) % gsz); u.pn = (wgid % nig) / gsz; return true;
    }
    __device__ __forceinline__ void a_ready(const Unit&) const {}
    __device__ __forceinline__ void done(const Unit&) const {}
    __device__ __forceinline__ int row_tok(const Unit&, int) const { return 0; }
};

__device__ __forceinline__ unsigned cvt_pk_bf16(float lo, float hi) { unsigned r; asm volatile("v_cvt_pk_bf16_f32 %0, %1, %2" : "=v"(r) : "v"(lo), "v"(hi)); return r; }
typedef float f32x2 __attribute__((ext_vector_type(2)));
template <int ACT  > struct EpiBf16 {
    static constexpr bool PERM = true, AFTER_DRAIN = false, PROBE = false; static_assert(ACT == 0 || ACT == 1, "EpiBf16: ACT is 0 (none) or 1 (gelu_pk)");
    bf16_t* O; int ldc; const float* bias; int split_cols; size_t split_stride; float scale0; const float* rowscale; int nt;
    __device__ __forceinline__ void operator()(const f32x4 (&acc)[2][2][4][2], const Unit& u, int wr, int wc, int fr, int fq) const {
        const int row0 = u.pm * BM + wr * 64 + fr; int colt = u.pn * BM; bf16_t* base = O;
        float sc = 1.f; if (split_cols) { const int t = colt / split_cols; base += (size_t)t * split_stride; colt -= t * split_cols; if (t == 0) sc = scale0; }
        const int col0 = colt + wc * 32 + 8 * fq, bcol0 = u.pn * BM + wc * 32 + 8 * fq;
        f32x4 bv[2][2];
#pragma unroll
        for (int bj = 0; bj < 2; ++bj)
#pragma unroll
            for (int n = 0; n < 2; ++n) bv[bj][n] = bias ? *(const f32x4*)(bias + bcol0 + bj * HALF + 4 * n) : (f32x4){0.f, 0.f, 0.f, 0.f};
#pragma unroll
        for (int ai = 0; ai < 2; ++ai)
#pragma unroll
            for (int m = 0; m < 4; ++m) { bf16_t* rowp = base + (size_t)(row0 + ai * HALF + m * 16) * ldc + col0; const float rsc = rowscale ? rowscale[row0 + ai * HALF + m * 16] * sc : sc;
#pragma unroll
                for (int bj = 0; bj < 2; ++bj) { f32x4 v0 = acc[ai][bj][m][0] + bv[bj][0], v1 = acc[ai][bj][m][1] + bv[bj][1];
                    v0 = v0 * rsc; v1 = v1 * rsc; u32x4 w; w.x = cvt_pk_bf16(v0[0], v0[1]); w.y = cvt_pk_bf16(v0[2], v0[3]); w.z = cvt_pk_bf16(v1[0], v1[1]); w.w = cvt_pk_bf16(v1[2], v1[3]);
                    if (nt) __builtin_nontemporal_store(w, (u32x4*)(rowp + bj * HALF)); else *(u32x4*)(rowp + bj * HALF) = w; } }
    }
};

__device__ __forceinline__ float bflo(unsigned w) { return __uint_as_float(w << 16); }
__device__ __forceinline__ float bfhi(unsigned w) { return __uint_as_float(w & 0xffff0000u); }
struct EpiRes {
    static constexpr bool PERM = true, AFTER_DRAIN = false, PROBE = true;
    bf16_t* hb; int ldc;
    __device__ __forceinline__ void operator()(const f32x4 (&acc)[2][2][4][2], const Unit& u, int wr, int wc, int fr, int fq) const {
        const int row0 = u.pm * BM + wr * 64 + fr, col0 = u.pn * BM + wc * 32 + 8 * fq;
        u32x4 q[2][4][2];
#pragma unroll
        for (int ai = 0; ai < 2; ++ai)
#pragma unroll
            for (int m = 0; m < 4; ++m)
#pragma unroll
                for (int bj = 0; bj < 2; ++bj) q[ai][m][bj] = *(const u32x4*)(hb + (size_t)(row0 + ai * HALF + m * 16) * ldc + col0 + bj * HALF);
#pragma unroll
        for (int ai = 0; ai < 2; ++ai)
#pragma unroll
            for (int m = 0; m < 4; ++m)
#pragma unroll
                for (int bj = 0; bj < 2; ++bj) { const u32x4 qq = q[ai][m][bj]; const f32x4 a0 = acc[ai][bj][m][0], a1 = acc[ai][bj][m][1];
                    u32x4 w; w.x = cvt_pk_bf16(bflo(qq.x) + a0[0], bfhi(qq.x) + a0[1]); w.y = cvt_pk_bf16(bflo(qq.y) + a0[2], bfhi(qq.y) + a0[3]); w.z = cvt_pk_bf16(bflo(qq.z) + a1[0], bfhi(qq.z) + a1[1]); w.w = cvt_pk_bf16(bflo(qq.w) + a1[2], bfhi(qq.w) + a1[3]);
                    *(u32x4*)(hb + (size_t)(row0 + ai * HALF + m * 16) * ldc + col0 + bj * HALF) = w; }
    }
};
__device__ __forceinline__ float sigmoidf_(float a) { return __builtin_amdgcn_rcpf(1.0f + __builtin_amdgcn_exp2f(-1.4426950408889634f * a)); }
struct EpiSiluMul {
    static constexpr bool PERM = true, AFTER_DRAIN = false, PROBE = false;
    bf16_t* O; int ldc; const int* list; const PG8_LAS int* offs; const float* rstd;
    __device__ __forceinline__ void operator()(const f32x4 (&acc)[2][2][4][2], const Unit& u, int wr, int wc, int fr, int fq) const {
        const int row0 = u.pm * BM + wr * 64 + fr, col0 = (u.pn & 3) * HALF + wc * 32 + 8 * fq;
        const int e = u.pn >> 2; const float* lp = rstd + e * 32768 + (u.pm * BM - offs[e]) + wr * 64 + fr;
        float rsv[2][4];
#pragma unroll
        for (int ai = 0; ai < 2; ++ai)
#pragma unroll
            for (int m = 0; m < 4; ++m) rsv[ai][m] = lp[ai * HALF + m * 16];
#pragma unroll
        for (int ai = 0; ai < 2; ++ai)
#pragma unroll
            for (int m = 0; m < 4; ++m) { bf16_t* rowp = O + (size_t)(row0 + ai * HALF + m * 16) * ldc + col0;
                const float rs = rsv[ai][m];
                f32x4 v0, v1;
#pragma unroll
                for (int i = 0; i < 4; ++i) { const float a0 = acc[ai][0][m][0][i] * rs, a1 = acc[ai][0][m][1][i] * rs;
                    v0[i] = a0 * sigmoidf_(a0) * (acc[ai][1][m][0][i] * rs); v1[i] = a1 * sigmoidf_(a1) * (acc[ai][1][m][1][i] * rs); }
                u32x4 w; w.x = cvt_pk_bf16(v0[0], v0[1]); w.y = cvt_pk_bf16(v0[2], v0[3]); w.z = cvt_pk_bf16(v1[0], v1[1]); w.w = cvt_pk_bf16(v1[2], v1[3]);
                *(u32x4*)rowp = w; }
    }
};
struct EpiGate {
    static constexpr bool PERM = true, AFTER_DRAIN = false, PROBE = false;
    const bf16_t* hin; bf16_t* hout; const bf16_t* PL; const float* rs; int ldc; float* part;
    __device__ __forceinline__ void operator()(const f32x4 (&acc)[2][2][4][2], const Unit& u, int wr, int wc, int fr, int fq) const {
        const int row0 = u.pm * BM + wr * 64 + fr, col0 = u.pn * BM + wc * 32 + 8 * fq;
#pragma unroll
        for (int ai = 0; ai < 2; ++ai) { u32x4 q[4][2], p[4][2]; float r_[4], ss[4];
#pragma unroll
            for (int m = 0; m < 4; ++m) { r_[m] = rs[row0 + ai * HALF + m * 16];
#pragma unroll
                for (int bj = 0; bj < 2; ++bj) { const size_t off = (size_t)(row0 + ai * HALF + m * 16) * ldc + col0 + bj * HALF; q[m][bj] = __builtin_nontemporal_load((const u32x4*)(hin + off)); p[m][bj] = __builtin_nontemporal_load((const u32x4*)(PL + off)); } }
#pragma unroll
            for (int m = 0; m < 4; ++m) { float s = 0.f;
#pragma unroll
                for (int bj = 0; bj < 2; ++bj) { const u32x4 qq = q[m][bj], pp = p[m][bj]; const f32x4 a0 = acc[ai][bj][m][0] * r_[m], a1 = acc[ai][bj][m][1] * r_[m];
                    const float v0 = bflo(qq.x) + sigmoidf_(a0[0]) * bflo(pp.x), v1 = bfhi(qq.x) + sigmoidf_(a0[1]) * bfhi(pp.x), v2 = bflo(qq.y) + sigmoidf_(a0[2]) * bflo(pp.y), v3 = bfhi(qq.y) + sigmoidf_(a0[3]) * bfhi(pp.y);
                    const float v4 = bflo(qq.z) + sigmoidf_(a1[0]) * bflo(pp.z), v5 = bfhi(qq.z) + sigmoidf_(a1[1]) * bfhi(pp.z), v6 = bflo(qq.w) + sigmoidf_(a1[2]) * bflo(pp.w), v7 = bfhi(qq.w) + sigmoidf_(a1[3]) * bfhi(pp.w);
                    u32x4 w; w.x = cvt_pk_bf16(v0, v1); w.y = cvt_pk_bf16(v2, v3); w.z = cvt_pk_bf16(v4, v5); w.w = cvt_pk_bf16(v6, v7);
                    s += ((v0 * v0 + v1 * v1) + (v2 * v2 + v3 * v3)) + ((v4 * v4 + v5 * v5) + (v6 * v6 + v7 * v7));
                    *(u32x4*)(hout + (size_t)(row0 + ai * HALF + m * 16) * ldc + col0 + bj * HALF) = w; }
                ss[m] = s; }
            if (part) { const int l = mk_lane();
#pragma unroll
                for (int m = 0; m < 4; ++m) { float s = ss[m]; s += mk_shfl_xor_l(s, 16, l); s += mk_shfl_xor_l(s, 32, l);
                    if (fq == 0) part[(size_t)(row0 + ai * HALF + m * 16) * 32 + 4 * u.pn + wc] = s; } }
            asm volatile("" ::: "memory"); }
    }
};
__device__ __forceinline__ float row_sum16(float v) {
    v += __int_as_float(__builtin_amdgcn_update_dpp(0, __float_as_int(v), 0x128, 0xf, 0xf, false));
    v += __int_as_float(__builtin_amdgcn_update_dpp(0, __float_as_int(v), 0x124, 0xf, 0xf, false));
    v += __int_as_float(__builtin_amdgcn_update_dpp(0, __float_as_int(v), 0x122, 0xf, 0xf, false));
    v += __int_as_float(__builtin_amdgcn_update_dpp(0, __float_as_int(v), 0x121, 0xf, 0xf, false));
    return v;
}
struct EpiProj {
    static constexpr bool PERM = true, AFTER_DRAIN = false, PROBE = false;
    bf16_t* O; int ldc; const PG8_LAS int* tab; const PG8_LAS float* rs; float* kp; int kt0, kpn; const float* rsg;
    __device__ __forceinline__ void operator()(const f32x4 (&acc)[2][2][4][2], const Unit& u, int wr, int wc, int fr, int fq) const {
        const int row0 = u.pm * BM + wr * 64 + fr, col0 = u.pn * BM + wc * 32 + 8 * fq;
        int s = -1;
#pragma unroll
        for (int k = 0; k < 4; ++k) s = (tab[k] == u.pm) ? k : s;
        s = __builtin_amdgcn_readfirstlane(s);
        float rsv[2][4];
        if (s >= 0) { const PG8_LAS float* r = rs + s * 256 + wr * 64 + fr;
#pragma unroll
            for (int ai = 0; ai < 2; ++ai)
#pragma unroll
                for (int m = 0; m < 4; ++m) rsv[ai][m] = r[ai * HALF + m * 16]; }
        else { const float* rg = rsg + row0;
#pragma unroll
            for (int ai = 0; ai < 2; ++ai)
#pragma unroll
                for (int m = 0; m < 4; ++m) { rsv[ai][m] = rg[ai * HALF + m * 16]; asm volatile("" : "+v"(rsv[ai][m])); } }
        if (u.pn == kt0 || u.pn == kt0 + 1) {
            float cs[2][8];
#pragma unroll
            for (int bj = 0; bj < 2; ++bj)
#pragma unroll
                for (int i = 0; i < 8; ++i) cs[bj][i] = 0.f;
#pragma unroll
            for (int ai = 0; ai < 2; ++ai)
#pragma unroll
                for (int m = 0; m < 4; ++m) { bf16_t* rowp = O + (size_t)(row0 + ai * HALF + m * 16) * ldc + col0; const float rsc = rsv[ai][m];
#pragma unroll
                    for (int bj = 0; bj < 2; ++bj) { const f32x4 v0 = acc[ai][bj][m][0] * rsc, v1 = acc[ai][bj][m][1] * rsc;
                        u32x4 w; w.x = cvt_pk_bf16(v0[0], v0[1]); w.y = cvt_pk_bf16(v0[2], v0[3]); w.z = cvt_pk_bf16(v1[0], v1[1]); w.w = cvt_pk_bf16(v1[2], v1[3]);
                        cs[bj][0] += bflo(w.x); cs[bj][1] += bfhi(w.x); cs[bj][2] += bflo(w.y); cs[bj][3] += bfhi(w.y); cs[bj][4] += bflo(w.z); cs[bj][5] += bfhi(w.z); cs[bj][6] += bflo(w.w); cs[bj][7] += bfhi(w.w);
                        *(u32x4*)(rowp + bj * HALF) = w; } }
#pragma unroll
            for (int bj = 0; bj < 2; ++bj) { f32x4 a, b;
#pragma unroll
                for (int i = 0; i < 4; ++i) { a[i] = row_sum16(cs[bj][i]); b[i] = row_sum16(cs[bj][4 + i]); }
                if (fr == 0) { float* dp = kp + (size_t)wr * kpn + (size_t)((((u.pm >> 4) * 4 + (u.pn - kt0) * 2 + bj) * 16 + (u.pm & 15)) * 128 + wc * 32 + 8 * fq); *(f32x4*)dp = a; *(f32x4*)(dp + 4) = b; } }
            return;
        }
#pragma unroll
        for (int ai = 0; ai < 2; ++ai)
#pragma unroll
            for (int m = 0; m < 4; ++m) { bf16_t* rowp = O + (size_t)(row0 + ai * HALF + m * 16) * ldc + col0; const float rsc = rsv[ai][m];
#pragma unroll
                for (int bj = 0; bj < 2; ++bj) { const f32x4 v0 = acc[ai][bj][m][0] * rsc, v1 = acc[ai][bj][m][1] * rsc;
                    u32x4 w; w.x = cvt_pk_bf16(v0[0], v0[1]); w.y = cvt_pk_bf16(v0[2], v0[3]); w.z = cvt_pk_bf16(v1[0], v1[1]); w.w = cvt_pk_bf16(v1[2], v1[3]);
                    *(u32x4*)(rowp + bj * HALF) = w; } }
    }
};
struct GroupedOrder {
    static constexpr bool B_NT = false;
    const PG8_LAS unsigned char* tile_e; int nTiles, nN, G, c;
    const int* list; const PG8_LAS int* offs;
    __device__ __forceinline__ bool next(int i, Unit& u) const {
        const int x = c & 7, slot = c >> 3, per = G >> 3; int L = i * per + slot;
#pragma unroll
        for (int k = 0; k < 4; ++k) { const int e = x + 8 * k; const int t0 = offs[e] >> 8, t1 = (e == 31) ? nTiles : (offs[e + 1] >> 8); const int n = (t1 - t0) * nN;
            if (L < n) { u.pm = __builtin_amdgcn_readfirstlane(t0 + L / nN); u.pn = __builtin_amdgcn_readfirstlane(e * nN + L % nN); return true; }
            L -= n; }
        return false;
    }
    __device__ __forceinline__ void a_ready(const Unit&) const {}
    __device__ __forceinline__ void done(const Unit&) const {}
    static constexpr int LTAB_UNITS = 8;
    const PG8_LAS int* ltab;
    __device__ __forceinline__ int row_tok(const Unit& u, int r, int ord) const { if (ltab != nullptr && ord < LTAB_UNITS) return ltab[ord * 256 + r]; const int e = u.pn / nN; int v = list[e * 32768 + (u.pm * BM - offs[e]) + r];
        asm volatile("" : "+v"(v)); return v; }
};
template <class Epi, class Sched, bool ALIGN_EPI = false, bool SP2 = false, bool GATHER = false>
__device__ __forceinline__ void gemm_phase(PG8_LAS unsigned char* lds, const Gemm g, const Sched& S, const Epi& E, const int wave_idx) {
    int wid_o = wave_idx; asm volatile("" : "+s"(wid_o));
    const int tid = wid_o * 64 + mk_lane(), wid = wid_o    , lane = tid & 63, wr = wid >> 2, wc = wid & 3, fr = lane & 15, fq = lane >> 4;
    const int K = g.K, nt = K / BK;
    unsigned voffA[2], voffB[2];
#pragma unroll
    for (int i = 0; i < 2; ++i) { int R, C; stage_rc(tid * 16 + i * 8192, R, C); const int Rb = Epi::PERM ? ((R & ~31) + perm32(R & 31)) : R;
        voffA[i] = (unsigned)(R * K + C) * 2u; voffB[i] = (unsigned)(Rb * K + C) * 2u; }
    const size_t kstep = (size_t)(BK * 2);
    const size_t hstep = (size_t)HALF * K * 2;
    const size_t tstep = 2 * hstep;
    const unsigned ldsw = (unsigned)wid * 1024u;
    const int aoff = lds_byte(wr * 64 + fr, fq * 8), boff = lds_byte(wc * 32 + fr, fq * 8);
#define PG8_SA(b, h) (((b) * 2 + (h)) * HTB)
#define PG8_SB(b, h) ((4 + (b) * 2 + (h)) * HTB)
#define PG8_STAGE(bufoff, gbase, voff) do { _Pragma("unroll") for (int _i = 0; _i < 2; ++_i) \
        __builtin_amdgcn_global_load_lds((const unsigned*)((const char*)(gbase) + (voff)[_i]), (PG8_LAS unsigned*)(lds + (bufoff) + ldsw + _i * 8192), 16, 0, 0); } while (0)
#define PG8_STAGE_B(bufoff, gbase, voff) do { _Pragma("unroll") for (int _i = 0; _i < 2; ++_i) \
        __builtin_amdgcn_global_load_lds((const unsigned*)((const char*)(gbase) + (voff)[_i]), (PG8_LAS unsigned*)(lds + (bufoff) + ldsw + _i * 8192), 16, 0, Sched::B_NT ? 2 : 0); } while (0)
#define PG8_STAGE_A(bufoff, base, hh_, nx_) do { if constexpr (GATHER) { unsigned og_[2] = {(nx_) ? offN[hh_][0] : offA[hh_][0], (nx_) ? offN[hh_][1] : offA[hh_][1]}; asm volatile("" : "+v"(og_[0]), "+v"(og_[1]));   PG8_STAGE(bufoff, base, og_); } \
        else PG8_STAGE(bufoff, (base) + ((hh_) ? hstep : 0), voffA); } while (0)
#define PG8_ROWOFFS(dst, un, ord) do { _Pragma("unroll") for (int h_ = 0; h_ < 2; ++h_) _Pragma("unroll") for (int i_ = 0; i_ < 2; ++i_) { int R_, C_; stage_rc(tid * 16 + i_ * 8192, R_, C_); \
        dst[h_][i_] = ((unsigned)S.row_tok(un, h_ * HALF + R_, ord) & 0x7fffu) * (unsigned)(K * 2) + (unsigned)(C_ * 2); } } while (0)
#define PG8_LDA(dst, b, h) do { _Pragma("unroll") for (int m = 0; m < 4; ++m) _Pragma("unroll") for (int k = 0; k < 2; ++k) dst[m][k] = *(const PG8_LAS bf16x8*)(lds + PG8_SA(b, h) + aoff + m * 2048 + k * 1024); } while (0)
#define PG8_LDB(dst, b, h) do { _Pragma("unroll") for (int n = 0; n < 2; ++n) _Pragma("unroll") for (int k = 0; k < 2; ++k) dst[n][k] = *(const PG8_LAS bf16x8*)(lds + PG8_SB(b, h) + boff + n * 2048 + k * 1024); } while (0)
#define PG8_MMA(ai, bj, At, Bt) do { __builtin_amdgcn_s_setprio(1); _Pragma("unroll") for (int m = 0; m < 4; ++m) _Pragma("unroll") for (int n = 0; n < 2; ++n) _Pragma("unroll") for (int k = 0; k < 2; ++k) \
        acc[ai][bj][m][n] = __builtin_amdgcn_mfma_f32_16x16x32_bf16(Bt[n][k], At[m][k], acc[ai][bj][m][n], 0, 0, 0); __builtin_amdgcn_s_setprio(0); } while (0)
#define PG8_WAIT_V(n) asm volatile("s_waitcnt vmcnt(" #n ")" ::: "memory")
#define PG8_WAIT_L(n) asm volatile("s_waitcnt lgkmcnt(" #n ")" ::: "memory")
#define PG8_BAR __builtin_amdgcn_s_barrier()
#define PG8_SCHED __builtin_amdgcn_sched_barrier(0)
    Unit cur, nxt; int ui = 0;
    if (!S.next(0, cur)) return;
    f32x4 acc[2][2][4][2];
#pragma unroll
    for (int a = 0; a < 2; ++a)
#pragma unroll
        for (int b = 0; b < 2; ++b)
#pragma unroll
            for (int m = 0; m < 4; ++m)
#pragma unroll
                for (int n = 0; n < 2; ++n) acc[a][b][m][n] = (f32x4){0.f, 0.f, 0.f, 0.f};
    bf16x8 At[4][2], B0[2][2], B1[2][2];
    const char* cA = (const char*)g.A + (GATHER ? (size_t)0 : (size_t)cur.pm * tstep);
    unsigned offA[2][2] = {{0u, 0u}, {0u, 0u}}, offN[2][2] = {{0u, 0u}, {0u, 0u}};
    if constexpr (GATHER) PG8_ROWOFFS(offA, cur, 0); const char* cB = (const char*)g.Bt + (size_t)cur.pn * tstep;
    S.a_ready(cur);
    if constexpr (SP2) {
        PG8_STAGE_B(PG8_SB(0, 0), cB, voffB); PG8_STAGE_B(PG8_SB(0, 1), cB + hstep, voffB); PG8_STAGE_A(PG8_SA(0, 0), cA, 0, false); PG8_STAGE_A(PG8_SA(0, 1), cA, 1, false);
        if (wr == 1) PG8_BAR;
        PG8_WAIT_V(2); PG8_BAR;
        PG8_STAGE_B(PG8_SB(1, 0), cB + kstep, voffB); PG8_STAGE_A(PG8_SA(1, 0), cA + kstep, 0, false); PG8_STAGE_B(PG8_SB(1, 1), cB + hstep + kstep, voffB);
        PG8_WAIT_V(6); PG8_BAR;
    } else {
        PG8_STAGE_B(PG8_SB(0, 0), cB, voffB); PG8_STAGE_A(PG8_SA(0, 0), cA, 0, false); PG8_STAGE_B(PG8_SB(0, 1), cB + hstep, voffB); PG8_STAGE_A(PG8_SA(0, 1), cA, 1, false);
        if (wr == 1) PG8_BAR;
        PG8_WAIT_V(4); PG8_BAR;
        PG8_STAGE_B(PG8_SB(1, 0), cB + kstep, voffB); PG8_STAGE_A(PG8_SA(1, 0), cA + kstep, 0, false); PG8_STAGE_B(PG8_SB(1, 1), cB + hstep + kstep, voffB);
        PG8_WAIT_V(6); PG8_BAR;
    }
    for (;;) {
        const bool has_next = S.next(ui + 1, nxt);
        const char* nA = (has_next && !GATHER) ? (const char*)g.A + (size_t)nxt.pm * tstep : cA;
        if constexpr (GATHER) { if (has_next) PG8_ROWOFFS(offN, nxt, ui + 1); else { offN[0][0] = offA[0][0]; offN[0][1] = offA[0][1]; offN[1][0] = offA[1][0]; offN[1][1] = offA[1][1]; } } const char* nB = has_next ? (const char*)g.Bt + (size_t)nxt.pn * tstep : cB;
        for (int t = 0; t < nt; t += 2) {
            const bool last = (t == nt - 2);
            const char* a1 = cA + (size_t)(t + 1) * kstep;
            const char* a2 = last ? nA : cA + (size_t)(t + 2) * kstep; const char* b2 = last ? nB : cB + (size_t)(t + 2) * kstep;
            const char* a3 = a2 + kstep; const char* b3 = b2 + kstep;
            if (last && has_next) S.a_ready(nxt);
            if constexpr (SP2) {
            PG8_LDB(B0, 0, 0); PG8_LDB(B1, 0, 1); PG8_SCHED; PG8_LDA(At, 0, 0); PG8_STAGE_A(PG8_SA(1, 1), a1, 1, false);
            PG8_WAIT_V(8); PG8_WAIT_L(0); PG8_BAR; PG8_MMA(0, 0, At, B0); PG8_MMA(0, 1, At, B1); PG8_BAR; PG8_SCHED;
            PG8_LDA(At, 0, 1); PG8_STAGE_B(PG8_SB(0, 0), b2, voffB); PG8_STAGE_B(PG8_SB(0, 1), b2 + hstep, voffB); PG8_STAGE_A(PG8_SA(0, 0), a2, 0, last);
            PG8_WAIT_V(8); PG8_WAIT_L(0); PG8_BAR; PG8_MMA(1, 0, At, B0); PG8_MMA(1, 1, At, B1); PG8_BAR; PG8_SCHED;
            PG8_LDB(B0, 1, 0); PG8_LDB(B1, 1, 1); PG8_SCHED; PG8_LDA(At, 1, 0); PG8_STAGE_A(PG8_SA(0, 1), a2, 1, last);
            PG8_WAIT_V(8); PG8_WAIT_L(0); PG8_BAR; PG8_MMA(0, 0, At, B0); PG8_MMA(0, 1, At, B1); PG8_BAR; PG8_SCHED;
            PG8_LDA(At, 1, 1); PG8_STAGE_B(PG8_SB(1, 0), b3, voffB); PG8_STAGE_B(PG8_SB(1, 1), b3 + hstep, voffB); PG8_STAGE_A(PG8_SA(1, 0), a3, 0, last);
            PG8_WAIT_V(8); PG8_WAIT_L(0); PG8_BAR; PG8_MMA(1, 0, At, B0); PG8_MMA(1, 1, At, B1); PG8_BAR; PG8_SCHED;
            } else {
            PG8_LDB(B0, 0, 0); PG8_SCHED; PG8_LDA(At, 0, 0); PG8_STAGE_A(PG8_SA(1, 1), a1, 1, false);
            PG8_WAIT_L(8); PG8_BAR; PG8_WAIT_L(0); PG8_MMA(0, 0, At, B0); PG8_BAR; PG8_SCHED;
            PG8_LDB(B1, 0, 1); PG8_STAGE_B(PG8_SB(0, 0), b2, voffB);
            PG8_BAR; PG8_WAIT_L(0); PG8_MMA(0, 1, At, B1); PG8_BAR;
            PG8_LDA(At, 0, 1); PG8_STAGE_A(PG8_SA(0, 0), a2, 0, last);
            PG8_BAR; PG8_WAIT_L(0); PG8_MMA(1, 0, At, B0); PG8_BAR; PG8_SCHED;
            PG8_STAGE_B(PG8_SB(0, 1), b2 + hstep, voffB);
            PG8_WAIT_V(6); PG8_BAR; PG8_MMA(1, 1, At, B1); PG8_BAR;
            PG8_LDB(B0, 1, 0); PG8_SCHED; PG8_LDA(At, 1, 0); PG8_STAGE_A(PG8_SA(0, 1), a2, 1, last);
            PG8_WAIT_L(8); PG8_BAR; PG8_WAIT_L(0); PG8_MMA(0, 0, At, B0); PG8_BAR; PG8_SCHED;
            PG8_LDB(B1, 1, 1); PG8_STAGE_B(PG8_SB(1, 0), b3, voffB);
            PG8_BAR; PG8_WAIT_L(0); PG8_MMA(0, 1, At, B1); PG8_BAR;
            PG8_LDA(At, 1, 1); PG8_STAGE_A(PG8_SA(1, 0), a3, 0, last);
            PG8_BAR; PG8_WAIT_L(0); PG8_MMA(1, 0, At, B0); PG8_BAR; PG8_SCHED;
            PG8_STAGE_B(PG8_SB(1, 1), b3 + hstep, voffB);
            PG8_WAIT_V(6); PG8_BAR; PG8_MMA(1, 1, At, B1); PG8_BAR;
            }
        }
        if constexpr (ALIGN_EPI) { if (wr == 0) PG8_BAR; }
#ifdef PG8_EPI_PROBE
        if constexpr (!Epi::AFTER_DRAIN) { unsigned long long t0_ = 0ull; if constexpr (Epi::PROBE) t0_ = __builtin_amdgcn_s_memrealtime();
            E(acc, cur, wr, wc, fr, fq); S.done(cur);
            if constexpr (Epi::PROBE) { if (blockIdx.x == 0 && wid == 0 && mk_lane() == 0) *(PG8_LAS unsigned long long*)(lds + PG8_EPI_PROBE) += __builtin_amdgcn_s_memrealtime() - t0_; } }
#else
        if constexpr (!Epi::AFTER_DRAIN) { E(acc, cur, wr, wc, fr, fq); S.done(cur); }
#endif
        if (!has_next) break;
#pragma unroll
        for (int a = 0; a < 2; ++a)
#pragma unroll
            for (int b = 0; b < 2; ++b)
#pragma unroll
                for (int m = 0; m < 4; ++m)
#pragma unroll
                    for (int n = 0; n < 2; ++n) acc[a][b][m][n] = (f32x4){0.f, 0.f, 0.f, 0.f};
        cur = nxt; cA = nA; cB = nB; ++ui;
        if constexpr (GATHER) { offA[0][0] = offN[0][0]; offA[0][1] = offN[0][1]; offA[1][0] = offN[1][0]; offA[1][1] = offN[1][1]; }
        if constexpr (ALIGN_EPI) { if (wr == 1) PG8_BAR; }
    }
    PG8_WAIT_V(0);
    if constexpr (!ALIGN_EPI) { if (wr == 0) PG8_BAR; }
    PG8_BAR;
    if constexpr (Epi::AFTER_DRAIN) { E.fused(acc, cur, wr, wc, fr, fq, lds, wid, lane); S.done(cur); }
#undef PG8_SA
#undef PG8_SB
#undef PG8_STAGE
#undef PG8_STAGE_B
#undef PG8_STAGE_A
#undef PG8_ROWOFFS
#undef PG8_LDA
#undef PG8_LDB
#undef PG8_MMA
#undef PG8_WAIT_V
#undef PG8_WAIT_L
#undef PG8_BAR
#undef PG8_SCHED
}
}

#ifndef ATT_SDEPTH
#define ATT_SDEPTH 1
#endif
#ifndef ATT_PRIO
#define ATT_PRIO 1
#endif
#ifndef ATT_SWA_WAVE
#define ATT_SWA_WAVE 1
#endif
#ifndef ATT_DIFF_FUSED
#define ATT_DIFF_FUSED 1
#endif
#ifndef ATT_SDEPTH_DIFF
#define ATT_SDEPTH_DIFF 2
#endif
namespace att {
using bf16x8 = __attribute__((ext_vector_type(8))) short;
using s16x4  = __attribute__((ext_vector_type(4))) short;
using f32x16 = __attribute__((ext_vector_type(16))) float;
using f32x4  = __attribute__((ext_vector_type(4))) float;
using u32x4  = __attribute__((ext_vector_type(4))) unsigned;
constexpr int NW = 8, QBLK = 32, KVBLK = 64, LDP = 5120, LDY = 2048, SEQL = 4096;
constexpr int SHM_V = 16384, SHM_K = 16384;
constexpr int OFF_V = 0, OFF_K = 2 * SHM_V, OFF_WS = OFF_K + 2 * SHM_K, OFF_LUT = OFF_WS + NW * 64 * 4, OFF_MISC = OFF_LUT + 512, OFF_STG = 69632, STG_PITCH = 272, STG_WAVE = 32 * STG_PITCH;
constexpr int ATT_LDS = OFF_STG + NW * STG_WAVE;
constexpr int OFF_LUT4 = 147456, LUT4_N = 528, LUT4_COPIES = 5, OFF_LUTH = OFF_LUT4 + LUT4_COPIES * LUT4_N * 4, LUTH_BYTES = 6 * 128 * 4;
static_assert(OFF_MISC + 256 <= OFF_STG, "attention LDS map");
constexpr float LOG2E = 1.4426950408889634f, NEGB = -1e30f, THR2 = 11.5f;
#define SBAR() __builtin_amdgcn_sched_barrier(0)
__device__ __forceinline__ int crow(int r, int hi) { return (r & 3) + 8 * (r >> 2) + 4 * hi; }
__device__ __forceinline__ unsigned cvtpk(float lo, float hi) { unsigned r; asm volatile("v_cvt_pk_bf16_f32 %0, %1, %2" : "=v"(r) : "v"(lo), "v"(hi)); return r; }
__device__ __forceinline__ float bf2f(short x) { return __uint_as_float(((unsigned)(unsigned short)x) << 16); }
template <int DQK> __device__ __forceinline__ int kswz(int row, int colB) { return row * (2 * DQK) + (colB ^ ((((DQK == 128) ? row : (row >> 1)) & 7) << 4)); }

template <int MODE>
__device__ __forceinline__ void bias_mask(f32x16& p0, f32x16& p1, int kt, int qpos, int wave_qmin, int hi, float C, const float* lut4, float cfar, unsigned sel, int jblk) {
  bool lane_off = false;
  if (MODE == 1) { const int blk = kt >> 8; if (blk < jblk) lane_off = !((sel >> blk) & 1u); }
  const bool nearT = (kt + 63 + 128 > wave_qmin);
  if (!nearT) {
    if (MODE == 0) {
#pragma unroll
      for (int r = 0; r < 16; ++r) { p0[r] = NEGB; p1[r] = NEGB; }
    } else {
#pragma unroll
      for (int r = 0; r < 16; ++r) { p0[r] = lane_off ? NEGB : fmaf(p0[r], C, cfar); p1[r] = lane_off ? NEGB : fmaf(p1[r], C, cfar); }
    }
  } else {
    const int kb = kt + 4 * hi, D = qpos - kb, c4 = qpos & 3;
    const float* Lc = lut4 + ((MODE == 1 && lane_off) ? 4 * LUT4_N + (256 + c4 - D) : c4 * LUT4_N + (256 + c4 - D));
#pragma unroll
    for (int g = 0; g < 4; ++g) {
      const f32x4 b0 = *(const f32x4*)(Lc + 8 * g), b1 = *(const f32x4*)(Lc + 8 * g + 32);
#pragma unroll
      for (int i = 0; i < 4; ++i) { const int r = 4 * g + i; p0[r] = fmaf(p0[r], C, b0[i]); p1[r] = fmaf(p1[r], C, b1[i]); }
      if (g & 1) SBAR();
    }
  }
}
__device__ __forceinline__ void partialSM(f32x16& p0, f32x16& p1, float& m_reg, float& alpha) {
  float pmax = p0[0];
#pragma unroll
  for (int r = 1; r < 16; ++r) pmax = fmaxf(pmax, p0[r]);
#pragma unroll
  for (int r = 0; r < 16; ++r) pmax = fmaxf(pmax, p1[r]);
  { auto rr = __builtin_amdgcn_permlane32_swap(__float_as_uint(pmax), __float_as_uint(pmax), false, false);
    pmax = fmaxf(__uint_as_float(rr[0]), __uint_as_float(rr[1])); }
  float mn;
  if (__builtin_expect(__all(pmax - m_reg <= THR2), 1)) { mn = m_reg; alpha = 1.f; }
  else { mn = fmaxf(m_reg, pmax); alpha = __builtin_amdgcn_exp2f(m_reg - mn); m_reg = mn; }
#pragma unroll
  for (int r = 0; r < 16; ++r) { p0[r] = __builtin_amdgcn_exp2f(p0[r] - mn); p1[r] = p1[r] - mn; }
}
template <int MODE>
__device__ __forceinline__ void tile_sm(f32x16& p0, f32x16& p1, int kt, int qpos, int wave_qmin, int hi, float C, const float* lut, float cfar, unsigned sel, int jblk, float& m_reg, float& alpha) {
  const bool nearT = (kt + 63 + 128 > wave_qmin);
  if (nearT) { bias_mask<MODE>(p0, p1, kt, qpos, wave_qmin, hi, C, (const float*)((const char*)lut + (OFF_LUT4 - OFF_LUT)), cfar, sel, jblk); partialSM(p0, p1, m_reg, alpha); return; }
  if (MODE == 0) {
#pragma unroll
    for (int r = 0; r < 16; ++r) { p0[r] = 0.f; p1[r] = NEGB; }
    alpha = 1.f; return;
  }
  bool lane_off = false;
  if (MODE == 1) { const int blk = kt >> 8; if (blk < jblk) lane_off = !((sel >> blk) & 1u); }
  float pmax = p0[0];
#pragma unroll
  for (int r = 1; r < 16; ++r) pmax = fmaxf(pmax, p0[r]);
#pragma unroll
  for (int r = 0; r < 16; ++r) pmax = fmaxf(pmax, p1[r]);
  { auto rr = __builtin_amdgcn_permlane32_swap(__float_as_uint(pmax), __float_as_uint(pmax), false, false);
    pmax = fmaxf(__uint_as_float(rr[0]), __uint_as_float(rr[1])); }
  const float tmax = lane_off ? NEGB : fmaf(pmax, C, cfar);
  float mn;
  if (__builtin_expect(__all(tmax - m_reg <= THR2), 1)) { mn = m_reg; alpha = 1.f; }
  else { mn = fmaxf(m_reg, tmax); alpha = __builtin_amdgcn_exp2f(m_reg - mn); m_reg = mn; }
  const float off = lane_off ? NEGB : cfar - mn;
#pragma unroll
  for (int r = 0; r < 16; ++r) { p0[r] = __builtin_amdgcn_exp2f(fmaf(p0[r], C, off)); p1[r] = fmaf(p1[r], C, off); }
}
__device__ __forceinline__ void finishSM(f32x16& p0, f32x16& p1, float alpha, float& l_reg, bf16x8& pa0, bf16x8& pa1, bf16x8& pa2, bf16x8& pa3) {
#pragma unroll
  for (int r = 0; r < 16; ++r) p1[r] = __builtin_amdgcn_exp2f(p1[r]);
  float ps = 0;
#pragma unroll
  for (int r = 0; r < 16; ++r) ps += p0[r];
#pragma unroll
  for (int r = 0; r < 16; ++r) ps += p1[r];
  { auto rr = __builtin_amdgcn_permlane32_swap(__float_as_uint(ps), __float_as_uint(ps), false, false);
    ps = __uint_as_float(rr[0]) + __uint_as_float(rr[1]); }
  l_reg = l_reg * alpha + ps;
#define PK4(P, BASE, OUT) do { unsigned a0 = cvtpk(P[BASE + 0], P[BASE + 1]), a1 = cvtpk(P[BASE + 2], P[BASE + 3]);   \
    unsigned b0 = cvtpk(P[BASE + 4], P[BASE + 5]), b1 = cvtpk(P[BASE + 6], P[BASE + 7]);                              \
    auto r0 = __builtin_amdgcn_permlane32_swap(a0, b0, false, false); auto r1 = __builtin_amdgcn_permlane32_swap(a1, b1, false, false); \
    u32x4 w = {r0[0], r1[0], r0[1], r1[1]}; OUT = *reinterpret_cast<bf16x8*>(&w); } while (0)
  PK4(p0, 0, pa0); PK4(p0, 8, pa1); PK4(p1, 0, pa2); PK4(p1, 8, pa3);
#undef PK4
}
template <int DQK>
__device__ __forceinline__ void qkt(f32x16& p0, f32x16& p1, const char* Ks, const bf16x8* qr, int r32, int hi) {
  p0 = f32x16{}; p1 = f32x16{};
  bf16x8 fa[8], fb[8];
#define QLD(S, F) do { _Pragma("unroll") for (int i_ = 0; i_ < 4; ++i_) { const int cb_ = (((S) * 4 + i_) * 16 + hi * 8) * 2; F[2 * i_] = *reinterpret_cast<const bf16x8*>(Ks + kswz<DQK>(r32, cb_)); F[2 * i_ + 1] = *reinterpret_cast<const bf16x8*>(Ks + kswz<DQK>(32 + r32, cb_)); } } while (0)
#define QMM(S, F) do { _Pragma("unroll") for (int i_ = 0; i_ < 4; ++i_) { p0 = __builtin_amdgcn_mfma_f32_32x32x16_bf16(F[2 * i_], qr[(S) * 4 + i_], p0, 0, 0, 0); p1 = __builtin_amdgcn_mfma_f32_32x32x16_bf16(F[2 * i_ + 1], qr[(S) * 4 + i_], p1, 0, 0, 0); } } while (0)
  static_assert(DQK == 128 || DQK == 64, "qkt");
  QLD(0, fa);
  if (DQK == 128) { QLD(1, fb); SBAR(); QMM(0, fa); SBAR(); QMM(1, fb); }
  else { SBAR(); QMM(0, fa); }
#undef QMM
#undef QLD
}
__device__ __forceinline__ int v_st(int k, int c) { const int kk = (k & ~0xC) | ((k & 4) << 1) | ((k & 8) >> 1); return ((kk >> 3) * 4 + (c >> 5)) * 512 + ((kk & 7) * 32 + (c & 31)) * 2; }
__device__ __forceinline__ int v_rd_base(int lane) { return ((lane & 3) << 3) | (((lane >> 2) & 3) << 6) | (((lane >> 4) & 1) << 5) | (((lane >> 5) & 1) << 8); }
constexpr int v_rd_off(int d0, int ks, int half) { return d0 * 512 + ks * 4096 + half * 2048; }
template <int OFF> __device__ __forceinline__ s16x4 tr_read(int vb) {
  s16x4 r; asm volatile("ds_read_b64_tr_b16 %0, %1 offset:%2" : "=&v"(r) : "v"(vb), "i"(OFF) : "memory"); return r;
}
template <int D0> __device__ __forceinline__ void pv_one(f32x16& od, int vb, bf16x8 pa0, bf16x8 pa1, bf16x8 pa2, bf16x8 pa3) {
  const s16x4 l0 = tr_read<v_rd_off(D0, 0, 0)>(vb), h0 = tr_read<v_rd_off(D0, 0, 1)>(vb), l1 = tr_read<v_rd_off(D0, 1, 0)>(vb), h1 = tr_read<v_rd_off(D0, 1, 1)>(vb);
  const s16x4 l2 = tr_read<v_rd_off(D0, 2, 0)>(vb), h2 = tr_read<v_rd_off(D0, 2, 1)>(vb), l3 = tr_read<v_rd_off(D0, 3, 0)>(vb), h3 = tr_read<v_rd_off(D0, 3, 1)>(vb);
  asm volatile("s_waitcnt lgkmcnt(0)" ::: "memory"); SBAR();
#if ATT_PRIO
  __builtin_amdgcn_s_setprio(ATT_PRIO);
#endif
#define PK(L, H) (bf16x8){L[0], L[1], L[2], L[3], H[0], H[1], H[2], H[3]}
  od = __builtin_amdgcn_mfma_f32_32x32x16_bf16(pa0, PK(l0, h0), od, 0, 0, 0);
  od = __builtin_amdgcn_mfma_f32_32x32x16_bf16(pa1, PK(l1, h1), od, 0, 0, 0);
  od = __builtin_amdgcn_mfma_f32_32x32x16_bf16(pa2, PK(l2, h2), od, 0, 0, 0);
  od = __builtin_amdgcn_mfma_f32_32x32x16_bf16(pa3, PK(l3, h3), od, 0, 0, 0);
#if ATT_PRIO
  __builtin_amdgcn_s_setprio(0);
#endif
#undef PK
}
__device__ __forceinline__ void pv_d0(f32x16* o, int vb, bf16x8 pa0, bf16x8 pa1, bf16x8 pa2, bf16x8 pa3) {
  pv_one<0>(o[0], vb, pa0, pa1, pa2, pa3); pv_one<1>(o[1], vb, pa0, pa1, pa2, pa3); pv_one<2>(o[2], vb, pa0, pa1, pa2, pa3); pv_one<3>(o[3], vb, pa0, pa1, pa2, pa3);
}

__device__ __forceinline__ void pv_all1(f32x16* o, int vb, bf16x8 pa0, bf16x8 pa1, bf16x8 pa2, bf16x8 pa3) {
  s16x4 va[8], vc[8];
#define TR8(D0, L) do { L[0] = tr_read<v_rd_off(D0, 0, 0)>(vb); L[1] = tr_read<v_rd_off(D0, 0, 1)>(vb); L[2] = tr_read<v_rd_off(D0, 1, 0)>(vb); L[3] = tr_read<v_rd_off(D0, 1, 1)>(vb); \
    L[4] = tr_read<v_rd_off(D0, 2, 0)>(vb); L[5] = tr_read<v_rd_off(D0, 2, 1)>(vb); L[6] = tr_read<v_rd_off(D0, 3, 0)>(vb); L[7] = tr_read<v_rd_off(D0, 3, 1)>(vb); } while (0)
#define PK(L, H) (bf16x8){L[0], L[1], L[2], L[3], H[0], H[1], H[2], H[3]}
#define MM4(OA, L) do { OA = __builtin_amdgcn_mfma_f32_32x32x16_bf16(pa0, PK(L[0], L[1]), OA, 0, 0, 0); OA = __builtin_amdgcn_mfma_f32_32x32x16_bf16(pa1, PK(L[2], L[3]), OA, 0, 0, 0); \
    OA = __builtin_amdgcn_mfma_f32_32x32x16_bf16(pa2, PK(L[4], L[5]), OA, 0, 0, 0); OA = __builtin_amdgcn_mfma_f32_32x32x16_bf16(pa3, PK(L[6], L[7]), OA, 0, 0, 0); } while (0)
  TR8(0, va); TR8(1, vc); asm volatile("s_waitcnt lgkmcnt(8)" ::: "memory"); SBAR(); MM4(o[0], va); SBAR();
  TR8(2, va); asm volatile("s_waitcnt lgkmcnt(8)" ::: "memory"); SBAR(); MM4(o[1], vc); SBAR();
  TR8(3, vc); asm volatile("s_waitcnt lgkmcnt(8)" ::: "memory"); SBAR(); MM4(o[2], va); SBAR();
  asm volatile("s_waitcnt lgkmcnt(0)" ::: "memory"); SBAR(); MM4(o[3], vc);
#undef MM4
#undef PK
#undef TR8
}

template <int MODE>
__device__ __forceinline__ float far_head(const f32x16& p0, const f32x16& p1, int kt, float C, float cfar, unsigned sel, int jblk, float& m_reg, float& alpha) {
  bool lane_off = false;
  if (MODE == 1) { const int blk = kt >> 8; if (blk < jblk) lane_off = !((sel >> blk) & 1u); }
  float pmax = p0[0];
#pragma unroll
  for (int r = 1; r < 16; ++r) pmax = fmaxf(pmax, p0[r]);
#pragma unroll
  for (int r = 0; r < 16; ++r) pmax = fmaxf(pmax, p1[r]);
  { auto rr = __builtin_amdgcn_permlane32_swap(__float_as_uint(pmax), __float_as_uint(pmax), false, false);
    pmax = fmaxf(__uint_as_float(rr[0]), __uint_as_float(rr[1])); }
  const float tmax = lane_off ? NEGB : fmaf(pmax, C, cfar);
  float mn;
  if (__builtin_expect(__all(tmax - m_reg <= THR2), 1)) { mn = m_reg; alpha = 1.f; }
  else { mn = fmaxf(m_reg, tmax); alpha = __builtin_amdgcn_exp2f(m_reg - mn); m_reg = mn; }
  return lane_off ? NEGB : cfar - mn;
}
__device__ __forceinline__ float near_head(const f32x16& p0, const f32x16& p1, float& m_reg, float& alpha) {
  float pmax = p0[0];
#pragma unroll
  for (int r = 1; r < 16; ++r) pmax = fmaxf(pmax, p0[r]);
#pragma unroll
  for (int r = 0; r < 16; ++r) pmax = fmaxf(pmax, p1[r]);
  { auto rr = __builtin_amdgcn_permlane32_swap(__float_as_uint(pmax), __float_as_uint(pmax), false, false);
    pmax = fmaxf(__uint_as_float(rr[0]), __uint_as_float(rr[1])); }
  float mn;
  if (__builtin_expect(__all(pmax - m_reg <= THR2), 1)) { mn = m_reg; alpha = 1.f; }
  else { mn = fmaxf(m_reg, pmax); alpha = __builtin_amdgcn_exp2f(m_reg - mn); m_reg = mn; }
  return -mn;
}
__device__ __forceinline__ void far_tail(f32x16* o, int vb, f32x16& p0, f32x16& p1, float C, float off, float alpha, float& l_reg) {
  s16x4 va[8], vc[8]; float ps = 0.f; bf16x8 pa, pn;
#define TRK(KS, L) do { L[0] = tr_read<v_rd_off(0, KS, 0)>(vb); L[1] = tr_read<v_rd_off(0, KS, 1)>(vb); L[2] = tr_read<v_rd_off(1, KS, 0)>(vb); L[3] = tr_read<v_rd_off(1, KS, 1)>(vb); \
    L[4] = tr_read<v_rd_off(2, KS, 0)>(vb); L[5] = tr_read<v_rd_off(2, KS, 1)>(vb); L[6] = tr_read<v_rd_off(3, KS, 0)>(vb); L[7] = tr_read<v_rd_off(3, KS, 1)>(vb); } while (0)
#define PK(L, H) (bf16x8){L[0], L[1], L[2], L[3], H[0], H[1], H[2], H[3]}
#define EX2(P, I) do { P[I] = __builtin_amdgcn_exp2f(fmaf(P[I], C, off)); P[(I) + 1] = __builtin_amdgcn_exp2f(fmaf(P[(I) + 1], C, off)); } while (0)
#define PK4(P, BASE, OUT) do { unsigned a0 = cvtpk(P[BASE + 0], P[BASE + 1]), a1 = cvtpk(P[BASE + 2], P[BASE + 3]);   \
    unsigned c0 = cvtpk(P[BASE + 4], P[BASE + 5]), c1 = cvtpk(P[BASE + 6], P[BASE + 7]);                              \
    auto r0 = __builtin_amdgcn_permlane32_swap(a0, c0, false, false); auto r1 = __builtin_amdgcn_permlane32_swap(a1, c1, false, false); \
    u32x4 w = {r0[0], r1[0], r0[1], r1[1]}; OUT = *reinterpret_cast<bf16x8*>(&w); } while (0)
#define GRP(PA, L, P, BASE, PN, SUMP, SB) do { \
    o[0] = __builtin_amdgcn_mfma_f32_32x32x16_bf16(PA, PK(L[0], L[1]), o[0], 0, 0, 0); SBAR(); EX2(P, BASE); ps += SUMP[SB]; ps += SUMP[SB + 1]; SBAR(); \
    o[1] = __builtin_amdgcn_mfma_f32_32x32x16_bf16(PA, PK(L[2], L[3]), o[1], 0, 0, 0); SBAR(); EX2(P, BASE + 2); ps += SUMP[SB + 2]; ps += SUMP[SB + 3]; SBAR(); \
    o[2] = __builtin_amdgcn_mfma_f32_32x32x16_bf16(PA, PK(L[4], L[5]), o[2], 0, 0, 0); SBAR(); EX2(P, BASE + 4); ps += SUMP[SB + 4]; ps += SUMP[SB + 5]; SBAR(); \
    o[3] = __builtin_amdgcn_mfma_f32_32x32x16_bf16(PA, PK(L[6], L[7]), o[3], 0, 0, 0); SBAR(); EX2(P, BASE + 6); ps += SUMP[SB + 6]; ps += SUMP[SB + 7]; PK4(P, BASE, PN); SBAR(); } while (0)
  TRK(0, va); TRK(1, vc);
  EX2(p0, 0); EX2(p0, 2); EX2(p0, 4); EX2(p0, 6); PK4(p0, 0, pa);
  asm volatile("s_waitcnt lgkmcnt(8)" ::: "memory"); SBAR();
  GRP(pa, va, p0, 8, pn, p0, 0);
  TRK(2, va); asm volatile("s_waitcnt lgkmcnt(8)" ::: "memory"); SBAR();
  GRP(pn, vc, p1, 0, pa, p0, 8);
  TRK(3, vc); asm volatile("s_waitcnt lgkmcnt(8)" ::: "memory"); SBAR();
  GRP(pa, va, p1, 8, pn, p1, 0);
  asm volatile("s_waitcnt lgkmcnt(0)" ::: "memory"); SBAR();
  o[0] = __builtin_amdgcn_mfma_f32_32x32x16_bf16(pn, PK(vc[0], vc[1]), o[0], 0, 0, 0); SBAR(); ps += p1[8]; ps += p1[9]; ps += p1[10]; ps += p1[11]; SBAR();
  o[1] = __builtin_amdgcn_mfma_f32_32x32x16_bf16(pn, PK(vc[2], vc[3]), o[1], 0, 0, 0); SBAR(); ps += p1[12]; ps += p1[13]; ps += p1[14]; ps += p1[15]; SBAR();
  o[2] = __builtin_amdgcn_mfma_f32_32x32x16_bf16(pn, PK(vc[4], vc[5]), o[2], 0, 0, 0); SBAR();
  { auto rr = __builtin_amdgcn_permlane32_swap(__float_as_uint(ps), __float_as_uint(ps), false, false); ps = __uint_as_float(rr[0]) + __uint_as_float(rr[1]); }
  l_reg = l_reg * alpha + ps; SBAR();
  o[3] = __builtin_amdgcn_mfma_f32_32x32x16_bf16(pn, PK(vc[6], vc[7]), o[3], 0, 0, 0);
#undef GRP
#undef PK4
#undef EX2
#undef PK
#undef TRK
}

struct AttnArgs { int layer; float lambda_init; };
constexpr size_t ATT_WS_PROJ = (size_t)434 << 20, ATT_WS_YCAT = (size_t)754 << 20, ATT_WS_KMEAN = (size_t)1 << 20;
#define A_proj ((const unsigned short*)(wsptr() + ATT_WS_PROJ))
#define A_ycat ((unsigned short*)(wsptr() + ATT_WS_YCAT))
#define A_kmean ((const float*)(wsptr() + ATT_WS_KMEAN))
#define A_kpart ((const float*)(wsptr() + ATT_WS_KP))
constexpr size_t ATT_WS_KP = (size_t)882 << 20; constexpr int ATT_KP_N = 8 * 4 * 16 * 128;
#define A_rel_bias (inptr(2))
#define A_sinks (inptr(6) + A.layer * 6)
#define A_lq1 (inptr(7) + A.layer * 64)
#define A_lk1 (inptr(8) + A.layer * 64)
#define A_lq2 (inptr(9) + A.layer * 64)
#define A_lk2 (inptr(10) + A.layer * 64)
#define A_subln (inptr(11) + A.layer * 128)
__device__ const unsigned char REL_BUCKET_TAB[128] = {
  0, 1, 2, 3, 4, 5, 6, 7, 8, 9, 10, 11, 12, 13, 14, 15, 16, 16, 16, 17, 17, 18, 18, 18, 19, 19, 19, 20, 20, 20, 20, 21, 21, 21, 21, 22, 22, 22, 22, 22, 23, 23, 23, 23, 23, 23, 24, 24, 24, 24, 24, 24,
  25, 25, 25, 25, 25, 25, 25, 26, 26, 26, 26, 26, 26, 26, 26, 27, 27, 27, 27, 27, 27, 27, 27, 27, 27, 28, 28, 28, 28, 28, 28, 28, 28, 28, 28, 29, 29, 29, 29, 29, 29, 29, 29, 29, 29, 29, 29,
  30, 30, 30, 30, 30, 30, 30, 30, 30, 30, 30, 30, 30, 30, 31, 31, 31, 31, 31, 31, 31, 31, 31, 31, 31, 31, 31, 31, 31};

template <int MODE>
__device__ __forceinline__ void attn_pass(const AttnArgs& A, int b, int hh, int qb, int pass, float lam, char* lds, int tid) {
  constexpr int DQK = (MODE == 2) ? 64 : 128;
  constexpr int NPASS = (MODE == 2) ? 2 : 1;
  constexpr int SDEPTH = (MODE == 2) ? ATT_SDEPTH_DIFF : ATT_SDEPTH;
  constexpr int QCOL = (MODE == 0) ? 0 : (MODE == 1) ? 1280 : 2816;
  constexpr int KCOL = (MODE == 0) ? 768 : (MODE == 1) ? 1792 : 3584;
  constexpr int VCOL = (MODE == 0) ? 1024 : (MODE == 1) ? 2304 : 4352;
  constexpr int OCOL = (MODE == 0) ? 0 : (MODE == 1) ? 768 : 1280;
  const float C = ((MODE == 2) ? 0.125f : 0.088388347648318440f) * LOG2E;
  const int lane = tid & 63, r32 = lane & 31, hi = lane >> 5; const int wid = __builtin_amdgcn_readfirstlane(tid >> 6);
  const int kvh = (MODE == 0) ? hh / 3 : hh;
  char* V_lds = lds + OFF_V; char* K_lds = lds + OFF_K;
  float* wsl = (float*)(lds + OFF_WS) + wid * 64; float* li_l = wsl; float* al_l = wsl + 32;
  const float* lut = (const float*)(lds + OFF_LUT);
  char* stg = lds + OFF_STG + wid * STG_WAVE;
  const int q0 = qb * 256;
  const int qpos = q0 + wid * QBLK + r32, wave_qmin = q0 + wid * QBLK;
  const long rowb = (long)b * SEQL;
  const float cfar = lut[127];
  const int t0 = (MODE == 0) ? (qb == 0 ? 0 : 4 * qb - 2) : 0;
  const int NT = 4 * qb + 4 - t0;
  const int sr = tid >> 4, sc = (tid & 15) * 8, vst0 = v_st(sr, sc), vst1 = v_st(32 + sr, sc);
  const int vb0 = (int)(uintptr_t)V_lds + v_rd_base(lane);
  const unsigned short* Vh = A_proj + rowb * LDP + VCOL + kvh * 128;
  {

    const unsigned short* Qw = A_proj + (rowb + q0 + wid * QBLK + r32) * LDP + QCOL + hh * 128 + pass * 64 + hi * 8;
    const unsigned short* Kh = A_proj + rowb * LDP + KCOL + kvh * 128 + pass * 64;
    bf16x8 qr[DQK / 16];
#pragma unroll
    for (int d0 = 0; d0 < DQK / 16; ++d0) qr[d0] = *reinterpret_cast<const bf16x8*>(Qw + d0 * 16);
    unsigned sel = 0u;
    if (MODE == 1) {
      const int jb = qb;
      if (jb <= 3) sel = (1u << jb) - 1u;
      else {
        float g[15];
#pragma unroll
        for (int n = 0; n < 15; ++n) { g[n] = -INFINITY;
          if (n < jb) { const float* km = (const float*)(lds + OFF_STG) + n * 128 + hi * 8; float s = 0.f;
#pragma unroll
            for (int d0 = 0; d0 < 8; ++d0) { const f32x4 k0 = *(const f32x4*)(km + d0 * 16), k1 = *(const f32x4*)(km + d0 * 16 + 4);
              s += bf2f(qr[d0 % (DQK / 16)][0]) * k0[0] + bf2f(qr[d0 % (DQK / 16)][1]) * k0[1] + bf2f(qr[d0 % (DQK / 16)][2]) * k0[2] + bf2f(qr[d0 % (DQK / 16)][3]) * k0[3]
                 + bf2f(qr[d0 % (DQK / 16)][4]) * k1[0] + bf2f(qr[d0 % (DQK / 16)][5]) * k1[1] + bf2f(qr[d0 % (DQK / 16)][6]) * k1[2] + bf2f(qr[d0 % (DQK / 16)][7]) * k1[3]; }
            auto rr = __builtin_amdgcn_permlane32_swap(__float_as_uint(s), __float_as_uint(s), false, false);
            g[n] = __uint_as_float(rr[0]) + __uint_as_float(rr[1]); } }
#pragma unroll
        for (int pick = 0; pick < 3; ++pick) { float best = -INFINITY; int bi = 0;
#pragma unroll
          for (int n = 0; n < 15; ++n) { const bool take = (n < jb) && !((sel >> n) & 1u) && (g[n] > best); best = take ? g[n] : best; bi = take ? n : bi; }
          sel |= 1u << bi; }
      }
    }
    int NTm = NT;
    if (MODE == 1) {
      unsigned* mw = (unsigned*)(lds + OFF_MISC);
      if (qb > 3) { unsigned um = 0u;
#pragma unroll
        for (int n = 0; n < 15; ++n) if (__any((int)((sel >> n) & 1u))) um |= 1u << n;
        if (lane == 0) atomicOr(&mw[4], um); }
      __syncthreads();
      unsigned U = (qb <= 3) ? ((1u << qb) - 1u) : mw[4]; U |= 1u << qb;
      if (tid < 17) { unsigned rem = U; int bit = 0;
        for (int k = 0; k < tid; ++k) rem &= rem - 1u;
        bit = rem ? __builtin_ctz(rem) : 0; mw[8 + tid] = (unsigned)bit; }
      __syncthreads();
      NTm = 4 * __builtin_popcount(U);
    }
    const int NTT = __builtin_amdgcn_readfirstlane(NTm);
    float m_reg = NEGB, l_reg = 0.f;
    if (MODE == 0) { m_reg = A_sinks[hh] * LOG2E; l_reg = 1.f; }
    f32x16 o[4] = {};
#define KT(i) ((MODE == 1) ? (int)(__builtin_amdgcn_readfirstlane(((const unsigned*)(lds + OFF_MISC))[8 + ((i) >> 2)]) * 256u) + ((i) & 3) * KVBLK : (t0 + (i)) * KVBLK)
#define SLOAD(i, k0) do { sr_[i].vs0 = *reinterpret_cast<const bf16x8*>(&Vh[(long)((k0) + sr) * LDP + sc]); sr_[i].vs1 = *reinterpret_cast<const bf16x8*>(&Vh[(long)((k0) + 32 + sr) * LDP + sc]); \
    if (DQK == 128) { sr_[i].ks0 = *reinterpret_cast<const bf16x8*>(&Kh[(long)((k0) + sr) * LDP + sc]); sr_[i].ks1 = *reinterpret_cast<const bf16x8*>(&Kh[(long)((k0) + 32 + sr) * LDP + sc]); } \
    else { sr_[i].ks0 = *reinterpret_cast<const bf16x8*>(&Kh[(long)((k0) + (tid >> 3)) * LDP + (tid & 7) * 8]); } } while (0)
#define SWRITE(bb, i) do { *(bf16x8*)(V_lds + (bb) * SHM_V + vst0) = sr_[i].vs0; *(bf16x8*)(V_lds + (bb) * SHM_V + vst1) = sr_[i].vs1; \
    if (DQK == 128) { *(bf16x8*)(K_lds + (bb) * SHM_K + kswz<DQK>(sr, sc * 2)) = sr_[i].ks0; *(bf16x8*)(K_lds + (bb) * SHM_K + kswz<DQK>(32 + sr, sc * 2)) = sr_[i].ks1; } \
    else { *(bf16x8*)(K_lds + (bb) * SHM_K + kswz<DQK>(tid >> 3, (tid & 7) * 16)) = sr_[i].ks0; } } while (0)
#define SWAIT() do { if (SDEPTH == 1) asm volatile("s_waitcnt vmcnt(0)" ::: "memory"); else if (DQK == 128) asm volatile("s_waitcnt vmcnt(4)" ::: "memory"); else asm volatile("s_waitcnt vmcnt(3)" ::: "memory"); } while (0)
#define RESC(a) do { if (__any((a) < 1.f)) { if (hi == 0) al_l[r32] = (a); asm volatile("s_waitcnt lgkmcnt(0)" ::: "memory"); \
    _Pragma("unroll") for (int d = 0; d < 4; ++d) _Pragma("unroll") for (int r = 0; r < 16; ++r) o[d][r] *= al_l[crow(r, hi)]; } } while (0)
#define TSM(P0, P1, ti, AL) tile_sm<MODE>(P0, P1, KT(ti), qpos, wave_qmin, hi, C, lut, cfar, sel, qb, m_reg, AL)
    typedef __attribute__((address_space(3))) unsigned las_u32;
#define MLOAD2(k0, bb) do { const char* kg_ = (const char*)(Kh + (long)(k0) * LDP); const char* vg_ = (const char*)(Vh + (long)(k0) * LDP); \
    int ll_ = lane; asm volatile("" : "+v"(ll_));                 \
    _Pragma("unroll") for (int i_ = 0; i_ < 2; ++i_) { const int q_ = (i_ * 8 + wid) * 64 + ll_; \
      const int row_ = q_ >> 4, pos_ = q_ & 15; const unsigned koff_ = (unsigned)((row_ * LDP + ((pos_ ^ (row_ & 7)) << 3)) * 2); \
      const int st_ = q_ >> 5, kk_ = ((st_ >> 2) << 3) | ((q_ >> 2) & 7), c_ = ((st_ & 3) << 5) | ((q_ & 3) << 3), k_ = (kk_ & ~0xC) | ((kk_ & 4) << 1) | ((kk_ & 8) >> 1); const unsigned voff_ = (unsigned)((k_ * LDP + c_) * 2); \
      __builtin_amdgcn_global_load_lds((const unsigned*)(kg_ + koff_), (las_u32*)(K_lds + (bb) * SHM_K + (i_ * 8 + wid) * 1024), 16, 0, 0); \
      __builtin_amdgcn_global_load_lds((const unsigned*)(vg_ + voff_), (las_u32*)(V_lds + (bb) * SHM_V + (i_ * 8 + wid) * 1024), 16, 0, 0); } } while (0)
    __syncthreads();
    MLOAD2(KT(0), 0); asm volatile("s_waitcnt vmcnt(0)" ::: "memory"); __syncthreads();
#pragma unroll 1
    for (int j = 0; j < NTT; ++j) {
      const int bb = j & 1; const int kt = KT(j);
      if (j + 1 < NTT) MLOAD2(KT(j + 1), bb ^ 1);
      if (kt <= wave_qmin + QBLK - 1) {
        f32x16 p0, p1; float al;
        qkt<DQK>(p0, p1, K_lds + bb * SHM_K, qr, r32, hi);
        float Ce, off;
        if (kt + 63 + 128 > wave_qmin) { bias_mask<MODE>(p0, p1, kt, qpos, wave_qmin, hi, C, (const float*)((const char*)lut + (OFF_LUT4 - OFF_LUT)), cfar, sel, qb); off = near_head(p0, p1, m_reg, al); Ce = 1.f; }
        else { off = far_head<MODE>(p0, p1, kt, C, cfar, sel, qb, m_reg, al); Ce = C; }
        RESC(al);
        SBAR();
        far_tail(o, vb0 + bb * SHM_V, p0, p1, Ce, off, al, l_reg);
      }
      asm volatile("s_waitcnt vmcnt(0)" ::: "memory");
      __syncthreads();
    }
#undef MLOAD2
#undef KT
#undef SLOAD
#undef SWRITE
#undef SWAIT
#undef RESC
#undef TSM
    int r32e = r32, hie = hi; asm volatile("" : "+v"(r32e), "+v"(hie));
    if (hi == 0) li_l[r32] = l_reg; asm volatile("s_waitcnt lgkmcnt(0)" ::: "memory");
#pragma unroll
    for (int r = 0; r < 16; ++r) { const int orow = crow(r, hie); const float rli = __builtin_amdgcn_rcpf(li_l[orow]);
#pragma unroll
      for (int d0 = 0; d0 < 4; ++d0) { unsigned short* sp = (unsigned short*)(stg + orow * STG_PITCH) + d0 * 32 + r32e; float v = o[d0][r] * rli;
        if (MODE == 2 && pass == 1) v = __uint_as_float(((unsigned)*sp) << 16) - lam * v;
        *sp = (unsigned short)(cvtpk(v, v) & 0xffffu); } }
    asm volatile("s_waitcnt lgkmcnt(0)" ::: "memory");
    if (pass == NPASS - 1) {
      const char* rp = stg + r32e * STG_PITCH + hie * 128;
      u32x4 w[8];
#pragma unroll
      for (int i = 0; i < 8; ++i) w[i] = *(const u32x4*)(rp + i * 16);
      if (MODE == 2) {
        float ss = 0.f;
#pragma unroll
        for (int i = 0; i < 8; ++i)
#pragma unroll
          for (int k = 0; k < 4; ++k) { const float lo = __uint_as_float(w[i][k] << 16), hi_ = __uint_as_float(w[i][k] & 0xffff0000u); ss += lo * lo + hi_ * hi_; }
        { auto rr = __builtin_amdgcn_permlane32_swap(__float_as_uint(ss), __float_as_uint(ss), false, false); ss = __uint_as_float(rr[0]) + __uint_as_float(rr[1]); }
        const float sc2 = rsqrtf(ss * (1.0f / 128.0f) + 1e-6f) * (1.0f - A.lambda_init);
        const float* gp = A_subln + hie * 64;
#pragma unroll
        for (int i = 0; i < 8; ++i)
#pragma unroll
          for (int k = 0; k < 4; ++k) { const float lo = __uint_as_float(w[i][k] << 16) * sc2 * gp[i * 8 + 2 * k], hi_ = __uint_as_float(w[i][k] & 0xffff0000u) * sc2 * gp[i * 8 + 2 * k + 1]; w[i][k] = cvtpk(lo, hi_); }
      }
      unsigned short* op = A_ycat + (rowb + q0 + wid * QBLK + r32e) * LDY + OCOL + hh * 128 + hie * 64;
#pragma unroll
      for (int i = 0; i < 8; ++i) *(u32x4*)(op + i * 8) = w[i];
    }
  }
}
template <int MODE> __device__ __forceinline__ void unit_luts(char* lds, int hh, int tid) {
  float* lut = (float*)(lds + OFF_LUT); const float* lh = (const float*)(lds + OFF_LUTH) + hh * 128;
  if (tid < 128) lut[tid] = lh[tid];
  float* l4 = (float*)(lds + OFF_LUT4);
#pragma unroll 1
  for (int i = tid; i < LUT4_COPIES * LUT4_N; i += 512) { const int c = i / LUT4_N, j = i % LUT4_N, d = 256 + c - j;
    l4[i] = (c == 4 || d < 0 || (MODE == 0 && d >= 128)) ? NEGB : lh[d < 127 ? d : 127]; }
}
__device__ __forceinline__ void pv_sm_split(f32x16* o, int vb, bf16x8 pa0, bf16x8 pa1, bf16x8 pa2, bf16x8 pa3,
                                            f32x16& p0, f32x16& p1, float alpha, float& l_reg, bf16x8& pb0, bf16x8& pb1, bf16x8& pb2, bf16x8& pb3) {
  s16x4 va[8], vc[8]; float ps = 0.f;
#define TR8(D0, L) do { L[0] = tr_read<v_rd_off(D0, 0, 0)>(vb); L[1] = tr_read<v_rd_off(D0, 0, 1)>(vb); L[2] = tr_read<v_rd_off(D0, 1, 0)>(vb); L[3] = tr_read<v_rd_off(D0, 1, 1)>(vb); \
    L[4] = tr_read<v_rd_off(D0, 2, 0)>(vb); L[5] = tr_read<v_rd_off(D0, 2, 1)>(vb); L[6] = tr_read<v_rd_off(D0, 3, 0)>(vb); L[7] = tr_read<v_rd_off(D0, 3, 1)>(vb); } while (0)
#define PK(L, H) (bf16x8){L[0], L[1], L[2], L[3], H[0], H[1], H[2], H[3]}
#define MF(OA, PA, L, K) do { OA = __builtin_amdgcn_mfma_f32_32x32x16_bf16(PA, PK(L[2 * (K)], L[2 * (K) + 1]), OA, 0, 0, 0); SBAR(); } while (0)
#define FE(K) do { p1[2 * (K)] = __builtin_amdgcn_exp2f(p1[2 * (K)]); p1[2 * (K) + 1] = __builtin_amdgcn_exp2f(p1[2 * (K) + 1]); ps += p0[2 * (K)]; ps += p0[2 * (K) + 1]; SBAR(); } while (0)
#define FS(K) do { ps += p1[4 * (K)]; ps += p1[4 * (K) + 1]; ps += p1[4 * (K) + 2]; ps += p1[4 * (K) + 3]; SBAR(); } while (0)
#define PK4(P, BASE, OUT) do { unsigned a0 = cvtpk(P[BASE + 0], P[BASE + 1]), a1 = cvtpk(P[BASE + 2], P[BASE + 3]);   \
    unsigned b0 = cvtpk(P[BASE + 4], P[BASE + 5]), b1 = cvtpk(P[BASE + 6], P[BASE + 7]);                              \
    auto r0 = __builtin_amdgcn_permlane32_swap(a0, b0, false, false); auto r1 = __builtin_amdgcn_permlane32_swap(a1, b1, false, false); \
    u32x4 w = {r0[0], r1[0], r0[1], r1[1]}; OUT = *reinterpret_cast<bf16x8*>(&w); SBAR(); } while (0)
  TR8(0, va); TR8(1, vc); asm volatile("s_waitcnt lgkmcnt(8)" ::: "memory"); SBAR();
  MF(o[0], pa0, va, 0); FE(0); MF(o[0], pa1, va, 1); FE(1); MF(o[0], pa2, va, 2); FE(2); MF(o[0], pa3, va, 3); FE(3);
  TR8(2, va); asm volatile("s_waitcnt lgkmcnt(8)" ::: "memory"); SBAR();
  MF(o[1], pa0, vc, 0); FE(4); MF(o[1], pa1, vc, 1); FE(5); MF(o[1], pa2, vc, 2); FE(6); MF(o[1], pa3, vc, 3); FE(7);
  TR8(3, vc); asm volatile("s_waitcnt lgkmcnt(8)" ::: "memory"); SBAR();
  MF(o[2], pa0, va, 0); FS(0); MF(o[2], pa1, va, 1); FS(1); MF(o[2], pa2, va, 2); FS(2); MF(o[2], pa3, va, 3); FS(3);
  { auto rr = __builtin_amdgcn_permlane32_swap(__float_as_uint(ps), __float_as_uint(ps), false, false); ps = __uint_as_float(rr[0]) + __uint_as_float(rr[1]); }
  l_reg = l_reg * alpha + ps;
  asm volatile("s_waitcnt lgkmcnt(0)" ::: "memory"); SBAR();
  MF(o[3], pa0, vc, 0); PK4(p0, 0, pb0); MF(o[3], pa1, vc, 1); PK4(p0, 8, pb1); MF(o[3], pa2, vc, 2); PK4(p1, 0, pb2); MF(o[3], pa3, vc, 3); PK4(p1, 8, pb3);
#undef PK4
#undef FS
#undef FE
#undef MF
#undef PK
#undef TR8
}
__device__ __forceinline__ void qkt_half_sm_split(f32x16& q0, f32x16& q1, const char* Ks, const char* Qs, int r32, int hi,
                                                  f32x16& p0, f32x16& p1, float alpha, float& l_reg, bf16x8& pa0, bf16x8& pa1, bf16x8& pa2, bf16x8& pa3) {
  asm volatile("" : "+v"(r32));
  q0 = f32x16{}; q1 = f32x16{};
  float ps = 0.f;
  bf16x8 qfA, b0A, b1A, qfB, b0B, b1B;
#define LDF(D0, QF, B0, B1) do { const int cb_ = (64 + (D0) * 16 + hi * 8) * 2; QF = *reinterpret_cast<const bf16x8*>(Qs + kswz<128>(r32, cb_)); \
    B0 = *reinterpret_cast<const bf16x8*>(Ks + kswz<128>(r32, cb_)); B1 = *reinterpret_cast<const bf16x8*>(Ks + kswz<128>(32 + r32, cb_)); } while (0)
  LDF(0, qfA, b0A, b1A); LDF(1, qfB, b0B, b1B);
  SBAR();
#define FE4(K) do { p1[4 * (K)] = __builtin_amdgcn_exp2f(p1[4 * (K)]); p1[4 * (K) + 1] = __builtin_amdgcn_exp2f(p1[4 * (K) + 1]); p1[4 * (K) + 2] = __builtin_amdgcn_exp2f(p1[4 * (K) + 2]); p1[4 * (K) + 3] = __builtin_amdgcn_exp2f(p1[4 * (K) + 3]); \
    ps += p0[4 * (K)]; ps += p0[4 * (K) + 1]; ps += p0[4 * (K) + 2]; ps += p0[4 * (K) + 3]; SBAR(); } while (0)
#define FS8(K) do { ps += p1[8 * (K)]; ps += p1[8 * (K) + 1]; ps += p1[8 * (K) + 2]; ps += p1[8 * (K) + 3]; ps += p1[8 * (K) + 4]; ps += p1[8 * (K) + 5]; ps += p1[8 * (K) + 6]; ps += p1[8 * (K) + 7]; SBAR(); } while (0)
#define PK4(P, BASE, OUT) do { unsigned a0 = cvtpk(P[BASE + 0], P[BASE + 1]), a1 = cvtpk(P[BASE + 2], P[BASE + 3]);   \
    unsigned c0 = cvtpk(P[BASE + 4], P[BASE + 5]), c1 = cvtpk(P[BASE + 6], P[BASE + 7]);                              \
    auto r0 = __builtin_amdgcn_permlane32_swap(a0, c0, false, false); auto r1 = __builtin_amdgcn_permlane32_swap(a1, c1, false, false); \
    u32x4 w = {r0[0], r1[0], r0[1], r1[1]}; OUT = *reinterpret_cast<bf16x8*>(&w); SBAR(); } while (0)
  q0 = __builtin_amdgcn_mfma_f32_32x32x16_bf16(b0A, qfA, q0, 0, 0, 0); SBAR(); FE4(0);
  q1 = __builtin_amdgcn_mfma_f32_32x32x16_bf16(b1A, qfA, q1, 0, 0, 0); SBAR(); LDF(2, qfA, b0A, b1A); SBAR(); FE4(1);
  q0 = __builtin_amdgcn_mfma_f32_32x32x16_bf16(b0B, qfB, q0, 0, 0, 0); SBAR(); FE4(2);
  q1 = __builtin_amdgcn_mfma_f32_32x32x16_bf16(b1B, qfB, q1, 0, 0, 0); SBAR(); LDF(3, qfB, b0B, b1B); SBAR(); FE4(3);
  q0 = __builtin_amdgcn_mfma_f32_32x32x16_bf16(b0A, qfA, q0, 0, 0, 0); SBAR(); FS8(0);
  q1 = __builtin_amdgcn_mfma_f32_32x32x16_bf16(b1A, qfA, q1, 0, 0, 0); SBAR(); FS8(1);
  { auto rr = __builtin_amdgcn_permlane32_swap(__float_as_uint(ps), __float_as_uint(ps), false, false); ps = __uint_as_float(rr[0]) + __uint_as_float(rr[1]); }
  l_reg = l_reg * alpha + ps; SBAR();
  q0 = __builtin_amdgcn_mfma_f32_32x32x16_bf16(b0B, qfB, q0, 0, 0, 0); SBAR(); PK4(p0, 0, pa0); PK4(p0, 8, pa1);
  q1 = __builtin_amdgcn_mfma_f32_32x32x16_bf16(b1B, qfB, q1, 0, 0, 0); SBAR(); PK4(p1, 0, pa2); PK4(p1, 8, pa3);
#undef LDF
#undef PK4
#undef FS8
#undef FE4
}
template <int D0> __device__ __forceinline__ void pv_one2(f32x16& oa, f32x16& ob, int vb, bf16x8 pa0, bf16x8 pa1, bf16x8 pa2, bf16x8 pa3, bf16x8 pb0, bf16x8 pb1, bf16x8 pb2, bf16x8 pb3) {
  const s16x4 l0 = tr_read<v_rd_off(D0, 0, 0)>(vb), h0 = tr_read<v_rd_off(D0, 0, 1)>(vb), l1 = tr_read<v_rd_off(D0, 1, 0)>(vb), h1 = tr_read<v_rd_off(D0, 1, 1)>(vb);
  const s16x4 l2 = tr_read<v_rd_off(D0, 2, 0)>(vb), h2 = tr_read<v_rd_off(D0, 2, 1)>(vb), l3 = tr_read<v_rd_off(D0, 3, 0)>(vb), h3 = tr_read<v_rd_off(D0, 3, 1)>(vb);
  asm volatile("s_waitcnt lgkmcnt(0)" ::: "memory"); SBAR();
#if ATT_PRIO
  __builtin_amdgcn_s_setprio(ATT_PRIO);
#endif
#define PK(L, H) (bf16x8){L[0], L[1], L[2], L[3], H[0], H[1], H[2], H[3]}
  oa = __builtin_amdgcn_mfma_f32_32x32x16_bf16(pa0, PK(l0, h0), oa, 0, 0, 0); ob = __builtin_amdgcn_mfma_f32_32x32x16_bf16(pb0, PK(l0, h0), ob, 0, 0, 0);
  oa = __builtin_amdgcn_mfma_f32_32x32x16_bf16(pa1, PK(l1, h1), oa, 0, 0, 0); ob = __builtin_amdgcn_mfma_f32_32x32x16_bf16(pb1, PK(l1, h1), ob, 0, 0, 0);
  oa = __builtin_amdgcn_mfma_f32_32x32x16_bf16(pa2, PK(l2, h2), oa, 0, 0, 0); ob = __builtin_amdgcn_mfma_f32_32x32x16_bf16(pb2, PK(l2, h2), ob, 0, 0, 0);
  oa = __builtin_amdgcn_mfma_f32_32x32x16_bf16(pa3, PK(l3, h3), oa, 0, 0, 0); ob = __builtin_amdgcn_mfma_f32_32x32x16_bf16(pb3, PK(l3, h3), ob, 0, 0, 0);
#if ATT_PRIO
  __builtin_amdgcn_s_setprio(0);
#endif
#undef PK
}
__device__ __forceinline__ void qkt_half(f32x16& p0, f32x16& p1, const char* Ks, const char* Qs, int c, int r32, int hi) {
  asm volatile("" : "+v"(r32));
  p0 = f32x16{}; p1 = f32x16{};
#pragma unroll
  for (int d0 = 0; d0 < 4; ++d0) { const int cb = (c * 64 + d0 * 16 + hi * 8) * 2;
    const bf16x8 qf = *reinterpret_cast<const bf16x8*>(Qs + kswz<128>(r32, cb));
    const bf16x8 b0 = *reinterpret_cast<const bf16x8*>(Ks + kswz<128>(r32, cb));
    const bf16x8 b1 = *reinterpret_cast<const bf16x8*>(Ks + kswz<128>(32 + r32, cb));
    p0 = __builtin_amdgcn_mfma_f32_32x32x16_bf16(b0, qf, p0, 0, 0, 0);
    p1 = __builtin_amdgcn_mfma_f32_32x32x16_bf16(b1, qf, p1, 0, 0, 0); }
}
__device__ __forceinline__ void attn_diff_fused(const AttnArgs& A, int b, int hh, int qb, float lam, char* lds, int tid) {
  constexpr int QCOL = 2816, KCOL = 3584, VCOL = 4352, OCOL = 1280;
  const float C = 0.125f * LOG2E;
  const int lane = tid & 63, r32 = lane & 31, hi = lane >> 5; const int wid = __builtin_amdgcn_readfirstlane(tid >> 6);
  char* V_lds = lds + OFF_V; char* K_lds = lds + OFF_K;
  float* wsl = (float*)(lds + OFF_WS) + wid * 64;
  const float* lut = (const float*)(lds + OFF_LUT);
  char* stg = lds + OFF_STG + wid * STG_WAVE;
  const int q0 = qb * 256;
  const int qpos = q0 + wid * QBLK + r32, wave_qmin = q0 + wid * QBLK;
  const long rowb = (long)b * SEQL;
  const int NT = 4 * qb + 4;
  const int vb0 = (int)(uintptr_t)V_lds + v_rd_base(lane);
  const unsigned short* Vh = A_proj + rowb * LDP + VCOL + hh * 128;
  const unsigned short* Kh = A_proj + rowb * LDP + KCOL + hh * 128;
  float m0 = NEGB, l0 = 0.f, m1 = NEGB, l1 = 0.f;
  f32x16 o0[4] = {}, o1[4] = {};
  typedef __attribute__((address_space(3))) unsigned las_u32;
#define SLOAD2(k0, bb) do { const char* kg_ = (const char*)(Kh + (long)(k0) * LDP); const char* vg_ = (const char*)(Vh + (long)(k0) * LDP); \
    int ll_ = lane; asm volatile("" : "+v"(ll_));                 \
    _Pragma("unroll") for (int i_ = 0; i_ < 2; ++i_) { const int q_ = (i_ * 8 + wid) * 64 + ll_; \
      const int row_ = q_ >> 4, pos_ = q_ & 15; const unsigned koff_ = (unsigned)((row_ * LDP + ((pos_ ^ (row_ & 7)) << 3)) * 2); \
      const int st_ = q_ >> 5, kk_ = ((st_ >> 2) << 3) | ((q_ >> 2) & 7), c_ = ((st_ & 3) << 5) | ((q_ & 3) << 3), k_ = (kk_ & ~0xC) | ((kk_ & 4) << 1) | ((kk_ & 8) >> 1); const unsigned voff_ = (unsigned)((k_ * LDP + c_) * 2); \
      __builtin_amdgcn_global_load_lds((const unsigned*)(kg_ + koff_), (las_u32*)(K_lds + (bb) * SHM_K + (i_ * 8 + wid) * 1024), 16, 0, 0); \
      __builtin_amdgcn_global_load_lds((const unsigned*)(vg_ + voff_), (las_u32*)(V_lds + (bb) * SHM_V + (i_ * 8 + wid) * 1024), 16, 0, 0); } } while (0)
#define RESC2(a, oo, sl) do { if (__any((a) < 1.f)) { if (hi == 0) (sl)[r32] = (a); asm volatile("s_waitcnt lgkmcnt(0)" ::: "memory"); \
    _Pragma("unroll") for (int d = 0; d < 4; ++d) _Pragma("unroll") for (int r = 0; r < 16; ++r) oo[d][r] *= (sl)[crow(r, hi)]; } } while (0)
  SLOAD2(0, 0);
  { const unsigned short* Qg = A_proj + (rowb + q0 + wid * QBLK) * LDP + QCOL + hh * 128;
    bf16x8 qv[8];
#pragma unroll
    for (int i = 0; i < 8; ++i) { const int c = lane + 64 * i, row = c >> 4, cc = c & 15; qv[i] = *reinterpret_cast<const bf16x8*>(Qg + (long)row * LDP + cc * 8); }
    unit_luts<2>(lds, hh, tid);
#pragma unroll
    for (int i = 0; i < 8; ++i) { const int c = lane + 64 * i, row = c >> 4, cc = c & 15; *(bf16x8*)(stg + kswz<128>(row, cc * 16)) = qv[i]; } }
  asm volatile("s_waitcnt vmcnt(0)" ::: "memory"); __syncthreads();
  const float cfar = lut[127];
#pragma unroll 1
  for (int j = 0; j < NT; ++j) {
    const int bb = j & 1; const int kt = j * KVBLK;
    if (j + 1 < NT) SLOAD2((j + 1) * KVBLK, bb ^ 1);
    if (kt <= wave_qmin + QBLK - 1) {
    f32x16 p0, p1, q0, q1; float al0, al1; bf16x8 pa0, pa1, pa2, pa3, pb0, pb1, pb2, pb3;
    qkt_half(p0, p1, K_lds + bb * SHM_K, stg, 0, r32, hi);
    tile_sm<2>(p0, p1, kt, qpos, wave_qmin, hi, C, lut, cfar, 0u, qb, m0, al0);
    SBAR();
    qkt_half_sm_split(q0, q1, K_lds + bb * SHM_K, stg, r32, hi, p0, p1, al0, l0, pa0, pa1, pa2, pa3);
    RESC2(al0, o0, wsl);
    SBAR();
    tile_sm<2>(q0, q1, kt, qpos, wave_qmin, hi, C, lut, cfar, 0u, qb, m1, al1);
    RESC2(al1, o1, wsl + 32);
    SBAR();
    pv_sm_split(o0, vb0 + bb * SHM_V, pa0, pa1, pa2, pa3, q0, q1, al1, l1, pb0, pb1, pb2, pb3);
    SBAR();
    pv_all1(o1, vb0 + bb * SHM_V, pb0, pb1, pb2, pb3);
    }
    asm volatile("s_waitcnt vmcnt(0)" ::: "memory");
    __syncthreads();
  }
#undef SLOAD2
#undef RESC2
  int r32e = r32, hie = hi; asm volatile("" : "+v"(r32e), "+v"(hie));
  if (hi == 0) { wsl[r32] = l0; wsl[32 + r32] = l1; } asm volatile("s_waitcnt lgkmcnt(0)" ::: "memory");
#pragma unroll
  for (int r = 0; r < 16; ++r) { const int orow = crow(r, hie); const float ra = __builtin_amdgcn_rcpf(wsl[orow]), rb = lam * __builtin_amdgcn_rcpf(wsl[32 + orow]);
#pragma unroll
    for (int d0 = 0; d0 < 4; ++d0) { unsigned short* sp = (unsigned short*)(stg + orow * STG_PITCH) + d0 * 32 + r32e; const float v = o0[d0][r] * ra - o1[d0][r] * rb;
      *sp = (unsigned short)(cvtpk(v, v) & 0xffffu); } }
  asm volatile("s_waitcnt lgkmcnt(0)" ::: "memory");
  { const char* rp = stg + r32e * STG_PITCH + hie * 128;
    u32x4 w[8];
#pragma unroll
    for (int i = 0; i < 8; ++i) w[i] = *(const u32x4*)(rp + i * 16);
    float ss = 0.f;
#pragma unroll
    for (int i = 0; i < 8; ++i)
#pragma unroll
      for (int k = 0; k < 4; ++k) { const float lo = __uint_as_float(w[i][k] << 16), hi_ = __uint_as_float(w[i][k] & 0xffff0000u); ss += lo * lo + hi_ * hi_; }
    { auto rr = __builtin_amdgcn_permlane32_swap(__float_as_uint(ss), __float_as_uint(ss), false, false); ss = __uint_as_float(rr[0]) + __uint_as_float(rr[1]); }
    const float sc2 = rsqrtf(ss * (1.0f / 128.0f) + 1e-6f) * (1.0f - A.lambda_init);
    const f32x4* gp = (const f32x4*)(A_subln + hie * 64);
    f32x4 gq[16];
#pragma unroll
    for (int i = 0; i < 16; ++i) gq[i] = gp[i];
#pragma unroll
    for (int i = 0; i < 8; ++i)
#pragma unroll
      for (int k = 0; k < 4; ++k) { const float lo = __uint_as_float(w[i][k] << 16) * sc2 * gq[2 * i + (k >> 1)][2 * (k & 1)], hi_ = __uint_as_float(w[i][k] & 0xffff0000u) * sc2 * gq[2 * i + (k >> 1)][2 * (k & 1) + 1]; w[i][k] = cvtpk(lo, hi_); }
    unsigned short* op = A_ycat + (rowb + q0 + wid * QBLK + r32e) * LDY + OCOL + hh * 128 + hie * 64;
#pragma unroll
    for (int i = 0; i < 8; ++i) *(u32x4*)(op + i * 8) = w[i];
  }
}
__device__ __forceinline__ void attn_swa_wave(const AttnArgs& A, int b, int hh, int qb, char* lds, int tid) {
  constexpr int QCOL = 0, KCOL = 768, VCOL = 1024, OCOL = 0;
  const float C = 0.088388347648318440f * LOG2E;
  const int lane = tid & 63, r32 = lane & 31, hi = lane >> 5; const int wid = __builtin_amdgcn_readfirstlane(tid >> 6);
  const int kvh = hh / 3;
  char* vpriv = lds + (wid < 4 ? wid * 16384 : OFF_STG + (wid - 4) * 16384);
  float* wsl = (float*)(lds + OFF_WS) + wid * 64; float* li_l = wsl; float* al_l = wsl + 32;
  const float* lut = (const float*)(lds + OFF_LUT);
  const int q0 = qb * 256, q0w = q0 + wid * QBLK, qpos = q0w + r32;
  const long rowb = (long)b * SEQL;
  const float cfar = lut[127];
  const unsigned short* Vh = A_proj + rowb * LDP + VCOL + kvh * 128;
  const unsigned short* Kh = A_proj + rowb * LDP + KCOL + kvh * 128 + hi * 8;
  const unsigned short* Qw = A_proj + (rowb + qpos) * LDP + QCOL + hh * 128 + hi * 8;
  bf16x8 qr[8];
#pragma unroll
  for (int d0 = 0; d0 < 8; ++d0) qr[d0] = *reinterpret_cast<const bf16x8*>(Qw + d0 * 16);
  float m_reg = A_sinks[hh] * LOG2E, l_reg = 1.f;
  f32x16 o[4] = {};
  const int vb = (int)(uintptr_t)vpriv + v_rd_base(lane);
  const int tfirst = (q0w >= 127) ? ((q0w - 127) >> 6) : 0, tlast = (q0w + 31) >> 6;
#pragma unroll 1
  for (int t = tfirst; t <= tlast; ++t) {
    const int kt = t * KVBLK;
    f32x16 p0 = {}, p1 = {};
    { bf16x8 kf0[8], kf1[8];
#pragma unroll
      for (int d0 = 0; d0 < 8; ++d0) { kf0[d0] = *reinterpret_cast<const bf16x8*>(Kh + (long)(kt + r32) * LDP + d0 * 16); kf1[d0] = *reinterpret_cast<const bf16x8*>(Kh + (long)(kt + 32 + r32) * LDP + d0 * 16); }
#pragma unroll
      for (int d0 = 0; d0 < 8; ++d0) { p0 = __builtin_amdgcn_mfma_f32_32x32x16_bf16(kf0[d0], qr[d0], p0, 0, 0, 0); p1 = __builtin_amdgcn_mfma_f32_32x32x16_bf16(kf1[d0], qr[d0], p1, 0, 0, 0); } }
    bf16x8 vs[16];
#pragma unroll
    for (int i = 0; i < 16; ++i) { const int q = lane + 64 * i; vs[i] = *reinterpret_cast<const bf16x8*>(Vh + (long)(kt + (q >> 4)) * LDP + (q & 15) * 8); }
    float al; bf16x8 pa0, pa1, pa2, pa3;
    tile_sm<0>(p0, p1, kt, qpos, q0w, hi, C, lut, cfar, 0u, qb, m_reg, al);
    finishSM(p0, p1, al, l_reg, pa0, pa1, pa2, pa3);
    if (__any(al < 1.f)) { if (hi == 0) al_l[r32] = al; asm volatile("s_waitcnt lgkmcnt(0)" ::: "memory");
#pragma unroll
      for (int d = 0; d < 4; ++d)
#pragma unroll
        for (int r = 0; r < 16; ++r) o[d][r] *= al_l[crow(r, hi)]; }
#pragma unroll
    for (int i = 0; i < 16; ++i) { const int q = lane + 64 * i; *(bf16x8*)(vpriv + v_st(q >> 4, (q & 15) * 8)) = vs[i]; }
    asm volatile("s_waitcnt lgkmcnt(0)" ::: "memory"); SBAR();
    pv_d0(o, vb, pa0, pa1, pa2, pa3);
    asm volatile("s_waitcnt lgkmcnt(0)" ::: "memory"); SBAR();
  }
  int r32e = r32, hie = hi; asm volatile("" : "+v"(r32e), "+v"(hie));
  if (hi == 0) li_l[r32] = l_reg; asm volatile("s_waitcnt lgkmcnt(0)" ::: "memory");
#pragma unroll
  for (int r = 0; r < 16; ++r) { const int orow = crow(r, hie); const float rli = __builtin_amdgcn_rcpf(li_l[orow]);
#pragma unroll
    for (int d0 = 0; d0 < 4; ++d0) { unsigned short* sp = (unsigned short*)(vpriv + orow * STG_PITCH) + d0 * 32 + r32e; const float v = o[d0][r] * rli; *sp = (unsigned short)(cvtpk(v, v) & 0xffffu); } }
  asm volatile("s_waitcnt lgkmcnt(0)" ::: "memory");
  { const char* rp = vpriv + r32e * STG_PITCH + hie * 128; u32x4 w[8];
#pragma unroll
    for (int i = 0; i < 8; ++i) w[i] = *(const u32x4*)(rp + i * 16);
    unsigned short* op = A_ycat + (rowb + q0w + r32e) * LDY + OCOL + hh * 128 + hie * 64;
#pragma unroll
    for (int i = 0; i < 8; ++i) *(u32x4*)(op + i * 8) = w[i]; }
}
template <int MODE>
__device__ __forceinline__ float attn_mode_setup(const AttnArgs& A, char* lds, const int wave_idx) {
  constexpr int HB0 = (MODE == 0) ? 0 : (MODE == 1) ? 6 : 10, NH = (MODE == 1) ? 4 : 6;
  const int lane = mk_lane(), tid = wave_idx * 64 + lane;
  __syncthreads();
  float* lh = (float*)(lds + OFF_LUTH);
#pragma unroll 1
  for (int i = tid; i < NH * 128; i += 512) lh[i] = A_rel_bias[(int)REL_BUCKET_TAB[i & 127] * 16 + HB0 + (i >> 7)] * LOG2E;
  float lam = 0.f;
  if (MODE == 2) { float a = A_lq1[lane] * A_lk1[lane], c2 = A_lq2[lane] * A_lk2[lane];
#pragma unroll
    for (int o_ = 1; o_ < 64; o_ <<= 1) { a += mk_shfl_xor(a, o_); c2 += mk_shfl_xor(c2, o_); }
    lam = __expf(a) - __expf(c2) + A.lambda_init; }
  __syncthreads();
  return __builtin_bit_cast(float, __builtin_amdgcn_readfirstlane(__builtin_bit_cast(int, lam)));
}
template <int MODE>
__device__ __forceinline__ void attn_unit(const AttnArgs& A, int b, int hh, int qb, char* lds, const int wave_idx, float lam) {
  constexpr int NPASS = (MODE == 2) ? 2 : 1;
  const int lane = mk_lane(), tid = wave_idx * 64 + lane;
  float* lut = (float*)(lds + OFF_LUT);
  __syncthreads();
  if (MODE == 1 && tid == 0) ((unsigned*)(lds + OFF_MISC))[4] = 0u;
  if (MODE == 1) { const float* kp_ = A_kpart + (size_t)((b * 4 + hh) * 16) * 128 + tid * 4; *(f32x4*)(lds + OFF_STG + tid * 16) = (*(const f32x4*)kp_ + *(const f32x4*)(kp_ + ATT_KP_N)) * (1.f / 256.f); }
  if (!(MODE == 2 && ATT_DIFF_FUSED)) { unit_luts<MODE>(lds, hh, tid); __syncthreads(); }
  asm volatile("" : "+v"(lam));
  if (MODE == 2 && ATT_DIFF_FUSED) { attn_diff_fused(A, b, hh, qb, lam, lds, wave_idx * 64 + mk_lane()); }
  else if (MODE == 0 && ATT_SWA_WAVE) { attn_swa_wave(A, b, hh, qb, lds, wave_idx * 64 + mk_lane()); }
  else {
#pragma unroll 1
  for (int pass = 0; pass < NPASS; ++pass) {
    attn_pass<MODE>(A, b, hh, qb, pass, lam, lds, wave_idx * 64 + mk_lane());
  }
  }
}
#undef SBAR
}
#undef A_proj
#undef A_ycat
#undef A_kmean
#undef A_kpart
#undef A_rel_bias
#undef A_sinks
#undef A_lq1
#undef A_lk1
#undef A_lq2
#undef A_lk2
#undef A_subln
#define GAS __attribute__((address_space(1)))
#define LAS __attribute__((address_space(3)))
typedef unsigned short bf16;
typedef unsigned v4u __attribute__((ext_vector_type(4)));
typedef float f32x4 __attribute__((ext_vector_type(4)));
typedef short bf16x8 __attribute__((ext_vector_type(8)));
typedef GAS unsigned gu32;
typedef GAS unsigned long long gu64;
#define RLX_AGENT __ATOMIC_RELAXED, __HIP_MEMORY_SCOPE_AGENT
#define LDS_WAIT() asm volatile("s_waitcnt lgkmcnt(0)" ::: "memory")
#define VM_WAIT() asm volatile("s_waitcnt vmcnt(0)" ::: "memory")
__device__ __forceinline__ unsigned long long rt() { return __builtin_amdgcn_s_memrealtime(); }
__device__ __forceinline__ unsigned f2bf(float f) { unsigned u = __builtin_bit_cast(unsigned, f); return (u + 0x7fffu + ((u >> 16) & 1u)) >> 16; }
__device__ __forceinline__ unsigned pk2(float lo, float hi) { return f2bf(lo) | (f2bf(hi) << 16); }

#define XB_TMO      128
#define XB_XCNT(j)  (256  + 64 * (j))
#define XB_XSUB(j)  (1280 + 64 * (j))
#define XB_XGEN(j)  (2304 + 64 * (j))
#define XB_TOP      3328
#define XB_TOPGEN   3392
#define XCD_BAR_WORDS 3456
#define XB_SPIN_CAP (1u << 18)

__device__ __forceinline__ unsigned xb_ld(unsigned* p)              { return __hip_atomic_load(p, __ATOMIC_RELAXED, __HIP_MEMORY_SCOPE_AGENT); }
__device__ __forceinline__ unsigned xb_add(unsigned* p, unsigned v) { return __hip_atomic_fetch_add(p, v, __ATOMIC_RELAXED, __HIP_MEMORY_SCOPE_AGENT); }
__device__ __forceinline__ unsigned xb_xcc_id() { return (unsigned)__builtin_amdgcn_s_getreg((3 << 11) | 20) & 0xFu; }
#define XB_SPIN(cond, bar) do { unsigned _sp = 0; while (cond) { __builtin_amdgcn_s_sleep(1); \
    if ((++_sp & 255u) == 0u) { if (xb_ld(&(bar)[XB_TMO])) break; if (_sp > XB_SPIN_CAP) { atomicAdd(&(bar)[XB_TMO], 1u); break; } } } } while (0)

struct XcdBarrier {
    unsigned* bar; unsigned x;
    volatile LAS unsigned* st;
};

__device__ __forceinline__ XcdBarrier xcd_barrier_post(unsigned* bar, volatile LAS unsigned* st) {
    XcdBarrier b; b.bar = bar; b.x = xb_xcc_id(); b.st = st;
    if (threadIdx.x == 0) (void)xb_add(&bar[XB_XCNT(b.x)], 1u);
    return b;
}
__device__ __forceinline__ void xcd_barrier_complete(unsigned* bar, unsigned x, unsigned& nloc, unsigned& nx) {
    const unsigned G = gridDim.x * gridDim.y * gridDim.z;
    unsigned sum, cnt, mine, sp = 0u;
    for (;;) {
        sum = 0u; cnt = 0u; mine = 0u;
#pragma unroll
        for (unsigned j = 0; j < 16; ++j) { const unsigned c = xb_ld(&bar[XB_XCNT(j)]); sum += c; cnt += (c > 0u) ? 1u : 0u; mine = (j == x) ? c : mine; }
        if (sum == G) break;
        __builtin_amdgcn_s_sleep(1);
        if ((++sp & 255u) == 0u) { if (xb_ld(&bar[XB_TMO])) break; if (sp > XB_SPIN_CAP) { atomicAdd(&bar[XB_TMO], 1u); break; } }
    }
    nloc = mine > 0u ? mine : 1u; nx = cnt > 0u ? cnt : 1u;
}

__device__ __forceinline__ void xcd_barrier(const XcdBarrier& b) {
    asm volatile("s_waitcnt vmcnt(0)" ::: "memory");
    __syncthreads();
    if (threadIdx.x == 0) {
        unsigned* bar = b.bar;
        __builtin_amdgcn_s_waitcnt(0);
        unsigned nloc = b.st[0], nx = b.st[1];
        if (nloc == 0u) { xcd_barrier_complete(bar, b.x, nloc, nx); b.st[0] = nloc; b.st[1] = nx; }
        const unsigned old = xb_add(&bar[XB_XSUB(b.x)], 1u);
        const unsigned gen = old / nloc;
        if (old + 1u == (gen + 1u) * nloc) {
            __builtin_amdgcn_fence(__ATOMIC_RELEASE, "agent");
            asm volatile("s_waitcnt vmcnt(0)" ::: "memory");
            const unsigned og = xb_add(&bar[XB_TOP], 1u);
            const unsigned tg = og / nx;
            if (og + 1u == (tg + 1u) * nx) xb_add(&bar[XB_TOPGEN], 1u);
            else XB_SPIN(xb_ld(&bar[XB_TOPGEN]) == tg, bar);
            __builtin_amdgcn_fence(__ATOMIC_ACQUIRE, "agent");
            xb_add(&bar[XB_XGEN(b.x)], 1u);
            asm volatile("s_waitcnt vmcnt(0)" ::: "memory");
        } else {
            XB_SPIN(xb_ld(&bar[XB_XGEN(b.x)]) == gen, bar);
            __builtin_amdgcn_fence(__ATOMIC_ACQUIRE, "agent");
            asm volatile("s_waitcnt vmcnt(0)" ::: "memory");
        }
    }
    __syncthreads();
}

constexpr int NWAVES = 8;
constexpr int BATCH = 8, SEQ = 4096, DM = 2048, DEPTH = 2, M = BATCH * SEQ, NIN = 5120, NEXP = 32, DEXP = 512, PLE = 256, NROUTE = 36;
constexpr int KB_OFF = 1792;
constexpr int RPAD = 73728;
constexpr float EPS = 1e-6f;
constexpr size_t MiB = 1u << 20;
constexpr size_t WS_CTL = 0, CTL_ZERO_BYTES = 1 * MiB;
constexpr size_t WS_KMEAN = 1 * MiB, WS_RSTD = WS_KMEAN + 256 * 1024, WS_TOKREC = WS_RSTD + 128 * 1024, WS_POS = WS_TOKREC + 1 * MiB, WS_WR = WS_POS + 256 * 1024;
constexpr size_t WS_WIN = 8 * MiB, WS_WOUT = 48 * MiB, WS_W13 = 64 * MiB, WS_W2 = 192 * MiB, WS_WG = 256 * MiB, WS_WP = 272 * MiB, WS_PB = 274 * MiB;
constexpr size_t WS_U = 306 * MiB, WS_PROJ = 434 * MiB, WS_YCAT = 754 * MiB, WS_PL = 882 * MiB, WS_HB = 1010 * MiB, WS_END = 1138 * MiB;
constexpr size_t WS_SSQ = WS_YCAT + 64 * MiB;
constexpr size_t WS_SRS = WS_YCAT + 72 * MiB;
constexpr size_t WS_LIST = 4 * MiB;
constexpr size_t WS_RSIN = WS_POS, WS_RSPLE = WS_POS + 128 * 1024;
constexpr size_t WS_XG = WS_PROJ, WS_HID = WS_PROJ + 288 * MiB, WS_Y = WS_XG;
static_assert(WS_WR + 2 * 2 * 48 * DM * 2 <= WS_LIST && WS_LIST + NEXP * 32768 * 4 <= WS_WIN && WS_HID + (size_t)RPAD * DEXP * 2 <= WS_PL && (size_t)RPAD * DM * 2 <= 288 * MiB && WS_W13 + (size_t)NEXP * 1024 * DM * 2 <= WS_W2 && WS_W2 + (size_t)NEXP * DM * DEXP * 2 <= WS_WG && WS_PB + (size_t)DEPTH * M * PLE * 2 <= WS_U, "d_ws map");
constexpr int CW_TMO = 0, CW_CODE = 1, CW_BAR = 4096, CW_CNT = 16384, CW_Q = 24576;
constexpr int PHASE_LDS = 139264;
constexpr int LDS_TILE_E = PHASE_LDS, LDS_OFFS = PHASE_LDS + 512, LDS_MISC = PHASE_LDS + 1024, LDSCTL_OFF = PHASE_LDS;
constexpr int LDS_BYTES = 147456 + att::LUT4_COPIES * att::LUT4_N * 4 + att::LUTH_BYTES;
static_assert(att::OFF_LUT4 == 147456 && LDS_BYTES <= 163840 && att::ATT_LDS <= PHASE_LDS && pg8::STAGE_BYTES <= PHASE_LDS && LDS_MISC + 128 + 8 * 32 <= LDS_BYTES, "LDS map");

__device__ __forceinline__ gu32* ctlptr() { return (gu32*)(wsptr() + WS_CTL); }
typedef float f32x2g __attribute__((ext_vector_type(2)));
typedef unsigned u32x2g __attribute__((ext_vector_type(2)));
__device__ __forceinline__ size_t hb_off(int k) { return (k & 1) ? WS_U : WS_HB; }
struct Frame {
    LAS unsigned char* lds;
    volatile LAS unsigned* MISC;
    int tid, lane, wave, G, gw, NGW;
};
struct Args { const float* in[22]; float* out; unsigned char* ws; int ph_lo, ph_hi, use_bar, pad; };
__device__ __forceinline__ Frame relaunder(const Frame& F0) {
    Frame F = F0; int w = F0.wave; asm volatile("" : "+s"(w)); F.wave = w; F.lane = mk_lane(); F.tid = w * 64 + F.lane; F.gw = blockIdx.x * NWAVES + w; return F;
}
__device__ __forceinline__ int opaque_i(int x) { asm volatile("" : "+s"(x)); return x; }
__device__ __forceinline__ float wave_sum(float v) {
#pragma unroll
    for (int o = 1; o < 64; o <<= 1) v += mk_shfl_xor(v, o);
    return v;
}
__device__ __forceinline__ unsigned pk2rne(float lo, float hi) { return pg8::cvt_pk_bf16(lo, hi); }
__device__ __forceinline__ float bfround(float x) { return __uint_as_float(pk2rne(x, x) << 16); }

struct ConvDesc { const float* W; int K, N; bf16* WT; int dst_row0, k0, n0; const float* gk; };
__device__ __forceinline__ void transpose_gains(const ConvDesc& d, float (&gv)[8], int lane) {
    const int rr = lane >> 3;
#pragma unroll
    for (int i = 0; i < 8; ++i) gv[i] = d.gk ? d.gk[d.k0 + 8 * i + rr] : 1.f;
}
__device__ __forceinline__ void transpose_load(const ConvDesc& d, f32x4 (&v)[8], int lane) {
    const int rr = lane >> 3, c4 = (lane & 7) * 4;
#pragma unroll
    for (int i = 0; i < 8; ++i) v[i] = __builtin_nontemporal_load((const GAS f32x4*)(d.W + (size_t)(d.k0 + 8 * i + rr) * d.N + d.n0 + c4));
}
__device__ __forceinline__ void transpose_store(const ConvDesc& d, f32x4 (&v)[8], float (&gv)[8], LAS float* scr, int lane, bool nt = false) {
    { const int rr = lane >> 3, c4 = (lane & 7) * 4;
#pragma unroll
      for (int i = 0; i < 8; ++i) { const f32x4 w = v[i] * gv[i]; LAS float* p = scr + (8 * i + rr) * 33 + c4; p[0] = w.x; p[1] = w.y; p[2] = w.z; p[3] = w.w; } }
    LDS_WAIT(); asm volatile("" ::: "memory");
    const int c = lane & 7;
#pragma unroll
    for (int j = 0; j < 4; ++j) { const int n = (lane >> 3) + 8 * j; const LAS float* s = scr + (8 * c) * 33 + n;
        v4u o; o.x = pk2rne(s[0 * 33], s[1 * 33]); o.y = pk2rne(s[2 * 33], s[3 * 33]); o.z = pk2rne(s[4 * 33], s[5 * 33]); o.w = pk2rne(s[6 * 33], s[7 * 33]);
        GAS v4u* dp = (GAS v4u*)(d.WT + (size_t)(d.dst_row0 + n) * d.K + d.k0 + 8 * c); if (nt) __builtin_nontemporal_store(o, dp); else *dp = o; }
    LDS_WAIT(); asm volatile("" ::: "memory");
}
__device__ __forceinline__ void p0_transpose_item(const float* W, int K, int N, bf16* WT, int dst_row0, LAS float* scr, int k0, int n0, int lane, const float* gk = nullptr) {
    const ConvDesc d{W, K, N, WT, dst_row0, k0, n0, gk}; f32x4 v[8]; float gv[8]; transpose_gains(d, gv, lane); transpose_load(d, v, lane); transpose_store(d, v, gv, scr, lane);
}
__device__ __forceinline__ void norm_row_bf16(const float* xrow, const float* g, bf16* orow, int lane) {
    const GAS f32x4* xr = (const GAS f32x4*)xrow + lane; const GAS f32x4* gr = (const GAS f32x4*)g + lane;
    f32x4 v[8]; float s = 0.f;
#pragma unroll
    for (int j = 0; j < 8; ++j) { v[j] = xr[64 * j]; s += (v[j].x * v[j].x + v[j].y * v[j].y) + (v[j].z * v[j].z + v[j].w * v[j].w); }
    const float rstd = rsqrtf(wave_sum(s) * (1.f / DM) + EPS);
    GAS unsigned long long* o8 = (GAS unsigned long long*)orow + lane;
#pragma unroll
    for (int j = 0; j < 8; ++j) { const f32x4 gv = gr[64 * j]; o8[64 * j] = (unsigned long long)pk2rne(v[j].x * rstd * gv.x, v[j].y * rstd * gv.y) | ((unsigned long long)pk2rne(v[j].z * rstd * gv.z, v[j].w * rstd * gv.w) << 32); }
}

__device__ __forceinline__ void convert_expert_weights(Frame& F, int L) {
    LAS float* scr = (LAS float*)(F.lds + F.wave * 16384);
    constexpr int I_W1 = 32 * 512, I_W2 = 32 * 512;
    bf16* W13 = (bf16*)(wsptr() + WS_W13); bf16* W2 = (bf16*)(wsptr() + WS_W2);
    for (int it = F.gw; it < 2 * I_W1 + I_W2; it += F.NGW) { int r = it;
        if (r < 2 * I_W1) { const int w3 = r >= I_W1; if (w3) r -= I_W1; const int e = r / 512, rr = r % 512, n0 = 32 * (rr % 16);
            p0_transpose_item((w3 ? inptr(17) : inptr(16)) + ((size_t)L * NEXP + e) * DM * DEXP, DM, DEXP, W13 + (size_t)e * 1024 * DM, 256 * (n0 / 128) + (n0 % 128) + (w3 ? 128 : 0), scr, 64 * (rr / 16), n0, F.lane, inptr(13) + (size_t)L * DM); continue; } r -= 2 * I_W1;
        const int e = r / 512, rr = r % 512;
        p0_transpose_item(inptr(18) + ((size_t)L * NEXP + e) * DEXP * DM, DEXP, DM, W2 + (size_t)e * DM * DEXP, 32 * (rr % 64), scr, 64 * (rr / 64), 32 * (rr % 64), F.lane); }
}
static_assert(true, "");
constexpr int CONV_NCH = 8, CONV_IE = 3 * 32 * 512, CONV_ID = 32 * 160 + 32 * 64 + 32 * 64 + 4 * 64;
__device__ __forceinline__ ConvDesc conv_desc(int job, int idx) {
    bf16* W13 = (bf16*)(wsptr() + WS_W13); bf16* W2 = (bf16*)(wsptr() + WS_W2);
    if (idx < CONV_IE) { const int L = job; int r = idx;
        if (r < 2 * 32 * 512) { const int w3 = r >= 32 * 512; if (w3) r -= 32 * 512; const int e = r / 512, rr = r % 512, n0 = 32 * (rr % 16);
            return ConvDesc{(w3 ? inptr(17) : inptr(16)) + ((size_t)L * NEXP + e) * DM * DEXP, DM, DEXP, W13 + (size_t)e * 1024 * DM, 256 * (n0 / 128) + (n0 % 128) + (w3 ? 128 : 0), 64 * (rr / 16), n0, inptr(13) + (size_t)L * DM}; }
        r -= 2 * 32 * 512; const int e = r / 512, rr = r % 512;
        return ConvDesc{inptr(18) + ((size_t)L * NEXP + e) * DEXP * DM, DEXP, DM, W2 + (size_t)e * DM * DEXP, 32 * (rr % 64), 64 * (rr / 64), 32 * (rr % 64), nullptr}; }
    int r = idx - CONV_IE; const int L = 1;
    bf16* WIN = (bf16*)(wsptr() + WS_WIN); bf16* WOUT = (bf16*)(wsptr() + WS_WOUT); bf16* WG = (bf16*)(wsptr() + WS_WG); bf16* WP = (bf16*)(wsptr() + WS_WP);
    if (r < 32 * 160) { return ConvDesc{inptr(5) + (size_t)L * DM * NIN, DM, NIN, WIN + (size_t)L * NIN * DM, 32 * (r % 160), 64 * (r / 160), 32 * (r % 160), inptr(4) + (size_t)L * DM}; } r -= 32 * 160;
    if (r < 32 * 64) { return ConvDesc{inptr(12) + (size_t)L * DM * DM, DM, DM, WOUT + (size_t)L * DM * DM, 32 * (r % 64), 64 * (r / 64), 32 * (r % 64), nullptr}; } r -= 32 * 64;
    if (r < 32 * 64) { return ConvDesc{inptr(20) + (size_t)L * DM * DM, DM, DM, WG + (size_t)L * DM * DM, 32 * (r % 64), 64 * (r / 64), 32 * (r % 64), inptr(19) + (size_t)L * DM}; } r -= 32 * 64;
    return ConvDesc{inptr(21) + (size_t)L * PLE * DM, PLE, DM, WP + (size_t)L * DM * PLE, 32 * (r % 64), 64 * (r / 64), 32 * (r % 64), nullptr};
}
__device__ __forceinline__ void conv_chunk(Frame& F0, int job, int k, gu32* tq = nullptr) {
    unsigned tk_ = 0u; const bool tkd = (tq != nullptr) && (F0.wave == 0) && (mk_lane() == 0);
    if (tkd) tk_ = __hip_atomic_fetch_add(tq, 1u, RLX_AGENT);
    __syncthreads();
    Frame F = relaunder(F0);
    LAS float* scr = (LAS float*)(F.lds + F.wave * 16384 + (F.wave >= 4 ? 8192 : 0));
    const int N = job == 0 ? CONV_IE + CONV_ID : CONV_IE, ipc = (N + F.G * CONV_NCH - 1) / (F.G * CONV_NCH), base = ((int)blockIdx.x * CONV_NCH + k) * ipc;
    f32x4 v[4][8]; ConvDesc d[4]; bool has[4];
#pragma unroll
    for (int t = 0; t < 4; ++t) { const int i = F.wave + NWAVES * t, idx = base + i; has[t] = (i < ipc) && (idx < N); d[t] = conv_desc(job, has[t] ? idx : 0); }
    float gA[8], gB[8];
    transpose_gains(d[0], gA, F.lane); transpose_gains(d[1], gB, F.lane);
#pragma unroll
    for (int t = 0; t < 4; ++t) if (has[t]) transpose_load(d[t], v[t], F.lane);
    if (has[0]) transpose_store(d[0], v[0], gA, scr, F.lane, true);
    transpose_gains(d[2], gA, F.lane); if (has[1]) transpose_store(d[1], v[1], gB, scr, F.lane, true);
    transpose_gains(d[3], gB, F.lane); if (has[2]) transpose_store(d[2], v[2], gA, scr, F.lane, true);
    if (has[3]) transpose_store(d[3], v[3], gB, scr, F.lane, true);
    if (tkd) ((volatile LAS int*)(F.lds + att::OFF_MISC))[0] = (int)tk_;
    __syncthreads();
}
__device__ __forceinline__ void p0_prologue(Frame& F0, const Args& AR) {
    Frame F = relaunder(F0);
    LAS float* scr = (LAS float*)(F.lds + F.wave * 16384);
    constexpr int I_IN = 32 * 160, I_OUT = 32 * 64, I_WG = 32 * 64, I_WP = 4 * 64, I_L = I_IN + I_OUT + I_WG + I_WP;
    bf16* WIN = (bf16*)(wsptr() + WS_WIN); bf16* WOUT = (bf16*)(wsptr() + WS_WOUT); bf16* WG = (bf16*)(wsptr() + WS_WG); bf16* WP = (bf16*)(wsptr() + WS_WP);
    for (int it = F.gw; it < I_L; it += F.NGW) {
        const int L = 0; int r = it;
        if (r < I_IN) { p0_transpose_item(inptr(5) + (size_t)L * DM * NIN, DM, NIN, WIN + (size_t)L * NIN * DM, 32 * (r % 160), scr, 64 * (r / 160), 32 * (r % 160), F.lane, inptr(4) + (size_t)L * DM); continue; } r -= I_IN;
        if (r < I_OUT) { p0_transpose_item(inptr(12) + (size_t)L * DM * DM, DM, DM, WOUT + (size_t)L * DM * DM, 32 * (r % 64), scr, 64 * (r / 64), 32 * (r % 64), F.lane); continue; } r -= I_OUT;
        if (r < I_WG) { p0_transpose_item(inptr(20) + (size_t)L * DM * DM, DM, DM, WG + (size_t)L * DM * DM, 32 * (r % 64), scr, 64 * (r / 64), 32 * (r % 64), F.lane, inptr(19) + (size_t)L * DM); continue; } r -= I_WG;
        p0_transpose_item(inptr(21) + (size_t)L * PLE * DM, PLE, DM, WP + (size_t)L * DM * PLE, 32 * (r % 64), scr, 64 * (r / 64), 32 * (r % 64), F.lane);
    }
    { GAS v4u* lz = (GAS v4u*)(wsptr() + WS_LIST); for (int i = F.gw * 64 + F.lane; i < NEXP * 32768 / 4; i += F.NGW * 64) lz[i] = (v4u){0u, 0u, 0u, 0u}; }
    { const GAS f32x4* src = (const GAS f32x4*)inptr(1); GAS v4u* dst = (GAS v4u*)(wsptr() + WS_PB); const long n8 = (long)DEPTH * M * PLE / 8;
      const long st = (long)F.NGW * 64;
      for (long i = (long)F.gw * 64 + F.lane; i < n8; i += 4 * st) {
        f32x4 a[4], b[4];
#pragma unroll
        for (int u = 0; u < 4; ++u) if (i + u * st < n8) { a[u] = __builtin_nontemporal_load(src + 2 * (i + u * st)); b[u] = __builtin_nontemporal_load(src + 2 * (i + u * st) + 1); }
#pragma unroll
        for (int u = 0; u < 4; ++u) if (i + u * st < n8) { v4u o; o.x = pk2rne(a[u].x, a[u].y); o.y = pk2rne(a[u].z, a[u].w); o.z = pk2rne(b[u].x, b[u].y); o.w = pk2rne(b[u].z, b[u].w); dst[i + u * st] = o; } } }

    { bf16* WRH = (bf16*)(wsptr() + WS_WR); bf16* WRL = WRH + DEPTH * 48 * DM;
      for (int i = F.gw * 64 + F.lane; i < DEPTH * 48 * DM; i += F.NGW * 64) { const int L = i / (48 * DM), n = (i / DM) % 48, k = i % DM;
        const float w = (n < 4 ? inptr(14)[((size_t)L * DM + k) * 4 + n] : n < NROUTE ? inptr(15)[((size_t)L * DM + k) * 32 + (n - 4)] : 0.f) * inptr(13)[(size_t)L * DM + k];
        const unsigned h = pk2rne(w, 0.f) & 0xffffu; const float r = w - __uint_as_float(h << 16);
        WRH[i] = (bf16)h; WRL[i] = (bf16)(pk2rne(r, 0.f) & 0xffffu); } }
    { float* rsin = (float*)(wsptr() + WS_RSIN); bf16* hb = (bf16*)(wsptr() + hb_off(0));
      for (int m4 = F.gw; m4 < M / 4; m4 += F.NGW) {
        f32x4 v[4][8];
#pragma unroll
        for (int r = 0; r < 4; ++r) { const GAS f32x4* xr = (const GAS f32x4*)(inptr(0) + (size_t)(4 * m4 + r) * DM) + F.lane;
#pragma unroll
          for (int j = 0; j < 8; ++j) v[r][j] = __builtin_nontemporal_load(xr + 64 * j); }
#pragma unroll
        for (int r = 0; r < 4; ++r) { GAS unsigned long long* o8 = (GAS unsigned long long*)(hb + (size_t)(4 * m4 + r) * DM) + F.lane; float s = 0.f;
#pragma unroll
          for (int j = 0; j < 8; ++j) { const f32x4 w = v[r][j]; s += (w.x * w.x + w.y * w.y) + (w.z * w.z + w.w * w.w); o8[64 * j] = (unsigned long long)pk2rne(w.x, w.y) | ((unsigned long long)pk2rne(w.z, w.w) << 32); }
          s = wave_sum(s); if (F.lane == 0) rsin[4 * m4 + r] = rsqrtf(s * (1.f / DM) + EPS); } } }
}
constexpr int LDS_RSTAB = 131072, LDS_RSVAL = 131072 + 64;
template <class Sched> __device__ __forceinline__ void rsin_table(Frame& F0, const Sched& S, bool from_parts) {
    Frame F = relaunder(F0);
    LAS int* tab = (LAS int*)(F.lds + LDS_RSTAB); LAS float* rs = (LAS float*)(F.lds + LDS_RSVAL);
    if (F.tid < 4) tab[F.tid] = -1;
    __syncthreads();
    int ns = 0; pg8::Unit u;
#pragma unroll 1
    for (int i = 0; S.next(i, u); ++i) {
        bool have = false;
#pragma unroll 1
        for (int k = 0; k < ns; ++k) have = have || (tab[k] == u.pm);
        if (have || ns >= 4) continue;
        const int row = F.tid >> 1, h = F.tid & 1; float v;
        if (from_parts) { const GAS f32x4* pp = (const GAS f32x4*)((const float*)(wsptr() + WS_SSQ) + ((size_t)u.pm * 256 + row) * 32 + 16 * h);
            const f32x4 a = pp[0], b = pp[1], c = pp[2], d = pp[3]; float s = ((a.x + a.y) + (a.z + a.w)) + ((b.x + b.y) + (b.z + b.w)) + (((c.x + c.y) + (c.z + c.w)) + ((d.x + d.y) + (d.z + d.w)));
            s += mk_shfl_xor(s, 1); v = rsqrtf(s * (1.f / DM) + EPS); }
        else v = ((const float*)(wsptr() + WS_RSIN))[u.pm * 256 + row];
        if (h == 0) rs[ns * 256 + row] = v;
        if (F.tid == 0) tab[ns] = u.pm;
        ++ns;
        __syncthreads();
    }
}
__device__ __forceinline__ void kmean_phase(Frame& F0, const Args& AR) {
    Frame F = relaunder(F0);
    const bf16* proj = (const bf16*)(wsptr() + WS_PROJ); float* km = (float*)(wsptr() + WS_KMEAN);
    LAS float* part = (LAS float*)F.lds;
    for (int w = blockIdx.x; w < BATCH * 4 * 16 / 2; w += F.G) {
        const int u = 2 * w + (F.wave >> 2), q = F.wave & 3, b = u >> 6, h = (u >> 4) & 3, blk = u & 15, rg = F.lane >> 4, c = F.lane & 15;
        const bf16* kp = proj + ((size_t)b * SEQ + blk * 256 + q * 64 + rg) * NIN + KB_OFF + h * 128 + 8 * c;
        float s[8] = {0.f, 0.f, 0.f, 0.f, 0.f, 0.f, 0.f, 0.f};
#pragma unroll
        for (int i = 0; i < 16; ++i) { const v4u v = *(const GAS v4u*)(kp + (size_t)(4 * i) * NIN);
            s[0] += __uint_as_float(v.x << 16); s[1] += __uint_as_float(v.x & 0xffff0000u); s[2] += __uint_as_float(v.y << 16); s[3] += __uint_as_float(v.y & 0xffff0000u);
            s[4] += __uint_as_float(v.z << 16); s[5] += __uint_as_float(v.z & 0xffff0000u); s[6] += __uint_as_float(v.w << 16); s[7] += __uint_as_float(v.w & 0xffff0000u); }
#pragma unroll
        for (int j = 0; j < 8; ++j) { s[j] += mk_shfl_xor(s[j], 16); s[j] += mk_shfl_xor(s[j], 32); }
        __syncthreads();
        if (F.lane < 16) {
#pragma unroll
            for (int j = 0; j < 8; ++j) part[F.wave * 128 + 8 * c + j] = s[j]; }
        __syncthreads();
        if (F.tid < 256) { const int uu = F.tid >> 7, d = F.tid & 127; const LAS float* pp = part + uu * 512 + d;
            km[(size_t)(2 * w + uu) * 128 + d] = ((pp[0] + pp[128]) + (pp[256] + pp[384])) * (1.f / 256.f); }
    }
    __syncthreads();
}
struct TokRec { int e0, e1, s0, s1; float w0, w1; int pad0, pad1; };
__device__ __forceinline__ void router_phase(Frame& F0, const Args& AR, int layer) {
    Frame F = relaunder(F0);
    typedef float f32x4r __attribute__((ext_vector_type(4)));
    const bf16* h = (const bf16*)(wsptr() + hb_off(layer));
    const bf16* WRH = (const bf16*)(wsptr() + WS_WR) + (size_t)layer * 48 * DM; const bf16* WRL = WRH + DEPTH * 48 * DM;
    float* rstd_o = (float*)(wsptr() + WS_RSTD); TokRec* rec = (TokRec*)(wsptr() + WS_TOKREC); gu32* cnt = ctlptr() + CW_CNT + layer * 32 * 64;
    int* list = (int*)(wsptr() + WS_LIST);
    constexpr int KC = 512, NCH = DM / KC, WB_BYTES = 96 * KC * 2;
    LAS float* lg = (LAS float*)(F.lds + WB_BYTES) + F.wave * (16 * 49);
    LAS int* lc = (LAS int*)(F.lds + WB_BYTES + 8 * (16 * 49) * 4);
    static_assert(WB_BYTES + 8 * 16 * 49 * 4 + 64 * 4 <= PHASE_LDS, "router LDS");
    const int row = F.lane & 15, kg = F.lane >> 4;
    constexpr int NTASK = M / 128;
    typedef __attribute__((address_space(3))) unsigned las_u32r;
#pragma unroll 1
    for (int tk = (int)blockIdx.x; tk < NTASK; tk += F.G) {
        if (F.tid < 32) lc[F.tid] = 0;
        const bf16* hp = h + (size_t)(128 * tk + 16 * F.wave + row) * DM + 8 * kg;
        f32x4r acc[3]; float ss = 0.f;
#pragma unroll
        for (int t = 0; t < 3; ++t) acc[t] = (f32x4r){0.f, 0.f, 0.f, 0.f};
        v4u hq[2][16];
#pragma unroll
        for (int s = 0; s < 16; ++s) hq[0][s] = *(const GAS v4u*)(hp + 32 * s);
#pragma unroll
        for (int c = 0; c < NCH; ++c) {
            __syncthreads();
#pragma unroll
            for (int q = 0; q < 9; ++q) { const int r72 = q * 8 + F.wave, rc = r72 < NROUTE ? r72 : r72 + (48 - NROUTE), n = rc < 48 ? rc : rc - 48; const bf16* src = (rc < 48 ? WRH : WRL) + (size_t)n * DM + c * KC;
                int ll = F.lane; asm volatile("" : "+v"(ll));
                __builtin_amdgcn_global_load_lds((const unsigned*)((const char*)src + ((ll ^ (n & 15)) << 4)), (las_u32r*)(F.lds + rc * (KC * 2)), 16, 0, 0); }
            asm volatile("s_waitcnt vmcnt(0)" ::: "memory");
            __syncthreads();
            if (c + 1 < NCH) {
#pragma unroll
                for (int s = 0; s < 16; ++s) hq[(c + 1) & 1][s] = *(const GAS v4u*)(hp + (c + 1) * KC + 32 * s); }
#pragma unroll
            for (int s = 0; s < 16; ++s) { const v4u q = hq[c & 1][s];
                const float a0 = __uint_as_float(q.x << 16), a1 = __uint_as_float(q.x & 0xffff0000u), a2 = __uint_as_float(q.y << 16), a3 = __uint_as_float(q.y & 0xffff0000u);
                const float a4 = __uint_as_float(q.z << 16), a5 = __uint_as_float(q.z & 0xffff0000u), a6 = __uint_as_float(q.w << 16), a7 = __uint_as_float(q.w & 0xffff0000u);
                ss += (a0 * a0 + a1 * a1) + (a2 * a2 + a3 * a3) + (a4 * a4 + a5 * a5) + (a6 * a6 + a7 * a7);
                const bf16x8 Ah = __builtin_bit_cast(bf16x8, q);
                const int piece = ((4 * s + kg) ^ row) << 4;
#pragma unroll
                for (int t = 0; t < 3; ++t) { const bf16x8 Bh = *(const LAS bf16x8*)(F.lds + (16 * t + row) * (KC * 2) + piece), Bl = *(const LAS bf16x8*)(F.lds + (48 + 16 * t + row) * (KC * 2) + piece);
                    acc[t] = __builtin_amdgcn_mfma_f32_16x16x32_bf16(Ah, Bh, acc[t], 0, 0, 0); acc[t] = __builtin_amdgcn_mfma_f32_16x16x32_bf16(Ah, Bl, acc[t], 0, 0, 0); } }
        }
        { float s2 = ss; s2 += mk_shfl_xor(s2, 16); s2 += mk_shfl_xor(s2, 32); if (kg == 0) lg[row * 49 + 48] = s2;
#pragma unroll
            for (int t = 0; t < 3; ++t)
#pragma unroll
                for (int i = 0; i < 4; ++i) lg[(4 * kg + i) * 49 + 16 * t + row] = acc[t][i]; }
        LDS_WAIT(); asm volatile("" ::: "memory");
        int e0 = 0, e1 = 0, sl0 = 0, sl1 = 0; float w0 = 0.f, w1 = 0.f, rs = 0.f;
        if (F.lane < 16) {
            const LAS float* lr = lg + F.lane * 49;
            const float rs_ = rsqrtf(lr[48] * (1.f / DM) + EPS);
            float gl[4];
#pragma unroll
            for (int i = 0; i < 4; ++i) gl[i] = lr[i] * rs_;
            int grp = 0; float gm = gl[0];
#pragma unroll
            for (int i = 1; i < 4; ++i) if (gl[i] > gm) { gm = gl[i]; grp = i; }
            float gs = 0.f;
#pragma unroll
            for (int i = 0; i < 4; ++i) gs += __expf(gl[i] - gm);
            const float gw_ = 1.f / gs;
            float el[8];
#pragma unroll
            for (int i = 0; i < 8; ++i) el[i] = lr[4 + grp * 8 + i] * rs_;
            int i1 = 0; float t1 = el[0];
#pragma unroll
            for (int i = 1; i < 8; ++i) if (el[i] > t1) { t1 = el[i]; i1 = i; }
            int i2 = -1; float t2 = -INFINITY;
#pragma unroll
            for (int i = 0; i < 8; ++i) if (i != i1 && el[i] > t2) { t2 = el[i]; i2 = i; }
            const float ex = __expf(t2 - t1), w0_ = gw_ / (1.f + ex), w1_ = gw_ * ex / (1.f + ex);
            e0 = grp * 8 + i1; e1 = grp * 8 + i2; w0 = w0_; w1 = w1_; rs = rs_;
            sl0 = __hip_atomic_fetch_add(lc + e0, 1, __ATOMIC_RELAXED, __HIP_MEMORY_SCOPE_WORKGROUP); sl1 = __hip_atomic_fetch_add(lc + e1, 1, __ATOMIC_RELAXED, __HIP_MEMORY_SCOPE_WORKGROUP);
        }
        LDS_WAIT(); asm volatile("" ::: "memory");
        __syncthreads();
        if (F.tid < 32) { const int c = lc[F.tid]; lc[32 + F.tid] = c > 0 ? (int)__hip_atomic_fetch_add(cnt + F.tid * 64, (unsigned)c, RLX_AGENT) : 0; }
        __syncthreads();
        if (F.lane < 16) { const int rowg = 128 * tk + 16 * F.wave + F.lane; const int s0 = lc[32 + e0] + sl0, s1 = lc[32 + e1] + sl1;
            TokRec t; t.e0 = e0; t.e1 = e1; t.s0 = s0; t.s1 = s1; t.w0 = w0; t.w1 = w1; t.pad0 = 0; t.pad1 = 0; rec[rowg] = t; rstd_o[rowg] = rs;
            list[e0 * 32768 + s0] = rowg; list[e1 * 32768 + s1] = rowg; float* srs = (float*)(wsptr() + WS_SRS); srs[e0 * 32768 + s0] = rs; srs[e1 * 32768 + s1] = rs; }
        __syncthreads();
    }
}
constexpr int PL_UNITS = (M / 256) * (DM / 256), PL_R = 5;
__device__ __forceinline__ int build_tiles(Frame& F0, int layer) {
    Frame F = relaunder(F0);
    gu32* cnt = ctlptr() + CW_CNT + layer * 32 * 64; LAS int* offs = (LAS int*)(F.lds + LDS_OFFS); LAS unsigned char* te = F.lds + LDS_TILE_E;
    __syncthreads();
    if (F.tid < NEXP) offs[40 + F.tid] = (int)__hip_atomic_load(cnt + F.tid * 64, RLX_AGENT);
    __syncthreads();
    if (F.tid == 0) { int acc = 0;
#pragma unroll 1
        for (int e = 0; e < NEXP; ++e) { const int c = offs[40 + e]; offs[e] = acc * 256; const int nt = (c + 255) >> 8; for (int t = 0; t < nt && acc + t < RPAD / 256; ++t) te[acc + t] = (unsigned char)e; acc += nt; }
        offs[32] = acc < RPAD / 256 ? acc : RPAD / 256;
        const int nTl = offs[32], per = F.G >> 3, x = (int)blockIdx.x & 7, s = (int)blockIdx.x >> 3; int gmax = 0;
#pragma unroll 1
        for (int xx = 0; xx < 8; ++xx) { int n = 0;
#pragma unroll 1
            for (int k = 0; k < 4; ++k) { const int e = xx + 8 * k; const int t0 = offs[e] >> 8, t1 = (e == 31) ? nTl : (offs[e + 1] >> 8); n += (t1 > t0 ? t1 - t0 : 0) * 4; }
            offs[72 + xx] = n; const int gh = (n + per - 1) / per; gmax = gh > gmax ? gh : gmax; }
        int Dtot = 0, Dbefore = 0, dme = 0, dpre = 0;
#pragma unroll 1
        for (int xx = 0; xx < 8; ++xx) { const int n = offs[72 + xx], gh = (n + per - 1) / per, r = n > 0 ? n - (gh - 1) * per : per; const int D = per * (gmax - gh) + (per - r);
            if (xx < x) Dbefore += D; Dtot += D;
            if (xx == x) { dme = (gmax - gh) + (s >= r ? 1 : 0); dpre = s * (gmax - gh) + (s > r ? s - r : 0); } }
        int base = (PL_UNITS - PL_R * Dtot + F.G - 1) / F.G; base = base > 0 ? base : 0;
        int start = PL_R * (Dbefore + dpre) + (x * per + s) * base, count = PL_R * dme + base;
        if ((F.G & 7) || per == 0) { start = (int)blockIdx.x * ((PL_UNITS + F.G - 1) / F.G); count = (PL_UNITS + F.G - 1) / F.G; }
        if (start > PL_UNITS) start = PL_UNITS; if (start + count > PL_UNITS) count = PL_UNITS - start;
        offs[33] = start; offs[34] = count; }
    __syncthreads();
    return offs[32];
}
struct ListOrder {
    static constexpr bool B_NT = false;
    int start, count;
    __device__ __forceinline__ bool next(int i, pg8::Unit& u) const { if (i >= count) return false; const int L = start + i; u.pm = L >> 3; u.pn = L & 7; return true; }
    __device__ __forceinline__ void a_ready(const pg8::Unit&) const {}
    __device__ __forceinline__ void done(const pg8::Unit&) const {}
};
__device__ __forceinline__ void combine_phase(Frame& F0, const Args& AR, int layer) {
#if MK_PER_PHASE
    (void)build_tiles(F0, layer);
#endif
    Frame F = relaunder(F0);
    const LAS int* offs = (const LAS int*)(F.lds + LDS_OFFS);
    bf16* hb = (bf16*)(wsptr() + hb_off(layer)); const TokRec* rec = (const TokRec*)(wsptr() + WS_TOKREC);
    const bf16* y = (const bf16*)(wsptr() + WS_Y); float* rsple = (float*)(wsptr() + WS_RSPLE);
    TokRec tn[2];
    if (F.gw < M / 2) {
#pragma unroll
        for (int r = 0; r < 2; ++r) tn[r] = rec[F.gw + r * (M / 2)]; }
    for (int m2 = F.gw; m2 < M / 2; m2 += F.NGW) {
        TokRec t[2]; int p0[2], p1[2];
#pragma unroll
        for (int r = 0; r < 2; ++r) t[r] = tn[r];
        if (m2 + F.NGW < M / 2) {
#pragma unroll
            for (int r = 0; r < 2; ++r) tn[r] = rec[m2 + F.NGW + r * (M / 2)]; }
#pragma unroll
        for (int r = 0; r < 2; ++r) { p0[r] = offs[t[r].e0] + t[r].s0; p1[r] = offs[t[r].e1] + t[r].s1; }
        v4u hq[2][4], ya[2][4], yb[2][4];
#pragma unroll
        for (int r = 0; r < 2; ++r) { const GAS v4u* xr = (const GAS v4u*)(hb + (size_t)(m2 + r * (M / 2)) * DM) + F.lane;
            const GAS v4u* y0 = (const GAS v4u*)(y + (size_t)p0[r] * DM) + F.lane; const GAS v4u* y1 = (const GAS v4u*)(y + (size_t)p1[r] * DM) + F.lane;
#pragma unroll
            for (int j = 0; j < 4; ++j) { hq[r][j] = xr[64 * j]; ya[r][j] = __builtin_nontemporal_load(y0 + 64 * j); yb[r][j] = __builtin_nontemporal_load(y1 + 64 * j); } }
#pragma unroll
        for (int r = 0; r < 2; ++r) { const int m = m2 + r * (M / 2); GAS v4u* xw = (GAS v4u*)(hb + (size_t)m * DM) + F.lane; float s = 0.f; const float w0 = t[r].w0, w1 = t[r].w1;
#pragma unroll
            for (int j = 0; j < 4; ++j) { const v4u q = hq[r][j], a = ya[r][j], b = yb[r][j]; v4u o;
#define CMB(QW, AW, BW, OW) do { const float lo_ = __uint_as_float((QW) << 16) + w0 * __uint_as_float((AW) << 16) + w1 * __uint_as_float((BW) << 16), hi_ = __uint_as_float((QW) & 0xffff0000u) + w0 * __uint_as_float((AW) & 0xffff0000u) + w1 * __uint_as_float((BW) & 0xffff0000u); \
                    OW = pk2rne(lo_, hi_); s += lo_ * lo_ + hi_ * hi_; } while (0)
                CMB(q.x, a.x, b.x, o.x); CMB(q.y, a.y, b.y, o.y); CMB(q.z, a.z, b.z, o.z); CMB(q.w, a.w, b.w, o.w);
#undef CMB
                xw[64 * j] = o; }
            s = wave_sum(s); if (F.lane == 0) rsple[m] = rsqrtf(s * (1.f / DM) + EPS); }
    }
}
__device__ __forceinline__ void endnorm_phase(Frame& F0, const Args& AR, int layer) {
    Frame F = relaunder(F0);
    const bf16* hb = (const bf16*)(wsptr() + hb_off(layer + 1));
    const bool last = layer + 1 >= DEPTH;
    float* rsin = (float*)(wsptr() + WS_RSIN);
    f32x4 g8[8];
#pragma unroll
    for (int j = 0; j < 8; ++j) g8[j] = last ? ((const GAS f32x4*)inptr(3) + F.lane)[64 * j] : (f32x4){0.f, 0.f, 0.f, 0.f};
    for (int m4 = F.gw; m4 < M / 4; m4 += F.NGW) {
        u32x2g q[4][8];
#pragma unroll
        for (int r = 0; r < 4; ++r) { const GAS u32x2g* xr = (const GAS u32x2g*)(hb + (size_t)(4 * m4 + r) * DM) + F.lane;
#pragma unroll
            for (int j = 0; j < 8; ++j) q[r][j] = last ? __builtin_nontemporal_load(xr + 64 * j) : xr[64 * j]; }
#pragma unroll
        for (int r = 0; r < 4; ++r) { const int m = 4 * m4 + r; float s = 0.f;
#pragma unroll
            for (int j = 0; j < 8; ++j) { const float a = __uint_as_float(q[r][j].x << 16), b = __uint_as_float(q[r][j].x & 0xffff0000u), c = __uint_as_float(q[r][j].y << 16), d = __uint_as_float(q[r][j].y & 0xffff0000u); s += (a * a + b * b) + (c * c + d * d); }
            const float rstd = rsqrtf(wave_sum(s) * (1.f / DM) + EPS);
            if (last) { GAS f32x4* o = (GAS f32x4*)(outptr() + (size_t)m * DM) + F.lane;
#pragma unroll
                for (int j = 0; j < 8; ++j) { const f32x4 v = (f32x4){__uint_as_float(q[r][j].x << 16), __uint_as_float(q[r][j].x & 0xffff0000u), __uint_as_float(q[r][j].y << 16), __uint_as_float(q[r][j].y & 0xffff0000u)}; __builtin_nontemporal_store(v * rstd * g8[j], o + 64 * j); } }
            else if (F.lane == 0) rsin[m] = rstd; }
    }
}
template <int MODE> __device__ __forceinline__ void attn_queue(Frame& F0, const att::AttnArgs& A, gu32* qbase, int& cc) {
    Frame F = relaunder(F0);
    volatile LAS int* mb = (volatile LAS int*)(F.lds + att::OFF_MISC);
    constexpr int NPER = (MODE == 2) ? 96 : (MODE == 1) ? 64 : 96;
    const int myx = (int)(xb_xcc_id() & 7u);
    const float lam = att::attn_mode_setup<MODE>(A, (char*)F.lds, F.wave);
#pragma unroll 1
    for (int xs = 0; xs < 8; ++xs) {
        const int x = (myx + xs) & 7;
        if (xs == 1) {
            __syncthreads();
            { const int t8 = mk_lane(); if (F.wave == 0 && t8 < 8) mb[32 + t8] = (int)__hip_atomic_load(qbase + t8 * 64, RLX_AGENT); }
            __syncthreads(); }
        if (xs >= 1 && mb[32 + x] >= NPER) continue;
        bool have = false;
        for (;;) {
            if (!have) { __syncthreads();
                if (F.tid == 0) mb[0] = (int)__hip_atomic_fetch_add(qbase + x * 64, 1u, RLX_AGENT);
                __syncthreads(); }
            have = false;
            const int idx = __builtin_amdgcn_readfirstlane(mb[0]);
            if (idx >= NPER) break;
            int b, hh, qb;
            if (MODE == 2) { const int p = (idx % 6) * 8 + x; b = p / 6; hh = p % 6; qb = 15 - idx / 6; }
            else if (MODE == 1) { const int p = (idx & 3) * 8 + x; b = p >> 2; hh = p & 3; qb = 15 - (idx >> 2); }
            else { const int kvp = (idx / 48) * 8 + x, r = idx % 48; b = kvp >> 1; hh = (kvp & 1) * 3 + r % 3; qb = r / 3; }
            att::attn_unit<MODE>(A, b, hh, qb, (char*)F.lds, F.wave, lam);
            if (cc < CONV_NCH) { conv_chunk(F0, A.layer, cc, qbase + x * 64); ++cc; have = true; }
        }
    }
}
__device__ __forceinline__ att::AttnArgs make_attn_args(int layer) { att::AttnArgs A{}; A.layer = layer; A.lambda_init = 0.8f - 0.6f * __expf(-0.3f * (float)layer); return A; }
static_assert(NROUTE == 36 && 2 * NROUTE == 72, "router staging: 72 row chunks over 8 waves");
static_assert(att::ATT_WS_KP == WS_PL && KB_OFF % 256 == 0 && SEQ % 256 == 0 && SEQ / 256 == 16, "block means from the projection epilogue");
static_assert(att::ATT_WS_PROJ == WS_PROJ && att::ATT_WS_YCAT == WS_YCAT && att::ATT_WS_KMEAN == WS_KMEAN, "attention body's workspace offsets");

#ifndef MK_PH_MASK
#define MK_PH_MASK 0xFFFFFFFFu
#endif
#ifndef MK_ATT_MASK
#define MK_ATT_MASK 7
#endif
#define ATM(k) ((MK_ATT_MASK >> (k)) & 1)
#define PHM(k) ((MK_PH_MASK >> (k)) & 1u)
constexpr int NPH_LAYER = 11, NPHASES = 1 + DEPTH * NPH_LAYER;
__global__ void __launch_bounds__(NWAVES * 64, 2) mk_fwd(Args args) {
    extern __shared__ __attribute__((aligned(16))) unsigned char lds[];
    Frame F;
    F.lds = (LAS unsigned char*)lds; F.MISC = (volatile LAS unsigned*)(F.lds + LDS_MISC);
    F.wave = __builtin_amdgcn_readfirstlane((int)threadIdx.x >> 6); F.lane = mk_lane(); F.tid = F.wave * 64 + F.lane; F.G = gridDim.x;
    F.gw = blockIdx.x * NWAVES + F.wave; F.NGW = F.G * NWAVES;
    for (int u = F.tid; u < (LDS_BYTES - LDSCTL_OFF) / 4; u += NWAVES * 64) ((LAS unsigned*)(F.lds + LDSCTL_OFF))[u] = 0u;
    __syncthreads();
    XcdBarrier bar; bar.bar = (unsigned*)(ctlptr() + CW_BAR); bar.x = 0; bar.st = nullptr;
    if (args.use_bar) bar = xcd_barrier_post((unsigned*)(ctlptr() + CW_BAR), F.MISC + 8);
    const int lo = args.ph_lo, hi = args.ph_hi;
#define IN(k) (lo <= (k) && (k) < hi)
#define SEAM(k) do { if (IN(k) && IN((k) + 1)) xcd_barrier(bar); } while (0)
    if (PHM(0) && IN(0)) { p0_prologue(F, args); } SEAM(0);
#pragma unroll 1
    for (int layer = 0; layer < DEPTH; ++layer) {
        const int pb = 1 + layer * NPH_LAYER;
        const bool fuse_norm = (F.G == 256);
        if (PHM(1) && IN(pb + 0)) { pg8::Gemm g{(const bf16*)(wsptr() + hb_off(layer)), (const bf16*)(wsptr() + WS_WIN) + (size_t)layer * NIN * DM, M, NIN, DM}; pg8::StaticOrder S; S.init(M, NIN, F.G, (int)blockIdx.x);
            rsin_table(F, S, fuse_norm && layer > 0);
            pg8::EpiProj E{(bf16*)(wsptr() + WS_PROJ), NIN, (const LAS int*)(F.lds + LDS_RSTAB), (const LAS float*)(F.lds + LDS_RSVAL), (float*)(wsptr() + WS_PL), KB_OFF / 256, att::ATT_KP_N, (const float*)(wsptr() + WS_RSIN)};
            pg8::gemm_phase<pg8::EpiProj, pg8::StaticOrder, true, true>(F.lds, g, S, E, F.wave);
            }
        SEAM(pb + 0);
        if (PHM(3) && IN(pb + 2)) { const att::AttnArgs A = make_attn_args(layer);
            int cc = 0;
            if (ATM(2)) attn_queue<2>(F, A, ctlptr() + CW_Q + ((layer * 3 + 0) * 8) * 64, cc);
            if (ATM(1)) attn_queue<1>(F, A, ctlptr() + CW_Q + ((layer * 3 + 1) * 8) * 64, cc);
            if (ATM(0)) attn_queue<0>(F, A, ctlptr() + CW_Q + ((layer * 3 + 2) * 8) * 64, cc);
#pragma unroll 1
            for (; cc < CONV_NCH; ++cc) conv_chunk(F, layer, cc);
            }
        SEAM(pb + 2);
        if (PHM(4) && IN(pb + 3)) { pg8::Gemm g{(const bf16*)(wsptr() + WS_YCAT), (const bf16*)(wsptr() + WS_WOUT) + (size_t)layer * DM * DM, M, DM, DM}; pg8::StaticOrder S; S.init(M, DM, F.G, (int)blockIdx.x);
            pg8::EpiRes E{(bf16*)(wsptr() + hb_off(layer)), DM};
            pg8::gemm_phase<pg8::EpiRes, pg8::StaticOrder, true, true>(F.lds, g, S, E, F.wave); }
        SEAM(pb + 3);
        if (PHM(5) && IN(pb + 4)) router_phase(F, args, layer);
        SEAM(pb + 4);
        if (PHM(7) && IN(pb + 6)) { const int nT = build_tiles(F, layer);
            pg8::Gemm g{(const bf16*)(wsptr() + hb_off(layer)), (const bf16*)(wsptr() + WS_W13), M, NEXP * 1024, DM};
            pg8::GroupedOrder S{(const LAS unsigned char*)(F.lds + LDS_TILE_E), nT, 4, F.G, (int)blockIdx.x, (const int*)(wsptr() + WS_LIST), (const LAS int*)(F.lds + LDS_OFFS), (const LAS int*)(F.lds + 131072)};
            { LAS int* lt = (LAS int*)(F.lds + 131072); pg8::Unit u;
              const int t_ = F.wave * 64 + mk_lane();
#pragma unroll 1
              for (int i = 0; i < pg8::GroupedOrder::LTAB_UNITS && S.next(i, u); ++i) if (t_ < 256) { const int e = u.pn / 4; lt[i * 256 + t_] = ((const int*)(wsptr() + WS_LIST))[e * 32768 + (u.pm * 256 - ((const LAS int*)(F.lds + LDS_OFFS))[e]) + t_]; }
              __syncthreads(); }
            pg8::EpiSiluMul E{(bf16*)(wsptr() + WS_HID), DEXP, (const int*)(wsptr() + WS_LIST), (const LAS int*)(F.lds + LDS_OFFS), (const float*)(wsptr() + WS_SRS)};
            pg8::gemm_phase<pg8::EpiSiluMul, pg8::GroupedOrder, true, true, true>(F.lds, g, S, E, F.wave);
            { const LAS int* offs = (const LAS int*)(F.lds + LDS_OFFS); ListOrder S2{offs[33], offs[34]};
              pg8::Gemm g2{(const bf16*)(wsptr() + WS_PB) + (size_t)layer * M * PLE, (const bf16*)(wsptr() + WS_WP) + (size_t)layer * DM * PLE, M, DM, opaque_i(PLE)};
              pg8::EpiBf16<0> E2{(bf16*)(wsptr() + WS_PL), DM, nullptr, 0, 0, 1.f, nullptr, 1};
              pg8::gemm_phase<pg8::EpiBf16<0>, ListOrder, true, true>(F.lds, g2, S2, E2, F.wave); }
            }
        SEAM(pb + 6);
        if (PHM(8) && IN(pb + 7)) {
#if MK_PER_PHASE
            (void)build_tiles(F, layer);
#endif
            const int nT = ((const LAS int*)(F.lds + LDS_OFFS))[32];
            pg8::Gemm g{(const bf16*)(wsptr() + WS_HID), (const bf16*)(wsptr() + WS_W2), RPAD, NEXP * DM, DEXP};
            pg8::GroupedOrder S{(const LAS unsigned char*)(F.lds + LDS_TILE_E), nT, 8, F.G, (int)blockIdx.x, nullptr, (const LAS int*)(F.lds + LDS_OFFS), nullptr};
            pg8::EpiBf16<0> E{(bf16*)(wsptr() + WS_Y), DM, nullptr, DM, 0, 1.f, nullptr, 1};
            pg8::gemm_phase<pg8::EpiBf16<0>, pg8::GroupedOrder, true, true>(F.lds, g, S, E, F.wave);
            }
        SEAM(pb + 7);
        if (PHM(9) && IN(pb + 8)) combine_phase(F, args, layer);
        SEAM(pb + 8);
        if (PHM(10) && IN(pb + 9)) { pg8::Gemm g{(const bf16*)(wsptr() + hb_off(layer)), (const bf16*)(wsptr() + WS_WG) + (size_t)layer * DM * DM, M, DM, DM}; pg8::StaticOrder S; S.init(M, DM, F.G, (int)blockIdx.x);
            pg8::EpiGate E{(const bf16*)(wsptr() + hb_off(layer)), (bf16*)(wsptr() + hb_off(layer + 1)), (const bf16*)(wsptr() + WS_PL), (const float*)(wsptr() + WS_RSPLE), DM, (fuse_norm && layer + 1 < DEPTH) ? (float*)(wsptr() + WS_SSQ) : nullptr};
            pg8::gemm_phase<pg8::EpiGate, pg8::StaticOrder, true, true>(F.lds, g, S, E, F.wave); }
        SEAM(pb + 9);
        if (!(fuse_norm && layer + 1 < DEPTH)) { if (PHM(11) && IN(pb + 10)) endnorm_phase(F, args, layer);
        SEAM(pb + 10); }
    }
#undef IN
#undef SEAM
}

extern "C" void kernel_launch(void* const* d_in, const int* in_sizes, int n_in, void* d_out, int out_size, void* d_ws, size_t ws_size, hipStream_t stream) {
    static int grid = 0;
    if (grid == 0) {
        if (n_in != 22 || in_sizes[0] != M * DM || out_size != M * DM || ws_size < WS_END) { fprintf(stderr, "kernel_launch: shape mismatch (n_in %d, in0 %d, out %d, ws %zu < %zu); nothing launched\n", n_in, n_in > 0 ? in_sizes[0] : -1, out_size, ws_size, (size_t)WS_END); grid = -1; return; }
        int dev = 0, cus = 0, per_cu = 0;
        if (hipGetDevice(&dev) != hipSuccess || hipDeviceGetAttribute(&cus, hipDeviceAttributeMultiprocessorCount, dev) != hipSuccess) { grid = -1; return; }
        if (hipFuncSetAttribute((const void*)mk_fwd, hipFuncAttributeMaxDynamicSharedMemorySize, LDS_BYTES) != hipSuccess) { fprintf(stderr, "kernel_launch: hipFuncSetAttribute failed\n"); grid = -1; return; }
        if (hipOccupancyMaxActiveBlocksPerMultiprocessor(&per_cu, (const void*)mk_fwd, NWAVES * 64, LDS_BYTES) != hipSuccess || per_cu < 1) { fprintf(stderr, "kernel_launch: occupancy query says %d blocks per CU\n", per_cu); }
        (void)hipGetLastError();
        grid = cus;
    }
    if (grid < 0) return;
    if (hipMemsetAsync((char*)d_ws + WS_CTL, 0, CTL_ZERO_BYTES, stream) != hipSuccess) return;
    Args a{};
    for (int i = 0; i < 22; ++i) a.in[i] = (const float*)d_in[i];
    a.out = (float*)d_out; a.ws = (unsigned char*)d_ws;
#if MK_PER_PHASE
    a.use_bar = 0;
    for (int ph = 0; ph < NPHASES; ++ph) {
        const int layer = ph > 0 ? (ph - 1) / NPH_LAYER : -1, k = ph > 0 ? (ph - 1) % NPH_LAYER : -1;
        a.ph_lo = ph; a.ph_hi = ph + 1;
        hipLaunchKernelGGL(mk_fwd, dim3(grid), dim3(NWAVES * 64), LDS_BYTES, stream, a);
    }
#else
    a.use_bar = 1; a.ph_lo = 0; a.ph_hi = NPHASES;
    hipLaunchKernelGGL(mk_fwd, dim3(grid), dim3(NWAVES * 64), LDS_BYTES, stream, a);
#endif
    const hipError_t le = hipPeekAtLastError();
    if (le != hipSuccess) fprintf(stderr, "kernel_launch: launch failed: %s\n", hipGetErrorName(le));
}
```
